# Optimizing an MI355X kernel written in HIP

```python
import math
import jax, jax.numpy as jnp
from jax import lax
import numpy as np

D_MODEL = 1024
BATCH = 16
SEQ = 256
DEPTH = 2
DEC_BATCH = 4
DEC_SEQ = 4096
PAST_LEN = 256

GRID_W = 64
N_MIXERS = 2
N_CONV_LAYERS = (DEPTH + 1) // 2
N_SSD_LAYERS = DEPTH // 2
CONV_W = 3
SSD_EXPAND = 2
D_INNER = SSD_EXPAND * D_MODEL
SSD_HEAD_DIM = 64
SSD_HEADS = D_INNER // SSD_HEAD_DIM
SSD_STATE = 128
SSD_GROUPS = 8
SSD_CHUNK = 128
SSD_CONV_DIM = D_INNER + 2 * SSD_GROUPS * SSD_STATE
SSD_IN_DIM = D_INNER + SSD_CONV_DIM + 2 * SSD_HEADS
N_KEYS = 128
N_EXPERTS = N_KEYS * N_KEYS
PEER_HEADS = 8
PEER_TOPK = 16
PEER_KEY_DIM = 256
PEER_GROUP = 128
EPS = 1e-6

kernel_name = "hybrid_conv_ssd_peer_diffusion_step"


def rmsnorm(x, g):
    xf = x.astype(jnp.float32)
    y = xf * lax.rsqrt(jnp.mean(xf * xf, axis=-1, keepdims=True) + EPS)
    return (y * g.astype(jnp.float32)).astype(x.dtype)


def dwconv3(x, w, grid):
    b, L, C = x.shape
    rows, cols = grid
    xp = jnp.pad(x.reshape(b, rows, cols, C), ((0, 0), (0, 0), (1, 1), (0, 0)))
    y = xp[:, :, :-2] * w[0] + xp[:, :, 1:-1] * w[1] + xp[:, :, 2:] * w[2]
    return y.reshape(b, L, C)


def short_conv_mixer(h, w_in, conv_w, w_out, grid):
    bg, cg, xv = jnp.split(h @ w_in, 3, axis=-1)
    return (bg * dwconv3(cg * xv, conv_w, grid)) @ w_out


def ssd_scan(x, dt, a, bm, cm, h0):
    b, L, H, P = x.shape
    G, N = bm.shape[-2:]
    R = H // G
    Q = SSD_CHUNK
    nc = L // Q
    f32 = jnp.float32
    x = x.astype(f32).reshape(b, nc, Q, G, R, P)
    dt = dt.astype(f32).reshape(b, nc, Q, G, R)
    bm = bm.astype(f32).reshape(b, nc, Q, G, N)
    cm = cm.astype(f32).reshape(b, nc, Q, G, N)
    cum = jnp.cumsum(dt * a.astype(f32).reshape(G, R), axis=2)
    xdt = x * dt[..., None]
    mask = jnp.tril(jnp.ones((Q, Q), dtype=bool))[None, None, :, :, None, None]
    seg = cum[:, :, :, None] - cum[:, :, None, :]
    decay = jnp.exp(jnp.where(mask, seg, -jnp.inf))
    cb = jnp.einsum('bcign,bcjgn->bcijg', cm, bm)
    y_diag = jnp.einsum('bcijgr,bcjgrp->bcigrp', decay * cb[..., None], xdt)
    end_decay = jnp.exp(cum[:, :, -1:] - cum)
    states = jnp.einsum('bcjgn,bcjgrp->bcgrpn', bm, xdt * end_decay[..., None])
    chunk_decay = jnp.exp(cum[:, :, -1])

    def step(h, inp):
        s, d = inp
        return d[..., None, None] * h + s, h

    h_last, h_prev = lax.scan(step, h0.astype(f32).reshape(b, G, R, P, N),
                              (jnp.moveaxis(states, 1, 0), jnp.moveaxis(chunk_decay, 1, 0)))
    h_prev = jnp.moveaxis(h_prev, 0, 1)
    y_off = jnp.einsum('bcign,bcgrpn->bcigrp', cm, h_prev) * jnp.exp(cum)[..., None]
    return (y_diag + y_off).reshape(b, L, H, P), h_last.reshape(b, H, P, N)


def ssd_mixer(h, w_in, conv_w, conv_b, dt_bias, a_log, d_skip, norm_g, w_out, grid, h0):
    b, L, _ = h.shape
    proj = h @ w_in
    z = proj[..., :D_INNER]
    xbc = proj[..., D_INNER:D_INNER + SSD_CONV_DIM]
    dt_raw = proj[..., D_INNER + SSD_CONV_DIM:]
    xbc = jax.nn.silu(dwconv3(xbc, conv_w, grid) + conv_b)
    gn = SSD_GROUPS * SSD_STATE
    xs = xbc[..., :D_INNER].reshape(b, L, SSD_HEADS, SSD_HEAD_DIM)
    bm = xbc[..., D_INNER:D_INNER + gn].reshape(b, L, SSD_GROUPS, SSD_STATE)
    cm = xbc[..., D_INNER + gn:].reshape(b, L, SSD_GROUPS, SSD_STATE)
    dt = jax.nn.softplus(dt_raw.astype(jnp.float32).reshape(b, L, 2, SSD_HEADS)
                         + dt_bias.astype(jnp.float32))
    a = -jnp.exp(a_log.astype(jnp.float32))
    y_f, h_f = ssd_scan(xs, dt[:, :, 0], a[0], bm, cm, h0[:, 0])
    flip = lambda t: jnp.flip(t, axis=1)
    y_b, h_b = ssd_scan(flip(xs), flip(dt[:, :, 1]), a[1], flip(bm), flip(cm), h0[:, 1])
    d_tot = (d_skip[0] + d_skip[1]).astype(jnp.float32)[:, None]
    y = y_f + flip(y_b) + d_tot * xs.astype(jnp.float32)
    y = y.reshape(b, L, D_INNER).astype(h.dtype)
    y = rmsnorm(y * jax.nn.silu(z), norm_g)
    return y @ w_out, jnp.stack([h_f, h_b], axis=1).astype(h.dtype)


def peer(h, wq, keys, u, v):
    b, L, D = h.shape
    T = b * L
    t = h.reshape(T, D)
    q = (t @ wq).reshape(T, PEER_HEADS, 2, PEER_KEY_DIM // 2)
    s = jnp.einsum('thpe,hpne->thpn', q, keys).astype(jnp.float32)
    s1, i1 = lax.top_k(s[:, :, 0], PEER_TOPK)
    s2, i2 = lax.top_k(s[:, :, 1], PEER_TOPK)
    cand = (s1[..., :, None] + s2[..., None, :]).reshape(T, PEER_HEADS, PEER_TOPK * PEER_TOPK)
    cidx = (i1[..., :, None] * N_KEYS + i2[..., None, :]).reshape(T, PEER_HEADS, PEER_TOPK * PEER_TOPK)
    sc, pos = lax.top_k(cand, PEER_TOPK)
    idx = jnp.take_along_axis(cidx, pos, axis=-1)
    g = jax.nn.softmax(sc, axis=-1).astype(h.dtype)
    ng = T // PEER_GROUP

    def group(args):
        tb, ib, gb = args
        act = jnp.einsum('td,thkd->thk', tb, u[ib])
        return jnp.einsum('thk,thkd->td', jax.nn.gelu(act, approximate=False) * gb, v[ib])

    out = lax.map(group, (t.reshape(ng, PEER_GROUP, D),
                          idx.reshape(ng, PEER_GROUP, PEER_HEADS, PEER_TOPK),
                          g.reshape(ng, PEER_GROUP, PEER_HEADS, PEER_TOPK)))
    return out.reshape(b, L, D)


def run_trunk(x, cond, grid, ssm_init, norm_mix_g, norm_ffn_g, norm_f_g, ada_w, ada_b,
              sc_w_in, sc_conv_w, sc_w_out, ssd_w_in, ssd_conv_w, ssd_conv_b, ssd_dt_bias,
              ssd_a_log, ssd_d, ssd_norm_g, ssd_w_out, peer_wq, peer_keys, peer_u, peer_v):
    b = x.shape[0]
    states = []
    for i in range(DEPTH):
        mod = (jax.nn.silu(cond) @ ada_w[i] + ada_b[i])[:, None, :]
        sh_a, scl_a, gt_a, sh_f, scl_f, gt_f = jnp.split(mod, 6, axis=-1)
        hn = rmsnorm(x, norm_mix_g[i]) * (1 + scl_a) + sh_a
        j = i // N_MIXERS
        if i % N_MIXERS == 0:
            mix = short_conv_mixer(hn, sc_w_in[j], sc_conv_w[j], sc_w_out[j], grid)
        else:
            if ssm_init is None:
                h0 = jnp.zeros((b, 2, SSD_HEADS, SSD_HEAD_DIM, SSD_STATE), x.dtype)
            else:
                h0 = ssm_init[:, j]
            mix, st = ssd_mixer(hn, ssd_w_in[j], ssd_conv_w[j], ssd_conv_b[j], ssd_dt_bias[j],
                                ssd_a_log[j], ssd_d[j], ssd_norm_g[j], ssd_w_out[j], grid, h0)
            states.append(st)
        x = x + gt_a * mix
        hn = rmsnorm(x, norm_ffn_g[i]) * (1 + scl_f) + sh_f
        x = x + gt_f * peer(hn, peer_wq[i], peer_keys[i], peer_u[i], peer_v[i])
    return rmsnorm(x, norm_f_g), jnp.stack(states, axis=1)


def setup_inputs(seed: int = 0) -> dict:
    key = jax.random.key(seed)
    ks = iter(jax.random.split(key, 32))
    nrm = lambda shape, scale: jax.random.normal(next(ks), shape, jnp.float32) * scale
    D = D_MODEL
    dt0 = jnp.exp(jax.random.uniform(next(ks), (N_SSD_LAYERS, 2, SSD_HEADS))
                  * (math.log(0.1) - math.log(0.001)) + math.log(0.001))
    return {
        "x_prompt": nrm((BATCH, SEQ, D), 1.0),
        "x_sample": nrm((DEC_BATCH, DEC_SEQ, D), 1.0),
        "state_ssm": nrm((DEC_BATCH, N_SSD_LAYERS, 2, SSD_HEADS, SSD_HEAD_DIM, SSD_STATE), 0.5),
        "c": nrm((DEC_BATCH, D), 1.0),
        "c_ctx": nrm((D,), 1.0),
        "norm_mix_g": 1.0 + nrm((DEPTH, D), 0.02),
        "norm_ffn_g": 1.0 + nrm((DEPTH, D), 0.02),
        "norm_f_g": 1.0 + nrm((D,), 0.02),
        "ada_w": nrm((DEPTH, D, 6 * D), 0.5 * D ** -0.5),
        "ada_b": nrm((DEPTH, 6 * D), 0.02),
        "sc_w_in": nrm((N_CONV_LAYERS, D, 3 * D), D ** -0.5),
        "sc_conv_w": nrm((N_CONV_LAYERS, CONV_W, D), CONV_W ** -0.5),
        "sc_w_out": nrm((N_CONV_LAYERS, D, D), D ** -0.5),
        "ssd_w_in": nrm((N_SSD_LAYERS, D, SSD_IN_DIM), D ** -0.5),
        "ssd_conv_w": nrm((N_SSD_LAYERS, CONV_W, SSD_CONV_DIM), CONV_W ** -0.5),
        "ssd_conv_b": nrm((N_SSD_LAYERS, SSD_CONV_DIM), 0.02),
        "ssd_dt_bias": dt0 + jnp.log(-jnp.expm1(-dt0)),
        "ssd_a_log": jnp.log(jax.random.uniform(next(ks), (N_SSD_LAYERS, 2, SSD_HEADS), jnp.float32, 1.0, 16.0)),
        "ssd_d": 0.5 + nrm((N_SSD_LAYERS, 2, SSD_HEADS), 0.05),
        "ssd_norm_g": 1.0 + nrm((N_SSD_LAYERS, D_INNER), 0.02),
        "ssd_w_out": nrm((N_SSD_LAYERS, D_INNER, D), D_INNER ** -0.5),
        "peer_wq": nrm((DEPTH, D, PEER_HEADS * PEER_KEY_DIM), D ** -0.5),
        "peer_keys": nrm((DEPTH, PEER_HEADS, 2, N_KEYS, PEER_KEY_DIM // 2), (PEER_KEY_DIM // 2) ** -0.5),
        "peer_u": nrm((DEPTH, N_EXPERTS, D), D ** -0.5),
        "peer_v": nrm((DEPTH, N_EXPERTS, D), PEER_HEADS ** -0.5),
    }


def reference(x_prompt, x_sample, state_ssm, c, c_ctx, norm_mix_g, norm_ffn_g, norm_f_g,
              ada_w, ada_b, sc_w_in, sc_conv_w, sc_w_out, ssd_w_in, ssd_conv_w, ssd_conv_b,
              ssd_dt_bias, ssd_a_log, ssd_d, ssd_norm_g, ssd_w_out, peer_wq, peer_keys,
              peer_u, peer_v):
    weights = dict(norm_mix_g=norm_mix_g, norm_ffn_g=norm_ffn_g, norm_f_g=norm_f_g,
                   ada_w=ada_w, ada_b=ada_b, sc_w_in=sc_w_in, sc_conv_w=sc_conv_w,
                   sc_w_out=sc_w_out, ssd_w_in=ssd_w_in, ssd_conv_w=ssd_conv_w,
                   ssd_conv_b=ssd_conv_b, ssd_dt_bias=ssd_dt_bias, ssd_a_log=ssd_a_log,
                   ssd_d=ssd_d, ssd_norm_g=ssd_norm_g, ssd_w_out=ssd_w_out, peer_wq=peer_wq,
                   peer_keys=peer_keys, peer_u=peer_u, peer_v=peer_v)
    ctx_len = x_prompt.shape[1]
    y_prompt, state_ssm_new = run_trunk(x_prompt, c_ctx[None, :], (1, ctx_len), None, **weights)
    rows = x_sample.shape[1] // GRID_W
    y_sample, _ = run_trunk(x_sample, c, (rows, GRID_W), state_ssm, **weights)
    return (y_prompt, y_sample, state_ssm_new)
```

```cpp
#include <hip/hip_runtime.h>
#include <hip/hip_cooperative_groups.h>
#include <cstdio>
namespace cg = cooperative_groups;

#ifndef COOP
#define COOP 0
#endif

typedef unsigned short bf16_t;
typedef __attribute__((ext_vector_type(8))) short bf16x8;
typedef __attribute__((ext_vector_type(16))) float f32x16;

#define NT 20480
#define NCTX 4096
#define DM 1024
#define MIB ((size_t)1 << 20)
#define OFF_BIG   ((size_t)0)
#define OFF_YF    (240 * MIB)
#define OFF_YB    (320 * MIB)
#define OFF_WT    (400 * MIB)
#define OFF_KEYSB (433 * MIB)
#define OFF_DT    (434 * MIB)
#define OFF_MOD   (439 * MIB)
#define OFF_IDX   (440 * MIB)
#define OFF_GATE  (450 * MIB)
#define WT_SCIN   ((size_t)0)
#define WT_SCOUT  (WT_SCIN + (size_t)3072 * 1024)
#define WT_SSDIN  (WT_SCOUT + (size_t)1024 * 1024)
#define WT_SSDOUT (WT_SSDIN + (size_t)6208 * 1024)
#define WT_WQ     (WT_SSDOUT + (size_t)1024 * 2048)

#define SMEM_BYTES 75776

struct Params {
  const float *x_prompt, *x_sample, *state_ssm, *c, *c_ctx, *norm_mix_g, *norm_ffn_g, *norm_f_g, *ada_w, *ada_b;
  const float *sc_w_in, *sc_conv_w, *sc_w_out, *ssd_w_in, *ssd_conv_w, *ssd_conv_b, *ssd_dt_bias, *ssd_a_log, *ssd_d;
  const float *ssd_norm_g, *ssd_w_out, *peer_wq, *peer_keys, *peer_u, *peer_v;
  float* out;
  char* ws;
};

__device__ __forceinline__ float bf2f(bf16_t h) { return __uint_as_float(((unsigned)h) << 16); }
__device__ __forceinline__ bf16_t f2bf(float f) {
  unsigned u = __float_as_uint(f);
  u += 0x7FFFu + ((u >> 16) & 1u);
  return (bf16_t)(u >> 16);
}
__device__ __forceinline__ unsigned pack2(float a, float b) { return (unsigned)f2bf(a) | ((unsigned)f2bf(b) << 16); }
__device__ __forceinline__ float lo2f(unsigned u) { return __uint_as_float(u << 16); }
__device__ __forceinline__ float hi2f(unsigned u) { return __uint_as_float(u & 0xffff0000u); }
__device__ __forceinline__ float siluf(float x) { return x / (1.f + __expf(-x)); }
__device__ __forceinline__ int cidx(int tok) { return tok < NCTX ? 0 : 1 + ((tok - NCTX) >> 12); }

template <int CTRL>
__device__ __forceinline__ unsigned dpp_u(unsigned v) {
  return (unsigned)__builtin_amdgcn_update_dpp(0, (int)v, CTRL, 0xF, 0xF, true);
}
template <int CTRL>
__device__ __forceinline__ float dpp_f(float v) {
  return __int_as_float(__builtin_amdgcn_update_dpp(0, __float_as_int(v), CTRL, 0xF, 0xF, true));
}
__device__ __forceinline__ float row16_sum(float v) {
  v += dpp_f<0xB1>(v);
  v += dpp_f<0x4E>(v);
  v += dpp_f<0x141>(v);
  v += dpp_f<0x140>(v);
  return v;
}
__device__ __forceinline__ unsigned umax_(unsigned a, unsigned b) { return a > b ? a : b; }
__device__ __forceinline__ unsigned wave_max_u32(unsigned v) {
  v = umax_(v, dpp_u<0xB1>(v));
  v = umax_(v, dpp_u<0x4E>(v));
  v = umax_(v, dpp_u<0x141>(v));
  v = umax_(v, dpp_u<0x140>(v));
  unsigned a = (unsigned)__builtin_amdgcn_readlane((int)v, 0);
  unsigned b = (unsigned)__builtin_amdgcn_readlane((int)v, 16);
  unsigned c = (unsigned)__builtin_amdgcn_readlane((int)v, 32);
  unsigned d = (unsigned)__builtin_amdgcn_readlane((int)v, 48);
  return umax_(umax_(a, b), umax_(c, d));
}
__device__ __forceinline__ float wave_sum(float v) {
  v = row16_sum(v);
  float a, b, c, d;
  a = __int_as_float(__builtin_amdgcn_readlane(__float_as_int(v), 0));
  b = __int_as_float(__builtin_amdgcn_readlane(__float_as_int(v), 16));
  c = __int_as_float(__builtin_amdgcn_readlane(__float_as_int(v), 32));
  d = __int_as_float(__builtin_amdgcn_readlane(__float_as_int(v), 48));
  return (a + b) + (c + d);
}
__device__ __forceinline__ unsigned fkey(float f) {
  unsigned u = __float_as_uint(f);
  return (u & 0x80000000u) ? ~u : (u | 0x80000000u);
}
__device__ __forceinline__ float keyf(unsigned k) {
  unsigned u = (k & 0x80000000u) ? (k & 0x7fffffffu) : ~k;
  return __uint_as_float(u);
}

__device__ void transpose_tile(const float* __restrict__ src, int K, int N, bf16_t* __restrict__ dst, int tile, float* tb) {
  const int tid = threadIdx.x;
  const int ntn = N >> 6;
  const int kt = tile / ntn, nt = tile % ntn;
  {
    const int n = tid & 63, kb = tid >> 6;
#pragma unroll
    for (int i = 0; i < 16; ++i) {
      int k = kb + 4 * i;
      tb[k * 65 + n] = src[(size_t)(kt * 64 + k) * N + nt * 64 + n];
    }
  }
  __syncthreads();
  {
    const int k8 = (tid & 7) * 8;
#pragma unroll
    for (int pass = 0; pass < 2; ++pass) {
      int n = (tid >> 3) + 32 * pass;
      uint4 o;
      o.x = pack2(tb[(k8 + 0) * 65 + n], tb[(k8 + 1) * 65 + n]);
      o.y = pack2(tb[(k8 + 2) * 65 + n], tb[(k8 + 3) * 65 + n]);
      o.z = pack2(tb[(k8 + 4) * 65 + n], tb[(k8 + 5) * 65 + n]);
      o.w = pack2(tb[(k8 + 6) * 65 + n], tb[(k8 + 7) * 65 + n]);
      *(uint4*)(dst + (size_t)(nt * 64 + n) * K + kt * 64 + k8) = o;
    }
  }
  __syncthreads();
}

__device__ void prep_phase(const Params& p, char* smem) {
  const int tid = threadIdx.x;
  bf16_t* WT = (bf16_t*)(p.ws + OFF_WT);
  float* MOD = (float*)(p.ws + OFF_MOD);
  bf16_t* KEYSB = (bf16_t*)(p.ws + OFF_KEYSB);
  const int U_MOD = 192, U_T0 = 768, U_T1 = 256, U_T2 = 1552, U_T3 = 512, U_T4 = 1024, U_KEYS = 256;
  const int total = U_MOD + U_T0 + U_T1 + U_T2 + U_T3 + U_T4 + U_KEYS;
  for (int u = blockIdx.x; u < total; u += gridDim.x) {
    int v = u;
    if (v < U_MOD) {
      float* scond = (float*)smem;
      float* red = scond + 5 * 1024;
      for (int i = tid; i < 5 * 1024; i += 256) {
        int r = i >> 10, k = i & 1023;
        float cv = (r == 0) ? p.c_ctx[k] : p.c[(r - 1) * 1024 + k];
        scond[i] = siluf(cv);
      }
      __syncthreads();
      const int l = v / 96, jc = v % 96;
      const int jj = tid & 63, kq = tid >> 6;
      const int j = jc * 64 + jj;
      float acc[5] = {0.f, 0.f, 0.f, 0.f, 0.f};
      const float* wp = p.ada_w + ((size_t)l * 1024 + kq * 256) * 6144 + j;
#pragma unroll 8
      for (int k = 0; k < 256; ++k) {
        float wv = wp[(size_t)k * 6144];
#pragma unroll
        for (int r = 0; r < 5; ++r) acc[r] += scond[r * 1024 + kq * 256 + k] * wv;
      }
#pragma unroll
      for (int r = 0; r < 5; ++r) red[(kq * 5 + r) * 64 + jj] = acc[r];
      __syncthreads();
      for (int i = tid; i < 320; i += 256) {
        int r = i >> 6, j2 = i & 63;
        float s = red[(0 * 5 + r) * 64 + j2] + red[(1 * 5 + r) * 64 + j2] + red[(2 * 5 + r) * 64 + j2] + red[(3 * 5 + r) * 64 + j2];
        MOD[(size_t)(l * 5 + r) * 6144 + jc * 64 + j2] = s + p.ada_b[l * 6144 + jc * 64 + j2];
      }
      __syncthreads();
      continue;
    }
    v -= U_MOD;
    float* tb = (float*)smem;
    if (v < U_T0) { transpose_tile(p.sc_w_in, 1024, 3072, WT + WT_SCIN, v, tb); continue; }
    v -= U_T0;
    if (v < U_T1) { transpose_tile(p.sc_w_out, 1024, 1024, WT + WT_SCOUT, v, tb); continue; }
    v -= U_T1;
    if (v < U_T2) { transpose_tile(p.ssd_w_in, 1024, 6208, WT + WT_SSDIN, v, tb); continue; }
    v -= U_T2;
    if (v < U_T3) { transpose_tile(p.ssd_w_out, 2048, 1024, WT + WT_SSDOUT, v, tb); continue; }
    v -= U_T3;
    if (v < U_T4) {
      int l = v >> 9, t = v & 511;
      transpose_tile(p.peer_wq + (size_t)l * 1024 * 2048, 1024, 2048, WT + WT_WQ + (size_t)l * 2048 * 1024, t, tb);
      continue;
    }
    v -= U_T4;
    {
      size_t base = (size_t)v * 2048 + tid * 8;
      float4 a = *(const float4*)(p.peer_keys + base);
      float4 b = *(const float4*)(p.peer_keys + base + 4);
      uint4 o;
      o.x = pack2(a.x, a.y); o.y = pack2(a.z, a.w); o.z = pack2(b.x, b.y); o.w = pack2(b.z, b.w);
      *(uint4*)(KEYSB + base) = o;
    }
  }
}

__device__ void norm_mod_phase(const Params& p, int layer, int which, bool from_input) {
  const float* g = (which == 0 ? p.norm_mix_g : p.norm_ffn_g) + layer * 1024;
  const float* MOD = (const float*)(p.ws + OFF_MOD);
  bf16_t* A = (bf16_t*)(p.ws + OFF_YF);
  const int lane = threadIdx.x & 63, w = threadIdx.x >> 6;
  for (int tok = blockIdx.x * 4 + w; tok < NT; tok += gridDim.x * 4) {
    const float* xr = from_input ? (tok < NCTX ? p.x_prompt + (size_t)tok * 1024 : p.x_sample + (size_t)(tok - NCTX) * 1024)
                                 : p.out + (size_t)tok * 1024;
    const float* md = MOD + (size_t)(layer * 5 + cidx(tok)) * 6144 + (which ? 3 * 1024 : 0);
    float4 v[4];
    float ss = 0.f;
#pragma unroll
    for (int i = 0; i < 4; ++i) {
      v[i] = *(const float4*)(xr + lane * 4 + 256 * i);
      ss += v[i].x * v[i].x + v[i].y * v[i].y + v[i].z * v[i].z + v[i].w * v[i].w;
    }
    ss = wave_sum(ss);
    const float sc = rsqrtf(ss * (1.f / 1024.f) + 1e-6f);
#pragma unroll
    for (int i = 0; i < 4; ++i) {
      const int col = lane * 4 + 256 * i;
      float4 gg = *(const float4*)(g + col);
      float4 sh = *(const float4*)(md + col);
      float4 sl = *(const float4*)(md + 1024 + col);
      float o0 = v[i].x * sc * gg.x * (1.f + sl.x) + sh.x;
      float o1 = v[i].y * sc * gg.y * (1.f + sl.y) + sh.y;
      float o2 = v[i].z * sc * gg.z * (1.f + sl.z) + sh.z;
      float o3 = v[i].w * sc * gg.w * (1.f + sl.w) + sh.w;
      uint2 o;
      o.x = pack2(o0, o1);
      o.y = pack2(o2, o3);
      *(uint2*)(A + (size_t)tok * 1024 + col) = o;
    }
  }
}

#define LSTR 72
template <class Epi>
__device__ __forceinline__ void gemm_phase(const bf16_t* __restrict__ A, const bf16_t* __restrict__ Bt, int M, int N, int K, Epi epi, char* smem) {
  bf16_t* sA = (bf16_t*)smem;
  bf16_t* sB = sA + 2 * 128 * LSTR;
  const int tid = threadIdx.x, lane = tid & 63, w = tid >> 6;
  const int wm = w >> 1, wn = w & 1;
  const int ntn = (N + 127) >> 7, ntm = M >> 7;
  const int ntiles = ntm * ntn;
  const int KT = K >> 6;
  const int lrow = tid >> 3, lkc = (tid & 7) * 8;
  for (int tile = blockIdx.x; tile < ntiles; tile += gridDim.x) {
    const int m0 = (tile / ntn) << 7, n0 = (tile % ntn) << 7;
    f32x16 acc[2][2];
#pragma unroll
    for (int i = 0; i < 2; ++i)
#pragma unroll
      for (int j = 0; j < 2; ++j)
#pragma unroll
        for (int r = 0; r < 16; ++r) acc[i][j][r] = 0.f;
    const bf16_t* ap[4];
    const bf16_t* bp[4];
#pragma unroll
    for (int i = 0; i < 4; ++i) {
      int row = lrow + 32 * i;
      ap[i] = A + (size_t)(m0 + row) * K + lkc;
      int br = n0 + row;
      br = br < N ? br : N - 1;
      bp[i] = Bt + (size_t)br * K + lkc;
    }
    uint4 ra[4], rb[4];
#pragma unroll
    for (int i = 0; i < 4; ++i) { ra[i] = *(const uint4*)(ap[i]); rb[i] = *(const uint4*)(bp[i]); }
#pragma unroll
    for (int i = 0; i < 4; ++i) {
      *(uint4*)(sA + (lrow + 32 * i) * LSTR + lkc) = ra[i];
      *(uint4*)(sB + (lrow + 32 * i) * LSTR + lkc) = rb[i];
    }
    __syncthreads();
    for (int kt = 0; kt < KT; ++kt) {
      const int buf = kt & 1;
      if (kt + 1 < KT) {
#pragma unroll
        for (int i = 0; i < 4; ++i) { ra[i] = *(const uint4*)(ap[i] + (kt + 1) * 64); rb[i] = *(const uint4*)(bp[i] + (kt + 1) * 64); }
      }
      const bf16_t* cA = sA + buf * 128 * LSTR + (wm * 64 + (lane & 31)) * LSTR + (lane >> 5) * 8;
      const bf16_t* cB = sB + buf * 128 * LSTR + (wn * 64 + (lane & 31)) * LSTR + (lane >> 5) * 8;
#pragma unroll
      for (int kk = 0; kk < 4; ++kk) {
        bf16x8 a0 = *(const bf16x8*)(cA + kk * 16);
        bf16x8 a1 = *(const bf16x8*)(cA + 32 * LSTR + kk * 16);
        bf16x8 b0 = *(const bf16x8*)(cB + kk * 16);
        bf16x8 b1 = *(const bf16x8*)(cB + 32 * LSTR + kk * 16);
        acc[0][0] = __builtin_amdgcn_mfma_f32_32x32x16_bf16(a0, b0, acc[0][0], 0, 0, 0);
        acc[0][1] = __builtin_amdgcn_mfma_f32_32x32x16_bf16(a0, b1, acc[0][1], 0, 0, 0);
        acc[1][0] = __builtin_amdgcn_mfma_f32_32x32x16_bf16(a1, b0, acc[1][0], 0, 0, 0);
        acc[1][1] = __builtin_amdgcn_mfma_f32_32x32x16_bf16(a1, b1, acc[1][1], 0, 0, 0);
      }
      if (kt + 1 < KT) {
        bf16_t* dA = sA + (buf ^ 1) * 128 * LSTR;
        bf16_t* dB = sB + (buf ^ 1) * 128 * LSTR;
#pragma unroll
        for (int i = 0; i < 4; ++i) {
          *(uint4*)(dA + (lrow + 32 * i) * LSTR + lkc) = ra[i];
          *(uint4*)(dB + (lrow + 32 * i) * LSTR + lkc) = rb[i];
        }
      }
      __syncthreads();
    }
#pragma unroll
    for (int mi = 0; mi < 2; ++mi)
#pragma unroll
      for (int ni = 0; ni < 2; ++ni) {
        const int n = n0 + wn * 64 + ni * 32 + (lane & 31);
#pragma unroll
        for (int r = 0; r < 16; ++r) {
          const int m = m0 + wm * 64 + mi * 32 + (r & 3) + 8 * (r >> 2) + 4 * (lane >> 5);
          if (n < N) epi(m, n, acc[mi][ni][r]);
        }
      }
  }
}

struct EpiBf16 {
  bf16_t* C; int ldc;
  __device__ __forceinline__ void operator()(int m, int n, float v) const { C[(size_t)m * ldc + n] = f2bf(v); }
};
struct EpiSsdIn {
  bf16_t* C; float* DT; const float* dt_bias;
  __device__ __forceinline__ void operator()(int m, int n, float v) const {
    if (n < 6144) C[(size_t)m * 6144 + n] = f2bf(v);
    else {
      float x = v + dt_bias[n - 6144];
      float sp = x > 20.f ? x : log1pf(expf(x));
      DT[(size_t)m * 64 + (n - 6144)] = sp;
    }
  }
};
struct EpiRes {
  const float* xin_ctx; const float* xin_lat; float* X; const float* gate;
  __device__ __forceinline__ void operator()(int m, int n, float v) const {
    const float* xr = m < NCTX ? xin_ctx + (size_t)m * 1024 : xin_lat + (size_t)(m - NCTX) * 1024;
    X[(size_t)m * 1024 + n] = xr[n] + gate[(size_t)cidx(m) * 6144 + n] * v;
  }
};

__device__ void conv_gate_phase(const Params& p) {
  const bf16_t* P = (const bf16_t*)(p.ws + OFF_BIG);
  bf16_t* G = (bf16_t*)(p.ws + OFF_BIG + 120 * MIB);
  const float* cw = p.sc_conv_w;
  const int total = NT * 128;
  for (int it = blockIdx.x * 256 + threadIdx.x; it < total; it += gridDim.x * 256) {
    const int tok = it >> 7, c = (it & 127) * 8;
    const int rowlen = tok < NCTX ? 256 : 64;
    const int pos = tok & (rowlen - 1);
    const bf16_t* pr = P + (size_t)tok * 3072;
    uint4 bg = *(const uint4*)(pr + c);
    uint4 cg = *(const uint4*)(pr + 1024 + c);
    uint4 xv = *(const uint4*)(pr + 2048 + c);
    uint4 cgl = make_uint4(0, 0, 0, 0), xvl = cgl, cgr = cgl, xvr = cgl;
    if (pos > 0) { cgl = *(const uint4*)(pr - 3072 + 1024 + c); xvl = *(const uint4*)(pr - 3072 + 2048 + c); }
    if (pos < rowlen - 1) { cgr = *(const uint4*)(pr + 3072 + 1024 + c); xvr = *(const uint4*)(pr + 3072 + 2048 + c); }
    const unsigned* bgp = (const unsigned*)&bg; const unsigned* cgp = (const unsigned*)&cg; const unsigned* xvp = (const unsigned*)&xv;
    const unsigned* cglp = (const unsigned*)&cgl; const unsigned* xvlp = (const unsigned*)&xvl;
    const unsigned* cgrp = (const unsigned*)&cgr; const unsigned* xvrp = (const unsigned*)&xvr;
    float4 w0a = *(const float4*)(cw + c), w0b = *(const float4*)(cw + c + 4);
    float4 w1a = *(const float4*)(cw + 1024 + c), w1b = *(const float4*)(cw + 1024 + c + 4);
    float4 w2a = *(const float4*)(cw + 2048 + c), w2b = *(const float4*)(cw + 2048 + c + 4);
    const float w0[8] = {w0a.x, w0a.y, w0a.z, w0a.w, w0b.x, w0b.y, w0b.z, w0b.w};
    const float w1[8] = {w1a.x, w1a.y, w1a.z, w1a.w, w1b.x, w1b.y, w1b.z, w1b.w};
    const float w2[8] = {w2a.x, w2a.y, w2a.z, w2a.w, w2b.x, w2b.y, w2b.z, w2b.w};
    unsigned o[4];
#pragma unroll
    for (int q = 0; q < 4; ++q) {
      float r0 = lo2f(bgp[q]) * (w0[2 * q] * lo2f(cglp[q]) * lo2f(xvlp[q]) + w1[2 * q] * lo2f(cgp[q]) * lo2f(xvp[q]) + w2[2 * q] * lo2f(cgrp[q]) * lo2f(xvrp[q]));
      float r1 = hi2f(bgp[q]) * (w0[2 * q + 1] * hi2f(cglp[q]) * hi2f(xvlp[q]) + w1[2 * q + 1] * hi2f(cgp[q]) * hi2f(xvp[q]) + w2[2 * q + 1] * hi2f(cgrp[q]) * hi2f(xvrp[q]));
      o[q] = pack2(r0, r1);
    }
    *(uint4*)(G + (size_t)tok * 1024 + c) = make_uint4(o[0], o[1], o[2], o[3]);
  }
}

__device__ __forceinline__ void topk_token(const float* Srow, int lane, int* idx_out, float* g_out) {
  unsigned res1 = 0, res2 = 0;
  {
    unsigned k0 = (fkey(Srow[lane]) & ~0x7Fu) | (unsigned)(127 - lane);
    unsigned k1 = (fkey(Srow[lane + 64]) & ~0x7Fu) | (unsigned)(63 - lane);
#pragma unroll 1
    for (int it = 0; it < 16; ++it) {
      unsigned wm = wave_max_u32(umax_(k0, k1));
      k0 = (k0 == wm) ? 0u : k0;
      k1 = (k1 == wm) ? 0u : k1;
      res1 = (lane == it) ? wm : res1;
    }
  }
  {
    unsigned k0 = (fkey(Srow[128 + lane]) & ~0x7Fu) | (unsigned)(127 - lane);
    unsigned k1 = (fkey(Srow[192 + lane]) & ~0x7Fu) | (unsigned)(63 - lane);
#pragma unroll 1
    for (int it = 0; it < 16; ++it) {
      unsigned wm = wave_max_u32(umax_(k0, k1));
      k0 = (k0 == wm) ? 0u : k0;
      k1 = (k1 == wm) ? 0u : k1;
      res2 = (lane == it) ? wm : res2;
    }
  }
  const float v2 = keyf((unsigned)__shfl((int)res2, lane & 15) & ~0x7Fu);
  unsigned ck[4];
#pragma unroll
  for (int m = 0; m < 4; ++m) {
    const int a = (lane >> 4) + 4 * m;
    const float v1 = keyf((unsigned)__shfl((int)res1, a) & ~0x7Fu);
    ck[m] = (fkey(v1 + v2) & ~0xFFu) | (unsigned)(255 - (lane + 64 * m));
  }
  unsigned resc = 0;
#pragma unroll 1
  for (int it = 0; it < 16; ++it) {
    unsigned wm = wave_max_u32(umax_(umax_(ck[0], ck[1]), umax_(ck[2], ck[3])));
#pragma unroll
    for (int m = 0; m < 4; ++m) ck[m] = (ck[m] == wm) ? 0u : ck[m];
    resc = (lane == it) ? wm : resc;
  }
  const int cpos = 255 - (int)(resc & 0xFFu);
  const int ca = cpos >> 4, cb = cpos & 15;
  const float val = keyf(resc & ~0xFFu);
  const unsigned r1 = (unsigned)__shfl((int)res1, ca);
  const unsigned r2 = (unsigned)__shfl((int)res2, cb);
  const int i1 = 127 - (int)(r1 & 0x7Fu), i2 = 127 - (int)(r2 & 0x7Fu);
  const float vmax = __shfl(val, 0);
  float e = (lane < 16) ? __expf(val - vmax) : 0.f;
  float s = row16_sum(e);
  if (lane < 16) {
    idx_out[lane] = i1 * 128 + i2;
    g_out[lane] = e / s;
  }
}

__device__ void topk_phase(const Params& p, int layer, char* smem) {
  float* S = (float*)smem;
  const bf16_t* Q = (const bf16_t*)(p.ws + OFF_BIG);
  const bf16_t* KB = (const bf16_t*)(p.ws + OFF_KEYSB) + (size_t)layer * (8 * 2 * 128 * 128);
  int* IDX = (int*)(p.ws + OFF_IDX);
  float* GATE = (float*)(p.ws + OFF_GATE);
  const int tid = threadIdx.x, lane = tid & 63;
  const int w = __builtin_amdgcn_readfirstlane(tid >> 6);
  const int G = gridDim.x;
  const int per = (5120 + G - 1) / G;
  const int start = blockIdx.x * per;
  const int end = (start + per < 5120) ? start + per : 5120;
  const int pp = w >> 1, nt0 = (w & 1) * 2;
  int curh = -1;
  bf16x8 kf[2][8];
  for (int pr = start; pr < end; ++pr) {
    const int h = pr / 640, tile = pr % 640;
    const int t0 = tile * 32;
    if (h != curh) {
#pragma unroll
      for (int j = 0; j < 2; ++j)
#pragma unroll
        for (int kk = 0; kk < 8; ++kk)
          kf[j][kk] = *(const bf16x8*)(KB + ((size_t)((h * 2 + pp) * 128 + (nt0 + j) * 32 + (lane & 31))) * 128 + kk * 16 + (lane >> 5) * 8);
      curh = h;
    }
    f32x16 acc[2];
#pragma unroll
    for (int j = 0; j < 2; ++j)
#pragma unroll
      for (int r = 0; r < 16; ++r) acc[j][r] = 0.f;
    const bf16_t* qp = Q + (size_t)(t0 + (lane & 31)) * 2048 + h * 256 + pp * 128 + (lane >> 5) * 8;
#pragma unroll
    for (int kk = 0; kk < 8; ++kk) {
      bf16x8 a = *(const bf16x8*)(qp + kk * 16);
      acc[0] = __builtin_amdgcn_mfma_f32_32x32x16_bf16(a, kf[0][kk], acc[0], 0, 0, 0);
      acc[1] = __builtin_amdgcn_mfma_f32_32x32x16_bf16(a, kf[1][kk], acc[1], 0, 0, 0);
    }
#pragma unroll
    for (int j = 0; j < 2; ++j)
#pragma unroll
      for (int r = 0; r < 16; ++r) {
        const int tl = (r & 3) + 8 * (r >> 2) + 4 * (lane >> 5);
        S[tl * 256 + pp * 128 + (nt0 + j) * 32 + (lane & 31)] = acc[j][r];
      }
    __syncthreads();
#pragma unroll 1
    for (int q = 0; q < 8; ++q) {
      const int tl = w * 8 + q;
      const size_t ob = ((size_t)(t0 + tl) * 8 + h) * 16;
      topk_token(S + tl * 256, lane, IDX + ob, GATE + ob);
    }
    __syncthreads();
  }
}

__device__ void peer_phase(const Params& p, int layer, char* smem) {
  float* coefs = (float*)smem;
  int* idxs = (int*)(smem + 2048);
  const float* U = p.peer_u + (size_t)layer * 16384 * 1024;
  const float* V = p.peer_v + (size_t)layer * 16384 * 1024;
  const bf16_t* A = (const bf16_t*)(p.ws + OFF_YF);
  const int* IDX = (const int*)(p.ws + OFF_IDX);
  const float* GATE = (const float*)(p.ws + OFF_GATE);
  const float* MOD = (const float*)(p.ws + OFF_MOD);
  float* X = p.out;
  const int lane = threadIdx.x & 63;
  const int w = __builtin_amdgcn_readfirstlane(threadIdx.x >> 6);
  const int sub = lane & 15, rg = lane >> 4;
  for (int tok = blockIdx.x * 4 + w; tok < NT; tok += gridDim.x * 4) {
    float t[64];
#pragma unroll
    for (int i = 0; i < 16; ++i) {
      uint2 r = *(const uint2*)(A + (size_t)tok * 1024 + sub * 4 + 64 * i);
      t[4 * i] = lo2f(r.x); t[4 * i + 1] = hi2f(r.x); t[4 * i + 2] = lo2f(r.y); t[4 * i + 3] = hi2f(r.y);
    }
#pragma unroll 1
    for (int it = 0; it < 32; ++it) {
      const int k = it * 4 + rg;
      const int e = IDX[(size_t)tok * 128 + k];
      const float gk = GATE[(size_t)tok * 128 + k];
      const float4* row = (const float4*)(U + (size_t)e * 1024) + sub;
      float acc = 0.f;
#pragma unroll
      for (int i = 0; i < 16; ++i) {
        float4 r = row[16 * i];
        acc += r.x * t[4 * i] + r.y * t[4 * i + 1] + r.z * t[4 * i + 2] + r.w * t[4 * i + 3];
      }
      acc = row16_sum(acc);
      const float co = 0.5f * acc * (1.f + erff(acc * 0.70710678118654752f)) * gk;
      if (sub == 0) { coefs[w * 128 + k] = co; idxs[w * 128 + k] = e; }
    }
    float4 o[4];
#pragma unroll
    for (int i = 0; i < 4; ++i) o[i] = make_float4(0.f, 0.f, 0.f, 0.f);
#pragma unroll 1
    for (int k = 0; k < 128; k += 4) {
      int e[4]; float c[4];
#pragma unroll
      for (int j = 0; j < 4; ++j) {
        e[j] = __builtin_amdgcn_readfirstlane(idxs[w * 128 + k + j]);
        c[j] = coefs[w * 128 + k + j];
      }
      float4 r[4][4];
#pragma unroll
      for (int j = 0; j < 4; ++j) {
        const float4* row = (const float4*)(V + (size_t)e[j] * 1024) + lane;
#pragma unroll
        for (int i = 0; i < 4; ++i) r[j][i] = row[64 * i];
      }
#pragma unroll
      for (int j = 0; j < 4; ++j)
#pragma unroll
        for (int i = 0; i < 4; ++i) {
          o[i].x += c[j] * r[j][i].x; o[i].y += c[j] * r[j][i].y; o[i].z += c[j] * r[j][i].z; o[i].w += c[j] * r[j][i].w;
        }
    }
    const float* gate = MOD + (size_t)(layer * 5 + cidx(tok)) * 6144 + 5 * 1024;
#pragma unroll
    for (int i = 0; i < 4; ++i) {
      const int col = lane * 4 + 256 * i;
      float4 xv = *(const float4*)(X + (size_t)tok * 1024 + col);
      float4 gt = *(const float4*)(gate + col);
      xv.x += gt.x * o[i].x; xv.y += gt.y * o[i].y; xv.z += gt.z * o[i].z; xv.w += gt.w * o[i].w;
      *(float4*)(X + (size_t)tok * 1024 + col) = xv;
    }
  }
}

__device__ void ssd_conv_phase(const Params& p) {
  bf16_t* BIG = (bf16_t*)(p.ws + OFF_BIG);
  const float* cw = p.ssd_conv_w;
  const float* cb = p.ssd_conv_b;
  const int total = 272 * 512;
  for (int it = blockIdx.x * 256 + threadIdx.x; it < total; it += gridDim.x * 256) {
    const int c8 = it & 511, r = it >> 9;
    const int c = c8 * 8;
    int tok0, len;
    if (r < 16) { tok0 = r * 256; len = 256; } else { tok0 = NCTX + (r - 16) * 64; len = 64; }
    float w0[8], w1[8], w2[8], bb[8];
#pragma unroll
    for (int j = 0; j < 8; ++j) { w0[j] = cw[c + j]; w1[j] = cw[4096 + c + j]; w2[j] = cw[8192 + c + j]; bb[j] = cb[c + j]; }
    bf16_t* base = BIG + (size_t)tok0 * 6144 + 2048 + c;
    uint4 buf[8], nxt[8];
#pragma unroll
    for (int j = 0; j < 8; ++j) buf[j] = *(const uint4*)(base + (size_t)j * 6144);
    uint4 prev = make_uint4(0, 0, 0, 0);
    for (int t0 = 0; t0 < len; t0 += 8) {
      const bool more = (t0 + 8) < len;
#pragma unroll
      for (int j = 0; j < 8; ++j) nxt[j] = more ? *(const uint4*)(base + (size_t)(t0 + 8 + j) * 6144) : make_uint4(0, 0, 0, 0);
#pragma unroll
      for (int j = 0; j < 8; ++j) {
        const uint4 cur = buf[j];
        const uint4 nx = (j < 7) ? buf[j + 1] : nxt[0];
        const unsigned* pp = (const unsigned*)&prev; const unsigned* cp = (const unsigned*)&cur; const unsigned* np = (const unsigned*)&nx;
        unsigned o[4];
#pragma unroll
        for (int q = 0; q < 4; ++q) {
          float a0 = w0[2 * q] * lo2f(pp[q]) + w1[2 * q] * lo2f(cp[q]) + w2[2 * q] * lo2f(np[q]) + bb[2 * q];
          float a1 = w0[2 * q + 1] * hi2f(pp[q]) + w1[2 * q + 1] * hi2f(cp[q]) + w2[2 * q + 1] * hi2f(np[q]) + bb[2 * q + 1];
          o[q] = pack2(siluf(a0), siluf(a1));
        }
        *(uint4*)(base + (size_t)(t0 + j) * 6144) = make_uint4(o[0], o[1], o[2], o[3]);
        prev = cur;
      }
#pragma unroll
      for (int j = 0; j < 8; ++j) buf[j] = nxt[j];
    }
  }
}

__device__ void scan_phase(const Params& p, char* smem) {
  float* xs = (float*)smem;
  float* Bs = xs + 2 * 16 * 64;
  float* Cs = Bs + 2 * 16 * 128;
  float* dts = Cs + 2 * 16 * 128;
  float* yb = dts + 64;
  const bf16_t* BIG = (const bf16_t*)(p.ws + OFF_BIG);
  const float* DT = (const float*)(p.ws + OFF_DT);
  const int tid = threadIdx.x, lane = tid & 63;
  const int w = __builtin_amdgcn_readfirstlane(tid >> 6);
  const int stt = tid >> 4, ssub = tid & 15;
  for (int item = blockIdx.x; item < 1280; item += gridDim.x) {
    int b, head, dir, L, tok0;
    const bool latent = item < 256;
    if (latent) { b = item >> 6; head = (item >> 1) & 31; dir = item & 1; L = 4096; tok0 = NCTX + b * 4096; }
    else { int j = item - 256; b = j >> 6; head = (j >> 1) & 31; dir = j & 1; L = 256; tok0 = b * 256; }
    const int g = head >> 2;
    const float a = -expf(p.ssd_a_log[dir * 32 + head]);
    bf16_t* Y = (bf16_t*)(p.ws + (dir ? OFF_YB : OFF_YF));
    float h[32];
    if (latent) {
      const float* sp = p.state_ssm + ((size_t)((b * 2 + dir) * 32 + head)) * 8192 + lane * 128 + w * 32;
#pragma unroll
      for (int i = 0; i < 8; ++i) { float4 v = *(const float4*)(sp + 4 * i); h[4 * i] = v.x; h[4 * i + 1] = v.y; h[4 * i + 2] = v.z; h[4 * i + 3] = v.w; }
    } else {
#pragma unroll
      for (int i = 0; i < 32; ++i) h[i] = 0.f;
    }
    const int nb = L >> 4;
    uint4 rbc0, rbc1; uint2 rx; float rdt;
    {
      const int t = stt;
      const int tok = tok0 + (dir ? L - 1 - t : t);
      const bf16_t* rowp = BIG + (size_t)tok * 6144;
      const bf16_t* bc = rowp + (ssub < 8 ? 4096 + g * 128 + ssub * 16 : 5120 + g * 128 + (ssub - 8) * 16);
      rbc0 = *(const uint4*)(bc); rbc1 = *(const uint4*)(bc + 8);
      rx = *(const uint2*)(rowp + 2048 + head * 64 + ssub * 4);
      rdt = DT[(size_t)tok * 64 + dir * 32 + head];
    }
    __syncthreads();
    {
      float* dst = (ssub < 8 ? Bs : Cs) + (0 * 16 + stt) * 128 + (ssub & 7) * 16;
      const unsigned* q0 = (const unsigned*)&rbc0; const unsigned* q1 = (const unsigned*)&rbc1;
#pragma unroll
      for (int j = 0; j < 4; ++j) { dst[2 * j] = lo2f(q0[j]); dst[2 * j + 1] = hi2f(q0[j]); dst[8 + 2 * j] = lo2f(q1[j]); dst[8 + 2 * j + 1] = hi2f(q1[j]); }
      float* xd = xs + (0 * 16 + stt) * 64 + ssub * 4;
      xd[0] = lo2f(rx.x); xd[1] = hi2f(rx.x); xd[2] = lo2f(rx.y); xd[3] = hi2f(rx.y);
      if (ssub == 0) dts[stt] = rdt;
    }
    __syncthreads();
    for (int k = 0; k < nb; ++k) {
      const int buf = k & 1;
      if (k + 1 < nb) {
        const int t = (k + 1) * 16 + stt;
        const int tok = tok0 + (dir ? L - 1 - t : t);
        const bf16_t* rowp = BIG + (size_t)tok * 6144;
        const bf16_t* bc = rowp + (ssub < 8 ? 4096 + g * 128 + ssub * 16 : 5120 + g * 128 + (ssub - 8) * 16);
        rbc0 = *(const uint4*)(bc); rbc1 = *(const uint4*)(bc + 8);
        rx = *(const uint2*)(rowp + 2048 + head * 64 + ssub * 4);
        rdt = DT[(size_t)tok * 64 + dir * 32 + head];
      }
#pragma unroll 2
      for (int tt = 0; tt < 16; ++tt) {
        const float dtv = dts[buf * 16 + tt];
        const float dA = __expf(dtv * a);
        const float xv = xs[(buf * 16 + tt) * 64 + lane];
        const float dtx = dtv * xv;
        const float4* bp = (const float4*)(Bs + (buf * 16 + tt) * 128 + w * 32);
        const float4* cp = (const float4*)(Cs + (buf * 16 + tt) * 128 + w * 32);
        float y0 = 0.f, y1 = 0.f;
#pragma unroll
        for (int i = 0; i < 8; ++i) {
          const float4 bv = bp[i], cv = cp[i];
          h[4 * i] = h[4 * i] * dA + dtx * bv.x;         y0 += h[4 * i] * cv.x;
          h[4 * i + 1] = h[4 * i + 1] * dA + dtx * bv.y; y1 += h[4 * i + 1] * cv.y;
          h[4 * i + 2] = h[4 * i + 2] * dA + dtx * bv.z; y0 += h[4 * i + 2] * cv.z;
          h[4 * i + 3] = h[4 * i + 3] * dA + dtx * bv.w; y1 += h[4 * i + 3] * cv.w;
        }
        yb[((buf * 16 + tt) * 4 + w) * 64 + lane] = y0 + y1;
      }
      if (k + 1 < nb) {
        const int nbuf = buf ^ 1;
        float* dst = (ssub < 8 ? Bs : Cs) + (nbuf * 16 + stt) * 128 + (ssub & 7) * 16;
        const unsigned* q0 = (const unsigned*)&rbc0; const unsigned* q1 = (const unsigned*)&rbc1;
#pragma unroll
        for (int j = 0; j < 4; ++j) { dst[2 * j] = lo2f(q0[j]); dst[2 * j + 1] = hi2f(q0[j]); dst[8 + 2 * j] = lo2f(q1[j]); dst[8 + 2 * j + 1] = hi2f(q1[j]); }
        float* xd = xs + (nbuf * 16 + stt) * 64 + ssub * 4;
        xd[0] = lo2f(rx.x); xd[1] = hi2f(rx.x); xd[2] = lo2f(rx.y); xd[3] = hi2f(rx.y);
        if (ssub == 0) dts[nbuf * 16 + stt] = rdt;
      }
      __syncthreads();
      {
        float4 s = make_float4(0.f, 0.f, 0.f, 0.f);
#pragma unroll
        for (int ww = 0; ww < 4; ++ww) {
          float4 v = *(const float4*)(yb + ((buf * 16 + stt) * 4 + ww) * 64 + ssub * 4);
          s.x += v.x; s.y += v.y; s.z += v.z; s.w += v.w;
        }
        const int t = k * 16 + stt;
        const int tok = tok0 + (dir ? L - 1 - t : t);
        uint2 o; o.x = pack2(s.x, s.y); o.y = pack2(s.z, s.w);
        *(uint2*)(Y + (size_t)tok * 2048 + head * 64 + ssub * 4) = o;
      }
    }
    if (!latent) {
      float* sp = p.out + (size_t)NT * 1024 + ((size_t)((b * 2 + dir) * 32 + head)) * 8192 + lane * 128 + w * 32;
#pragma unroll
      for (int i = 0; i < 8; ++i) *(float4*)(sp + 4 * i) = make_float4(h[4 * i], h[4 * i + 1], h[4 * i + 2], h[4 * i + 3]);
    }
  }
}

__device__ void gate_norm_phase(const Params& p) {
  const bf16_t* BIG = (const bf16_t*)(p.ws + OFF_BIG);
  bf16_t* YF = (bf16_t*)(p.ws + OFF_YF);
  const bf16_t* YB = (const bf16_t*)(p.ws + OFF_YB);
  const int lane = threadIdx.x & 63, w = threadIdx.x >> 6;
  for (int tok = blockIdx.x * 4 + w; tok < NT; tok += gridDim.x * 4) {
    float v[32];
    float ss = 0.f;
#pragma unroll
    for (int i = 0; i < 4; ++i) {
      const int col = lane * 8 + 512 * i;
      const int head = col >> 6;
      const float dtot = p.ssd_d[head] + p.ssd_d[32 + head];
      uint4 a = *(const uint4*)(YF + (size_t)tok * 2048 + col);
      uint4 b = *(const uint4*)(YB + (size_t)tok * 2048 + col);
      uint4 x = *(const uint4*)(BIG + (size_t)tok * 6144 + 2048 + col);
      uint4 z = *(const uint4*)(BIG + (size_t)tok * 6144 + col);
      const unsigned* ap = (const unsigned*)&a; const unsigned* bp = (const unsigned*)&b;
      const unsigned* xp = (const unsigned*)&x; const unsigned* zp = (const unsigned*)&z;
#pragma unroll
      for (int q = 0; q < 4; ++q) {
        float y0 = lo2f(ap[q]) + lo2f(bp[q]) + dtot * lo2f(xp[q]);
        float y1 = hi2f(ap[q]) + hi2f(bp[q]) + dtot * hi2f(xp[q]);
        y0 *= siluf(lo2f(zp[q]));
        y1 *= siluf(hi2f(zp[q]));
        v[8 * i + 2 * q] = y0; v[8 * i + 2 * q + 1] = y1;
        ss += y0 * y0 + y1 * y1;
      }
    }
    ss = wave_sum(ss);
    const float sc = rsqrtf(ss * (1.f / 2048.f) + 1e-6f);
#pragma unroll
    for (int i = 0; i < 4; ++i) {
      const int col = lane * 8 + 512 * i;
      float4 g0 = *(const float4*)(p.ssd_norm_g + col), g1 = *(const float4*)(p.ssd_norm_g + col + 4);
      uint4 o;
      o.x = pack2(v[8 * i] * sc * g0.x, v[8 * i + 1] * sc * g0.y);
      o.y = pack2(v[8 * i + 2] * sc * g0.z, v[8 * i + 3] * sc * g0.w);
      o.z = pack2(v[8 * i + 4] * sc * g1.x, v[8 * i + 5] * sc * g1.y);
      o.w = pack2(v[8 * i + 6] * sc * g1.z, v[8 * i + 7] * sc * g1.w);
      *(uint4*)(YF + (size_t)tok * 2048 + col) = o;
    }
  }
}

__device__ void final_norm_phase(const Params& p) {
  const int lane = threadIdx.x & 63, w = threadIdx.x >> 6;
  for (int tok = blockIdx.x * 4 + w; tok < NT; tok += gridDim.x * 4) {
    float* xr = p.out + (size_t)tok * 1024;
    float4 v[4];
    float ss = 0.f;
#pragma unroll
    for (int i = 0; i < 4; ++i) {
      v[i] = *(const float4*)(xr + lane * 4 + 256 * i);
      ss += v[i].x * v[i].x + v[i].y * v[i].y + v[i].z * v[i].z + v[i].w * v[i].w;
    }
    ss = wave_sum(ss);
    const float sc = rsqrtf(ss * (1.f / 1024.f) + 1e-6f);
#pragma unroll
    for (int i = 0; i < 4; ++i) {
      const int col = lane * 4 + 256 * i;
      float4 gg = *(const float4*)(p.norm_f_g + col);
      *(float4*)(xr + col) = make_float4(v[i].x * sc * gg.x, v[i].y * sc * gg.y, v[i].z * sc * gg.z, v[i].w * sc * gg.w);
    }
  }
}

#define N_PHASES 20
__global__ void __launch_bounds__(256, 2) mk(Params p, int ph_begin, int ph_end) {
  __shared__ __attribute__((aligned(16))) char smem[SMEM_BYTES];
  bf16_t* WT = (bf16_t*)(p.ws + OFF_WT);
  bf16_t* BIG = (bf16_t*)(p.ws + OFF_BIG);
  bf16_t* Abuf = (bf16_t*)(p.ws + OFF_YF);
  float* MOD = (float*)(p.ws + OFF_MOD);
#define RUN(PH, CALL) if (ph_begin <= PH && PH < ph_end) { CALL; if (PH + 1 < ph_end) cg::this_grid().sync(); }
  RUN(0, prep_phase(p, smem))
  RUN(1, norm_mod_phase(p, 0, 0, true))
  RUN(2, gemm_phase(Abuf, WT + WT_SCIN, NT, 3072, 1024, EpiBf16{BIG, 3072}, smem))
  RUN(3, conv_gate_phase(p))
  RUN(4, gemm_phase((const bf16_t*)(p.ws + OFF_BIG + 120 * MIB), WT + WT_SCOUT, NT, 1024, 1024,
                    EpiRes{p.x_prompt, p.x_sample, p.out, MOD + 0 * 5 * 6144 + 2 * 1024}, smem))
  RUN(5, norm_mod_phase(p, 0, 1, false))
  RUN(6, gemm_phase(Abuf, WT + WT_WQ, NT, 2048, 1024, EpiBf16{BIG, 2048}, smem))
  RUN(7, topk_phase(p, 0, smem))
  RUN(8, peer_phase(p, 0, smem))
  RUN(9, norm_mod_phase(p, 1, 0, false))
  RUN(10, gemm_phase(Abuf, WT + WT_SSDIN, NT, 6208, 1024, EpiSsdIn{BIG, (float*)(p.ws + OFF_DT), p.ssd_dt_bias}, smem))
  RUN(11, ssd_conv_phase(p))
  RUN(12, scan_phase(p, smem))
  RUN(13, gate_norm_phase(p))
  RUN(14, gemm_phase(Abuf, WT + WT_SSDOUT, NT, 1024, 2048,
                     EpiRes{p.out, p.out + (size_t)NCTX * 1024, p.out, MOD + 1 * 5 * 6144 + 2 * 1024}, smem))
  RUN(15, norm_mod_phase(p, 1, 1, false))
  RUN(16, gemm_phase(Abuf, WT + WT_WQ + (size_t)2048 * 1024, NT, 2048, 1024, EpiBf16{BIG, 2048}, smem))
  RUN(17, topk_phase(p, 1, smem))
  RUN(18, peer_phase(p, 1, smem))
  RUN(19, final_norm_phase(p))
}

extern "C" void kernel_launch(void* const* d_in, const int* in_sizes, int n_in, void* d_out, int out_size, void* d_ws, size_t ws_size,
                              hipStream_t stream) {
  static int grid_blocks = 0;
  if (!grid_blocks) {
    int dev = 0, cus = 0, per_cu = 0;
    hipGetDevice(&dev);
    hipDeviceGetAttribute(&cus, hipDeviceAttributeMultiprocessorCount, dev);
    hipOccupancyMaxActiveBlocksPerMultiprocessor(&per_cu, mk, 256, 0);
    if (per_cu < 1) per_cu = 1;
    if (per_cu > 2) per_cu = 2;
    grid_blocks = cus * per_cu;
  }
  Params p{};
  const float** pf = (const float**)&p;
  for (int i = 0; i < 25; ++i) pf[i] = (const float*)d_in[i];
  p.out = (float*)d_out;
  p.ws = (char*)d_ws;
#if COOP
  int b = 0, e = N_PHASES;
  void* args[] = {&p, &b, &e};
  hipError_t err = hipLaunchCooperativeKernel((void*)mk, dim3(grid_blocks), dim3(256), args, 0, stream);
  if (err != hipSuccess) fprintf(stderr, "cooperative launch failed: %s (grid %d)\n", hipGetErrorString(err), grid_blocks);
#else
  for (int ph = 0; ph < N_PHASES; ++ph) hipLaunchKernelGGL(mk, dim3(grid_blocks), dim3(256), 0, stream, p, ph, ph + 1);
#endif
}
```

```cpp
#include <hip/hip_runtime.h>
#include <hip/hip_cooperative_groups.h>
#include <cstdio>
namespace cg = cooperative_groups;

#ifndef COOP
#define COOP 1
#endif

typedef unsigned short bf16_t;
typedef __attribute__((ext_vector_type(8))) short bf16x8;
typedef __attribute__((ext_vector_type(16))) float f32x16;

#define NT 20480
#define NCTX 4096
#define DM 1024
#define MIB ((size_t)1 << 20)
#define OFF_BIG   ((size_t)0)
#define OFF_YF    (240 * MIB)
#define OFF_YB    (320 * MIB)
#define OFF_WT    (400 * MIB)
#define OFF_KEYSB (433 * MIB)
#define OFF_DT    (434 * MIB)
#define OFF_MOD   (439 * MIB)
#define OFF_IDX   (440 * MIB)
#define OFF_GATE  (450 * MIB)
#define WT_SCIN   ((size_t)0)
#define WT_SCOUT  (WT_SCIN + (size_t)3072 * 1024)
#define WT_SSDIN  (WT_SCOUT + (size_t)1024 * 1024)
#define WT_SSDOUT (WT_SSDIN + (size_t)6208 * 1024)
#define WT_WQ     (WT_SSDOUT + (size_t)1024 * 2048)

#define SMEM_BYTES 75776

struct Params {
  const float *x_prompt, *x_sample, *state_ssm, *c, *c_ctx, *norm_mix_g, *norm_ffn_g, *norm_f_g, *ada_w, *ada_b;
  const float *sc_w_in, *sc_conv_w, *sc_w_out, *ssd_w_in, *ssd_conv_w, *ssd_conv_b, *ssd_dt_bias, *ssd_a_log, *ssd_d;
  const float *ssd_norm_g, *ssd_w_out, *peer_wq, *peer_keys, *peer_u, *peer_v;
  float* out;
  char* ws;
};

__device__ __forceinline__ float bf2f(bf16_t h) { return __uint_as_float(((unsigned)h) << 16); }
__device__ __forceinline__ bf16_t f2bf(float f) {
  unsigned u = __float_as_uint(f);
  u += 0x7FFFu + ((u >> 16) & 1u);
  return (bf16_t)(u >> 16);
}
__device__ __forceinline__ unsigned pack2(float a, float b) { return (unsigned)f2bf(a) | ((unsigned)f2bf(b) << 16); }
__device__ __forceinline__ float lo2f(unsigned u) { return __uint_as_float(u << 16); }
__device__ __forceinline__ float hi2f(unsigned u) { return __uint_as_float(u & 0xffff0000u); }
__device__ __forceinline__ float siluf(float x) { return x / (1.f + __expf(-x)); }
__device__ __forceinline__ int cidx(int tok) { return tok < NCTX ? 0 : 1 + ((tok - NCTX) >> 12); }

template <int CTRL>
__device__ __forceinline__ unsigned dpp_u(unsigned v) {
  return (unsigned)__builtin_amdgcn_update_dpp(0, (int)v, CTRL, 0xF, 0xF, true);
}
template <int CTRL>
__device__ __forceinline__ float dpp_f(float v) {
  return __int_as_float(__builtin_amdgcn_update_dpp(0, __float_as_int(v), CTRL, 0xF, 0xF, true));
}
__device__ __forceinline__ float row16_sum(float v) {
  v += dpp_f<0xB1>(v);
  v += dpp_f<0x4E>(v);
  v += dpp_f<0x141>(v);
  v += dpp_f<0x140>(v);
  return v;
}
__device__ __forceinline__ unsigned umax_(unsigned a, unsigned b) { return a > b ? a : b; }
__device__ __forceinline__ unsigned wave_max_u32(unsigned v) {
  v = umax_(v, dpp_u<0xB1>(v));
  v = umax_(v, dpp_u<0x4E>(v));
  v = umax_(v, dpp_u<0x141>(v));
  v = umax_(v, dpp_u<0x140>(v));
  unsigned a = (unsigned)__builtin_amdgcn_readlane((int)v, 0);
  unsigned b = (unsigned)__builtin_amdgcn_readlane((int)v, 16);
  unsigned c = (unsigned)__builtin_amdgcn_readlane((int)v, 32);
  unsigned d = (unsigned)__builtin_amdgcn_readlane((int)v, 48);
  return umax_(umax_(a, b), umax_(c, d));
}
__device__ __forceinline__ float wave_sum(float v) {
  v = row16_sum(v);
  float a, b, c, d;
  a = __int_as_float(__builtin_amdgcn_readlane(__float_as_int(v), 0));
  b = __int_as_float(__builtin_amdgcn_readlane(__float_as_int(v), 16));
  c = __int_as_float(__builtin_amdgcn_readlane(__float_as_int(v), 32));
  d = __int_as_float(__builtin_amdgcn_readlane(__float_as_int(v), 48));
  return (a + b) + (c + d);
}
__device__ __forceinline__ unsigned fkey(float f) {
  unsigned u = __float_as_uint(f);
  return (u & 0x80000000u) ? ~u : (u | 0x80000000u);
}
__device__ __forceinline__ float keyf(unsigned k) {
  unsigned u = (k & 0x80000000u) ? (k & 0x7fffffffu) : ~k;
  return __uint_as_float(u);
}

__device__ void transpose_tile(const float* __restrict__ src, int K, int N, bf16_t* __restrict__ dst, int tile, float* tb) {
  const int tid = threadIdx.x;
  const int ntn = N >> 6;
  const int kt = tile / ntn, nt = tile % ntn;
  {
    const int n = tid & 63, kb = tid >> 6;
#pragma unroll
    for (int i = 0; i < 16; ++i) {
      int k = kb + 4 * i;
      tb[k * 65 + n] = src[(size_t)(kt * 64 + k) * N + nt * 64 + n];
    }
  }
  __syncthreads();
  {
    const int k8 = (tid & 7) * 8;
#pragma unroll
    for (int pass = 0; pass < 2; ++pass) {
      int n = (tid >> 3) + 32 * pass;
      uint4 o;
      o.x = pack2(tb[(k8 + 0) * 65 + n], tb[(k8 + 1) * 65 + n]);
      o.y = pack2(tb[(k8 + 2) * 65 + n], tb[(k8 + 3) * 65 + n]);
      o.z = pack2(tb[(k8 + 4) * 65 + n], tb[(k8 + 5) * 65 + n]);
      o.w = pack2(tb[(k8 + 6) * 65 + n], tb[(k8 + 7) * 65 + n]);
      *(uint4*)(dst + (size_t)(nt * 64 + n) * K + kt * 64 + k8) = o;
    }
  }
  __syncthreads();
}

__device__ void prep_phase(const Params& p, char* smem) {
  const int tid = threadIdx.x;
  bf16_t* WT = (bf16_t*)(p.ws + OFF_WT);
  float* MOD = (float*)(p.ws + OFF_MOD);
  bf16_t* KEYSB = (bf16_t*)(p.ws + OFF_KEYSB);
  const int U_MOD = 192, U_T0 = 768, U_T1 = 256, U_T2 = 1552, U_T3 = 512, U_T4 = 1024, U_KEYS = 256;
  const int total = U_MOD + U_T0 + U_T1 + U_T2 + U_T3 + U_T4 + U_KEYS;
  for (int u = blockIdx.x; u < total; u += gridDim.x) {
    int v = u;
    if (v < U_MOD) {
      float* scond = (float*)smem;
      float* red = scond + 5 * 1024;
      for (int i = tid; i < 5 * 1024; i += 256) {
        int r = i >> 10, k = i & 1023;
        float cv = (r == 0) ? p.c_ctx[k] : p.c[(r - 1) * 1024 + k];
        scond[i] = siluf(cv);
      }
      __syncthreads();
      const int l = v / 96, jc = v % 96;
      const int jj = tid & 63, kq = tid >> 6;
      const int j = jc * 64 + jj;
      float acc[5] = {0.f, 0.f, 0.f, 0.f, 0.f};
      const float* wp = p.ada_w + ((size_t)l * 1024 + kq * 256) * 6144 + j;
#pragma unroll 8
      for (int k = 0; k < 256; ++k) {
        float wv = wp[(size_t)k * 6144];
#pragma unroll
        for (int r = 0; r < 5; ++r) acc[r] += scond[r * 1024 + kq * 256 + k] * wv;
      }
#pragma unroll
      for (int r = 0; r < 5; ++r) red[(kq * 5 + r) * 64 + jj] = acc[r];
      __syncthreads();
      for (int i = tid; i < 320; i += 256) {
        int r = i >> 6, j2 = i & 63;
        float s = red[(0 * 5 + r) * 64 + j2] + red[(1 * 5 + r) * 64 + j2] + red[(2 * 5 + r) * 64 + j2] + red[(3 * 5 + r) * 64 + j2];
        MOD[(size_t)(l * 5 + r) * 6144 + jc * 64 + j2] = s + p.ada_b[l * 6144 + jc * 64 + j2];
      }
      __syncthreads();
      continue;
    }
    v -= U_MOD;
    float* tb = (float*)smem;
    if (v < U_T0) { transpose_tile(p.sc_w_in, 1024, 3072, WT + WT_SCIN, v, tb); continue; }
    v -= U_T0;
    if (v < U_T1) { transpose_tile(p.sc_w_out, 1024, 1024, WT + WT_SCOUT, v, tb); continue; }
    v -= U_T1;
    if (v < U_T2) { transpose_tile(p.ssd_w_in, 1024, 6208, WT + WT_SSDIN, v, tb); continue; }
    v -= U_T2;
    if (v < U_T3) { transpose_tile(p.ssd_w_out, 2048, 1024, WT + WT_SSDOUT, v, tb); continue; }
    v -= U_T3;
    if (v < U_T4) {
      int l = v >> 9, t = v & 511;
      transpose_tile(p.peer_wq + (size_t)l * 1024 * 2048, 1024, 2048, WT + WT_WQ + (size_t)l * 2048 * 1024, t, tb);
      continue;
    }
    v -= U_T4;
    {
      size_t base = (size_t)v * 2048 + tid * 8;
      float4 a = *(const float4*)(p.peer_keys + base);
      float4 b = *(const float4*)(p.peer_keys + base + 4);
      uint4 o;
      o.x = pack2(a.x, a.y); o.y = pack2(a.z, a.w); o.z = pack2(b.x, b.y); o.w = pack2(b.z, b.w);
      *(uint4*)(KEYSB + base) = o;
    }
  }
}

__device__ void norm_mod_phase(const Params& p, int layer, int which, bool from_input) {
  const float* g = (which == 0 ? p.norm_mix_g : p.norm_ffn_g) + layer * 1024;
  const float* MOD = (const float*)(p.ws + OFF_MOD);
  bf16_t* A = (bf16_t*)(p.ws + OFF_YF);
  const int lane = threadIdx.x & 63, w = threadIdx.x >> 6;
  for (int tok = blockIdx.x * 4 + w; tok < NT; tok += gridDim.x * 4) {
    const float* xr = from_input ? (tok < NCTX ? p.x_prompt + (size_t)tok * 1024 : p.x_sample + (size_t)(tok - NCTX) * 1024)
                                 : p.out + (size_t)tok * 1024;
    const float* md = MOD + (size_t)(layer * 5 + cidx(tok)) * 6144 + (which ? 3 * 1024 : 0);
    float4 v[4];
    float ss = 0.f;
#pragma unroll
    for (int i = 0; i < 4; ++i) {
      v[i] = *(const float4*)(xr + lane * 4 + 256 * i);
      ss += v[i].x * v[i].x + v[i].y * v[i].y + v[i].z * v[i].z + v[i].w * v[i].w;
    }
    ss = wave_sum(ss);
    const float sc = rsqrtf(ss * (1.f / 1024.f) + 1e-6f);
#pragma unroll
    for (int i = 0; i < 4; ++i) {
      const int col = lane * 4 + 256 * i;
      float4 gg = *(const float4*)(g + col);
      float4 sh = *(const float4*)(md + col);
      float4 sl = *(const float4*)(md + 1024 + col);
      float o0 = v[i].x * sc * gg.x * (1.f + sl.x) + sh.x;
      float o1 = v[i].y * sc * gg.y * (1.f + sl.y) + sh.y;
      float o2 = v[i].z * sc * gg.z * (1.f + sl.z) + sh.z;
      float o3 = v[i].w * sc * gg.w * (1.f + sl.w) + sh.w;
      uint2 o;
      o.x = pack2(o0, o1);
      o.y = pack2(o2, o3);
      *(uint2*)(A + (size_t)tok * 1024 + col) = o;
    }
  }
}

#define LSTR 72
template <class Epi>
__device__ __forceinline__ void gemm_phase(const bf16_t* __restrict__ A, const bf16_t* __restrict__ Bt, int M, int N, int K, Epi epi, char* smem) {
  bf16_t* sA = (bf16_t*)smem;
  bf16_t* sB = sA + 2 * 128 * LSTR;
  const int tid = threadIdx.x, lane = tid & 63, w = tid >> 6;
  const int wm = w >> 1, wn = w & 1;
  const int ntn = (N + 127) >> 7, ntm = M >> 7;
  const int ntiles = ntm * ntn;
  const int KT = K >> 6;
  const int lrow = tid >> 3, lkc = (tid & 7) * 8;
  for (int tile = blockIdx.x; tile < ntiles; tile += gridDim.x) {
    const int m0 = (tile / ntn) << 7, n0 = (tile % ntn) << 7;
    f32x16 acc[2][2];
#pragma unroll
    for (int i = 0; i < 2; ++i)
#pragma unroll
      for (int j = 0; j < 2; ++j)
#pragma unroll
        for (int r = 0; r < 16; ++r) acc[i][j][r] = 0.f;
    const bf16_t* ap[4];
    const bf16_t* bp[4];
#pragma unroll
    for (int i = 0; i < 4; ++i) {
      int row = lrow + 32 * i;
      ap[i] = A + (size_t)(m0 + row) * K + lkc;
      int br = n0 + row;
      br = br < N ? br : N - 1;
      bp[i] = Bt + (size_t)br * K + lkc;
    }
    uint4 ra[4], rb[4];
#pragma unroll
    for (int i = 0; i < 4; ++i) { ra[i] = *(const uint4*)(ap[i]); rb[i] = *(const uint4*)(bp[i]); }
#pragma unroll
    for (int i = 0; i < 4; ++i) {
      *(uint4*)(sA + (lrow + 32 * i) * LSTR + lkc) = ra[i];
      *(uint4*)(sB + (lrow + 32 * i) * LSTR + lkc) = rb[i];
    }
    __syncthreads();
    for (int kt = 0; kt < KT; ++kt) {
      const int buf = kt & 1;
      if (kt + 1 < KT) {
#pragma unroll
        for (int i = 0; i < 4; ++i) { ra[i] = *(const uint4*)(ap[i] + (kt + 1) * 64); rb[i] = *(const uint4*)(bp[i] + (kt + 1) * 64); }
      }
      const bf16_t* cA = sA + buf * 128 * LSTR + (wm * 64 + (lane & 31)) * LSTR + (lane >> 5) * 8;
      const bf16_t* cB = sB + buf * 128 * LSTR + (wn * 64 + (lane & 31)) * LSTR + (lane >> 5) * 8;
#pragma unroll
      for (int kk = 0; kk < 4; ++kk) {
        bf16x8 a0 = *(const bf16x8*)(cA + kk * 16);
        bf16x8 a1 = *(const bf16x8*)(cA + 32 * LSTR + kk * 16);
        bf16x8 b0 = *(const bf16x8*)(cB + kk * 16);
        bf16x8 b1 = *(const bf16x8*)(cB + 32 * LSTR + kk * 16);
        acc[0][0] = __builtin_amdgcn_mfma_f32_32x32x16_bf16(a0, b0, acc[0][0], 0, 0, 0);
        acc[0][1] = __builtin_amdgcn_mfma_f32_32x32x16_bf16(a0, b1, acc[0][1], 0, 0, 0);
        acc[1][0] = __builtin_amdgcn_mfma_f32_32x32x16_bf16(a1, b0, acc[1][0], 0, 0, 0);
        acc[1][1] = __builtin_amdgcn_mfma_f32_32x32x16_bf16(a1, b1, acc[1][1], 0, 0, 0);
      }
      if (kt + 1 < KT) {
        bf16_t* dA = sA + (buf ^ 1) * 128 * LSTR;
        bf16_t* dB = sB + (buf ^ 1) * 128 * LSTR;
#pragma unroll
        for (int i = 0; i < 4; ++i) {
          *(uint4*)(dA + (lrow + 32 * i) * LSTR + lkc) = ra[i];
          *(uint4*)(dB + (lrow + 32 * i) * LSTR + lkc) = rb[i];
        }
      }
      __syncthreads();
    }
#pragma unroll
    for (int mi = 0; mi < 2; ++mi)
#pragma unroll
      for (int ni = 0; ni < 2; ++ni) {
        const int n = n0 + wn * 64 + ni * 32 + (lane & 31);
#pragma unroll
        for (int r = 0; r < 16; ++r) {
          const int m = m0 + wm * 64 + mi * 32 + (r & 3) + 8 * (r >> 2) + 4 * (lane >> 5);
          if (n < N) epi(m, n, acc[mi][ni][r]);
        }
      }
  }
}

struct EpiBf16 {
  bf16_t* C; int ldc;
  __device__ __forceinline__ void operator()(int m, int n, float v) const { C[(size_t)m * ldc + n] = f2bf(v); }
};
struct EpiSsdIn {
  bf16_t* C; float* DT; const float* dt_bias;
  __device__ __forceinline__ void operator()(int m, int n, float v) const {
    if (n < 6144) C[(size_t)m * 6144 + n] = f2bf(v);
    else {
      float x = v + dt_bias[n - 6144];
      float sp = x > 20.f ? x : log1pf(expf(x));
      DT[(size_t)m * 64 + (n - 6144)] = sp;
    }
  }
};
struct EpiRes {
  const float* xin_ctx; const float* xin_lat; float* X; const float* gate;
  __device__ __forceinline__ void operator()(int m, int n, float v) const {
    const float* xr = m < NCTX ? xin_ctx + (size_t)m * 1024 : xin_lat + (size_t)(m - NCTX) * 1024;
    X[(size_t)m * 1024 + n] = xr[n] + gate[(size_t)cidx(m) * 6144 + n] * v;
  }
};

__device__ void conv_gate_phase(const Params& p) {
  const bf16_t* P = (const bf16_t*)(p.ws + OFF_BIG);
  bf16_t* G = (bf16_t*)(p.ws + OFF_BIG + 120 * MIB);
  const float* cw = p.sc_conv_w;
  const int total = NT * 128;
  for (int it = blockIdx.x * 256 + threadIdx.x; it < total; it += gridDim.x * 256) {
    const int tok = it >> 7, c = (it & 127) * 8;
    const int rowlen = tok < NCTX ? 256 : 64;
    const int pos = tok & (rowlen - 1);
    const bf16_t* pr = P + (size_t)tok * 3072;
    uint4 bg = *(const uint4*)(pr + c);
    uint4 cg = *(const uint4*)(pr + 1024 + c);
    uint4 xv = *(const uint4*)(pr + 2048 + c);
    uint4 cgl = make_uint4(0, 0, 0, 0), xvl = cgl, cgr = cgl, xvr = cgl;
    if (pos > 0) { cgl = *(const uint4*)(pr - 3072 + 1024 + c); xvl = *(const uint4*)(pr - 3072 + 2048 + c); }
    if (pos < rowlen - 1) { cgr = *(const uint4*)(pr + 3072 + 1024 + c); xvr = *(const uint4*)(pr + 3072 + 2048 + c); }
    const unsigned* bgp = (const unsigned*)&bg; const unsigned* cgp = (const unsigned*)&cg; const unsigned* xvp = (const unsigned*)&xv;
    const unsigned* cglp = (const unsigned*)&cgl; const unsigned* xvlp = (const unsigned*)&xvl;
    const unsigned* cgrp = (const unsigned*)&cgr; const unsigned* xvrp = (const unsigned*)&xvr;
    float4 w0a = *(const float4*)(cw + c), w0b = *(const float4*)(cw + c + 4);
    float4 w1a = *(const float4*)(cw + 1024 + c), w1b = *(const float4*)(cw + 1024 + c + 4);
    float4 w2a = *(const float4*)(cw + 2048 + c), w2b = *(const float4*)(cw + 2048 + c + 4);
    const float w0[8] = {w0a.x, w0a.y, w0a.z, w0a.w, w0b.x, w0b.y, w0b.z, w0b.w};
    const float w1[8] = {w1a.x, w1a.y, w1a.z, w1a.w, w1b.x, w1b.y, w1b.z, w1b.w};
    const float w2[8] = {w2a.x, w2a.y, w2a.z, w2a.w, w2b.x, w2b.y, w2b.z, w2b.w};
    unsigned o[4];
#pragma unroll
    for (int q = 0; q < 4; ++q) {
      float r0 = lo2f(bgp[q]) * (w0[2 * q] * lo2f(cglp[q]) * lo2f(xvlp[q]) + w1[2 * q] * lo2f(cgp[q]) * lo2f(xvp[q]) + w2[2 * q] * lo2f(cgrp[q]) * lo2f(xvrp[q]));
      float r1 = hi2f(bgp[q]) * (w0[2 * q + 1] * hi2f(cglp[q]) * hi2f(xvlp[q]) + w1[2 * q + 1] * hi2f(cgp[q]) * hi2f(xvp[q]) + w2[2 * q + 1] * hi2f(cgrp[q]) * hi2f(xvrp[q]));
      o[q] = pack2(r0, r1);
    }
    *(uint4*)(G + (size_t)tok * 1024 + c) = make_uint4(o[0], o[1], o[2], o[3]);
  }
}

__device__ __forceinline__ void topk_token(const float* Srow, int lane, int* idx_out, float* g_out) {
  unsigned res1 = 0, res2 = 0;
  {
    unsigned k0 = (fkey(Srow[lane]) & ~0x7Fu) | (unsigned)(127 - lane);
    unsigned k1 = (fkey(Srow[lane + 64]) & ~0x7Fu) | (unsigned)(63 - lane);
#pragma unroll 1
    for (int it = 0; it < 16; ++it) {
      unsigned wm = wave_max_u32(umax_(k0, k1));
      k0 = (k0 == wm) ? 0u : k0;
      k1 = (k1 == wm) ? 0u : k1;
      res1 = (lane == it) ? wm : res1;
    }
  }
  {
    unsigned k0 = (fkey(Srow[128 + lane]) & ~0x7Fu) | (unsigned)(127 - lane);
    unsigned k1 = (fkey(Srow[192 + lane]) & ~0x7Fu) | (unsigned)(63 - lane);
#pragma unroll 1
    for (int it = 0; it < 16; ++it) {
      unsigned wm = wave_max_u32(umax_(k0, k1));
      k0 = (k0 == wm) ? 0u : k0;
      k1 = (k1 == wm) ? 0u : k1;
      res2 = (lane == it) ? wm : res2;
    }
  }
  const float v2 = keyf((unsigned)__shfl((int)res2, lane & 15) & ~0x7Fu);
  unsigned ck[4];
#pragma unroll
  for (int m = 0; m < 4; ++m) {
    const int a = (lane >> 4) + 4 * m;
    const float v1 = keyf((unsigned)__shfl((int)res1, a) & ~0x7Fu);
    ck[m] = (fkey(v1 + v2) & ~0xFFu) | (unsigned)(255 - (lane + 64 * m));
  }
  unsigned resc = 0;
#pragma unroll 1
  for (int it = 0; it < 16; ++it) {
    unsigned wm = wave_max_u32(umax_(umax_(ck[0], ck[1]), umax_(ck[2], ck[3])));
#pragma unroll
    for (int m = 0; m < 4; ++m) ck[m] = (ck[m] == wm) ? 0u : ck[m];
    resc = (lane == it) ? wm : resc;
  }
  const int cpos = 255 - (int)(resc & 0xFFu);
  const int ca = cpos >> 4, cb = cpos & 15;
  const float val = keyf(resc & ~0xFFu);
  const unsigned r1 = (unsigned)__shfl((int)res1, ca);
  const unsigned r2 = (unsigned)__shfl((int)res2, cb);
  const int i1 = 127 - (int)(r1 & 0x7Fu), i2 = 127 - (int)(r2 & 0x7Fu);
  const float vmax = __shfl(val, 0);
  float e = (lane < 16) ? __expf(val - vmax) : 0.f;
  float s = row16_sum(e);
  if (lane < 16) {
    idx_out[lane] = i1 * 128 + i2;
    g_out[lane] = e / s;
  }
}

__device__ void topk_phase(const Params& p, int layer, char* smem) {
  float* S = (float*)smem;
  const bf16_t* Q = (const bf16_t*)(p.ws + OFF_BIG);
  const bf16_t* KB = (const bf16_t*)(p.ws + OFF_KEYSB) + (size_t)layer * (8 * 2 * 128 * 128);
  int* IDX = (int*)(p.ws + OFF_IDX);
  float* GATE = (float*)(p.ws + OFF_GATE);
  const int tid = threadIdx.x, lane = tid & 63;
  const int w = __builtin_amdgcn_readfirstlane(tid >> 6);
  const int G = gridDim.x;
  const int per = (5120 + G - 1) / G;
  const int start = blockIdx.x * per;
  const int end = (start + per < 5120) ? start + per : 5120;
  const int pp = w >> 1, nt0 = (w & 1) * 2;
  int curh = -1;
  bf16x8 kf[2][8];
  for (int pr = start; pr < end; ++pr) {
    const int h = pr / 640, tile = pr % 640;
    const int t0 = tile * 32;
    if (h != curh) {
#pragma unroll
      for (int j = 0; j < 2; ++j)
#pragma unroll
        for (int kk = 0; kk < 8; ++kk)
          kf[j][kk] = *(const bf16x8*)(KB + ((size_t)((h * 2 + pp) * 128 + (nt0 + j) * 32 + (lane & 31))) * 128 + kk * 16 + (lane >> 5) * 8);
      curh = h;
    }
    f32x16 acc[2];
#pragma unroll
    for (int j = 0; j < 2; ++j)
#pragma unroll
      for (int r = 0; r < 16; ++r) acc[j][r] = 0.f;
    const bf16_t* qp = Q + (size_t)(t0 + (lane & 31)) * 2048 + h * 256 + pp * 128 + (lane >> 5) * 8;
#pragma unroll
    for (int kk = 0; kk < 8; ++kk) {
      bf16x8 a = *(const bf16x8*)(qp + kk * 16);
      acc[0] = __builtin_amdgcn_mfma_f32_32x32x16_bf16(a, kf[0][kk], acc[0], 0, 0, 0);
      acc[1] = __builtin_amdgcn_mfma_f32_32x32x16_bf16(a, kf[1][kk], acc[1], 0, 0, 0);
    }
#pragma unroll
    for (int j = 0; j < 2; ++j)
#pragma unroll
      for (int r = 0; r < 16; ++r) {
        const int tl = (r & 3) + 8 * (r >> 2) + 4 * (lane >> 5);
        S[tl * 256 + pp * 128 + (nt0 + j) * 32 + (lane & 31)] = acc[j][r];
      }
    __syncthreads();
#pragma unroll 1
    for (int q = 0; q < 8; ++q) {
      const int tl = w * 8 + q;
      const size_t ob = ((size_t)(t0 + tl) * 8 + h) * 16;
      topk_token(S + tl * 256, lane, IDX + ob, GATE + ob);
    }
    __syncthreads();
  }
}

__device__ void peer_phase(const Params& p, int layer, char* smem) {
  float* coefs = (float*)smem;
  int* idxs = (int*)(smem + 2048);
  const float* U = p.peer_u + (size_t)layer * 16384 * 1024;
  const float* V = p.peer_v + (size_t)layer * 16384 * 1024;
  const bf16_t* A = (const bf16_t*)(p.ws + OFF_YF);
  const int* IDX = (const int*)(p.ws + OFF_IDX);
  const float* GATE = (const float*)(p.ws + OFF_GATE);
  const float* MOD = (const float*)(p.ws + OFF_MOD);
  float* X = p.out;
  const int lane = threadIdx.x & 63;
  const int w = __builtin_amdgcn_readfirstlane(threadIdx.x >> 6);
  const int sub = lane & 15, rg = lane >> 4;
  for (int tok = blockIdx.x * 4 + w; tok < NT; tok += gridDim.x * 4) {
    float t[64];
#pragma unroll
    for (int i = 0; i < 16; ++i) {
      uint2 r = *(const uint2*)(A + (size_t)tok * 1024 + sub * 4 + 64 * i);
      t[4 * i] = lo2f(r.x); t[4 * i + 1] = hi2f(r.x); t[4 * i + 2] = lo2f(r.y); t[4 * i + 3] = hi2f(r.y);
    }
#pragma unroll 1
    for (int it = 0; it < 32; ++it) {
      const int k = it * 4 + rg;
      const int e = IDX[(size_t)tok * 128 + k];
      const float gk = GATE[(size_t)tok * 128 + k];
      const float4* row = (const float4*)(U + (size_t)e * 1024) + sub;
      float acc = 0.f;
#pragma unroll
      for (int i = 0; i < 16; ++i) {
        float4 r = row[16 * i];
        acc += r.x * t[4 * i] + r.y * t[4 * i + 1] + r.z * t[4 * i + 2] + r.w * t[4 * i + 3];
      }
      acc = row16_sum(acc);
      const float co = 0.5f * acc * (1.f + erff(acc * 0.70710678118654752f)) * gk;
      if (sub == 0) { coefs[w * 128 + k] = co; idxs[w * 128 + k] = e; }
    }
    float4 o[4];
#pragma unroll
    for (int i = 0; i < 4; ++i) o[i] = make_float4(0.f, 0.f, 0.f, 0.f);
#pragma unroll 1
    for (int k = 0; k < 128; k += 4) {
      int e[4]; float c[4];
#pragma unroll
      for (int j = 0; j < 4; ++j) {
        e[j] = __builtin_amdgcn_readfirstlane(idxs[w * 128 + k + j]);
        c[j] = coefs[w * 128 + k + j];
      }
      float4 r[4][4];
#pragma unroll
      for (int j = 0; j < 4; ++j) {
        const float4* row = (const float4*)(V + (size_t)e[j] * 1024) + lane;
#pragma unroll
        for (int i = 0; i < 4; ++i) r[j][i] = row[64 * i];
      }
#pragma unroll
      for (int j = 0; j < 4; ++j)
#pragma unroll
        for (int i = 0; i < 4; ++i) {
          o[i].x += c[j] * r[j][i].x; o[i].y += c[j] * r[j][i].y; o[i].z += c[j] * r[j][i].z; o[i].w += c[j] * r[j][i].w;
        }
    }
    const float* gate = MOD + (size_t)(layer * 5 + cidx(tok)) * 6144 + 5 * 1024;
#pragma unroll
    for (int i = 0; i < 4; ++i) {
      const int col = lane * 4 + 256 * i;
      float4 xv = *(const float4*)(X + (size_t)tok * 1024 + col);
      float4 gt = *(const float4*)(gate + col);
      xv.x += gt.x * o[i].x; xv.y += gt.y * o[i].y; xv.z += gt.z * o[i].z; xv.w += gt.w * o[i].w;
      *(float4*)(X + (size_t)tok * 1024 + col) = xv;
    }
  }
}

__device__ void ssd_conv_phase(const Params& p) {
  bf16_t* BIG = (bf16_t*)(p.ws + OFF_BIG);
  const float* cw = p.ssd_conv_w;
  const float* cb = p.ssd_conv_b;
  const int total = 272 * 512;
  for (int it = blockIdx.x * 256 + threadIdx.x; it < total; it += gridDim.x * 256) {
    const int c8 = it & 511, r = it >> 9;
    const int c = c8 * 8;
    int tok0, len;
    if (r < 16) { tok0 = r * 256; len = 256; } else { tok0 = NCTX + (r - 16) * 64; len = 64; }
    float w0[8], w1[8], w2[8], bb[8];
#pragma unroll
    for (int j = 0; j < 8; ++j) { w0[j] = cw[c + j]; w1[j] = cw[4096 + c + j]; w2[j] = cw[8192 + c + j]; bb[j] = cb[c + j]; }
    bf16_t* base = BIG + (size_t)tok0 * 6144 + 2048 + c;
    uint4 buf[8], nxt[8];
#pragma unroll
    for (int j = 0; j < 8; ++j) buf[j] = *(const uint4*)(base + (size_t)j * 6144);
    uint4 prev = make_uint4(0, 0, 0, 0);
    for (int t0 = 0; t0 < len; t0 += 8) {
      const bool more = (t0 + 8) < len;
#pragma unroll
      for (int j = 0; j < 8; ++j) nxt[j] = more ? *(const uint4*)(base + (size_t)(t0 + 8 + j) * 6144) : make_uint4(0, 0, 0, 0);
#pragma unroll
      for (int j = 0; j < 8; ++j) {
        const uint4 cur = buf[j];
        const uint4 nx = (j < 7) ? buf[j + 1] : nxt[0];
        const unsigned* pp = (const unsigned*)&prev; const unsigned* cp = (const unsigned*)&cur; const unsigned* np = (const unsigned*)&nx;
        unsigned o[4];
#pragma unroll
        for (int q = 0; q < 4; ++q) {
          float a0 = w0[2 * q] * lo2f(pp[q]) + w1[2 * q] * lo2f(cp[q]) + w2[2 * q] * lo2f(np[q]) + bb[2 * q];
          float a1 = w0[2 * q + 1] * hi2f(pp[q]) + w1[2 * q + 1] * hi2f(cp[q]) + w2[2 * q + 1] * hi2f(np[q]) + bb[2 * q + 1];
          o[q] = pack2(siluf(a0), siluf(a1));
        }
        *(uint4*)(base + (size_t)(t0 + j) * 6144) = make_uint4(o[0], o[1], o[2], o[3]);
        prev = cur;
      }
#pragma unroll
      for (int j = 0; j < 8; ++j) buf[j] = nxt[j];
    }
  }
}

__device__ void scan_phase(const Params& p, char* smem) {
  float* xs = (float*)smem;
  float* Bs = xs + 2 * 16 * 64;
  float* Cs = Bs + 2 * 16 * 128;
  float* dts = Cs + 2 * 16 * 128;
  float* yb = dts + 64;
  const bf16_t* BIG = (const bf16_t*)(p.ws + OFF_BIG);
  const float* DT = (const float*)(p.ws + OFF_DT);
  const int tid = threadIdx.x, lane = tid & 63;
  const int w = __builtin_amdgcn_readfirstlane(tid >> 6);
  const int stt = tid >> 4, ssub = tid & 15;
  for (int item = blockIdx.x; item < 1280; item += gridDim.x) {
    int b, head, dir, L, tok0;
    const bool latent = item < 256;
    if (latent) { b = item >> 6; head = (item >> 1) & 31; dir = item & 1; L = 4096; tok0 = NCTX + b * 4096; }
    else { int j = item - 256; b = j >> 6; head = (j >> 1) & 31; dir = j & 1; L = 256; tok0 = b * 256; }
    const int g = head >> 2;
    const float a = -expf(p.ssd_a_log[dir * 32 + head]);
    bf16_t* Y = (bf16_t*)(p.ws + (dir ? OFF_YB : OFF_YF));
    float h[32];
    if (latent) {
      const float* sp = p.state_ssm + ((size_t)((b * 2 + dir) * 32 + head)) * 8192 + lane * 128 + w * 32;
#pragma unroll
      for (int i = 0; i < 8; ++i) { float4 v = *(const float4*)(sp + 4 * i); h[4 * i] = v.x; h[4 * i + 1] = v.y; h[4 * i + 2] = v.z; h[4 * i + 3] = v.w; }
    } else {
#pragma unroll
      for (int i = 0; i < 32; ++i) h[i] = 0.f;
    }
    const int nb = L >> 4;
    uint4 rbc0, rbc1; uint2 rx; float rdt;
    {
      const int t = stt;
      const int tok = tok0 + (dir ? L - 1 - t : t);
      const bf16_t* rowp = BIG + (size_t)tok * 6144;
      const bf16_t* bc = rowp + (ssub < 8 ? 4096 + g * 128 + ssub * 16 : 5120 + g * 128 + (ssub - 8) * 16);
      rbc0 = *(const uint4*)(bc); rbc1 = *(const uint4*)(bc + 8);
      rx = *(const uint2*)(rowp + 2048 + head * 64 + ssub * 4);
      rdt = DT[(size_t)tok * 64 + dir * 32 + head];
    }
    __syncthreads();
    {
      float* dst = (ssub < 8 ? Bs : Cs) + (0 * 16 + stt) * 128 + (ssub & 7) * 16;
      const unsigned* q0 = (const unsigned*)&rbc0; const unsigned* q1 = (const unsigned*)&rbc1;
#pragma unroll
      for (int j = 0; j < 4; ++j) { dst[2 * j] = lo2f(q0[j]); dst[2 * j + 1] = hi2f(q0[j]); dst[8 + 2 * j] = lo2f(q1[j]); dst[8 + 2 * j + 1] = hi2f(q1[j]); }
      float* xd = xs + (0 * 16 + stt) * 64 + ssub * 4;
      xd[0] = lo2f(rx.x); xd[1] = hi2f(rx.x); xd[2] = lo2f(rx.y); xd[3] = hi2f(rx.y);
      if (ssub == 0) dts[stt] = rdt;
    }
    __syncthreads();
    for (int k = 0; k < nb; ++k) {
      const int buf = k & 1;
      if (k + 1 < nb) {
        const int t = (k + 1) * 16 + stt;
        const int tok = tok0 + (dir ? L - 1 - t : t);
        const bf16_t* rowp = BIG + (size_t)tok * 6144;
        const bf16_t* bc = rowp + (ssub < 8 ? 4096 + g * 128 + ssub * 16 : 5120 + g * 128 + (ssub - 8) * 16);
        rbc0 = *(const uint4*)(bc); rbc1 = *(const uint4*)(bc + 8);
        rx = *(const uint2*)(rowp + 2048 + head * 64 + ssub * 4);
        rdt = DT[(size_t)tok * 64 + dir * 32 + head];
      }
#pragma unroll 2
      for (int tt = 0; tt < 16; ++tt) {
        const float dtv = dts[buf * 16 + tt];
        const float dA = __expf(dtv * a);
        const float xv = xs[(buf * 16 + tt) * 64 + lane];
        const float dtx = dtv * xv;
        const float4* bp = (const float4*)(Bs + (buf * 16 + tt) * 128 + w * 32);
        const float4* cp = (const float4*)(Cs + (buf * 16 + tt) * 128 + w * 32);
        float y0 = 0.f, y1 = 0.f;
#pragma unroll
        for (int i = 0; i < 8; ++i) {
          const float4 bv = bp[i], cv = cp[i];
          h[4 * i] = h[4 * i] * dA + dtx * bv.x;         y0 += h[4 * i] * cv.x;
          h[4 * i + 1] = h[4 * i + 1] * dA + dtx * bv.y; y1 += h[4 * i + 1] * cv.y;
          h[4 * i + 2] = h[4 * i + 2] * dA + dtx * bv.z; y0 += h[4 * i + 2] * cv.z;
          h[4 * i + 3] = h[4 * i + 3] * dA + dtx * bv.w; y1 += h[4 * i + 3] * cv.w;
        }
        yb[((buf * 16 + tt) * 4 + w) * 64 + lane] = y0 + y1;
      }
      if (k + 1 < nb) {
        const int nbuf = buf ^ 1;
        float* dst = (ssub < 8 ? Bs : Cs) + (nbuf * 16 + stt) * 128 + (ssub & 7) * 16;
        const unsigned* q0 = (const unsigned*)&rbc0; const unsigned* q1 = (const unsigned*)&rbc1;
#pragma unroll
        for (int j = 0; j < 4; ++j) { dst[2 * j] = lo2f(q0[j]); dst[2 * j + 1] = hi2f(q0[j]); dst[8 + 2 * j] = lo2f(q1[j]); dst[8 + 2 * j + 1] = hi2f(q1[j]); }
        float* xd = xs + (nbuf * 16 + stt) * 64 + ssub * 4;
        xd[0] = lo2f(rx.x); xd[1] = hi2f(rx.x); xd[2] = lo2f(rx.y); xd[3] = hi2f(rx.y);
        if (ssub == 0) dts[nbuf * 16 + stt] = rdt;
      }
      __syncthreads();
      {
        float4 s = make_float4(0.f, 0.f, 0.f, 0.f);
#pragma unroll
        for (int ww = 0; ww < 4; ++ww) {
          float4 v = *(const float4*)(yb + ((buf * 16 + stt) * 4 + ww) * 64 + ssub * 4);
          s.x += v.x; s.y += v.y; s.z += v.z; s.w += v.w;
        }
        const int t = k * 16 + stt;
        const int tok = tok0 + (dir ? L - 1 - t : t);
        uint2 o; o.x = pack2(s.x, s.y); o.y = pack2(s.z, s.w);
        *(uint2*)(Y + (size_t)tok * 2048 + head * 64 + ssub * 4) = o;
      }
    }
    if (!latent) {
      float* sp = p.out + (size_t)NT * 1024 + ((size_t)((b * 2 + dir) * 32 + head)) * 8192 + lane * 128 + w * 32;
#pragma unroll
      for (int i = 0; i < 8; ++i) *(float4*)(sp + 4 * i) = make_float4(h[4 * i], h[4 * i + 1], h[4 * i + 2], h[4 * i + 3]);
    }
  }
}

__device__ void gate_norm_phase(const Params& p) {
  const bf16_t* BIG = (const bf16_t*)(p.ws + OFF_BIG);
  bf16_t* YF = (bf16_t*)(p.ws + OFF_YF);
  const bf16_t* YB = (const bf16_t*)(p.ws + OFF_YB);
  const int lane = threadIdx.x & 63, w = threadIdx.x >> 6;
  for (int tok = blockIdx.x * 4 + w; tok < NT; tok += gridDim.x * 4) {
    float v[32];
    float ss = 0.f;
#pragma unroll
    for (int i = 0; i < 4; ++i) {
      const int col = lane * 8 + 512 * i;
      const int head = col >> 6;
      const float dtot = p.ssd_d[head] + p.ssd_d[32 + head];
      uint4 a = *(const uint4*)(YF + (size_t)tok * 2048 + col);
      uint4 b = *(const uint4*)(YB + (size_t)tok * 2048 + col);
      uint4 x = *(const uint4*)(BIG + (size_t)tok * 6144 + 2048 + col);
      uint4 z = *(const uint4*)(BIG + (size_t)tok * 6144 + col);
      const unsigned* ap = (const unsigned*)&a; const unsigned* bp = (const unsigned*)&b;
      const unsigned* xp = (const unsigned*)&x; const unsigned* zp = (const unsigned*)&z;
#pragma unroll
      for (int q = 0; q < 4; ++q) {
        float y0 = lo2f(ap[q]) + lo2f(bp[q]) + dtot * lo2f(xp[q]);
        float y1 = hi2f(ap[q]) + hi2f(bp[q]) + dtot * hi2f(xp[q]);
        y0 *= siluf(lo2f(zp[q]));
        y1 *= siluf(hi2f(zp[q]));
        v[8 * i + 2 * q] = y0; v[8 * i + 2 * q + 1] = y1;
        ss += y0 * y0 + y1 * y1;
      }
    }
    ss = wave_sum(ss);
    const float sc = rsqrtf(ss * (1.f / 2048.f) + 1e-6f);
#pragma unroll
    for (int i = 0; i < 4; ++i) {
      const int col = lane * 8 + 512 * i;
      float4 g0 = *(const float4*)(p.ssd_norm_g + col), g1 = *(const float4*)(p.ssd_norm_g + col + 4);
      uint4 o;
      o.x = pack2(v[8 * i] * sc * g0.x, v[8 * i + 1] * sc * g0.y);
      o.y = pack2(v[8 * i + 2] * sc * g0.z, v[8 * i + 3] * sc * g0.w);
      o.z = pack2(v[8 * i + 4] * sc * g1.x, v[8 * i + 5] * sc * g1.y);
      o.w = pack2(v[8 * i + 6] * sc * g1.z, v[8 * i + 7] * sc * g1.w);
      *(uint4*)(YF + (size_t)tok * 2048 + col) = o;
    }
  }
}

__device__ void final_norm_phase(const Params& p) {
  const int lane = threadIdx.x & 63, w = threadIdx.x >> 6;
  for (int tok = blockIdx.x * 4 + w; tok < NT; tok += gridDim.x * 4) {
    float* xr = p.out + (size_t)tok * 1024;
    float4 v[4];
    float ss = 0.f;
#pragma unroll
    for (int i = 0; i < 4; ++i) {
      v[i] = *(const float4*)(xr + lane * 4 + 256 * i);
      ss += v[i].x * v[i].x + v[i].y * v[i].y + v[i].z * v[i].z + v[i].w * v[i].w;
    }
    ss = wave_sum(ss);
    const float sc = rsqrtf(ss * (1.f / 1024.f) + 1e-6f);
#pragma unroll
    for (int i = 0; i < 4; ++i) {
      const int col = lane * 4 + 256 * i;
      float4 gg = *(const float4*)(p.norm_f_g + col);
      *(float4*)(xr + col) = make_float4(v[i].x * sc * gg.x, v[i].y * sc * gg.y, v[i].z * sc * gg.z, v[i].w * sc * gg.w);
    }
  }
}

#define N_PHASES 20
__global__ void __launch_bounds__(256, 2) mk(Params p, int ph_begin, int ph_end) {
  __shared__ __attribute__((aligned(16))) char smem[SMEM_BYTES];
  bf16_t* WT = (bf16_t*)(p.ws + OFF_WT);
  bf16_t* BIG = (bf16_t*)(p.ws + OFF_BIG);
  bf16_t* Abuf = (bf16_t*)(p.ws + OFF_YF);
  float* MOD = (float*)(p.ws + OFF_MOD);
#define RUN(PH, CALL) if (ph_begin <= PH && PH < ph_end) { CALL; if (PH + 1 < ph_end) cg::this_grid().sync(); }
  RUN(0, prep_phase(p, smem))
  RUN(1, norm_mod_phase(p, 0, 0, true))
  RUN(2, gemm_phase(Abuf, WT + WT_SCIN, NT, 3072, 1024, EpiBf16{BIG, 3072}, smem))
  RUN(3, conv_gate_phase(p))
  RUN(4, gemm_phase((const bf16_t*)(p.ws + OFF_BIG + 120 * MIB), WT + WT_SCOUT, NT, 1024, 1024,
                    EpiRes{p.x_prompt, p.x_sample, p.out, MOD + 0 * 5 * 6144 + 2 * 1024}, smem))
  RUN(5, norm_mod_phase(p, 0, 1, false))
  RUN(6, gemm_phase(Abuf, WT + WT_WQ, NT, 2048, 1024, EpiBf16{BIG, 2048}, smem))
  RUN(7, topk_phase(p, 0, smem))
  RUN(8, peer_phase(p, 0, smem))
  RUN(9, norm_mod_phase(p, 1, 0, false))
  RUN(10, gemm_phase(Abuf, WT + WT_SSDIN, NT, 6208, 1024, EpiSsdIn{BIG, (float*)(p.ws + OFF_DT), p.ssd_dt_bias}, smem))
  RUN(11, ssd_conv_phase(p))
  RUN(12, scan_phase(p, smem))
  RUN(13, gate_norm_phase(p))
  RUN(14, gemm_phase(Abuf, WT + WT_SSDOUT, NT, 1024, 2048,
                     EpiRes{p.out, p.out + (size_t)NCTX * 1024, p.out, MOD + 1 * 5 * 6144 + 2 * 1024}, smem))
  RUN(15, norm_mod_phase(p, 1, 1, false))
  RUN(16, gemm_phase(Abuf, WT + WT_WQ + (size_t)2048 * 1024, NT, 2048, 1024, EpiBf16{BIG, 2048}, smem))
  RUN(17, topk_phase(p, 1, smem))
  RUN(18, peer_phase(p, 1, smem))
  RUN(19, final_norm_phase(p))
}

extern "C" void kernel_launch(void* const* d_in, const int* in_sizes, int n_in, void* d_out, int out_size, void* d_ws, size_t ws_size,
                              hipStream_t stream) {
  static int grid_blocks = 0;
  if (!grid_blocks) {
    int dev = 0, cus = 0, per_cu = 0;
    hipGetDevice(&dev);
    hipDeviceGetAttribute(&cus, hipDeviceAttributeMultiprocessorCount, dev);
    hipOccupancyMaxActiveBlocksPerMultiprocessor(&per_cu, mk, 256, 0);
    if (per_cu < 1) per_cu = 1;
    if (per_cu > 2) per_cu = 2;
    grid_blocks = cus * per_cu;
  }
  Params p{};
  const float** pf = (const float**)&p;
  for (int i = 0; i < 25; ++i) pf[i] = (const float*)d_in[i];
  p.out = (float*)d_out;
  p.ws = (char*)d_ws;
#if COOP
  int b = 0, e = N_PHASES;
  void* args[] = {&p, &b, &e};
  hipError_t err = hipLaunchCooperativeKernel((void*)mk, dim3(grid_blocks), dim3(256), args, 0, stream);
  if (err != hipSuccess) fprintf(stderr, "cooperative launch failed: %s (grid %d)\n", hipGetErrorString(err), grid_blocks);
#else
  for (int ph = 0; ph < N_PHASES; ++ph) hipLaunchKernelGGL(mk, dim3(grid_blocks), dim3(256), 0, stream, p, ph, ph + 1);
#endif
}
```

```cpp
#include <hip/hip_runtime.h>
#include <hip/hip_cooperative_groups.h>
#include <cstdio>
namespace cg = cooperative_groups;

#ifndef COOP
#define COOP 1
#endif
#ifndef DUP_MASK
#define DUP_MASK 0
#endif

typedef unsigned short bf16_t;
typedef __attribute__((ext_vector_type(8))) short bf16x8;
typedef __attribute__((ext_vector_type(16))) float f32x16;

#define NT 20480
#define NCTX 4096
#define DM 1024
#define MIB ((size_t)1 << 20)
#define OFF_BIG   ((size_t)0)
#define OFF_YF    (240 * MIB)
#define OFF_YB    (320 * MIB)
#define OFF_WT    (400 * MIB)
#define OFF_KEYSB (433 * MIB)
#define OFF_DT    (434 * MIB)
#define OFF_MOD   (439 * MIB)
#define OFF_IDX   (440 * MIB)
#define OFF_GATE  (450 * MIB)
#define OFF_TAB1  (460 * MIB)
#define OFF_SCALE (492 * MIB)
#define WS_NEEDED (493 * MIB)
#define WT_SCIN   ((size_t)0)
#define WT_SCOUT  (WT_SCIN + (size_t)3072 * 1024)
#define WT_SSDIN  (WT_SCOUT + (size_t)1024 * 1024)
#define WT_SSDOUT (WT_SSDIN + (size_t)6208 * 1024)
#define WT_WQ     (WT_SSDOUT + (size_t)1024 * 2048)

#define SMEM_BYTES 75776

struct Params {
  const float *x_prompt, *x_sample, *state_ssm, *c, *c_ctx, *norm_mix_g, *norm_ffn_g, *norm_f_g, *ada_w, *ada_b;
  const float *sc_w_in, *sc_conv_w, *sc_w_out, *ssd_w_in, *ssd_conv_w, *ssd_conv_b, *ssd_dt_bias, *ssd_a_log, *ssd_d;
  const float *ssd_norm_g, *ssd_w_out, *peer_wq, *peer_keys, *peer_u, *peer_v;
  float* out;
  char* ws;
};

__device__ __forceinline__ float bf2f(bf16_t h) { return __uint_as_float(((unsigned)h) << 16); }
__device__ __forceinline__ bf16_t f2bf(float f) {
  unsigned u = __float_as_uint(f);
  u += 0x7FFFu + ((u >> 16) & 1u);
  return (bf16_t)(u >> 16);
}
__device__ __forceinline__ unsigned pack2(float a, float b) { return (unsigned)f2bf(a) | ((unsigned)f2bf(b) << 16); }
__device__ __forceinline__ float lo2f(unsigned u) { return __uint_as_float(u << 16); }
__device__ __forceinline__ float hi2f(unsigned u) { return __uint_as_float(u & 0xffff0000u); }
__device__ __forceinline__ float siluf(float x) { return x / (1.f + __expf(-x)); }
__device__ __forceinline__ int cidx(int tok) { return tok < NCTX ? 0 : 1 + ((tok - NCTX) >> 12); }

template <int CTRL>
__device__ __forceinline__ unsigned dpp_u(unsigned v) {
  return (unsigned)__builtin_amdgcn_update_dpp(0, (int)v, CTRL, 0xF, 0xF, true);
}
template <int CTRL>
__device__ __forceinline__ float dpp_f(float v) {
  return __int_as_float(__builtin_amdgcn_update_dpp(0, __float_as_int(v), CTRL, 0xF, 0xF, true));
}
__device__ __forceinline__ float row16_sum(float v) {
  v += dpp_f<0xB1>(v);
  v += dpp_f<0x4E>(v);
  v += dpp_f<0x141>(v);
  v += dpp_f<0x140>(v);
  return v;
}
__device__ __forceinline__ unsigned umax_(unsigned a, unsigned b) { return a > b ? a : b; }
__device__ __forceinline__ unsigned wave_max_u32(unsigned v) {
  v = umax_(v, dpp_u<0xB1>(v));
  v = umax_(v, dpp_u<0x4E>(v));
  v = umax_(v, dpp_u<0x141>(v));
  v = umax_(v, dpp_u<0x140>(v));
  unsigned a = (unsigned)__builtin_amdgcn_readlane((int)v, 0);
  unsigned b = (unsigned)__builtin_amdgcn_readlane((int)v, 16);
  unsigned c = (unsigned)__builtin_amdgcn_readlane((int)v, 32);
  unsigned d = (unsigned)__builtin_amdgcn_readlane((int)v, 48);
  return umax_(umax_(a, b), umax_(c, d));
}
__device__ __forceinline__ float wave_sum(float v) {
  v = row16_sum(v);
  float a, b, c, d;
  a = __int_as_float(__builtin_amdgcn_readlane(__float_as_int(v), 0));
  b = __int_as_float(__builtin_amdgcn_readlane(__float_as_int(v), 16));
  c = __int_as_float(__builtin_amdgcn_readlane(__float_as_int(v), 32));
  d = __int_as_float(__builtin_amdgcn_readlane(__float_as_int(v), 48));
  return (a + b) + (c + d);
}
__device__ __forceinline__ unsigned fkey(float f) {
  unsigned u = __float_as_uint(f);
  return (u & 0x80000000u) ? ~u : (u | 0x80000000u);
}
__device__ __forceinline__ float keyf(unsigned k) {
  unsigned u = (k & 0x80000000u) ? (k & 0x7fffffffu) : ~k;
  return __uint_as_float(u);
}

__device__ __forceinline__ void transpose_tile(const float* __restrict__ src, int K, int N, bf16_t* __restrict__ dst, int tile, float* tb) {
  const int tid = threadIdx.x;
  const int ntn = N >> 6;
  const int kt = tile / ntn, nt = tile % ntn;
  {
    const int n = tid & 63, kb = tid >> 6;
#pragma unroll
    for (int i = 0; i < 16; ++i) {
      int k = kb + 4 * i;
      tb[k * 65 + n] = src[(size_t)(kt * 64 + k) * N + nt * 64 + n];
    }
  }
  __syncthreads();
  {
    const int k8 = (tid & 7) * 8;
#pragma unroll
    for (int pass = 0; pass < 2; ++pass) {
      int n = (tid >> 3) + 32 * pass;
      uint4 o;
      o.x = pack2(tb[(k8 + 0) * 65 + n], tb[(k8 + 1) * 65 + n]);
      o.y = pack2(tb[(k8 + 2) * 65 + n], tb[(k8 + 3) * 65 + n]);
      o.z = pack2(tb[(k8 + 4) * 65 + n], tb[(k8 + 5) * 65 + n]);
      o.w = pack2(tb[(k8 + 6) * 65 + n], tb[(k8 + 7) * 65 + n]);
      *(uint4*)(dst + (size_t)(nt * 64 + n) * K + kt * 64 + k8) = o;
    }
  }
  __syncthreads();
}

__device__ __forceinline__ void prep_phase(const Params& p, char* smem) {
  const int tid = threadIdx.x;
  bf16_t* WT = (bf16_t*)(p.ws + OFF_WT);
  float* MOD = (float*)(p.ws + OFF_MOD);
  bf16_t* KEYSB = (bf16_t*)(p.ws + OFF_KEYSB);
  const int U_MOD = 192, U_T0 = 768, U_T1 = 256, U_T2 = 1552, U_T3 = 512, U_T4 = 1024, U_KEYS = 256, U_TAB = 16384;
  const int total = U_MOD + U_T0 + U_T1 + U_T2 + U_T3 + U_T4 + U_KEYS + U_TAB;
  for (int u = blockIdx.x; u < total; u += gridDim.x) {
    int v = u;
    if (v < U_MOD) {
      float* scond = (float*)smem;
      float* red = scond + 5 * 1024;
      for (int i = tid; i < 5 * 1024; i += 256) {
        int r = i >> 10, k = i & 1023;
        float cv = (r == 0) ? p.c_ctx[k] : p.c[(r - 1) * 1024 + k];
        scond[i] = siluf(cv);
      }
      __syncthreads();
      const int l = v / 96, jc = v % 96;
      const int jj = tid & 63, kq = tid >> 6;
      const int j = jc * 64 + jj;
      float acc[5] = {0.f, 0.f, 0.f, 0.f, 0.f};
      const float* wp = p.ada_w + ((size_t)l * 1024 + kq * 256) * 6144 + j;
#pragma unroll 8
      for (int k = 0; k < 256; ++k) {
        float wv = wp[(size_t)k * 6144];
#pragma unroll
        for (int r = 0; r < 5; ++r) acc[r] += scond[r * 1024 + kq * 256 + k] * wv;
      }
#pragma unroll
      for (int r = 0; r < 5; ++r) red[(kq * 5 + r) * 64 + jj] = acc[r];
      __syncthreads();
      for (int i = tid; i < 320; i += 256) {
        int r = i >> 6, j2 = i & 63;
        float s = red[(0 * 5 + r) * 64 + j2] + red[(1 * 5 + r) * 64 + j2] + red[(2 * 5 + r) * 64 + j2] + red[(3 * 5 + r) * 64 + j2];
        MOD[(size_t)(l * 5 + r) * 6144 + jc * 64 + j2] = s + p.ada_b[l * 6144 + jc * 64 + j2];
      }
      __syncthreads();
      continue;
    }
    v -= U_MOD;
    float* tb = (float*)smem;
    if (v < U_T0) { transpose_tile(p.sc_w_in, 1024, 3072, WT + WT_SCIN, v, tb); continue; }
    v -= U_T0;
    if (v < U_T1) { transpose_tile(p.sc_w_out, 1024, 1024, WT + WT_SCOUT, v, tb); continue; }
    v -= U_T1;
    if (v < U_T2) { transpose_tile(p.ssd_w_in, 1024, 6208, WT + WT_SSDIN, v, tb); continue; }
    v -= U_T2;
    if (v < U_T3) { transpose_tile(p.ssd_w_out, 2048, 1024, WT + WT_SSDOUT, v, tb); continue; }
    v -= U_T3;
    if (v < U_T4) {
      int l = v >> 9, t = v & 511;
      transpose_tile(p.peer_wq + (size_t)l * 1024 * 2048, 1024, 2048, WT + WT_WQ + (size_t)l * 2048 * 1024, t, tb);
      continue;
    }
    v -= U_T4;
    if (v < U_KEYS) {
      size_t base = (size_t)v * 2048 + tid * 8;
      float4 a = *(const float4*)(p.peer_keys + base);
      float4 b = *(const float4*)(p.peer_keys + base + 4);
      uint4 o;
      o.x = pack2(a.x, a.y); o.y = pack2(a.z, a.w); o.z = pack2(b.x, b.y); o.w = pack2(b.z, b.w);
      *(uint4*)(KEYSB + base) = o;
      continue;
    }
    v -= U_KEYS;
    {
      const int lane = tid & 63;
      const int gr = v * 4 + (tid >> 6);
      const int l = gr >> 15, tab = (gr >> 14) & 1, row = gr & 16383;
      const float* src = (tab ? p.peer_v : p.peer_u) + ((size_t)l * 16384 + row) * 1024 + lane * 16;
      float4 x[4];
      float am = 0.f;
#pragma unroll
      for (int j = 0; j < 4; ++j) {
        x[j] = *(const float4*)(src + 4 * j);
        am = fmaxf(am, fmaxf(fmaxf(fabsf(x[j].x), fabsf(x[j].y)), fmaxf(fabsf(x[j].z), fabsf(x[j].w))));
      }
      am = __uint_as_float(wave_max_u32(__float_as_uint(am)));
      const float inv = am > 0.f ? 440.f / am : 0.f;
      const float scale = am > 0.f ? am / 440.f : 0.f;
      unsigned o[4];
#pragma unroll
      for (int j = 0; j < 4; ++j) {
        int wv = __builtin_amdgcn_cvt_pk_fp8_f32(x[j].x * inv, x[j].y * inv, 0, false);
        wv = __builtin_amdgcn_cvt_pk_fp8_f32(x[j].z * inv, x[j].w * inv, wv, true);
        o[j] = (unsigned)wv;
      }
      unsigned char* dst = (unsigned char*)(p.ws + (l ? OFF_TAB1 : OFF_YB)) + ((size_t)tab * 16384 + row) * 1024 + lane * 16;
      *(uint4*)dst = make_uint4(o[0], o[1], o[2], o[3]);
      if (lane == 0) ((float*)(p.ws + OFF_SCALE))[gr] = scale;
    }
  }
}

__device__ __forceinline__ void norm_mod_phase(const Params& p, int layer, int which, bool from_input) {
  const float* g = (which == 0 ? p.norm_mix_g : p.norm_ffn_g) + layer * 1024;
  const float* MOD = (const float*)(p.ws + OFF_MOD);
  bf16_t* A = (bf16_t*)(p.ws + OFF_YF);
  const int lane = threadIdx.x & 63, w = threadIdx.x >> 6;
  for (int tok = blockIdx.x * 4 + w; tok < NT; tok += gridDim.x * 4) {
    const float* xr = from_input ? (tok < NCTX ? p.x_prompt + (size_t)tok * 1024 : p.x_sample + (size_t)(tok - NCTX) * 1024)
                                 : p.out + (size_t)tok * 1024;
    const float* md = MOD + (size_t)(layer * 5 + cidx(tok)) * 6144 + (which ? 3 * 1024 : 0);
    float4 v[4];
    float ss = 0.f;
#pragma unroll
    for (int i = 0; i < 4; ++i) {
      v[i] = *(const float4*)(xr + lane * 4 + 256 * i);
      ss += v[i].x * v[i].x + v[i].y * v[i].y + v[i].z * v[i].z + v[i].w * v[i].w;
    }
    ss = wave_sum(ss);
    const float sc = rsqrtf(ss * (1.f / 1024.f) + 1e-6f);
#pragma unroll
    for (int i = 0; i < 4; ++i) {
      const int col = lane * 4 + 256 * i;
      float4 gg = *(const float4*)(g + col);
      float4 sh = *(const float4*)(md + col);
      float4 sl = *(const float4*)(md + 1024 + col);
      float o0 = v[i].x * sc * gg.x * (1.f + sl.x) + sh.x;
      float o1 = v[i].y * sc * gg.y * (1.f + sl.y) + sh.y;
      float o2 = v[i].z * sc * gg.z * (1.f + sl.z) + sh.z;
      float o3 = v[i].w * sc * gg.w * (1.f + sl.w) + sh.w;
      uint2 o;
      o.x = pack2(o0, o1);
      o.y = pack2(o2, o3);
      *(uint2*)(A + (size_t)tok * 1024 + col) = o;
    }
  }
}

#define LSTR 72
template <class Epi>
__device__ __forceinline__ void gemm_phase(const bf16_t* __restrict__ A, const bf16_t* __restrict__ Bt, int M, int N, int K, Epi epi, char* smem) {
  bf16_t* sA = (bf16_t*)smem;
  bf16_t* sB = sA + 2 * 128 * LSTR;
  const int tid = threadIdx.x, lane = tid & 63, w = tid >> 6;
  const int wm = w >> 1, wn = w & 1;
  const int ntn = (N + 127) >> 7, ntm = M >> 7;
  const int ntiles = ntm * ntn;
  const int KT = K >> 6;
  const int lrow = tid >> 3, lkc = (tid & 7) * 8;
  for (int tile = blockIdx.x; tile < ntiles; tile += gridDim.x) {
    const int m0 = (tile / ntn) << 7, n0 = (tile % ntn) << 7;
    f32x16 acc[2][2];
#pragma unroll
    for (int i = 0; i < 2; ++i)
#pragma unroll
      for (int j = 0; j < 2; ++j)
#pragma unroll
        for (int r = 0; r < 16; ++r) acc[i][j][r] = 0.f;
    const bf16_t* ap[4];
    const bf16_t* bp[4];
#pragma unroll
    for (int i = 0; i < 4; ++i) {
      int row = lrow + 32 * i;
      ap[i] = A + (size_t)(m0 + row) * K + lkc;
      int br = n0 + row;
      br = br < N ? br : N - 1;
      bp[i] = Bt + (size_t)br * K + lkc;
    }
    uint4 ra[4], rb[4];
#pragma unroll
    for (int i = 0; i < 4; ++i) { ra[i] = *(const uint4*)(ap[i]); rb[i] = *(const uint4*)(bp[i]); }
#pragma unroll
    for (int i = 0; i < 4; ++i) {
      *(uint4*)(sA + (lrow + 32 * i) * LSTR + lkc) = ra[i];
      *(uint4*)(sB + (lrow + 32 * i) * LSTR + lkc) = rb[i];
    }
    __syncthreads();
    for (int kt = 0; kt < KT; ++kt) {
      const int buf = kt & 1;
      if (kt + 1 < KT) {
#pragma unroll
        for (int i = 0; i < 4; ++i) { ra[i] = *(const uint4*)(ap[i] + (kt + 1) * 64); rb[i] = *(const uint4*)(bp[i] + (kt + 1) * 64); }
      }
      const bf16_t* cA = sA + buf * 128 * LSTR + (wm * 64 + (lane & 31)) * LSTR + (lane >> 5) * 8;
      const bf16_t* cB = sB + buf * 128 * LSTR + (wn * 64 + (lane & 31)) * LSTR + (lane >> 5) * 8;
#pragma unroll
      for (int kk = 0; kk < 4; ++kk) {
        bf16x8 a0 = *(const bf16x8*)(cA + kk * 16);
        bf16x8 a1 = *(const bf16x8*)(cA + 32 * LSTR + kk * 16);
        bf16x8 b0 = *(const bf16x8*)(cB + kk * 16);
        bf16x8 b1 = *(const bf16x8*)(cB + 32 * LSTR + kk * 16);
        acc[0][0] = __builtin_amdgcn_mfma_f32_32x32x16_bf16(a0, b0, acc[0][0], 0, 0, 0);
        acc[0][1] = __builtin_amdgcn_mfma_f32_32x32x16_bf16(a0, b1, acc[0][1], 0, 0, 0);
        acc[1][0] = __builtin_amdgcn_mfma_f32_32x32x16_bf16(a1, b0, acc[1][0], 0, 0, 0);
        acc[1][1] = __builtin_amdgcn_mfma_f32_32x32x16_bf16(a1, b1, acc[1][1], 0, 0, 0);
      }
      if (kt + 1 < KT) {
        bf16_t* dA = sA + (buf ^ 1) * 128 * LSTR;
        bf16_t* dB = sB + (buf ^ 1) * 128 * LSTR;
#pragma unroll
        for (int i = 0; i < 4; ++i) {
          *(uint4*)(dA + (lrow + 32 * i) * LSTR + lkc) = ra[i];
          *(uint4*)(dB + (lrow + 32 * i) * LSTR + lkc) = rb[i];
        }
      }
      __syncthreads();
    }
#pragma unroll
    for (int mi = 0; mi < 2; ++mi)
#pragma unroll
      for (int ni = 0; ni < 2; ++ni) {
        const int n = n0 + wn * 64 + ni * 32 + (lane & 31);
#pragma unroll
        for (int r = 0; r < 16; ++r) {
          const int m = m0 + wm * 64 + mi * 32 + (r & 3) + 8 * (r >> 2) + 4 * (lane >> 5);
          if (n < N) epi(m, n, acc[mi][ni][r]);
        }
      }
  }
}

struct EpiBf16 {
  bf16_t* C; int ldc;
  __device__ __forceinline__ void operator()(int m, int n, float v) const { C[(size_t)m * ldc + n] = f2bf(v); }
};
struct EpiSsdIn {
  bf16_t* C; float* DT; const float* dt_bias;
  __device__ __forceinline__ void operator()(int m, int n, float v) const {
    if (n < 6144) C[(size_t)m * 6144 + n] = f2bf(v);
    else {
      float x = v + dt_bias[n - 6144];
      float sp = x > 20.f ? x : log1pf(expf(x));
      DT[(size_t)m * 64 + (n - 6144)] = sp;
    }
  }
};
struct EpiRes {
  const float* xin_ctx; const float* xin_lat; float* X; const float* gate;
  __device__ __forceinline__ void operator()(int m, int n, float v) const {
    const float* xr = m < NCTX ? xin_ctx + (size_t)m * 1024 : xin_lat + (size_t)(m - NCTX) * 1024;
    X[(size_t)m * 1024 + n] = xr[n] + gate[(size_t)cidx(m) * 6144 + n] * v;
  }
};

__device__ __forceinline__ void conv_gate_phase(const Params& p) {
  const bf16_t* P = (const bf16_t*)(p.ws + OFF_BIG);
  bf16_t* G = (bf16_t*)(p.ws + OFF_BIG + 120 * MIB);
  const float* cw = p.sc_conv_w;
  const int total = NT * 128;
  for (int it = blockIdx.x * 256 + threadIdx.x; it < total; it += gridDim.x * 256) {
    const int tok = it >> 7, c = (it & 127) * 8;
    const int rowlen = tok < NCTX ? 256 : 64;
    const int pos = tok & (rowlen - 1);
    const bf16_t* pr = P + (size_t)tok * 3072;
    uint4 bg = *(const uint4*)(pr + c);
    uint4 cg = *(const uint4*)(pr + 1024 + c);
    uint4 xv = *(const uint4*)(pr + 2048 + c);
    uint4 cgl = make_uint4(0, 0, 0, 0), xvl = cgl, cgr = cgl, xvr = cgl;
    if (pos > 0) { cgl = *(const uint4*)(pr - 3072 + 1024 + c); xvl = *(const uint4*)(pr - 3072 + 2048 + c); }
    if (pos < rowlen - 1) { cgr = *(const uint4*)(pr + 3072 + 1024 + c); xvr = *(const uint4*)(pr + 3072 + 2048 + c); }
    const unsigned* bgp = (const unsigned*)&bg; const unsigned* cgp = (const unsigned*)&cg; const unsigned* xvp = (const unsigned*)&xv;
    const unsigned* cglp = (const unsigned*)&cgl; const unsigned* xvlp = (const unsigned*)&xvl;
    const unsigned* cgrp = (const unsigned*)&cgr; const unsigned* xvrp = (const unsigned*)&xvr;
    float4 w0a = *(const float4*)(cw + c), w0b = *(const float4*)(cw + c + 4);
    float4 w1a = *(const float4*)(cw + 1024 + c), w1b = *(const float4*)(cw + 1024 + c + 4);
    float4 w2a = *(const float4*)(cw + 2048 + c), w2b = *(const float4*)(cw + 2048 + c + 4);
    const float w0[8] = {w0a.x, w0a.y, w0a.z, w0a.w, w0b.x, w0b.y, w0b.z, w0b.w};
    const float w1[8] = {w1a.x, w1a.y, w1a.z, w1a.w, w1b.x, w1b.y, w1b.z, w1b.w};
    const float w2[8] = {w2a.x, w2a.y, w2a.z, w2a.w, w2b.x, w2b.y, w2b.z, w2b.w};
    unsigned o[4];
#pragma unroll
    for (int q = 0; q < 4; ++q) {
      float r0 = lo2f(bgp[q]) * (w0[2 * q] * lo2f(cglp[q]) * lo2f(xvlp[q]) + w1[2 * q] * lo2f(cgp[q]) * lo2f(xvp[q]) + w2[2 * q] * lo2f(cgrp[q]) * lo2f(xvrp[q]));
      float r1 = hi2f(bgp[q]) * (w0[2 * q + 1] * hi2f(cglp[q]) * hi2f(xvlp[q]) + w1[2 * q + 1] * hi2f(cgp[q]) * hi2f(xvp[q]) + w2[2 * q + 1] * hi2f(cgrp[q]) * hi2f(xvrp[q]));
      o[q] = pack2(r0, r1);
    }
    *(uint4*)(G + (size_t)tok * 1024 + c) = make_uint4(o[0], o[1], o[2], o[3]);
  }
}

__device__ __forceinline__ void topk_token(const float* Srow, int lane, int* idx_out, float* g_out) {
  unsigned res1 = 0, res2 = 0;
  {
    unsigned k0 = (fkey(Srow[lane]) & ~0x7Fu) | (unsigned)(127 - lane);
    unsigned k1 = (fkey(Srow[lane + 64]) & ~0x7Fu) | (unsigned)(63 - lane);
#pragma unroll 1
    for (int it = 0; it < 16; ++it) {
      unsigned wm = wave_max_u32(umax_(k0, k1));
      k0 = (k0 == wm) ? 0u : k0;
      k1 = (k1 == wm) ? 0u : k1;
      res1 = (lane == it) ? wm : res1;
    }
  }
  {
    unsigned k0 = (fkey(Srow[128 + lane]) & ~0x7Fu) | (unsigned)(127 - lane);
    unsigned k1 = (fkey(Srow[192 + lane]) & ~0x7Fu) | (unsigned)(63 - lane);
#pragma unroll 1
    for (int it = 0; it < 16; ++it) {
      unsigned wm = wave_max_u32(umax_(k0, k1));
      k0 = (k0 == wm) ? 0u : k0;
      k1 = (k1 == wm) ? 0u : k1;
      res2 = (lane == it) ? wm : res2;
    }
  }
  const float v2 = keyf((unsigned)__shfl((int)res2, lane & 15) & ~0x7Fu);
  unsigned ck[4];
#pragma unroll
  for (int m = 0; m < 4; ++m) {
    const int a = (lane >> 4) + 4 * m;
    const float v1 = keyf((unsigned)__shfl((int)res1, a) & ~0x7Fu);
    ck[m] = (fkey(v1 + v2) & ~0xFFu) | (unsigned)(255 - (lane + 64 * m));
  }
  unsigned resc = 0;
#pragma unroll 1
  for (int it = 0; it < 16; ++it) {
    unsigned wm = wave_max_u32(umax_(umax_(ck[0], ck[1]), umax_(ck[2], ck[3])));
#pragma unroll
    for (int m = 0; m < 4; ++m) ck[m] = (ck[m] == wm) ? 0u : ck[m];
    resc = (lane == it) ? wm : resc;
  }
  const int cpos = 255 - (int)(resc & 0xFFu);
  const int ca = cpos >> 4, cb = cpos & 15;
  const float val = keyf(resc & ~0xFFu);
  const unsigned r1 = (unsigned)__shfl((int)res1, ca);
  const unsigned r2 = (unsigned)__shfl((int)res2, cb);
  const int i1 = 127 - (int)(r1 & 0x7Fu), i2 = 127 - (int)(r2 & 0x7Fu);
  const float vmax = __shfl(val, 0);
  float e = (lane < 16) ? __expf(val - vmax) : 0.f;
  float s = row16_sum(e);
  if (lane < 16) {
    idx_out[lane] = i1 * 128 + i2;
    g_out[lane] = e / s;
  }
}

__device__ __forceinline__ void topk_phase(const Params& p, int layer, char* smem) {
  float* S = (float*)smem;
  const bf16_t* Q = (const bf16_t*)(p.ws + OFF_BIG);
  const bf16_t* KB = (const bf16_t*)(p.ws + OFF_KEYSB) + (size_t)layer * (8 * 2 * 128 * 128);
  int* IDX = (int*)(p.ws + OFF_IDX);
  float* GATE = (float*)(p.ws + OFF_GATE);
  const int tid = threadIdx.x, lane = tid & 63;
  const int w = __builtin_amdgcn_readfirstlane(tid >> 6);
  const int G = gridDim.x;
  const int per = (5120 + G - 1) / G;
  const int start = blockIdx.x * per;
  const int end = (start + per < 5120) ? start + per : 5120;
  const int pp = w >> 1, nt0 = (w & 1) * 2;
  int curh = -1;
  bf16x8 kf[2][8];
  for (int pr = start; pr < end; ++pr) {
    const int h = pr / 640, tile = pr % 640;
    const int t0 = tile * 32;
    if (h != curh) {
#pragma unroll
      for (int j = 0; j < 2; ++j)
#pragma unroll
        for (int kk = 0; kk < 8; ++kk)
          kf[j][kk] = *(const bf16x8*)(KB + ((size_t)((h * 2 + pp) * 128 + (nt0 + j) * 32 + (lane & 31))) * 128 + kk * 16 + (lane >> 5) * 8);
      curh = h;
    }
    f32x16 acc[2];
#pragma unroll
    for (int j = 0; j < 2; ++j)
#pragma unroll
      for (int r = 0; r < 16; ++r) acc[j][r] = 0.f;
    const bf16_t* qp = Q + (size_t)(t0 + (lane & 31)) * 2048 + h * 256 + pp * 128 + (lane >> 5) * 8;
#pragma unroll
    for (int kk = 0; kk < 8; ++kk) {
      bf16x8 a = *(const bf16x8*)(qp + kk * 16);
      acc[0] = __builtin_amdgcn_mfma_f32_32x32x16_bf16(a, kf[0][kk], acc[0], 0, 0, 0);
      acc[1] = __builtin_amdgcn_mfma_f32_32x32x16_bf16(a, kf[1][kk], acc[1], 0, 0, 0);
    }
#pragma unroll
    for (int j = 0; j < 2; ++j)
#pragma unroll
      for (int r = 0; r < 16; ++r) {
        const int tl = (r & 3) + 8 * (r >> 2) + 4 * (lane >> 5);
        S[tl * 256 + pp * 128 + (nt0 + j) * 32 + (lane & 31)] = acc[j][r];
      }
    __syncthreads();
#pragma unroll 1
    for (int q = 0; q < 8; ++q) {
      const int tl = w * 8 + q;
      const size_t ob = ((size_t)(t0 + tl) * 8 + h) * 16;
      topk_token(S + tl * 256, lane, IDX + ob, GATE + ob);
    }
    __syncthreads();
  }
}

typedef __attribute__((ext_vector_type(2))) float f32x2;
__device__ __forceinline__ unsigned u4get(const uint4 v, const int q) { return q == 0 ? v.x : (q == 1 ? v.y : (q == 2 ? v.z : v.w)); }
__device__ __forceinline__ void peer_phase(const Params& p, int layer, char* smem) {
  float* coefs = (float*)smem;
  int* idxs = (int*)(smem + 2048);
  const unsigned char* U8 = (const unsigned char*)(p.ws + (layer ? OFF_TAB1 : OFF_YB));
  const unsigned char* V8 = U8 + (size_t)16384 * 1024;
  const float* SCU = (const float*)(p.ws + OFF_SCALE) + (size_t)layer * 32768;
  const float* SCV = SCU + 16384;
  const bf16_t* A = (const bf16_t*)(p.ws + OFF_YF);
  const int* IDX = (const int*)(p.ws + OFF_IDX);
  const float* GATE = (const float*)(p.ws + OFF_GATE);
  const float* MOD = (const float*)(p.ws + OFF_MOD);
  float* X = p.out;
  const int lane = threadIdx.x & 63;
  const int w = __builtin_amdgcn_readfirstlane(threadIdx.x >> 6);
  const int sub = lane & 15, rg = lane >> 4;
  for (int tok = blockIdx.x * 4 + w; tok < NT; tok += gridDim.x * 4) {
    float t[64];
#pragma unroll
    for (int i = 0; i < 4; ++i) {
      const uint4* ap = (const uint4*)(A + (size_t)tok * 1024 + sub * 16 + 256 * i);
      const uint4 r0 = ap[0], r1 = ap[1];
#pragma unroll
      for (int q = 0; q < 4; ++q) {
        t[16 * i + 2 * q] = lo2f(u4get(r0, q)); t[16 * i + 2 * q + 1] = hi2f(u4get(r0, q));
        t[16 * i + 8 + 2 * q] = lo2f(u4get(r1, q)); t[16 * i + 8 + 2 * q + 1] = hi2f(u4get(r1, q));
      }
    }
#pragma unroll 2
    for (int it = 0; it < 32; ++it) {
      const int k = it * 4 + rg;
      const int e = IDX[(size_t)tok * 128 + k];
      const float gk = GATE[(size_t)tok * 128 + k];
      const float su = SCU[e];
      const float sv = SCV[e];
      const uint4* row = (const uint4*)(U8 + (size_t)e * 1024) + sub;
      uint4 r[4];
#pragma unroll
      for (int i = 0; i < 4; ++i) r[i] = row[16 * i];
      float acc0 = 0.f, acc1 = 0.f;
#pragma unroll
      for (int i = 0; i < 4; ++i) {
#pragma unroll
        for (int q = 0; q < 4; ++q) {
          const int rw = (int)u4get(r[i], q);
          f32x2 lo = __builtin_amdgcn_cvt_pk_f32_fp8(rw, false);
          f32x2 hi = __builtin_amdgcn_cvt_pk_f32_fp8(rw, true);
          acc0 += lo[0] * t[16 * i + 4 * q] + hi[0] * t[16 * i + 4 * q + 2];
          acc1 += lo[1] * t[16 * i + 4 * q + 1] + hi[1] * t[16 * i + 4 * q + 3];
        }
      }
      float acc = row16_sum(acc0 + acc1) * su;
      const float co = 0.5f * acc * (1.f + erff(acc * 0.70710678118654752f)) * gk * sv;
      if (sub == 0) { coefs[w * 128 + k] = co; idxs[w * 128 + k] = e; }
    }
    float o[16];
#pragma unroll
    for (int i = 0; i < 16; ++i) o[i] = 0.f;
#pragma unroll 1
    for (int k = 0; k < 128; k += 16) {
      uint4 r[16]; float c[16];
#pragma unroll
      for (int j = 0; j < 16; ++j) {
        const int e = __builtin_amdgcn_readfirstlane(idxs[w * 128 + k + j]);
        c[j] = coefs[w * 128 + k + j];
        r[j] = *((const uint4*)(V8 + (size_t)e * 1024) + lane);
      }
#pragma unroll
      for (int j = 0; j < 16; ++j) {
#pragma unroll
        for (int q = 0; q < 4; ++q) {
          const int rw = (int)u4get(r[j], q);
          f32x2 lo = __builtin_amdgcn_cvt_pk_f32_fp8(rw, false);
          f32x2 hi = __builtin_amdgcn_cvt_pk_f32_fp8(rw, true);
          o[4 * q] += c[j] * lo[0]; o[4 * q + 1] += c[j] * lo[1];
          o[4 * q + 2] += c[j] * hi[0]; o[4 * q + 3] += c[j] * hi[1];
        }
      }
    }
    const float* gate = MOD + (size_t)(layer * 5 + cidx(tok)) * 6144 + 5 * 1024;
#pragma unroll
    for (int i = 0; i < 4; ++i) {
      const int col = lane * 16 + 4 * i;
      float4 xv = *(const float4*)(X + (size_t)tok * 1024 + col);
      float4 gt = *(const float4*)(gate + col);
      xv.x += gt.x * o[4 * i]; xv.y += gt.y * o[4 * i + 1]; xv.z += gt.z * o[4 * i + 2]; xv.w += gt.w * o[4 * i + 3];
      *(float4*)(X + (size_t)tok * 1024 + col) = xv;
    }
  }
}

__device__ __forceinline__ void ssd_conv_phase(const Params& p) {
  bf16_t* BIG = (bf16_t*)(p.ws + OFF_BIG);
  const float* cw = p.ssd_conv_w;
  const float* cb = p.ssd_conv_b;
  const int total = 272 * 512;
  for (int it = blockIdx.x * 256 + threadIdx.x; it < total; it += gridDim.x * 256) {
    const int c8 = it & 511, r = it >> 9;
    const int c = c8 * 8;
    int tok0, len;
    if (r < 16) { tok0 = r * 256; len = 256; } else { tok0 = NCTX + (r - 16) * 64; len = 64; }
    float w0[8], w1[8], w2[8], bb[8];
#pragma unroll
    for (int j = 0; j < 8; ++j) { w0[j] = cw[c + j]; w1[j] = cw[4096 + c + j]; w2[j] = cw[8192 + c + j]; bb[j] = cb[c + j]; }
    bf16_t* base = BIG + (size_t)tok0 * 6144 + 2048 + c;
    uint4 buf[8], nxt[8];
#pragma unroll
    for (int j = 0; j < 8; ++j) buf[j] = *(const uint4*)(base + (size_t)j * 6144);
    uint4 prev = make_uint4(0, 0, 0, 0);
    for (int t0 = 0; t0 < len; t0 += 8) {
      const bool more = (t0 + 8) < len;
#pragma unroll
      for (int j = 0; j < 8; ++j) nxt[j] = more ? *(const uint4*)(base + (size_t)(t0 + 8 + j) * 6144) : make_uint4(0, 0, 0, 0);
#pragma unroll
      for (int j = 0; j < 8; ++j) {
        const uint4 cur = buf[j];
        const uint4 nx = (j < 7) ? buf[j + 1] : nxt[0];
        const unsigned* pp = (const unsigned*)&prev; const unsigned* cp = (const unsigned*)&cur; const unsigned* np = (const unsigned*)&nx;
        unsigned o[4];
#pragma unroll
        for (int q = 0; q < 4; ++q) {
          float a0 = w0[2 * q] * lo2f(pp[q]) + w1[2 * q] * lo2f(cp[q]) + w2[2 * q] * lo2f(np[q]) + bb[2 * q];
          float a1 = w0[2 * q + 1] * hi2f(pp[q]) + w1[2 * q + 1] * hi2f(cp[q]) + w2[2 * q + 1] * hi2f(np[q]) + bb[2 * q + 1];
          o[q] = pack2(siluf(a0), siluf(a1));
        }
        *(uint4*)(base + (size_t)(t0 + j) * 6144) = make_uint4(o[0], o[1], o[2], o[3]);
        prev = cur;
      }
#pragma unroll
      for (int j = 0; j < 8; ++j) buf[j] = nxt[j];
    }
  }
}

__device__ __forceinline__ void scan_phase(const Params& p, char* smem) {
  float* xs = (float*)smem;
  float* Bs = xs + 2 * 16 * 64;
  float* Cs = Bs + 2 * 16 * 128;
  float* dts = Cs + 2 * 16 * 128;
  float* yb = dts + 64;
  const bf16_t* BIG = (const bf16_t*)(p.ws + OFF_BIG);
  const float* DT = (const float*)(p.ws + OFF_DT);
  const int tid = threadIdx.x, lane = tid & 63;
  const int w = __builtin_amdgcn_readfirstlane(tid >> 6);
  const int stt = tid >> 4, ssub = tid & 15;
  for (int item = blockIdx.x; item < 1280; item += gridDim.x) {
    int b, head, dir, L, tok0;
    const bool latent = item < 256;
    if (latent) { b = item >> 6; head = (item >> 1) & 31; dir = item & 1; L = 4096; tok0 = NCTX + b * 4096; }
    else { int j = item - 256; b = j >> 6; head = (j >> 1) & 31; dir = j & 1; L = 256; tok0 = b * 256; }
    const int g = head >> 2;
    const float a = -expf(p.ssd_a_log[dir * 32 + head]);
    bf16_t* Y = (bf16_t*)(p.ws + (dir ? OFF_YB : OFF_YF));
    float h[32];
    if (latent) {
      const float* sp = p.state_ssm + ((size_t)((b * 2 + dir) * 32 + head)) * 8192 + lane * 128 + w * 32;
#pragma unroll
      for (int i = 0; i < 8; ++i) { float4 v = *(const float4*)(sp + 4 * i); h[4 * i] = v.x; h[4 * i + 1] = v.y; h[4 * i + 2] = v.z; h[4 * i + 3] = v.w; }
    } else {
#pragma unroll
      for (int i = 0; i < 32; ++i) h[i] = 0.f;
    }
    const int nb = L >> 4;
    uint4 rbc0, rbc1; uint2 rx; float rdt;
    {
      const int t = stt;
      const int tok = tok0 + (dir ? L - 1 - t : t);
      const bf16_t* rowp = BIG + (size_t)tok * 6144;
      const bf16_t* bc = rowp + (ssub < 8 ? 4096 + g * 128 + ssub * 16 : 5120 + g * 128 + (ssub - 8) * 16);
      rbc0 = *(const uint4*)(bc); rbc1 = *(const uint4*)(bc + 8);
      rx = *(const uint2*)(rowp + 2048 + head * 64 + ssub * 4);
      rdt = DT[(size_t)tok * 64 + dir * 32 + head];
    }
    __syncthreads();
    {
      float* dst = (ssub < 8 ? Bs : Cs) + (0 * 16 + stt) * 128 + (ssub & 7) * 16;
      const unsigned* q0 = (const unsigned*)&rbc0; const unsigned* q1 = (const unsigned*)&rbc1;
#pragma unroll
      for (int j = 0; j < 4; ++j) { dst[2 * j] = lo2f(q0[j]); dst[2 * j + 1] = hi2f(q0[j]); dst[8 + 2 * j] = lo2f(q1[j]); dst[8 + 2 * j + 1] = hi2f(q1[j]); }
      float* xd = xs + (0 * 16 + stt) * 64 + ssub * 4;
      xd[0] = lo2f(rx.x); xd[1] = hi2f(rx.x); xd[2] = lo2f(rx.y); xd[3] = hi2f(rx.y);
      if (ssub == 0) dts[stt] = rdt;
    }
    __syncthreads();
    for (int k = 0; k < nb; ++k) {
      const int buf = k & 1;
      if (k + 1 < nb) {
        const int t = (k + 1) * 16 + stt;
        const int tok = tok0 + (dir ? L - 1 - t : t);
        const bf16_t* rowp = BIG + (size_t)tok * 6144;
        const bf16_t* bc = rowp + (ssub < 8 ? 4096 + g * 128 + ssub * 16 : 5120 + g * 128 + (ssub - 8) * 16);
        rbc0 = *(const uint4*)(bc); rbc1 = *(const uint4*)(bc + 8);
        rx = *(const uint2*)(rowp + 2048 + head * 64 + ssub * 4);
        rdt = DT[(size_t)tok * 64 + dir * 32 + head];
      }
#pragma unroll 2
      for (int tt = 0; tt < 16; ++tt) {
        const float dtv = dts[buf * 16 + tt];
        const float dA = __expf(dtv * a);
        const float xv = xs[(buf * 16 + tt) * 64 + lane];
        const float dtx = dtv * xv;
        const float4* bp = (const float4*)(Bs + (buf * 16 + tt) * 128 + w * 32);
        const float4* cp = (const float4*)(Cs + (buf * 16 + tt) * 128 + w * 32);
        float y0 = 0.f, y1 = 0.f;
#pragma unroll
        for (int i = 0; i < 8; ++i) {
          const float4 bv = bp[i], cv = cp[i];
          h[4 * i] = h[4 * i] * dA + dtx * bv.x;         y0 += h[4 * i] * cv.x;
          h[4 * i + 1] = h[4 * i + 1] * dA + dtx * bv.y; y1 += h[4 * i + 1] * cv.y;
          h[4 * i + 2] = h[4 * i + 2] * dA + dtx * bv.z; y0 += h[4 * i + 2] * cv.z;
          h[4 * i + 3] = h[4 * i + 3] * dA + dtx * bv.w; y1 += h[4 * i + 3] * cv.w;
        }
        yb[((buf * 16 + tt) * 4 + w) * 64 + lane] = y0 + y1;
      }
      if (k + 1 < nb) {
        const int nbuf = buf ^ 1;
        float* dst = (ssub < 8 ? Bs : Cs) + (nbuf * 16 + stt) * 128 + (ssub & 7) * 16;
        const unsigned* q0 = (const unsigned*)&rbc0; const unsigned* q1 = (const unsigned*)&rbc1;
#pragma unroll
        for (int j = 0; j < 4; ++j) { dst[2 * j] = lo2f(q0[j]); dst[2 * j + 1] = hi2f(q0[j]); dst[8 + 2 * j] = lo2f(q1[j]); dst[8 + 2 * j + 1] = hi2f(q1[j]); }
        float* xd = xs + (nbuf * 16 + stt) * 64 + ssub * 4;
        xd[0] = lo2f(rx.x); xd[1] = hi2f(rx.x); xd[2] = lo2f(rx.y); xd[3] = hi2f(rx.y);
        if (ssub == 0) dts[nbuf * 16 + stt] = rdt;
      }
      __syncthreads();
      {
        float4 s = make_float4(0.f, 0.f, 0.f, 0.f);
#pragma unroll
        for (int ww = 0; ww < 4; ++ww) {
          float4 v = *(const float4*)(yb + ((buf * 16 + stt) * 4 + ww) * 64 + ssub * 4);
          s.x += v.x; s.y += v.y; s.z += v.z; s.w += v.w;
        }
        const int t = k * 16 + stt;
        const int tok = tok0 + (dir ? L - 1 - t : t);
        uint2 o; o.x = pack2(s.x, s.y); o.y = pack2(s.z, s.w);
        *(uint2*)(Y + (size_t)tok * 2048 + head * 64 + ssub * 4) = o;
      }
    }
    if (!latent) {
      float* sp = p.out + (size_t)NT * 1024 + ((size_t)((b * 2 + dir) * 32 + head)) * 8192 + lane * 128 + w * 32;
#pragma unroll
      for (int i = 0; i < 8; ++i) *(float4*)(sp + 4 * i) = make_float4(h[4 * i], h[4 * i + 1], h[4 * i + 2], h[4 * i + 3]);
    }
  }
}

__device__ __forceinline__ void gate_norm_phase(const Params& p) {
  const bf16_t* BIG = (const bf16_t*)(p.ws + OFF_BIG);
  bf16_t* YF = (bf16_t*)(p.ws + OFF_YF);
  const bf16_t* YB = (const bf16_t*)(p.ws + OFF_YB);
  const int lane = threadIdx.x & 63, w = threadIdx.x >> 6;
  for (int tok = blockIdx.x * 4 + w; tok < NT; tok += gridDim.x * 4) {
    float v[32];
    float ss = 0.f;
#pragma unroll
    for (int i = 0; i < 4; ++i) {
      const int col = lane * 8 + 512 * i;
      const int head = col >> 6;
      const float dtot = p.ssd_d[head] + p.ssd_d[32 + head];
      uint4 a = *(const uint4*)(YF + (size_t)tok * 2048 + col);
      uint4 b = *(const uint4*)(YB + (size_t)tok * 2048 + col);
      uint4 x = *(const uint4*)(BIG + (size_t)tok * 6144 + 2048 + col);
      uint4 z = *(const uint4*)(BIG + (size_t)tok * 6144 + col);
      const unsigned* ap = (const unsigned*)&a; const unsigned* bp = (const unsigned*)&b;
      const unsigned* xp = (const unsigned*)&x; const unsigned* zp = (const unsigned*)&z;
#pragma unroll
      for (int q = 0; q < 4; ++q) {
        float y0 = lo2f(ap[q]) + lo2f(bp[q]) + dtot * lo2f(xp[q]);
        float y1 = hi2f(ap[q]) + hi2f(bp[q]) + dtot * hi2f(xp[q]);
        y0 *= siluf(lo2f(zp[q]));
        y1 *= siluf(hi2f(zp[q]));
        v[8 * i + 2 * q] = y0; v[8 * i + 2 * q + 1] = y1;
        ss += y0 * y0 + y1 * y1;
      }
    }
    ss = wave_sum(ss);
    const float sc = rsqrtf(ss * (1.f / 2048.f) + 1e-6f);
#pragma unroll
    for (int i = 0; i < 4; ++i) {
      const int col = lane * 8 + 512 * i;
      float4 g0 = *(const float4*)(p.ssd_norm_g + col), g1 = *(const float4*)(p.ssd_norm_g + col + 4);
      uint4 o;
      o.x = pack2(v[8 * i] * sc * g0.x, v[8 * i + 1] * sc * g0.y);
      o.y = pack2(v[8 * i + 2] * sc * g0.z, v[8 * i + 3] * sc * g0.w);
      o.z = pack2(v[8 * i + 4] * sc * g1.x, v[8 * i + 5] * sc * g1.y);
      o.w = pack2(v[8 * i + 6] * sc * g1.z, v[8 * i + 7] * sc * g1.w);
      *(uint4*)(YF + (size_t)tok * 2048 + col) = o;
    }
  }
}

__device__ __forceinline__ void final_norm_phase(const Params& p) {
  const int lane = threadIdx.x & 63, w = threadIdx.x >> 6;
  for (int tok = blockIdx.x * 4 + w; tok < NT; tok += gridDim.x * 4) {
    float* xr = p.out + (size_t)tok * 1024;
    float4 v[4];
    float ss = 0.f;
#pragma unroll
    for (int i = 0; i < 4; ++i) {
      v[i] = *(const float4*)(xr + lane * 4 + 256 * i);
      ss += v[i].x * v[i].x + v[i].y * v[i].y + v[i].z * v[i].z + v[i].w * v[i].w;
    }
    ss = wave_sum(ss);
    const float sc = rsqrtf(ss * (1.f / 1024.f) + 1e-6f);
#pragma unroll
    for (int i = 0; i < 4; ++i) {
      const int col = lane * 4 + 256 * i;
      float4 gg = *(const float4*)(p.norm_f_g + col);
      *(float4*)(xr + col) = make_float4(v[i].x * sc * gg.x, v[i].y * sc * gg.y, v[i].z * sc * gg.z, v[i].w * sc * gg.w);
    }
  }
}

#define N_PHASES 20
__global__ void __launch_bounds__(256, 2) mk(Params p, int ph_begin, int ph_end) {
  __shared__ __attribute__((aligned(16))) char smem[SMEM_BYTES];
  bf16_t* WT = (bf16_t*)(p.ws + OFF_WT);
  bf16_t* BIG = (bf16_t*)(p.ws + OFF_BIG);
  bf16_t* Abuf = (bf16_t*)(p.ws + OFF_YF);
  float* MOD = (float*)(p.ws + OFF_MOD);
#define RUN(PH, CALL) if (ph_begin <= PH && PH < ph_end) { CALL; if (PH + 1 < ph_end) cg::this_grid().sync(); }
  RUN(0, prep_phase(p, smem))
  RUN(1, norm_mod_phase(p, 0, 0, true))
  RUN(2, gemm_phase(Abuf, WT + WT_SCIN, NT, 3072, 1024, EpiBf16{BIG, 3072}, smem))
  RUN(3, conv_gate_phase(p))
  RUN(4, gemm_phase((const bf16_t*)(p.ws + OFF_BIG + 120 * MIB), WT + WT_SCOUT, NT, 1024, 1024,
                    EpiRes{p.x_prompt, p.x_sample, p.out, MOD + 0 * 5 * 6144 + 2 * 1024}, smem))
  RUN(5, norm_mod_phase(p, 0, 1, false))
  RUN(6, gemm_phase(Abuf, WT + WT_WQ, NT, 2048, 1024, EpiBf16{BIG, 2048}, smem))
  RUN(7, topk_phase(p, 0, smem))
  RUN(8, peer_phase(p, 0, smem))
  RUN(9, norm_mod_phase(p, 1, 0, false))
  RUN(10, gemm_phase(Abuf, WT + WT_SSDIN, NT, 6208, 1024, EpiSsdIn{BIG, (float*)(p.ws + OFF_DT), p.ssd_dt_bias}, smem))
  RUN(11, ssd_conv_phase(p))
  RUN(12, scan_phase(p, smem))
  RUN(13, gate_norm_phase(p))
  RUN(14, gemm_phase(Abuf, WT + WT_SSDOUT, NT, 1024, 2048,
                     EpiRes{p.out, p.out + (size_t)NCTX * 1024, p.out, MOD + 1 * 5 * 6144 + 2 * 1024}, smem))
  RUN(15, norm_mod_phase(p, 1, 1, false))
  RUN(16, gemm_phase(Abuf, WT + WT_WQ + (size_t)2048 * 1024, NT, 2048, 1024, EpiBf16{BIG, 2048}, smem))
  RUN(17, topk_phase(p, 1, smem))
  RUN(18, peer_phase(p, 1, smem))
  RUN(19, final_norm_phase(p))
}

extern "C" void kernel_launch(void* const* d_in, const int* in_sizes, int n_in, void* d_out, int out_size, void* d_ws, size_t ws_size,
                              hipStream_t stream) {
  static int grid_blocks = 0;
  if (!grid_blocks) {
    int dev = 0, cus = 0, per_cu = 0;
    hipGetDevice(&dev);
    hipDeviceGetAttribute(&cus, hipDeviceAttributeMultiprocessorCount, dev);
    hipOccupancyMaxActiveBlocksPerMultiprocessor(&per_cu, mk, 256, 0);
    if (per_cu < 1) per_cu = 1;
    if (per_cu > 2) per_cu = 2;
    grid_blocks = cus * per_cu;
  }
  if (ws_size < WS_NEEDED) { fprintf(stderr, "workspace too small: %zu\n", ws_size); return; }
  Params p{};
  const float** pf = (const float**)&p;
  for (int i = 0; i < 25; ++i) pf[i] = (const float*)d_in[i];
  p.out = (float*)d_out;
  p.ws = (char*)d_ws;
#if COOP
  int b = 0, e = N_PHASES;
  void* args[] = {&p, &b, &e};
  hipError_t err = hipLaunchCooperativeKernel((void*)mk, dim3(grid_blocks), dim3(256), args, 0, stream);
  if (err != hipSuccess) fprintf(stderr, "cooperative launch failed: %s (grid %d)\n", hipGetErrorString(err), grid_blocks);
#else
  for (int ph = 0; ph < N_PHASES; ++ph) {
    hipLaunchKernelGGL(mk, dim3(grid_blocks), dim3(256), 0, stream, p, ph, ph + 1);
    if ((DUP_MASK >> ph) & 1) hipLaunchKernelGGL(mk, dim3(grid_blocks), dim3(256), 0, stream, p, ph, ph + 1);
  }
#endif
}
```

```cpp
#include <hip/hip_runtime.h>
#include <hip/hip_cooperative_groups.h>
#include <cstdio>
namespace cg = cooperative_groups;

#ifndef COOP
#define COOP 1
#endif
#ifndef DUP_MASK
#define DUP_MASK 0
#endif

typedef unsigned short bf16_t;
typedef __attribute__((ext_vector_type(8))) short bf16x8;
typedef __attribute__((ext_vector_type(16))) float f32x16;

#define NT 20480
#define NCTX 4096
#define DM 1024
#define MIB ((size_t)1 << 20)
#define OFF_BIG   ((size_t)0)
#define OFF_YF    (240 * MIB)
#define OFF_YB    (320 * MIB)
#define OFF_WT    (400 * MIB)
#define OFF_KEYSB (433 * MIB)
#define OFF_DT    (434 * MIB)
#define OFF_MOD   (439 * MIB)
#define OFF_IDX   (440 * MIB)
#define OFF_GATE  (450 * MIB)
#define OFF_TAB1  (460 * MIB)
#define OFF_SCALE (492 * MIB)
#define WS_NEEDED (493 * MIB)
#define WT_SCIN   ((size_t)0)
#define WT_SCOUT  (WT_SCIN + (size_t)3072 * 1024)
#define WT_SSDIN  (WT_SCOUT + (size_t)1024 * 1024)
#define WT_SSDOUT (WT_SSDIN + (size_t)6208 * 1024)
#define WT_WQ     (WT_SSDOUT + (size_t)1024 * 2048)

#define SMEM_BYTES 75776

struct Params {
  const float *x_prompt, *x_sample, *state_ssm, *c, *c_ctx, *norm_mix_g, *norm_ffn_g, *norm_f_g, *ada_w, *ada_b;
  const float *sc_w_in, *sc_conv_w, *sc_w_out, *ssd_w_in, *ssd_conv_w, *ssd_conv_b, *ssd_dt_bias, *ssd_a_log, *ssd_d;
  const float *ssd_norm_g, *ssd_w_out, *peer_wq, *peer_keys, *peer_u, *peer_v;
  float* out;
  char* ws;
};

__device__ __forceinline__ float bf2f(bf16_t h) { return __uint_as_float(((unsigned)h) << 16); }
__device__ __forceinline__ bf16_t f2bf(float f) {
  unsigned u = __float_as_uint(f);
  u += 0x7FFFu + ((u >> 16) & 1u);
  return (bf16_t)(u >> 16);
}
__device__ __forceinline__ unsigned pack2(float a, float b) { return (unsigned)f2bf(a) | ((unsigned)f2bf(b) << 16); }
__device__ __forceinline__ float lo2f(unsigned u) { return __uint_as_float(u << 16); }
__device__ __forceinline__ float hi2f(unsigned u) { return __uint_as_float(u & 0xffff0000u); }
__device__ __forceinline__ float siluf(float x) { return x / (1.f + __expf(-x)); }
__device__ __forceinline__ int cidx(int tok) { return tok < NCTX ? 0 : 1 + ((tok - NCTX) >> 12); }

template <int CTRL>
__device__ __forceinline__ unsigned dpp_u(unsigned v) {
  return (unsigned)__builtin_amdgcn_update_dpp(0, (int)v, CTRL, 0xF, 0xF, true);
}
template <int CTRL>
__device__ __forceinline__ float dpp_f(float v) {
  return __int_as_float(__builtin_amdgcn_update_dpp(0, __float_as_int(v), CTRL, 0xF, 0xF, true));
}
__device__ __forceinline__ float row16_sum(float v) {
  v += dpp_f<0xB1>(v);
  v += dpp_f<0x4E>(v);
  v += dpp_f<0x141>(v);
  v += dpp_f<0x140>(v);
  return v;
}
__device__ __forceinline__ unsigned umax_(unsigned a, unsigned b) { return a > b ? a : b; }
__device__ __forceinline__ unsigned wave_max_u32(unsigned v) {
  v = umax_(v, dpp_u<0xB1>(v));
  v = umax_(v, dpp_u<0x4E>(v));
  v = umax_(v, dpp_u<0x141>(v));
  v = umax_(v, dpp_u<0x140>(v));
  unsigned a = (unsigned)__builtin_amdgcn_readlane((int)v, 0);
  unsigned b = (unsigned)__builtin_amdgcn_readlane((int)v, 16);
  unsigned c = (unsigned)__builtin_amdgcn_readlane((int)v, 32);
  unsigned d = (unsigned)__builtin_amdgcn_readlane((int)v, 48);
  return umax_(umax_(a, b), umax_(c, d));
}
__device__ __forceinline__ float wave_sum(float v) {
  v = row16_sum(v);
  float a, b, c, d;
  a = __int_as_float(__builtin_amdgcn_readlane(__float_as_int(v), 0));
  b = __int_as_float(__builtin_amdgcn_readlane(__float_as_int(v), 16));
  c = __int_as_float(__builtin_amdgcn_readlane(__float_as_int(v), 32));
  d = __int_as_float(__builtin_amdgcn_readlane(__float_as_int(v), 48));
  return (a + b) + (c + d);
}
__device__ __forceinline__ unsigned fkey(float f) {
  unsigned u = __float_as_uint(f);
  return (u & 0x80000000u) ? ~u : (u | 0x80000000u);
}
__device__ __forceinline__ float keyf(unsigned k) {
  unsigned u = (k & 0x80000000u) ? (k & 0x7fffffffu) : ~k;
  return __uint_as_float(u);
}

__device__ __forceinline__ void transpose_tile(const float* __restrict__ src, int K, int N, bf16_t* __restrict__ dst, int tile, float* tb) {
  const int tid = threadIdx.x;
  const int ntn = N >> 6;
  const int kt = tile / ntn, nt = tile % ntn;
  {
    const int n = tid & 63, kb = tid >> 6;
#pragma unroll
    for (int i = 0; i < 16; ++i) {
      int k = kb + 4 * i;
      tb[k * 65 + n] = src[(size_t)(kt * 64 + k) * N + nt * 64 + n];
    }
  }
  __syncthreads();
  {
    const int k8 = (tid & 7) * 8;
#pragma unroll
    for (int pass = 0; pass < 2; ++pass) {
      int n = (tid >> 3) + 32 * pass;
      uint4 o;
      o.x = pack2(tb[(k8 + 0) * 65 + n], tb[(k8 + 1) * 65 + n]);
      o.y = pack2(tb[(k8 + 2) * 65 + n], tb[(k8 + 3) * 65 + n]);
      o.z = pack2(tb[(k8 + 4) * 65 + n], tb[(k8 + 5) * 65 + n]);
      o.w = pack2(tb[(k8 + 6) * 65 + n], tb[(k8 + 7) * 65 + n]);
      *(uint4*)(dst + (size_t)(nt * 64 + n) * K + kt * 64 + k8) = o;
    }
  }
  __syncthreads();
}

__device__ __forceinline__ void prep_phase(const Params& p, char* smem) {
  const int tid = threadIdx.x;
  bf16_t* WT = (bf16_t*)(p.ws + OFF_WT);
  float* MOD = (float*)(p.ws + OFF_MOD);
  bf16_t* KEYSB = (bf16_t*)(p.ws + OFF_KEYSB);
  const int U_MOD = 192, U_T0 = 768, U_T1 = 256, U_T2 = 1552, U_T3 = 512, U_T4 = 1024, U_KEYS = 256, U_TAB = 16384;
  const int total = U_MOD + U_T0 + U_T1 + U_T2 + U_T3 + U_T4 + U_KEYS + U_TAB;
  for (int u = blockIdx.x; u < total; u += gridDim.x) {
    int v = u;
    if (v < U_MOD) {
      float* scond = (float*)smem;
      float* red = scond + 5 * 1024;
      for (int i = tid; i < 5 * 1024; i += 256) {
        int r = i >> 10, k = i & 1023;
        float cv = (r == 0) ? p.c_ctx[k] : p.c[(r - 1) * 1024 + k];
        scond[i] = siluf(cv);
      }
      __syncthreads();
      const int l = v / 96, jc = v % 96;
      const int jj = tid & 63, kq = tid >> 6;
      const int j = jc * 64 + jj;
      float acc[5] = {0.f, 0.f, 0.f, 0.f, 0.f};
      const float* wp = p.ada_w + ((size_t)l * 1024 + kq * 256) * 6144 + j;
#pragma unroll 8
      for (int k = 0; k < 256; ++k) {
        float wv = wp[(size_t)k * 6144];
#pragma unroll
        for (int r = 0; r < 5; ++r) acc[r] += scond[r * 1024 + kq * 256 + k] * wv;
      }
#pragma unroll
      for (int r = 0; r < 5; ++r) red[(kq * 5 + r) * 64 + jj] = acc[r];
      __syncthreads();
      for (int i = tid; i < 320; i += 256) {
        int r = i >> 6, j2 = i & 63;
        float s = red[(0 * 5 + r) * 64 + j2] + red[(1 * 5 + r) * 64 + j2] + red[(2 * 5 + r) * 64 + j2] + red[(3 * 5 + r) * 64 + j2];
        MOD[(size_t)(l * 5 + r) * 6144 + jc * 64 + j2] = s + p.ada_b[l * 6144 + jc * 64 + j2];
      }
      __syncthreads();
      continue;
    }
    v -= U_MOD;
    float* tb = (float*)smem;
    if (v < U_T0) { transpose_tile(p.sc_w_in, 1024, 3072, WT + WT_SCIN, v, tb); continue; }
    v -= U_T0;
    if (v < U_T1) { transpose_tile(p.sc_w_out, 1024, 1024, WT + WT_SCOUT, v, tb); continue; }
    v -= U_T1;
    if (v < U_T2) { transpose_tile(p.ssd_w_in, 1024, 6208, WT + WT_SSDIN, v, tb); continue; }
    v -= U_T2;
    if (v < U_T3) { transpose_tile(p.ssd_w_out, 2048, 1024, WT + WT_SSDOUT, v, tb); continue; }
    v -= U_T3;
    if (v < U_T4) {
      int l = v >> 9, t = v & 511;
      transpose_tile(p.peer_wq + (size_t)l * 1024 * 2048, 1024, 2048, WT + WT_WQ + (size_t)l * 2048 * 1024, t, tb);
      continue;
    }
    v -= U_T4;
    if (v < U_KEYS) {
      size_t base = (size_t)v * 2048 + tid * 8;
      float4 a = *(const float4*)(p.peer_keys + base);
      float4 b = *(const float4*)(p.peer_keys + base + 4);
      uint4 o;
      o.x = pack2(a.x, a.y); o.y = pack2(a.z, a.w); o.z = pack2(b.x, b.y); o.w = pack2(b.z, b.w);
      *(uint4*)(KEYSB + base) = o;
      continue;
    }
    v -= U_KEYS;
    {
      const int lane = tid & 63;
      const int gr = v * 4 + (tid >> 6);
      const int l = gr >> 15, tab = (gr >> 14) & 1, row = gr & 16383;
      const float* src = (tab ? p.peer_v : p.peer_u) + ((size_t)l * 16384 + row) * 1024 + lane * 16;
      float4 x[4];
      float am = 0.f;
#pragma unroll
      for (int j = 0; j < 4; ++j) {
        x[j] = *(const float4*)(src + 4 * j);
        am = fmaxf(am, fmaxf(fmaxf(fabsf(x[j].x), fabsf(x[j].y)), fmaxf(fabsf(x[j].z), fabsf(x[j].w))));
      }
      am = __uint_as_float(wave_max_u32(__float_as_uint(am)));
      const float inv = am > 0.f ? 440.f / am : 0.f;
      const float scale = am > 0.f ? am / 440.f : 0.f;
      unsigned o[4];
#pragma unroll
      for (int j = 0; j < 4; ++j) {
        int wv = __builtin_amdgcn_cvt_pk_fp8_f32(x[j].x * inv, x[j].y * inv, 0, false);
        wv = __builtin_amdgcn_cvt_pk_fp8_f32(x[j].z * inv, x[j].w * inv, wv, true);
        o[j] = (unsigned)wv;
      }
      unsigned char* dst = (unsigned char*)(p.ws + (l ? OFF_TAB1 : OFF_YB)) + ((size_t)tab * 16384 + row) * 1024 + lane * 16;
      *(uint4*)dst = make_uint4(o[0], o[1], o[2], o[3]);
      if (lane == 0) ((float*)(p.ws + OFF_SCALE))[gr] = scale;
    }
  }
}

__device__ __forceinline__ void norm_mod_phase(const Params& p, int layer, int which, bool from_input) {
  const float* g = (which == 0 ? p.norm_mix_g : p.norm_ffn_g) + layer * 1024;
  const float* MOD = (const float*)(p.ws + OFF_MOD);
  bf16_t* A = (bf16_t*)(p.ws + OFF_YF);
  const int lane = threadIdx.x & 63, w = threadIdx.x >> 6;
  for (int tok = blockIdx.x * 4 + w; tok < NT; tok += gridDim.x * 4) {
    const float* xr = from_input ? (tok < NCTX ? p.x_prompt + (size_t)tok * 1024 : p.x_sample + (size_t)(tok - NCTX) * 1024)
                                 : p.out + (size_t)tok * 1024;
    const float* md = MOD + (size_t)(layer * 5 + cidx(tok)) * 6144 + (which ? 3 * 1024 : 0);
    float4 v[4];
    float ss = 0.f;
#pragma unroll
    for (int i = 0; i < 4; ++i) {
      v[i] = *(const float4*)(xr + lane * 4 + 256 * i);
      ss += v[i].x * v[i].x + v[i].y * v[i].y + v[i].z * v[i].z + v[i].w * v[i].w;
    }
    ss = wave_sum(ss);
    const float sc = rsqrtf(ss * (1.f / 1024.f) + 1e-6f);
#pragma unroll
    for (int i = 0; i < 4; ++i) {
      const int col = lane * 4 + 256 * i;
      float4 gg = *(const float4*)(g + col);
      float4 sh = *(const float4*)(md + col);
      float4 sl = *(const float4*)(md + 1024 + col);
      float o0 = v[i].x * sc * gg.x * (1.f + sl.x) + sh.x;
      float o1 = v[i].y * sc * gg.y * (1.f + sl.y) + sh.y;
      float o2 = v[i].z * sc * gg.z * (1.f + sl.z) + sh.z;
      float o3 = v[i].w * sc * gg.w * (1.f + sl.w) + sh.w;
      uint2 o;
      o.x = pack2(o0, o1);
      o.y = pack2(o2, o3);
      *(uint2*)(A + (size_t)tok * 1024 + col) = o;
    }
  }
}

#define LSTR 72
template <class Epi>
__device__ __forceinline__ void gemm_phase(const bf16_t* __restrict__ A, const bf16_t* __restrict__ Bt, int M, int N, int K, Epi epi, char* smem) {
  bf16_t* sA = (bf16_t*)smem;
  bf16_t* sB = sA + 2 * 128 * LSTR;
  const int tid = threadIdx.x, lane = tid & 63, w = tid >> 6;
  const int wm = w >> 1, wn = w & 1;
  const int ntn = (N + 127) >> 7, ntm = M >> 7;
  const int ntiles = ntm * ntn;
  const int KT = K >> 6;
  const int lrow = tid >> 3, lkc = (tid & 7) * 8;
  for (int tile = blockIdx.x; tile < ntiles; tile += gridDim.x) {
    const int m0 = (tile / ntn) << 7, n0 = (tile % ntn) << 7;
    f32x16 acc[2][2];
#pragma unroll
    for (int i = 0; i < 2; ++i)
#pragma unroll
      for (int j = 0; j < 2; ++j)
#pragma unroll
        for (int r = 0; r < 16; ++r) acc[i][j][r] = 0.f;
    const bf16_t* ap[4];
    const bf16_t* bp[4];
#pragma unroll
    for (int i = 0; i < 4; ++i) {
      int row = lrow + 32 * i;
      ap[i] = A + (size_t)(m0 + row) * K + lkc;
      int br = n0 + row;
      br = br < N ? br : N - 1;
      bp[i] = Bt + (size_t)br * K + lkc;
    }
    uint4 ra[4], rb[4];
#pragma unroll
    for (int i = 0; i < 4; ++i) { ra[i] = *(const uint4*)(ap[i]); rb[i] = *(const uint4*)(bp[i]); }
#pragma unroll
    for (int i = 0; i < 4; ++i) {
      *(uint4*)(sA + (lrow + 32 * i) * LSTR + lkc) = ra[i];
      *(uint4*)(sB + (lrow + 32 * i) * LSTR + lkc) = rb[i];
    }
    __syncthreads();
    for (int kt = 0; kt < KT; ++kt) {
      const int buf = kt & 1;
      if (kt + 1 < KT) {
#pragma unroll
        for (int i = 0; i < 4; ++i) { ra[i] = *(const uint4*)(ap[i] + (kt + 1) * 64); rb[i] = *(const uint4*)(bp[i] + (kt + 1) * 64); }
      }
      const bf16_t* cA = sA + buf * 128 * LSTR + (wm * 64 + (lane & 31)) * LSTR + (lane >> 5) * 8;
      const bf16_t* cB = sB + buf * 128 * LSTR + (wn * 64 + (lane & 31)) * LSTR + (lane >> 5) * 8;
#pragma unroll
      for (int kk = 0; kk < 4; ++kk) {
        bf16x8 a0 = *(const bf16x8*)(cA + kk * 16);
        bf16x8 a1 = *(const bf16x8*)(cA + 32 * LSTR + kk * 16);
        bf16x8 b0 = *(const bf16x8*)(cB + kk * 16);
        bf16x8 b1 = *(const bf16x8*)(cB + 32 * LSTR + kk * 16);
        acc[0][0] = __builtin_amdgcn_mfma_f32_32x32x16_bf16(a0, b0, acc[0][0], 0, 0, 0);
        acc[0][1] = __builtin_amdgcn_mfma_f32_32x32x16_bf16(a0, b1, acc[0][1], 0, 0, 0);
        acc[1][0] = __builtin_amdgcn_mfma_f32_32x32x16_bf16(a1, b0, acc[1][0], 0, 0, 0);
        acc[1][1] = __builtin_amdgcn_mfma_f32_32x32x16_bf16(a1, b1, acc[1][1], 0, 0, 0);
      }
      if (kt + 1 < KT) {
        bf16_t* dA = sA + (buf ^ 1) * 128 * LSTR;
        bf16_t* dB = sB + (buf ^ 1) * 128 * LSTR;
#pragma unroll
        for (int i = 0; i < 4; ++i) {
          *(uint4*)(dA + (lrow + 32 * i) * LSTR + lkc) = ra[i];
          *(uint4*)(dB + (lrow + 32 * i) * LSTR + lkc) = rb[i];
        }
      }
      __syncthreads();
    }
#pragma unroll
    for (int mi = 0; mi < 2; ++mi)
#pragma unroll
      for (int ni = 0; ni < 2; ++ni) {
        const int n = n0 + wn * 64 + ni * 32 + (lane & 31);
#pragma unroll
        for (int r = 0; r < 16; ++r) {
          const int m = m0 + wm * 64 + mi * 32 + (r & 3) + 8 * (r >> 2) + 4 * (lane >> 5);
          if (n < N) epi(m, n, acc[mi][ni][r]);
        }
      }
  }
}

struct EpiBf16 {
  bf16_t* C; int ldc;
  __device__ __forceinline__ void operator()(int m, int n, float v) const { C[(size_t)m * ldc + n] = f2bf(v); }
};
struct EpiSsdIn {
  bf16_t* C; float* DT; const float* dt_bias;
  __device__ __forceinline__ void operator()(int m, int n, float v) const {
    if (n < 6144) C[(size_t)m * 6144 + n] = f2bf(v);
    else {
      float x = v + dt_bias[n - 6144];
      float sp = x > 20.f ? x : log1pf(expf(x));
      DT[(size_t)m * 64 + (n - 6144)] = sp;
    }
  }
};
struct EpiRes {
  const float* xin_ctx; const float* xin_lat; float* X; const float* gate;
  __device__ __forceinline__ void operator()(int m, int n, float v) const {
    const float* xr = m < NCTX ? xin_ctx + (size_t)m * 1024 : xin_lat + (size_t)(m - NCTX) * 1024;
    X[(size_t)m * 1024 + n] = xr[n] + gate[(size_t)cidx(m) * 6144 + n] * v;
  }
};

__device__ __forceinline__ void conv_gate_phase(const Params& p) {
  const bf16_t* P = (const bf16_t*)(p.ws + OFF_BIG);
  bf16_t* G = (bf16_t*)(p.ws + OFF_BIG + 120 * MIB);
  const float* cw = p.sc_conv_w;
  const int total = NT * 128;
  for (int it = blockIdx.x * 256 + threadIdx.x; it < total; it += gridDim.x * 256) {
    const int tok = it >> 7, c = (it & 127) * 8;
    const int rowlen = tok < NCTX ? 256 : 64;
    const int pos = tok & (rowlen - 1);
    const bf16_t* pr = P + (size_t)tok * 3072;
    uint4 bg = *(const uint4*)(pr + c);
    uint4 cg = *(const uint4*)(pr + 1024 + c);
    uint4 xv = *(const uint4*)(pr + 2048 + c);
    uint4 cgl = make_uint4(0, 0, 0, 0), xvl = cgl, cgr = cgl, xvr = cgl;
    if (pos > 0) { cgl = *(const uint4*)(pr - 3072 + 1024 + c); xvl = *(const uint4*)(pr - 3072 + 2048 + c); }
    if (pos < rowlen - 1) { cgr = *(const uint4*)(pr + 3072 + 1024 + c); xvr = *(const uint4*)(pr + 3072 + 2048 + c); }
    const unsigned* bgp = (const unsigned*)&bg; const unsigned* cgp = (const unsigned*)&cg; const unsigned* xvp = (const unsigned*)&xv;
    const unsigned* cglp = (const unsigned*)&cgl; const unsigned* xvlp = (const unsigned*)&xvl;
    const unsigned* cgrp = (const unsigned*)&cgr; const unsigned* xvrp = (const unsigned*)&xvr;
    float4 w0a = *(const float4*)(cw + c), w0b = *(const float4*)(cw + c + 4);
    float4 w1a = *(const float4*)(cw + 1024 + c), w1b = *(const float4*)(cw + 1024 + c + 4);
    float4 w2a = *(const float4*)(cw + 2048 + c), w2b = *(const float4*)(cw + 2048 + c + 4);
    const float w0[8] = {w0a.x, w0a.y, w0a.z, w0a.w, w0b.x, w0b.y, w0b.z, w0b.w};
    const float w1[8] = {w1a.x, w1a.y, w1a.z, w1a.w, w1b.x, w1b.y, w1b.z, w1b.w};
    const float w2[8] = {w2a.x, w2a.y, w2a.z, w2a.w, w2b.x, w2b.y, w2b.z, w2b.w};
    unsigned o[4];
#pragma unroll
    for (int q = 0; q < 4; ++q) {
      float r0 = lo2f(bgp[q]) * (w0[2 * q] * lo2f(cglp[q]) * lo2f(xvlp[q]) + w1[2 * q] * lo2f(cgp[q]) * lo2f(xvp[q]) + w2[2 * q] * lo2f(cgrp[q]) * lo2f(xvrp[q]));
      float r1 = hi2f(bgp[q]) * (w0[2 * q + 1] * hi2f(cglp[q]) * hi2f(xvlp[q]) + w1[2 * q + 1] * hi2f(cgp[q]) * hi2f(xvp[q]) + w2[2 * q + 1] * hi2f(cgrp[q]) * hi2f(xvrp[q]));
      o[q] = pack2(r0, r1);
    }
    *(uint4*)(G + (size_t)tok * 1024 + c) = make_uint4(o[0], o[1], o[2], o[3]);
  }
}

#define SSTR 272
__device__ __forceinline__ unsigned row_max_u32(unsigned v) {
  v = umax_(v, dpp_u<0xB1>(v));
  v = umax_(v, dpp_u<0x4E>(v));
  v = umax_(v, dpp_u<0x141>(v));
  v = umax_(v, dpp_u<0x140>(v));
  return v;
}
#define CE_(a, b) { unsigned hi_ = umax_(key[a], key[b]); unsigned lo_ = key[a] < key[b] ? key[a] : key[b]; key[a] = hi_; key[b] = lo_; }
__device__ __forceinline__ unsigned top16_row(const float* Sr, int j) {
  unsigned key[8];
#pragma unroll
  for (int m = 0; m < 8; ++m) key[m] = (fkey(Sr[j + 16 * m]) & ~0x7Fu) | (unsigned)(127 - (j + 16 * m));
  CE_(0, 1) CE_(2, 3) CE_(4, 5) CE_(6, 7)
  CE_(0, 2) CE_(1, 3) CE_(4, 6) CE_(5, 7)
  CE_(1, 2) CE_(5, 6)
  CE_(0, 4) CE_(1, 5) CE_(2, 6) CE_(3, 7)
  CE_(2, 4) CE_(3, 5)
  CE_(1, 2) CE_(3, 4) CE_(5, 6)
  unsigned res = 0;
#pragma unroll 1
  for (int it = 0; it < 16; ++it) {
    const unsigned wm = row_max_u32(key[0]);
    const bool win = key[0] == wm;
#pragma unroll
    for (int m = 0; m < 7; ++m) key[m] = win ? key[m + 1] : key[m];
    key[7] = win ? 0u : key[7];
    res = (j == it) ? wm : res;
  }
  return res;
}

__device__ __forceinline__ void topk_phase(const Params& p, int layer, char* smem) {
  float* S = (float*)smem;
  const bf16_t* Q = (const bf16_t*)(p.ws + OFF_BIG);
  const bf16_t* KB = (const bf16_t*)(p.ws + OFF_KEYSB) + (size_t)layer * (8 * 2 * 128 * 128);
  int* IDX = (int*)(p.ws + OFF_IDX);
  float* GATE = (float*)(p.ws + OFF_GATE);
  const int tid = threadIdx.x, lane = tid & 63;
  const int w = __builtin_amdgcn_readfirstlane(tid >> 6);
  const int G = gridDim.x;
  const int per = (5120 + G - 1) / G;
  const int start = blockIdx.x * per;
  const int end = (start + per < 5120) ? start + per : 5120;
  const int pp = w >> 1, nt0 = (w & 1) * 2;
  const int j = lane & 15, rowbase = lane & 48;
  int ca[4], cb[4];
  bool cvalid3;
  ca[0] = 0; cb[0] = j;
  if (j < 8) { ca[1] = 1; cb[1] = j; } else { ca[1] = j; cb[1] = 0; }
  if (j < 5) { ca[2] = 2; cb[2] = j; } else if (j < 9) { ca[2] = 3; cb[2] = j - 5; } else if (j < 12) { ca[2] = 4; cb[2] = j - 9; }
  else if (j < 14) { ca[2] = 5; cb[2] = j - 12; } else { ca[2] = 6; cb[2] = j - 14; }
  ca[3] = 7; cb[3] = j & 1; cvalid3 = j < 2;
  int curh = -1;
  bf16x8 kf[2][8];
  for (int pr = start; pr < end; ++pr) {
    const int h = pr / 640, tile = pr % 640;
    const int t0 = tile * 32;
    if (h != curh) {
#pragma unroll
      for (int jj = 0; jj < 2; ++jj)
#pragma unroll
        for (int kk = 0; kk < 8; ++kk)
          kf[jj][kk] = *(const bf16x8*)(KB + ((size_t)((h * 2 + pp) * 128 + (nt0 + jj) * 32 + (lane & 31))) * 128 + kk * 16 + (lane >> 5) * 8);
      curh = h;
    }
    f32x16 acc[2];
#pragma unroll
    for (int jj = 0; jj < 2; ++jj)
#pragma unroll
      for (int r = 0; r < 16; ++r) acc[jj][r] = 0.f;
    const bf16_t* qp = Q + (size_t)(t0 + (lane & 31)) * 2048 + h * 256 + pp * 128 + (lane >> 5) * 8;
#pragma unroll
    for (int kk = 0; kk < 8; ++kk) {
      bf16x8 a = *(const bf16x8*)(qp + kk * 16);
      acc[0] = __builtin_amdgcn_mfma_f32_32x32x16_bf16(a, kf[0][kk], acc[0], 0, 0, 0);
      acc[1] = __builtin_amdgcn_mfma_f32_32x32x16_bf16(a, kf[1][kk], acc[1], 0, 0, 0);
    }
#pragma unroll
    for (int jj = 0; jj < 2; ++jj)
#pragma unroll
      for (int r = 0; r < 16; ++r) {
        const int tl = (r & 3) + 8 * (r >> 2) + 4 * (lane >> 5);
        S[tl * SSTR + pp * 128 + (nt0 + jj) * 32 + (lane & 31)] = acc[jj][r];
      }
    __syncthreads();
#pragma unroll 1
    for (int rnd = 0; rnd < 2; ++rnd) {
      const int tl = w * 8 + rnd * 4 + (lane >> 4);
      const float* Sr = S + tl * SSTR;
      const unsigned res1 = top16_row(Sr, j);
      const unsigned res2 = top16_row(Sr + 128, j);
      unsigned ck[4];
#pragma unroll
      for (int sl = 0; sl < 4; ++sl) {
        const float v1 = keyf((unsigned)__shfl((int)res1, rowbase + ca[sl]) & ~0x7Fu);
        const float v2 = keyf((unsigned)__shfl((int)res2, rowbase + cb[sl]) & ~0x7Fu);
        ck[sl] = (fkey(v1 + v2) & ~0xFFu) | (unsigned)(255 - (ca[sl] * 16 + cb[sl]));
      }
      ck[3] = cvalid3 ? ck[3] : 0u;
      unsigned resc = 0;
#pragma unroll 1
      for (int it = 0; it < 16; ++it) {
        const unsigned wm = row_max_u32(umax_(umax_(ck[0], ck[1]), umax_(ck[2], ck[3])));
#pragma unroll
        for (int sl = 0; sl < 4; ++sl) ck[sl] = (ck[sl] == wm) ? 0u : ck[sl];
        resc = (j == it) ? wm : resc;
      }
      const int code = 255 - (int)(resc & 0xFFu);
      const int wa = code >> 4, wb = code & 15;
      const float val = keyf(resc & ~0xFFu);
      const unsigned r1 = (unsigned)__shfl((int)res1, rowbase + wa);
      const unsigned r2 = (unsigned)__shfl((int)res2, rowbase + wb);
      const int i1 = 127 - (int)(r1 & 0x7Fu), i2 = 127 - (int)(r2 & 0x7Fu);
      const float vmax = __shfl(val, rowbase);
      const float e = __expf(val - vmax);
      const float ssum = row16_sum(e);
      const size_t ob = ((size_t)(t0 + tl) * 8 + h) * 16 + j;
      IDX[ob] = i1 * 128 + i2;
      GATE[ob] = e / ssum;
    }
    __syncthreads();
  }
}

typedef __attribute__((ext_vector_type(2))) float f32x2;
__device__ __forceinline__ unsigned u4get(const uint4 v, const int q) { return q == 0 ? v.x : (q == 1 ? v.y : (q == 2 ? v.z : v.w)); }
__device__ __forceinline__ void peer_phase(const Params& p, int layer, char* smem) {
  float* coefs = (float*)smem;
  int* idxs = (int*)(smem + 2048);
  const unsigned char* U8 = (const unsigned char*)(p.ws + (layer ? OFF_TAB1 : OFF_YB));
  const unsigned char* V8 = U8 + (size_t)16384 * 1024;
  const float* SCU = (const float*)(p.ws + OFF_SCALE) + (size_t)layer * 32768;
  const float* SCV = SCU + 16384;
  const bf16_t* A = (const bf16_t*)(p.ws + OFF_YF);
  const int* IDX = (const int*)(p.ws + OFF_IDX);
  const float* GATE = (const float*)(p.ws + OFF_GATE);
  const float* MOD = (const float*)(p.ws + OFF_MOD);
  float* X = p.out;
  const int lane = threadIdx.x & 63;
  const int w = __builtin_amdgcn_readfirstlane(threadIdx.x >> 6);
  const int sub = lane & 15, rg = lane >> 4;
  for (int tok = blockIdx.x * 4 + w; tok < NT; tok += gridDim.x * 4) {
    float t[64];
#pragma unroll
    for (int i = 0; i < 4; ++i) {
      const uint4* ap = (const uint4*)(A + (size_t)tok * 1024 + sub * 16 + 256 * i);
      const uint4 r0 = ap[0], r1 = ap[1];
#pragma unroll
      for (int q = 0; q < 4; ++q) {
        t[16 * i + 2 * q] = lo2f(u4get(r0, q)); t[16 * i + 2 * q + 1] = hi2f(u4get(r0, q));
        t[16 * i + 8 + 2 * q] = lo2f(u4get(r1, q)); t[16 * i + 8 + 2 * q + 1] = hi2f(u4get(r1, q));
      }
    }
#pragma unroll 2
    for (int it = 0; it < 32; ++it) {
      const int k = it * 4 + rg;
      const int e = IDX[(size_t)tok * 128 + k];
      const float gk = GATE[(size_t)tok * 128 + k];
      const float su = SCU[e];
      const float sv = SCV[e];
      const uint4* row = (const uint4*)(U8 + (size_t)e * 1024) + sub;
      uint4 r[4];
#pragma unroll
      for (int i = 0; i < 4; ++i) r[i] = row[16 * i];
      float acc0 = 0.f, acc1 = 0.f;
#pragma unroll
      for (int i = 0; i < 4; ++i) {
#pragma unroll
        for (int q = 0; q < 4; ++q) {
          const int rw = (int)u4get(r[i], q);
          f32x2 lo = __builtin_amdgcn_cvt_pk_f32_fp8(rw, false);
          f32x2 hi = __builtin_amdgcn_cvt_pk_f32_fp8(rw, true);
          acc0 += lo[0] * t[16 * i + 4 * q] + hi[0] * t[16 * i + 4 * q + 2];
          acc1 += lo[1] * t[16 * i + 4 * q + 1] + hi[1] * t[16 * i + 4 * q + 3];
        }
      }
      float acc = row16_sum(acc0 + acc1) * su;
      const float co = 0.5f * acc * (1.f + erff(acc * 0.70710678118654752f)) * gk * sv;
      if (sub == 0) { coefs[w * 128 + k] = co; idxs[w * 128 + k] = e; }
    }
    float o[16];
#pragma unroll
    for (int i = 0; i < 16; ++i) o[i] = 0.f;
#pragma unroll 1
    for (int k = 0; k < 128; k += 16) {
      uint4 r[16]; float c[16];
#pragma unroll
      for (int j = 0; j < 16; ++j) {
        const int e = __builtin_amdgcn_readfirstlane(idxs[w * 128 + k + j]);
        c[j] = coefs[w * 128 + k + j];
        r[j] = *((const uint4*)(V8 + (size_t)e * 1024) + lane);
      }
#pragma unroll
      for (int j = 0; j < 16; ++j) {
#pragma unroll
        for (int q = 0; q < 4; ++q) {
          const int rw = (int)u4get(r[j], q);
          f32x2 lo = __builtin_amdgcn_cvt_pk_f32_fp8(rw, false);
          f32x2 hi = __builtin_amdgcn_cvt_pk_f32_fp8(rw, true);
          o[4 * q] += c[j] * lo[0]; o[4 * q + 1] += c[j] * lo[1];
          o[4 * q + 2] += c[j] * hi[0]; o[4 * q + 3] += c[j] * hi[1];
        }
      }
    }
    const float* gate = MOD + (size_t)(layer * 5 + cidx(tok)) * 6144 + 5 * 1024;
#pragma unroll
    for (int i = 0; i < 4; ++i) {
      const int col = lane * 16 + 4 * i;
      float4 xv = *(const float4*)(X + (size_t)tok * 1024 + col);
      float4 gt = *(const float4*)(gate + col);
      xv.x += gt.x * o[4 * i]; xv.y += gt.y * o[4 * i + 1]; xv.z += gt.z * o[4 * i + 2]; xv.w += gt.w * o[4 * i + 3];
      *(float4*)(X + (size_t)tok * 1024 + col) = xv;
    }
  }
}

__device__ __forceinline__ void ssd_conv_phase(const Params& p) {
  bf16_t* BIG = (bf16_t*)(p.ws + OFF_BIG);
  const float* cw = p.ssd_conv_w;
  const float* cb = p.ssd_conv_b;
  const int total = 272 * 512;
  for (int it = blockIdx.x * 256 + threadIdx.x; it < total; it += gridDim.x * 256) {
    const int c8 = it & 511, r = it >> 9;
    const int c = c8 * 8;
    int tok0, len;
    if (r < 16) { tok0 = r * 256; len = 256; } else { tok0 = NCTX + (r - 16) * 64; len = 64; }
    float w0[8], w1[8], w2[8], bb[8];
#pragma unroll
    for (int j = 0; j < 8; ++j) { w0[j] = cw[c + j]; w1[j] = cw[4096 + c + j]; w2[j] = cw[8192 + c + j]; bb[j] = cb[c + j]; }
    bf16_t* base = BIG + (size_t)tok0 * 6144 + 2048 + c;
    uint4 buf[8], nxt[8];
#pragma unroll
    for (int j = 0; j < 8; ++j) buf[j] = *(const uint4*)(base + (size_t)j * 6144);
    uint4 prev = make_uint4(0, 0, 0, 0);
    for (int t0 = 0; t0 < len; t0 += 8) {
      const bool more = (t0 + 8) < len;
#pragma unroll
      for (int j = 0; j < 8; ++j) nxt[j] = more ? *(const uint4*)(base + (size_t)(t0 + 8 + j) * 6144) : make_uint4(0, 0, 0, 0);
#pragma unroll
      for (int j = 0; j < 8; ++j) {
        const uint4 cur = buf[j];
        const uint4 nx = (j < 7) ? buf[j + 1] : nxt[0];
        const unsigned* pp = (const unsigned*)&prev; const unsigned* cp = (const unsigned*)&cur; const unsigned* np = (const unsigned*)&nx;
        unsigned o[4];
#pragma unroll
        for (int q = 0; q < 4; ++q) {
          float a0 = w0[2 * q] * lo2f(pp[q]) + w1[2 * q] * lo2f(cp[q]) + w2[2 * q] * lo2f(np[q]) + bb[2 * q];
          float a1 = w0[2 * q + 1] * hi2f(pp[q]) + w1[2 * q + 1] * hi2f(cp[q]) + w2[2 * q + 1] * hi2f(np[q]) + bb[2 * q + 1];
          o[q] = pack2(siluf(a0), siluf(a1));
        }
        *(uint4*)(base + (size_t)(t0 + j) * 6144) = make_uint4(o[0], o[1], o[2], o[3]);
        prev = cur;
      }
#pragma unroll
      for (int j = 0; j < 8; ++j) buf[j] = nxt[j];
    }
  }
}

__device__ __forceinline__ void scan_phase(const Params& p, char* smem) {
  float* xs = (float*)smem;
  float* Bs = xs + 2 * 16 * 64;
  float* Cs = Bs + 2 * 16 * 128;
  float* dts = Cs + 2 * 16 * 128;
  float* yb = dts + 64;
  const bf16_t* BIG = (const bf16_t*)(p.ws + OFF_BIG);
  const float* DT = (const float*)(p.ws + OFF_DT);
  const int tid = threadIdx.x, lane = tid & 63;
  const int w = __builtin_amdgcn_readfirstlane(tid >> 6);
  const int stt = tid >> 4, ssub = tid & 15;
  for (int item = blockIdx.x; item < 1280; item += gridDim.x) {
    int b, head, dir, L, tok0;
    const bool latent = item < 256;
    if (latent) { b = item >> 6; head = (item >> 1) & 31; dir = item & 1; L = 4096; tok0 = NCTX + b * 4096; }
    else { int j = item - 256; b = j >> 6; head = (j >> 1) & 31; dir = j & 1; L = 256; tok0 = b * 256; }
    const int g = head >> 2;
    const float a = -expf(p.ssd_a_log[dir * 32 + head]);
    bf16_t* Y = (bf16_t*)(p.ws + (dir ? OFF_YB : OFF_YF));
    float h[32];
    if (latent) {
      const float* sp = p.state_ssm + ((size_t)((b * 2 + dir) * 32 + head)) * 8192 + lane * 128 + w * 32;
#pragma unroll
      for (int i = 0; i < 8; ++i) { float4 v = *(const float4*)(sp + 4 * i); h[4 * i] = v.x; h[4 * i + 1] = v.y; h[4 * i + 2] = v.z; h[4 * i + 3] = v.w; }
    } else {
#pragma unroll
      for (int i = 0; i < 32; ++i) h[i] = 0.f;
    }
    const int nb = L >> 4;
    uint4 rbc0, rbc1; uint2 rx; float rdt;
    {
      const int t = stt;
      const int tok = tok0 + (dir ? L - 1 - t : t);
      const bf16_t* rowp = BIG + (size_t)tok * 6144;
      const bf16_t* bc = rowp + (ssub < 8 ? 4096 + g * 128 + ssub * 16 : 5120 + g * 128 + (ssub - 8) * 16);
      rbc0 = *(const uint4*)(bc); rbc1 = *(const uint4*)(bc + 8);
      rx = *(const uint2*)(rowp + 2048 + head * 64 + ssub * 4);
      rdt = DT[(size_t)tok * 64 + dir * 32 + head];
    }
    __syncthreads();
    {
      float* dst = (ssub < 8 ? Bs : Cs) + (0 * 16 + stt) * 128 + (ssub & 7) * 16;
      const unsigned* q0 = (const unsigned*)&rbc0; const unsigned* q1 = (const unsigned*)&rbc1;
#pragma unroll
      for (int j = 0; j < 4; ++j) { dst[2 * j] = lo2f(q0[j]); dst[2 * j + 1] = hi2f(q0[j]); dst[8 + 2 * j] = lo2f(q1[j]); dst[8 + 2 * j + 1] = hi2f(q1[j]); }
      float* xd = xs + (0 * 16 + stt) * 64 + ssub * 4;
      xd[0] = lo2f(rx.x); xd[1] = hi2f(rx.x); xd[2] = lo2f(rx.y); xd[3] = hi2f(rx.y);
      if (ssub == 0) dts[stt] = rdt;
    }
    __syncthreads();
    for (int k = 0; k < nb; ++k) {
      const int buf = k & 1;
      if (k + 1 < nb) {
        const int t = (k + 1) * 16 + stt;
        const int tok = tok0 + (dir ? L - 1 - t : t);
        const bf16_t* rowp = BIG + (size_t)tok * 6144;
        const bf16_t* bc = rowp + (ssub < 8 ? 4096 + g * 128 + ssub * 16 : 5120 + g * 128 + (ssub - 8) * 16);
        rbc0 = *(const uint4*)(bc); rbc1 = *(const uint4*)(bc + 8);
        rx = *(const uint2*)(rowp + 2048 + head * 64 + ssub * 4);
        rdt = DT[(size_t)tok * 64 + dir * 32 + head];
      }
#pragma unroll 2
      for (int tt = 0; tt < 16; ++tt) {
        const float dtv = dts[buf * 16 + tt];
        const float dA = __expf(dtv * a);
        const float xv = xs[(buf * 16 + tt) * 64 + lane];
        const float dtx = dtv * xv;
        const float4* bp = (const float4*)(Bs + (buf * 16 + tt) * 128 + w * 32);
        const float4* cp = (const float4*)(Cs + (buf * 16 + tt) * 128 + w * 32);
        float y0 = 0.f, y1 = 0.f;
#pragma unroll
        for (int i = 0; i < 8; ++i) {
          const float4 bv = bp[i], cv = cp[i];
          h[4 * i] = h[4 * i] * dA + dtx * bv.x;         y0 += h[4 * i] * cv.x;
          h[4 * i + 1] = h[4 * i + 1] * dA + dtx * bv.y; y1 += h[4 * i + 1] * cv.y;
          h[4 * i + 2] = h[4 * i + 2] * dA + dtx * bv.z; y0 += h[4 * i + 2] * cv.z;
          h[4 * i + 3] = h[4 * i + 3] * dA + dtx * bv.w; y1 += h[4 * i + 3] * cv.w;
        }
        yb[((buf * 16 + tt) * 4 + w) * 64 + lane] = y0 + y1;
      }
      if (k + 1 < nb) {
        const int nbuf = buf ^ 1;
        float* dst = (ssub < 8 ? Bs : Cs) + (nbuf * 16 + stt) * 128 + (ssub & 7) * 16;
        const unsigned* q0 = (const unsigned*)&rbc0; const unsigned* q1 = (const unsigned*)&rbc1;
#pragma unroll
        for (int j = 0; j < 4; ++j) { dst[2 * j] = lo2f(q0[j]); dst[2 * j + 1] = hi2f(q0[j]); dst[8 + 2 * j] = lo2f(q1[j]); dst[8 + 2 * j + 1] = hi2f(q1[j]); }
        float* xd = xs + (nbuf * 16 + stt) * 64 + ssub * 4;
        xd[0] = lo2f(rx.x); xd[1] = hi2f(rx.x); xd[2] = lo2f(rx.y); xd[3] = hi2f(rx.y);
        if (ssub == 0) dts[nbuf * 16 + stt] = rdt;
      }
      __syncthreads();
      {
        float4 s = make_float4(0.f, 0.f, 0.f, 0.f);
#pragma unroll
        for (int ww = 0; ww < 4; ++ww) {
          float4 v = *(const float4*)(yb + ((buf * 16 + stt) * 4 + ww) * 64 + ssub * 4);
          s.x += v.x; s.y += v.y; s.z += v.z; s.w += v.w;
        }
        const int t = k * 16 + stt;
        const int tok = tok0 + (dir ? L - 1 - t : t);
        uint2 o; o.x = pack2(s.x, s.y); o.y = pack2(s.z, s.w);
        *(uint2*)(Y + (size_t)tok * 2048 + head * 64 + ssub * 4) = o;
      }
    }
    if (!latent) {
      float* sp = p.out + (size_t)NT * 1024 + ((size_t)((b * 2 + dir) * 32 + head)) * 8192 + lane * 128 + w * 32;
#pragma unroll
      for (int i = 0; i < 8; ++i) *(float4*)(sp + 4 * i) = make_float4(h[4 * i], h[4 * i + 1], h[4 * i + 2], h[4 * i + 3]);
    }
  }
}

__device__ __forceinline__ void gate_norm_phase(const Params& p) {
  const bf16_t* BIG = (const bf16_t*)(p.ws + OFF_BIG);
  bf16_t* YF = (bf16_t*)(p.ws + OFF_YF);
  const bf16_t* YB = (const bf16_t*)(p.ws + OFF_YB);
  const int lane = threadIdx.x & 63, w = threadIdx.x >> 6;
  for (int tok = blockIdx.x * 4 + w; tok < NT; tok += gridDim.x * 4) {
    float v[32];
    float ss = 0.f;
#pragma unroll
    for (int i = 0; i < 4; ++i) {
      const int col = lane * 8 + 512 * i;
      const int head = col >> 6;
      const float dtot = p.ssd_d[head] + p.ssd_d[32 + head];
      uint4 a = *(const uint4*)(YF + (size_t)tok * 2048 + col);
      uint4 b = *(const uint4*)(YB + (size_t)tok * 2048 + col);
      uint4 x = *(const uint4*)(BIG + (size_t)tok * 6144 + 2048 + col);
      uint4 z = *(const uint4*)(BIG + (size_t)tok * 6144 + col);
      const unsigned* ap = (const unsigned*)&a; const unsigned* bp = (const unsigned*)&b;
      const unsigned* xp = (const unsigned*)&x; const unsigned* zp = (const unsigned*)&z;
#pragma unroll
      for (int q = 0; q < 4; ++q) {
        float y0 = lo2f(ap[q]) + lo2f(bp[q]) + dtot * lo2f(xp[q]);
        float y1 = hi2f(ap[q]) + hi2f(bp[q]) + dtot * hi2f(xp[q]);
        y0 *= siluf(lo2f(zp[q]));
        y1 *= siluf(hi2f(zp[q]));
        v[8 * i + 2 * q] = y0; v[8 * i + 2 * q + 1] = y1;
        ss += y0 * y0 + y1 * y1;
      }
    }
    ss = wave_sum(ss);
    const float sc = rsqrtf(ss * (1.f / 2048.f) + 1e-6f);
#pragma unroll
    for (int i = 0; i < 4; ++i) {
      const int col = lane * 8 + 512 * i;
      float4 g0 = *(const float4*)(p.ssd_norm_g + col), g1 = *(const float4*)(p.ssd_norm_g + col + 4);
      uint4 o;
      o.x = pack2(v[8 * i] * sc * g0.x, v[8 * i + 1] * sc * g0.y);
      o.y = pack2(v[8 * i + 2] * sc * g0.z, v[8 * i + 3] * sc * g0.w);
      o.z = pack2(v[8 * i + 4] * sc * g1.x, v[8 * i + 5] * sc * g1.y);
      o.w = pack2(v[8 * i + 6] * sc * g1.z, v[8 * i + 7] * sc * g1.w);
      *(uint4*)(YF + (size_t)tok * 2048 + col) = o;
    }
  }
}

__device__ __forceinline__ void final_norm_phase(const Params& p) {
  const int lane = threadIdx.x & 63, w = threadIdx.x >> 6;
  for (int tok = blockIdx.x * 4 + w; tok < NT; tok += gridDim.x * 4) {
    float* xr = p.out + (size_t)tok * 1024;
    float4 v[4];
    float ss = 0.f;
#pragma unroll
    for (int i = 0; i < 4; ++i) {
      v[i] = *(const float4*)(xr + lane * 4 + 256 * i);
      ss += v[i].x * v[i].x + v[i].y * v[i].y + v[i].z * v[i].z + v[i].w * v[i].w;
    }
    ss = wave_sum(ss);
    const float sc = rsqrtf(ss * (1.f / 1024.f) + 1e-6f);
#pragma unroll
    for (int i = 0; i < 4; ++i) {
      const int col = lane * 4 + 256 * i;
      float4 gg = *(const float4*)(p.norm_f_g + col);
      *(float4*)(xr + col) = make_float4(v[i].x * sc * gg.x, v[i].y * sc * gg.y, v[i].z * sc * gg.z, v[i].w * sc * gg.w);
    }
  }
}

#define N_PHASES 20
__global__ void __launch_bounds__(256, 2) mk(Params p, int ph_begin, int ph_end) {
  __shared__ __attribute__((aligned(16))) char smem[SMEM_BYTES];
  bf16_t* WT = (bf16_t*)(p.ws + OFF_WT);
  bf16_t* BIG = (bf16_t*)(p.ws + OFF_BIG);
  bf16_t* Abuf = (bf16_t*)(p.ws + OFF_YF);
  float* MOD = (float*)(p.ws + OFF_MOD);
#define RUN(PH, CALL) if (ph_begin <= PH && PH < ph_end) { CALL; if (PH + 1 < ph_end) cg::this_grid().sync(); }
  RUN(0, prep_phase(p, smem))
  RUN(1, norm_mod_phase(p, 0, 0, true))
  RUN(2, gemm_phase(Abuf, WT + WT_SCIN, NT, 3072, 1024, EpiBf16{BIG, 3072}, smem))
  RUN(3, conv_gate_phase(p))
  RUN(4, gemm_phase((const bf16_t*)(p.ws + OFF_BIG + 120 * MIB), WT + WT_SCOUT, NT, 1024, 1024,
                    EpiRes{p.x_prompt, p.x_sample, p.out, MOD + 0 * 5 * 6144 + 2 * 1024}, smem))
  RUN(5, norm_mod_phase(p, 0, 1, false))
  RUN(6, gemm_phase(Abuf, WT + WT_WQ, NT, 2048, 1024, EpiBf16{BIG, 2048}, smem))
  RUN(7, topk_phase(p, 0, smem))
  RUN(8, peer_phase(p, 0, smem))
  RUN(9, norm_mod_phase(p, 1, 0, false))
  RUN(10, gemm_phase(Abuf, WT + WT_SSDIN, NT, 6208, 1024, EpiSsdIn{BIG, (float*)(p.ws + OFF_DT), p.ssd_dt_bias}, smem))
  RUN(11, ssd_conv_phase(p))
  RUN(12, scan_phase(p, smem))
  RUN(13, gate_norm_phase(p))
  RUN(14, gemm_phase(Abuf, WT + WT_SSDOUT, NT, 1024, 2048,
                     EpiRes{p.out, p.out + (size_t)NCTX * 1024, p.out, MOD + 1 * 5 * 6144 + 2 * 1024}, smem))
  RUN(15, norm_mod_phase(p, 1, 1, false))
  RUN(16, gemm_phase(Abuf, WT + WT_WQ + (size_t)2048 * 1024, NT, 2048, 1024, EpiBf16{BIG, 2048}, smem))
  RUN(17, topk_phase(p, 1, smem))
  RUN(18, peer_phase(p, 1, smem))
  RUN(19, final_norm_phase(p))
}

extern "C" void kernel_launch(void* const* d_in, const int* in_sizes, int n_in, void* d_out, int out_size, void* d_ws, size_t ws_size,
                              hipStream_t stream) {
  static int grid_blocks = 0;
  if (!grid_blocks) {
    int dev = 0, cus = 0, per_cu = 0;
    hipGetDevice(&dev);
    hipDeviceGetAttribute(&cus, hipDeviceAttributeMultiprocessorCount, dev);
    hipOccupancyMaxActiveBlocksPerMultiprocessor(&per_cu, mk, 256, 0);
    if (per_cu < 1) per_cu = 1;
    if (per_cu > 2) per_cu = 2;
    grid_blocks = cus * per_cu;
  }
  if (ws_size < WS_NEEDED) { fprintf(stderr, "workspace too small: %zu\n", ws_size); return; }
  Params p{};
  const float** pf = (const float**)&p;
  for (int i = 0; i < 25; ++i) pf[i] = (const float*)d_in[i];
  p.out = (float*)d_out;
  p.ws = (char*)d_ws;
#if COOP
  int b = 0, e = N_PHASES;
  void* args[] = {&p, &b, &e};
  hipError_t err = hipLaunchCooperativeKernel((void*)mk, dim3(grid_blocks), dim3(256), args, 0, stream);
  if (err != hipSuccess) fprintf(stderr, "cooperative launch failed: %s (grid %d)\n", hipGetErrorString(err), grid_blocks);
#else
  for (int ph = 0; ph < N_PHASES; ++ph) {
    hipLaunchKernelGGL(mk, dim3(grid_blocks), dim3(256), 0, stream, p, ph, ph + 1);
    if ((DUP_MASK >> ph) & 1) hipLaunchKernelGGL(mk, dim3(grid_blocks), dim3(256), 0, stream, p, ph, ph + 1);
  }
#endif
}
```

```cpp
#include <hip/hip_runtime.h>
#include <hip/hip_cooperative_groups.h>
#include <cstdio>
namespace cg = cooperative_groups;

#ifndef COOP
#define COOP 1
#endif
#ifndef DUP_MASK
#define DUP_MASK 0
#endif

typedef unsigned short bf16_t;
typedef __attribute__((ext_vector_type(8))) short bf16x8;
typedef __attribute__((ext_vector_type(16))) float f32x16;

#define NT 20480
#define NCTX 4096
#define DM 1024
#define MIB ((size_t)1 << 20)
#define OFF_BIG   ((size_t)0)
#define OFF_YF    (240 * MIB)
#define OFF_YB    (320 * MIB)
#define OFF_WT    (400 * MIB)
#define OFF_KEYSB (433 * MIB)
#define OFF_DT    (434 * MIB)
#define OFF_MOD   (439 * MIB)
#define OFF_IDX   (440 * MIB)
#define OFF_GATE  (450 * MIB)
#define OFF_TAB1  (460 * MIB)
#define OFF_SCALE (492 * MIB)
#define WS_NEEDED (493 * MIB)
#define WT_SCIN   ((size_t)0)
#define WT_SCOUT  (WT_SCIN + (size_t)3072 * 1024)
#define WT_SSDIN  (WT_SCOUT + (size_t)1024 * 1024)
#define WT_SSDOUT (WT_SSDIN + (size_t)6208 * 1024)
#define WT_WQ     (WT_SSDOUT + (size_t)1024 * 2048)

#define SMEM_BYTES 75776

struct Params {
  const float *x_prompt, *x_sample, *state_ssm, *c, *c_ctx, *norm_mix_g, *norm_ffn_g, *norm_f_g, *ada_w, *ada_b;
  const float *sc_w_in, *sc_conv_w, *sc_w_out, *ssd_w_in, *ssd_conv_w, *ssd_conv_b, *ssd_dt_bias, *ssd_a_log, *ssd_d;
  const float *ssd_norm_g, *ssd_w_out, *peer_wq, *peer_keys, *peer_u, *peer_v;
  float* out;
  char* ws;
};

__device__ __forceinline__ float bf2f(bf16_t h) { return __uint_as_float(((unsigned)h) << 16); }
__device__ __forceinline__ bf16_t f2bf(float f) {
  unsigned u = __float_as_uint(f);
  u += 0x7FFFu + ((u >> 16) & 1u);
  return (bf16_t)(u >> 16);
}
__device__ __forceinline__ unsigned pack2(float a, float b) { return (unsigned)f2bf(a) | ((unsigned)f2bf(b) << 16); }
__device__ __forceinline__ float lo2f(unsigned u) { return __uint_as_float(u << 16); }
__device__ __forceinline__ float hi2f(unsigned u) { return __uint_as_float(u & 0xffff0000u); }
__device__ __forceinline__ unsigned u4get(const uint4 v, const int q) { return q == 0 ? v.x : (q == 1 ? v.y : (q == 2 ? v.z : v.w)); }
__device__ __forceinline__ float siluf(float x) { return x / (1.f + __expf(-x)); }
__device__ __forceinline__ int cidx(int tok) { return tok < NCTX ? 0 : 1 + ((tok - NCTX) >> 12); }

template <int CTRL>
__device__ __forceinline__ unsigned dpp_u(unsigned v) {
  return (unsigned)__builtin_amdgcn_update_dpp(0, (int)v, CTRL, 0xF, 0xF, true);
}
template <int CTRL>
__device__ __forceinline__ float dpp_f(float v) {
  return __int_as_float(__builtin_amdgcn_update_dpp(0, __float_as_int(v), CTRL, 0xF, 0xF, true));
}
__device__ __forceinline__ float row16_sum(float v) {
  v += dpp_f<0xB1>(v);
  v += dpp_f<0x4E>(v);
  v += dpp_f<0x141>(v);
  v += dpp_f<0x140>(v);
  return v;
}
__device__ __forceinline__ unsigned umax_(unsigned a, unsigned b) { return a > b ? a : b; }
__device__ __forceinline__ unsigned wave_max_u32(unsigned v) {
  v = umax_(v, dpp_u<0xB1>(v));
  v = umax_(v, dpp_u<0x4E>(v));
  v = umax_(v, dpp_u<0x141>(v));
  v = umax_(v, dpp_u<0x140>(v));
  unsigned a = (unsigned)__builtin_amdgcn_readlane((int)v, 0);
  unsigned b = (unsigned)__builtin_amdgcn_readlane((int)v, 16);
  unsigned c = (unsigned)__builtin_amdgcn_readlane((int)v, 32);
  unsigned d = (unsigned)__builtin_amdgcn_readlane((int)v, 48);
  return umax_(umax_(a, b), umax_(c, d));
}
__device__ __forceinline__ float wave_sum(float v) {
  v = row16_sum(v);
  float a, b, c, d;
  a = __int_as_float(__builtin_amdgcn_readlane(__float_as_int(v), 0));
  b = __int_as_float(__builtin_amdgcn_readlane(__float_as_int(v), 16));
  c = __int_as_float(__builtin_amdgcn_readlane(__float_as_int(v), 32));
  d = __int_as_float(__builtin_amdgcn_readlane(__float_as_int(v), 48));
  return (a + b) + (c + d);
}
__device__ __forceinline__ unsigned fkey(float f) {
  unsigned u = __float_as_uint(f);
  return (u & 0x80000000u) ? ~u : (u | 0x80000000u);
}
__device__ __forceinline__ float keyf(unsigned k) {
  unsigned u = (k & 0x80000000u) ? (k & 0x7fffffffu) : ~k;
  return __uint_as_float(u);
}

__device__ __forceinline__ void transpose_tile(const float* __restrict__ src, int K, int N, bf16_t* __restrict__ dst, int tile, float* tb) {
  const int tid = threadIdx.x;
  const int ntn = N >> 6;
  const int kt = tile / ntn, nt = tile % ntn;
  {
    const int n = tid & 63, kb = tid >> 6;
#pragma unroll
    for (int i = 0; i < 16; ++i) {
      int k = kb + 4 * i;
      tb[k * 65 + n] = src[(size_t)(kt * 64 + k) * N + nt * 64 + n];
    }
  }
  __syncthreads();
  {
    const int k8 = (tid & 7) * 8;
#pragma unroll
    for (int pass = 0; pass < 2; ++pass) {
      int n = (tid >> 3) + 32 * pass;
      uint4 o;
      o.x = pack2(tb[(k8 + 0) * 65 + n], tb[(k8 + 1) * 65 + n]);
      o.y = pack2(tb[(k8 + 2) * 65 + n], tb[(k8 + 3) * 65 + n]);
      o.z = pack2(tb[(k8 + 4) * 65 + n], tb[(k8 + 5) * 65 + n]);
      o.w = pack2(tb[(k8 + 6) * 65 + n], tb[(k8 + 7) * 65 + n]);
      *(uint4*)(dst + (size_t)(nt * 64 + n) * K + kt * 64 + k8) = o;
    }
  }
  __syncthreads();
}

__device__ __forceinline__ void prep_phase(const Params& p, char* smem) {
  const int tid = threadIdx.x;
  bf16_t* WT = (bf16_t*)(p.ws + OFF_WT);
  float* MOD = (float*)(p.ws + OFF_MOD);
  bf16_t* KEYSB = (bf16_t*)(p.ws + OFF_KEYSB);
  const int U_MOD = 192, U_T0 = 768, U_T1 = 256, U_T2 = 1552, U_T3 = 512, U_T4 = 1024, U_KEYS = 256, U_TAB = 16384;
  const int total = U_MOD + U_T0 + U_T1 + U_T2 + U_T3 + U_T4 + U_KEYS + U_TAB;
  for (int u = blockIdx.x; u < total; u += gridDim.x) {
    int v = u;
    if (v < U_MOD) {
      float* scond = (float*)smem;
      float* red = scond + 5 * 1024;
      for (int i = tid; i < 5 * 1024; i += 256) {
        int r = i >> 10, k = i & 1023;
        float cv = (r == 0) ? p.c_ctx[k] : p.c[(r - 1) * 1024 + k];
        scond[i] = siluf(cv);
      }
      __syncthreads();
      const int l = v / 96, jc = v % 96;
      const int jj = tid & 63, kq = tid >> 6;
      const int j = jc * 64 + jj;
      float acc[5] = {0.f, 0.f, 0.f, 0.f, 0.f};
      const float* wp = p.ada_w + ((size_t)l * 1024 + kq * 256) * 6144 + j;
#pragma unroll 8
      for (int k = 0; k < 256; ++k) {
        float wv = wp[(size_t)k * 6144];
#pragma unroll
        for (int r = 0; r < 5; ++r) acc[r] += scond[r * 1024 + kq * 256 + k] * wv;
      }
#pragma unroll
      for (int r = 0; r < 5; ++r) red[(kq * 5 + r) * 64 + jj] = acc[r];
      __syncthreads();
      for (int i = tid; i < 320; i += 256) {
        int r = i >> 6, j2 = i & 63;
        float s = red[(0 * 5 + r) * 64 + j2] + red[(1 * 5 + r) * 64 + j2] + red[(2 * 5 + r) * 64 + j2] + red[(3 * 5 + r) * 64 + j2];
        MOD[(size_t)(l * 5 + r) * 6144 + jc * 64 + j2] = s + p.ada_b[l * 6144 + jc * 64 + j2];
      }
      __syncthreads();
      continue;
    }
    v -= U_MOD;
    float* tb = (float*)smem;
    if (v < U_T0) { transpose_tile(p.sc_w_in, 1024, 3072, WT + WT_SCIN, v, tb); continue; }
    v -= U_T0;
    if (v < U_T1) { transpose_tile(p.sc_w_out, 1024, 1024, WT + WT_SCOUT, v, tb); continue; }
    v -= U_T1;
    if (v < U_T2) { transpose_tile(p.ssd_w_in, 1024, 6208, WT + WT_SSDIN, v, tb); continue; }
    v -= U_T2;
    if (v < U_T3) { transpose_tile(p.ssd_w_out, 2048, 1024, WT + WT_SSDOUT, v, tb); continue; }
    v -= U_T3;
    if (v < U_T4) {
      int l = v >> 9, t = v & 511;
      transpose_tile(p.peer_wq + (size_t)l * 1024 * 2048, 1024, 2048, WT + WT_WQ + (size_t)l * 2048 * 1024, t, tb);
      continue;
    }
    v -= U_T4;
    if (v < U_KEYS) {
      size_t base = (size_t)v * 2048 + tid * 8;
      float4 a = *(const float4*)(p.peer_keys + base);
      float4 b = *(const float4*)(p.peer_keys + base + 4);
      uint4 o;
      o.x = pack2(a.x, a.y); o.y = pack2(a.z, a.w); o.z = pack2(b.x, b.y); o.w = pack2(b.z, b.w);
      *(uint4*)(KEYSB + base) = o;
      continue;
    }
    v -= U_KEYS;
    {
      const int lane = tid & 63;
      const int gr = v * 4 + (tid >> 6);
      const int l = gr >> 15, tab = (gr >> 14) & 1, row = gr & 16383;
      const float* src = (tab ? p.peer_v : p.peer_u) + ((size_t)l * 16384 + row) * 1024 + lane * 16;
      float4 x[4];
      float am = 0.f;
#pragma unroll
      for (int j = 0; j < 4; ++j) {
        x[j] = *(const float4*)(src + 4 * j);
        am = fmaxf(am, fmaxf(fmaxf(fabsf(x[j].x), fabsf(x[j].y)), fmaxf(fabsf(x[j].z), fabsf(x[j].w))));
      }
      am = __uint_as_float(wave_max_u32(__float_as_uint(am)));
      const float inv = am > 0.f ? 440.f / am : 0.f;
      const float scale = am > 0.f ? am / 440.f : 0.f;
      unsigned o[4];
#pragma unroll
      for (int j = 0; j < 4; ++j) {
        int wv = __builtin_amdgcn_cvt_pk_fp8_f32(x[j].x * inv, x[j].y * inv, 0, false);
        wv = __builtin_amdgcn_cvt_pk_fp8_f32(x[j].z * inv, x[j].w * inv, wv, true);
        o[j] = (unsigned)wv;
      }
      unsigned char* dst = (unsigned char*)(p.ws + (l ? OFF_TAB1 : OFF_YB)) + ((size_t)tab * 16384 + row) * 1024 + lane * 16;
      *(uint4*)dst = make_uint4(o[0], o[1], o[2], o[3]);
      if (lane == 0) ((float*)(p.ws + OFF_SCALE))[gr] = scale;
    }
  }
}

__device__ __forceinline__ void norm_mod_phase(const Params& p, int layer, int which, bool from_input) {
  const float* g = (which == 0 ? p.norm_mix_g : p.norm_ffn_g) + layer * 1024;
  const float* MOD = (const float*)(p.ws + OFF_MOD);
  bf16_t* A = (bf16_t*)(p.ws + OFF_YF);
  const int lane = threadIdx.x & 63, w = threadIdx.x >> 6;
  for (int tok = blockIdx.x * 4 + w; tok < NT; tok += gridDim.x * 4) {
    const float* xr = from_input ? (tok < NCTX ? p.x_prompt + (size_t)tok * 1024 : p.x_sample + (size_t)(tok - NCTX) * 1024)
                                 : p.out + (size_t)tok * 1024;
    const float* md = MOD + (size_t)(layer * 5 + cidx(tok)) * 6144 + (which ? 3 * 1024 : 0);
    float4 v[4];
    float ss = 0.f;
#pragma unroll
    for (int i = 0; i < 4; ++i) {
      v[i] = *(const float4*)(xr + lane * 4 + 256 * i);
      ss += v[i].x * v[i].x + v[i].y * v[i].y + v[i].z * v[i].z + v[i].w * v[i].w;
    }
    ss = wave_sum(ss);
    const float sc = rsqrtf(ss * (1.f / 1024.f) + 1e-6f);
#pragma unroll
    for (int i = 0; i < 4; ++i) {
      const int col = lane * 4 + 256 * i;
      float4 gg = *(const float4*)(g + col);
      float4 sh = *(const float4*)(md + col);
      float4 sl = *(const float4*)(md + 1024 + col);
      float o0 = v[i].x * sc * gg.x * (1.f + sl.x) + sh.x;
      float o1 = v[i].y * sc * gg.y * (1.f + sl.y) + sh.y;
      float o2 = v[i].z * sc * gg.z * (1.f + sl.z) + sh.z;
      float o3 = v[i].w * sc * gg.w * (1.f + sl.w) + sh.w;
      uint2 o;
      o.x = pack2(o0, o1);
      o.y = pack2(o2, o3);
      *(uint2*)(A + (size_t)tok * 1024 + col) = o;
    }
  }
}

#define LSTR 72
template <class Epi>
__device__ __forceinline__ void gemm_phase(const bf16_t* __restrict__ A, const bf16_t* __restrict__ Bt, int M, int N, int K, Epi epi, char* smem) {
  bf16_t* sA = (bf16_t*)smem;
  bf16_t* sB = sA + 2 * 128 * LSTR;
  const int tid = threadIdx.x, lane = tid & 63, w = tid >> 6;
  const int wm = w >> 1, wn = w & 1;
  const int ntn = (N + 127) >> 7, ntm = M >> 7;
  const int ntiles = ntm * ntn;
  const int KT = K >> 6;
  const int lrow = tid >> 3, lkc = (tid & 7) * 8;
  for (int tile = blockIdx.x; tile < ntiles; tile += gridDim.x) {
    const int m0 = (tile / ntn) << 7, n0 = (tile % ntn) << 7;
    f32x16 acc[2][2];
#pragma unroll
    for (int i = 0; i < 2; ++i)
#pragma unroll
      for (int j = 0; j < 2; ++j)
#pragma unroll
        for (int r = 0; r < 16; ++r) acc[i][j][r] = 0.f;
    const bf16_t* ap[4];
    const bf16_t* bp[4];
#pragma unroll
    for (int i = 0; i < 4; ++i) {
      int row = lrow + 32 * i;
      ap[i] = A + (size_t)(m0 + row) * K + lkc;
      int br = n0 + row;
      br = br < N ? br : N - 1;
      bp[i] = Bt + (size_t)br * K + lkc;
    }
    uint4 ra[4], rb[4];
#pragma unroll
    for (int i = 0; i < 4; ++i) { ra[i] = *(const uint4*)(ap[i]); rb[i] = *(const uint4*)(bp[i]); }
#pragma unroll
    for (int i = 0; i < 4; ++i) {
      *(uint4*)(sA + (lrow + 32 * i) * LSTR + lkc) = ra[i];
      *(uint4*)(sB + (lrow + 32 * i) * LSTR + lkc) = rb[i];
    }
    __syncthreads();
    for (int kt = 0; kt < KT; ++kt) {
      const int buf = kt & 1;
      if (kt + 1 < KT) {
#pragma unroll
        for (int i = 0; i < 4; ++i) { ra[i] = *(const uint4*)(ap[i] + (kt + 1) * 64); rb[i] = *(const uint4*)(bp[i] + (kt + 1) * 64); }
      }
      const bf16_t* cA = sA + buf * 128 * LSTR + (wm * 64 + (lane & 31)) * LSTR + (lane >> 5) * 8;
      const bf16_t* cB = sB + buf * 128 * LSTR + (wn * 64 + (lane & 31)) * LSTR + (lane >> 5) * 8;
#pragma unroll
      for (int kk = 0; kk < 4; ++kk) {
        bf16x8 a0 = *(const bf16x8*)(cA + kk * 16);
        bf16x8 a1 = *(const bf16x8*)(cA + 32 * LSTR + kk * 16);
        bf16x8 b0 = *(const bf16x8*)(cB + kk * 16);
        bf16x8 b1 = *(const bf16x8*)(cB + 32 * LSTR + kk * 16);
        acc[0][0] = __builtin_amdgcn_mfma_f32_32x32x16_bf16(a0, b0, acc[0][0], 0, 0, 0);
        acc[0][1] = __builtin_amdgcn_mfma_f32_32x32x16_bf16(a0, b1, acc[0][1], 0, 0, 0);
        acc[1][0] = __builtin_amdgcn_mfma_f32_32x32x16_bf16(a1, b0, acc[1][0], 0, 0, 0);
        acc[1][1] = __builtin_amdgcn_mfma_f32_32x32x16_bf16(a1, b1, acc[1][1], 0, 0, 0);
      }
      if (kt + 1 < KT) {
        bf16_t* dA = sA + (buf ^ 1) * 128 * LSTR;
        bf16_t* dB = sB + (buf ^ 1) * 128 * LSTR;
#pragma unroll
        for (int i = 0; i < 4; ++i) {
          *(uint4*)(dA + (lrow + 32 * i) * LSTR + lkc) = ra[i];
          *(uint4*)(dB + (lrow + 32 * i) * LSTR + lkc) = rb[i];
        }
      }
      __syncthreads();
    }
#pragma unroll
    for (int mi = 0; mi < 2; ++mi)
#pragma unroll
      for (int ni = 0; ni < 2; ++ni) {
        const int n = n0 + wn * 64 + ni * 32 + (lane & 31);
#pragma unroll
        for (int r = 0; r < 16; ++r) {
          const int m = m0 + wm * 64 + mi * 32 + (r & 3) + 8 * (r >> 2) + 4 * (lane >> 5);
          if (n < N) epi(m, n, acc[mi][ni][r]);
        }
      }
  }
}

struct EpiBf16 {
  bf16_t* C; int ldc;
  __device__ __forceinline__ void operator()(int m, int n, float v) const { C[(size_t)m * ldc + n] = f2bf(v); }
};
struct EpiSsdIn {
  bf16_t* C; float* DT; const float* dt_bias;
  __device__ __forceinline__ void operator()(int m, int n, float v) const {
    if (n < 6144) C[(size_t)m * 6144 + n] = f2bf(v);
    else {
      float x = v + dt_bias[n - 6144];
      float sp = x > 20.f ? x : log1pf(expf(x));
      DT[(size_t)m * 64 + (n - 6144)] = sp;
    }
  }
};
struct EpiRes {
  const float* xin_ctx; const float* xin_lat; float* X; const float* gate;
  __device__ __forceinline__ void operator()(int m, int n, float v) const {
    const float* xr = m < NCTX ? xin_ctx + (size_t)m * 1024 : xin_lat + (size_t)(m - NCTX) * 1024;
    X[(size_t)m * 1024 + n] = xr[n] + gate[(size_t)cidx(m) * 6144 + n] * v;
  }
};

__device__ __forceinline__ void conv_gate_phase(const Params& p) {
  const bf16_t* P = (const bf16_t*)(p.ws + OFF_BIG);
  bf16_t* G = (bf16_t*)(p.ws + OFF_BIG + 120 * MIB);
  const float* cw = p.sc_conv_w;
  const int total = NT * 128;
  for (int it = blockIdx.x * 256 + threadIdx.x; it < total; it += gridDim.x * 256) {
    const int tok = it >> 7, c = (it & 127) * 8;
    const int rowlen = tok < NCTX ? 256 : 64;
    const int pos = tok & (rowlen - 1);
    const bf16_t* pr = P + (size_t)tok * 3072;
    uint4 bg = *(const uint4*)(pr + c);
    uint4 cg = *(const uint4*)(pr + 1024 + c);
    uint4 xv = *(const uint4*)(pr + 2048 + c);
    uint4 cgl = make_uint4(0, 0, 0, 0), xvl = cgl, cgr = cgl, xvr = cgl;
    if (pos > 0) { cgl = *(const uint4*)(pr - 3072 + 1024 + c); xvl = *(const uint4*)(pr - 3072 + 2048 + c); }
    if (pos < rowlen - 1) { cgr = *(const uint4*)(pr + 3072 + 1024 + c); xvr = *(const uint4*)(pr + 3072 + 2048 + c); }
    const unsigned* bgp = (const unsigned*)&bg; const unsigned* cgp = (const unsigned*)&cg; const unsigned* xvp = (const unsigned*)&xv;
    const unsigned* cglp = (const unsigned*)&cgl; const unsigned* xvlp = (const unsigned*)&xvl;
    const unsigned* cgrp = (const unsigned*)&cgr; const unsigned* xvrp = (const unsigned*)&xvr;
    float4 w0a = *(const float4*)(cw + c), w0b = *(const float4*)(cw + c + 4);
    float4 w1a = *(const float4*)(cw + 1024 + c), w1b = *(const float4*)(cw + 1024 + c + 4);
    float4 w2a = *(const float4*)(cw + 2048 + c), w2b = *(const float4*)(cw + 2048 + c + 4);
    const float w0[8] = {w0a.x, w0a.y, w0a.z, w0a.w, w0b.x, w0b.y, w0b.z, w0b.w};
    const float w1[8] = {w1a.x, w1a.y, w1a.z, w1a.w, w1b.x, w1b.y, w1b.z, w1b.w};
    const float w2[8] = {w2a.x, w2a.y, w2a.z, w2a.w, w2b.x, w2b.y, w2b.z, w2b.w};
    unsigned o[4];
#pragma unroll
    for (int q = 0; q < 4; ++q) {
      float r0 = lo2f(bgp[q]) * (w0[2 * q] * lo2f(cglp[q]) * lo2f(xvlp[q]) + w1[2 * q] * lo2f(cgp[q]) * lo2f(xvp[q]) + w2[2 * q] * lo2f(cgrp[q]) * lo2f(xvrp[q]));
      float r1 = hi2f(bgp[q]) * (w0[2 * q + 1] * hi2f(cglp[q]) * hi2f(xvlp[q]) + w1[2 * q + 1] * hi2f(cgp[q]) * hi2f(xvp[q]) + w2[2 * q + 1] * hi2f(cgrp[q]) * hi2f(xvrp[q]));
      o[q] = pack2(r0, r1);
    }
    *(uint4*)(G + (size_t)tok * 1024 + c) = make_uint4(o[0], o[1], o[2], o[3]);
  }
}

#define SSTR 272
__device__ __forceinline__ unsigned row_max_u32(unsigned v) {
  v = umax_(v, dpp_u<0xB1>(v));
  v = umax_(v, dpp_u<0x4E>(v));
  v = umax_(v, dpp_u<0x141>(v));
  v = umax_(v, dpp_u<0x140>(v));
  return v;
}
#define CE_(a, b) { unsigned hi_ = umax_(key[a], key[b]); unsigned lo_ = key[a] < key[b] ? key[a] : key[b]; key[a] = hi_; key[b] = lo_; }
__device__ __forceinline__ unsigned top16_row(const float* Sr, int j) {
  unsigned key[8];
#pragma unroll
  for (int m = 0; m < 8; ++m) key[m] = (fkey(Sr[j + 16 * m]) & ~0x7Fu) | (unsigned)(127 - (j + 16 * m));
  CE_(0, 1) CE_(2, 3) CE_(4, 5) CE_(6, 7)
  CE_(0, 2) CE_(1, 3) CE_(4, 6) CE_(5, 7)
  CE_(1, 2) CE_(5, 6)
  CE_(0, 4) CE_(1, 5) CE_(2, 6) CE_(3, 7)
  CE_(2, 4) CE_(3, 5)
  CE_(1, 2) CE_(3, 4) CE_(5, 6)
  unsigned res = 0;
#pragma unroll 1
  for (int it = 0; it < 16; ++it) {
    const unsigned wm = row_max_u32(key[0]);
    const bool win = key[0] == wm;
#pragma unroll
    for (int m = 0; m < 7; ++m) key[m] = win ? key[m + 1] : key[m];
    key[7] = win ? 0u : key[7];
    res = (j == it) ? wm : res;
  }
  return res;
}

__device__ __forceinline__ void topk_phase(const Params& p, int layer, char* smem) {
  float* S = (float*)smem;
  const bf16_t* Q = (const bf16_t*)(p.ws + OFF_BIG);
  const bf16_t* KB = (const bf16_t*)(p.ws + OFF_KEYSB) + (size_t)layer * (8 * 2 * 128 * 128);
  int* IDX = (int*)(p.ws + OFF_IDX);
  float* GATE = (float*)(p.ws + OFF_GATE);
  const int tid = threadIdx.x, lane = tid & 63;
  const int w = __builtin_amdgcn_readfirstlane(tid >> 6);
  const int G = gridDim.x;
  const int per = (5120 + G - 1) / G;
  const int start = blockIdx.x * per;
  const int end = (start + per < 5120) ? start + per : 5120;
  const int pp = w >> 1, nt0 = (w & 1) * 2;
  const int j = lane & 15, rowbase = lane & 48;
  int ca[4], cb[4];
  bool cvalid3;
  ca[0] = 0; cb[0] = j;
  if (j < 8) { ca[1] = 1; cb[1] = j; } else { ca[1] = j; cb[1] = 0; }
  if (j < 5) { ca[2] = 2; cb[2] = j; } else if (j < 9) { ca[2] = 3; cb[2] = j - 5; } else if (j < 12) { ca[2] = 4; cb[2] = j - 9; }
  else if (j < 14) { ca[2] = 5; cb[2] = j - 12; } else { ca[2] = 6; cb[2] = j - 14; }
  ca[3] = 7; cb[3] = j & 1; cvalid3 = j < 2;
  int curh = -1;
  bf16x8 kf[2][8];
  for (int pr = start; pr < end; ++pr) {
    const int h = pr / 640, tile = pr % 640;
    const int t0 = tile * 32;
    if (h != curh) {
#pragma unroll
      for (int jj = 0; jj < 2; ++jj)
#pragma unroll
        for (int kk = 0; kk < 8; ++kk)
          kf[jj][kk] = *(const bf16x8*)(KB + ((size_t)((h * 2 + pp) * 128 + (nt0 + jj) * 32 + (lane & 31))) * 128 + kk * 16 + (lane >> 5) * 8);
      curh = h;
    }
    f32x16 acc[2];
#pragma unroll
    for (int jj = 0; jj < 2; ++jj)
#pragma unroll
      for (int r = 0; r < 16; ++r) acc[jj][r] = 0.f;
    const bf16_t* qp = Q + (size_t)(t0 + (lane & 31)) * 2048 + h * 256 + pp * 128 + (lane >> 5) * 8;
#pragma unroll
    for (int kk = 0; kk < 8; ++kk) {
      bf16x8 a = *(const bf16x8*)(qp + kk * 16);
      acc[0] = __builtin_amdgcn_mfma_f32_32x32x16_bf16(a, kf[0][kk], acc[0], 0, 0, 0);
      acc[1] = __builtin_amdgcn_mfma_f32_32x32x16_bf16(a, kf[1][kk], acc[1], 0, 0, 0);
    }
#pragma unroll
    for (int jj = 0; jj < 2; ++jj)
#pragma unroll
      for (int r = 0; r < 16; ++r) {
        const int tl = (r & 3) + 8 * (r >> 2) + 4 * (lane >> 5);
        S[tl * SSTR + pp * 128 + (nt0 + jj) * 32 + (lane & 31)] = acc[jj][r];
      }
    __syncthreads();
#pragma unroll 1
    for (int rnd = 0; rnd < 2; ++rnd) {
      const int tl = w * 8 + rnd * 4 + (lane >> 4);
      const float* Sr = S + tl * SSTR;
      const unsigned res1 = top16_row(Sr, j);
      const unsigned res2 = top16_row(Sr + 128, j);
      unsigned ck[4];
#pragma unroll
      for (int sl = 0; sl < 4; ++sl) {
        const float v1 = keyf((unsigned)__shfl((int)res1, rowbase + ca[sl]) & ~0x7Fu);
        const float v2 = keyf((unsigned)__shfl((int)res2, rowbase + cb[sl]) & ~0x7Fu);
        ck[sl] = (fkey(v1 + v2) & ~0xFFu) | (unsigned)(255 - (ca[sl] * 16 + cb[sl]));
      }
      ck[3] = cvalid3 ? ck[3] : 0u;
      unsigned resc = 0;
#pragma unroll 1
      for (int it = 0; it < 16; ++it) {
        const unsigned wm = row_max_u32(umax_(umax_(ck[0], ck[1]), umax_(ck[2], ck[3])));
#pragma unroll
        for (int sl = 0; sl < 4; ++sl) ck[sl] = (ck[sl] == wm) ? 0u : ck[sl];
        resc = (j == it) ? wm : resc;
      }
      const int code = 255 - (int)(resc & 0xFFu);
      const int wa = code >> 4, wb = code & 15;
      const float val = keyf(resc & ~0xFFu);
      const unsigned r1 = (unsigned)__shfl((int)res1, rowbase + wa);
      const unsigned r2 = (unsigned)__shfl((int)res2, rowbase + wb);
      const int i1 = 127 - (int)(r1 & 0x7Fu), i2 = 127 - (int)(r2 & 0x7Fu);
      const float vmax = __shfl(val, rowbase);
      const float e = __expf(val - vmax);
      const float ssum = row16_sum(e);
      const size_t ob = ((size_t)(t0 + tl) * 8 + h) * 16 + j;
      IDX[ob] = i1 * 128 + i2;
      GATE[ob] = e / ssum;
    }
    __syncthreads();
  }
}

typedef __attribute__((ext_vector_type(2))) float f32x2;
__device__ __forceinline__ void peer_phase(const Params& p, int layer, char* smem) {
  float* coefs = (float*)smem;
  int* idxs = (int*)(smem + 2048);
  const unsigned char* U8 = (const unsigned char*)(p.ws + (layer ? OFF_TAB1 : OFF_YB));
  const unsigned char* V8 = U8 + (size_t)16384 * 1024;
  const float* SCU = (const float*)(p.ws + OFF_SCALE) + (size_t)layer * 32768;
  const float* SCV = SCU + 16384;
  const bf16_t* A = (const bf16_t*)(p.ws + OFF_YF);
  const int* IDX = (const int*)(p.ws + OFF_IDX);
  const float* GATE = (const float*)(p.ws + OFF_GATE);
  const float* MOD = (const float*)(p.ws + OFF_MOD);
  float* X = p.out;
  const int lane = threadIdx.x & 63;
  const int w = __builtin_amdgcn_readfirstlane(threadIdx.x >> 6);
  const int sub = lane & 15, rg = lane >> 4;
  for (int tok = blockIdx.x * 4 + w; tok < NT; tok += gridDim.x * 4) {
    float t[64];
#pragma unroll
    for (int i = 0; i < 4; ++i) {
      const uint4* ap = (const uint4*)(A + (size_t)tok * 1024 + sub * 16 + 256 * i);
      const uint4 r0 = ap[0], r1 = ap[1];
#pragma unroll
      for (int q = 0; q < 4; ++q) {
        t[16 * i + 2 * q] = lo2f(u4get(r0, q)); t[16 * i + 2 * q + 1] = hi2f(u4get(r0, q));
        t[16 * i + 8 + 2 * q] = lo2f(u4get(r1, q)); t[16 * i + 8 + 2 * q + 1] = hi2f(u4get(r1, q));
      }
    }
#pragma unroll 2
    for (int it = 0; it < 32; ++it) {
      const int k = it * 4 + rg;
      const int e = IDX[(size_t)tok * 128 + k];
      const float gk = GATE[(size_t)tok * 128 + k];
      const float su = SCU[e];
      const float sv = SCV[e];
      const uint4* row = (const uint4*)(U8 + (size_t)e * 1024) + sub;
      uint4 r[4];
#pragma unroll
      for (int i = 0; i < 4; ++i) r[i] = row[16 * i];
      float acc0 = 0.f, acc1 = 0.f;
#pragma unroll
      for (int i = 0; i < 4; ++i) {
#pragma unroll
        for (int q = 0; q < 4; ++q) {
          const int rw = (int)u4get(r[i], q);
          f32x2 lo = __builtin_amdgcn_cvt_pk_f32_fp8(rw, false);
          f32x2 hi = __builtin_amdgcn_cvt_pk_f32_fp8(rw, true);
          acc0 += lo[0] * t[16 * i + 4 * q] + hi[0] * t[16 * i + 4 * q + 2];
          acc1 += lo[1] * t[16 * i + 4 * q + 1] + hi[1] * t[16 * i + 4 * q + 3];
        }
      }
      float acc = row16_sum(acc0 + acc1) * su;
      const float co = 0.5f * acc * (1.f + erff(acc * 0.70710678118654752f)) * gk * sv;
      if (sub == 0) { coefs[w * 128 + k] = co; idxs[w * 128 + k] = e; }
    }
    float o[16];
#pragma unroll
    for (int i = 0; i < 16; ++i) o[i] = 0.f;
#pragma unroll 1
    for (int k = 0; k < 128; k += 16) {
      uint4 r[16]; float c[16];
#pragma unroll
      for (int j = 0; j < 16; ++j) {
        const int e = __builtin_amdgcn_readfirstlane(idxs[w * 128 + k + j]);
        c[j] = coefs[w * 128 + k + j];
        r[j] = *((const uint4*)(V8 + (size_t)e * 1024) + lane);
      }
#pragma unroll
      for (int j = 0; j < 16; ++j) {
#pragma unroll
        for (int q = 0; q < 4; ++q) {
          const int rw = (int)u4get(r[j], q);
          f32x2 lo = __builtin_amdgcn_cvt_pk_f32_fp8(rw, false);
          f32x2 hi = __builtin_amdgcn_cvt_pk_f32_fp8(rw, true);
          o[4 * q] += c[j] * lo[0]; o[4 * q + 1] += c[j] * lo[1];
          o[4 * q + 2] += c[j] * hi[0]; o[4 * q + 3] += c[j] * hi[1];
        }
      }
    }
    const float* gate = MOD + (size_t)(layer * 5 + cidx(tok)) * 6144 + 5 * 1024;
#pragma unroll
    for (int i = 0; i < 4; ++i) {
      const int col = lane * 16 + 4 * i;
      float4 xv = *(const float4*)(X + (size_t)tok * 1024 + col);
      float4 gt = *(const float4*)(gate + col);
      xv.x += gt.x * o[4 * i]; xv.y += gt.y * o[4 * i + 1]; xv.z += gt.z * o[4 * i + 2]; xv.w += gt.w * o[4 * i + 3];
      *(float4*)(X + (size_t)tok * 1024 + col) = xv;
    }
  }
}

__device__ __forceinline__ void ssd_conv_phase(const Params& p) {
  bf16_t* BIG = (bf16_t*)(p.ws + OFF_BIG);
  const float* cw = p.ssd_conv_w;
  const float* cb = p.ssd_conv_b;
  const int total = 272 * 512;
  for (int it = blockIdx.x * 256 + threadIdx.x; it < total; it += gridDim.x * 256) {
    const int c8 = it & 511, r = it >> 9;
    const int c = c8 * 8;
    int tok0, len;
    if (r < 16) { tok0 = r * 256; len = 256; } else { tok0 = NCTX + (r - 16) * 64; len = 64; }
    float w0[8], w1[8], w2[8], bb[8];
#pragma unroll
    for (int j = 0; j < 8; ++j) { w0[j] = cw[c + j]; w1[j] = cw[4096 + c + j]; w2[j] = cw[8192 + c + j]; bb[j] = cb[c + j]; }
    bf16_t* base = BIG + (size_t)tok0 * 6144 + 2048 + c;
    uint4 buf[8], nxt[8];
#pragma unroll
    for (int j = 0; j < 8; ++j) buf[j] = *(const uint4*)(base + (size_t)j * 6144);
    uint4 prev = make_uint4(0, 0, 0, 0);
    for (int t0 = 0; t0 < len; t0 += 8) {
      const bool more = (t0 + 8) < len;
#pragma unroll
      for (int j = 0; j < 8; ++j) nxt[j] = more ? *(const uint4*)(base + (size_t)(t0 + 8 + j) * 6144) : make_uint4(0, 0, 0, 0);
#pragma unroll
      for (int j = 0; j < 8; ++j) {
        const uint4 cur = buf[j];
        const uint4 nx = (j < 7) ? buf[j + 1] : nxt[0];
        const unsigned* pp = (const unsigned*)&prev; const unsigned* cp = (const unsigned*)&cur; const unsigned* np = (const unsigned*)&nx;
        unsigned o[4];
#pragma unroll
        for (int q = 0; q < 4; ++q) {
          float a0 = w0[2 * q] * lo2f(pp[q]) + w1[2 * q] * lo2f(cp[q]) + w2[2 * q] * lo2f(np[q]) + bb[2 * q];
          float a1 = w0[2 * q + 1] * hi2f(pp[q]) + w1[2 * q + 1] * hi2f(cp[q]) + w2[2 * q + 1] * hi2f(np[q]) + bb[2 * q + 1];
          o[q] = pack2(siluf(a0), siluf(a1));
        }
        *(uint4*)(base + (size_t)(t0 + j) * 6144) = make_uint4(o[0], o[1], o[2], o[3]);
        prev = cur;
      }
#pragma unroll
      for (int j = 0; j < 8; ++j) buf[j] = nxt[j];
    }
  }
}

#define XT_STR 72
#define HB_STR 136
__device__ __forceinline__ void scan_phase(const Params& p, char* smem) {
  bf16_t* XTd = (bf16_t*)smem;
  bf16_t* BTs = XTd + 64 * XT_STR;
  bf16_t* Ms = BTs + 128 * XT_STR;
  bf16_t* Hb = Ms + 64 * XT_STR;
  float* cumS = (float*)(Hb + 2 * 64 * HB_STR);
  const bf16_t* BIG = (const bf16_t*)(p.ws + OFF_BIG);
  const float* DT = (const float*)(p.ws + OFF_DT);
  const int tid = threadIdx.x, lane = tid & 63;
  const int w = __builtin_amdgcn_readfirstlane(tid >> 6);
  const int h5 = lane >> 5, l31 = lane & 31;
  const int it = w >> 1, jt = w & 1, pt = w & 1, nt0 = (w >> 1) * 2;
  for (int item = blockIdx.x; item < 1280; item += gridDim.x) {
    int b, head, dir, L, tok0;
    const bool latent = item < 256;
    if (latent) { b = item >> 6; head = (item >> 1) & 31; dir = item & 1; L = 4096; tok0 = NCTX + b * 4096; }
    else { int jj = item - 256; b = jj >> 6; head = (jj >> 1) & 31; dir = jj & 1; L = 256; tok0 = b * 256; }
    const int g = head >> 2;
    const float a = -expf(p.ssd_a_log[dir * 32 + head]);
    bf16_t* Y = (bf16_t*)(p.ws + (dir ? OFF_YB : OFF_YF));
    f32x16 st[2];
    const size_t sbase = ((size_t)((b * 2 + dir) * 32 + head)) * 8192;
    const int loff = (32 * pt + 4 * h5) * 128 + 32 * nt0 + l31;
    if (latent) {
      const float* sp = p.state_ssm + sbase + loff;
#pragma unroll
      for (int q = 0; q < 2; ++q)
#pragma unroll
        for (int r = 0; r < 16; ++r) st[q][r] = sp[((r & 3) + 8 * (r >> 2)) * 128 + 32 * q];
    } else {
#pragma unroll
      for (int q = 0; q < 2; ++q)
#pragma unroll
        for (int r = 0; r < 16; ++r) st[q][r] = 0.f;
    }
    {
      bf16_t* hb0 = Hb + (32 * pt + 4 * h5) * HB_STR + 32 * nt0 + l31;
#pragma unroll
      for (int q = 0; q < 2; ++q)
#pragma unroll
        for (int r = 0; r < 16; ++r) hb0[((r & 3) + 8 * (r >> 2)) * HB_STR + 32 * q] = f2bf(st[q][r]);
    }
    __syncthreads();
    const int nchunks = L >> 6;
    uint4 sx[2], sb[4];
    float sdt;
    {
      const int t = lane;
      const int tok = tok0 + (dir ? L - 1 - t : t);
      const bf16_t* rowp = BIG + (size_t)tok * 6144;
#pragma unroll
      for (int r = 0; r < 2; ++r) sx[r] = *(const uint4*)(rowp + 2048 + head * 64 + (w + 4 * r) * 8);
#pragma unroll
      for (int r = 0; r < 4; ++r) sb[r] = *(const uint4*)(rowp + 4096 + g * 128 + (w + 4 * r) * 8);
      sdt = DT[(size_t)tok * 64 + dir * 32 + head];
    }
#pragma nounroll
    for (int c = 0; c < nchunks; ++c) {
      const int cur = c & 1;
      bf16x8 cfr[8], bfr[8];
      {
        const int t = c * 64 + 32 * it + l31;
        const int tok = tok0 + (dir ? L - 1 - t : t);
        const bf16_t* cp = BIG + (size_t)tok * 6144 + 5120 + g * 128 + 8 * h5;
#pragma unroll
        for (int kk = 0; kk < 8; ++kk) cfr[kk] = *(const bf16x8*)(cp + 16 * kk);
      }
      if (jt <= it) {
        const int t = c * 64 + 32 * jt + l31;
        const int tok = tok0 + (dir ? L - 1 - t : t);
        const bf16_t* bp = BIG + (size_t)tok * 6144 + 4096 + g * 128 + 8 * h5;
#pragma unroll
        for (int kk = 0; kk < 8; ++kk) bfr[kk] = *(const bf16x8*)(bp + 16 * kk);
      }
      __builtin_amdgcn_sched_barrier(0);
      float cum = sdt * a;
#pragma unroll
      for (int off = 1; off < 64; off <<= 1) {
        const float tv = __shfl_up(cum, off);
        cum += (lane >= off) ? tv : 0.f;
      }
      const float cum_last = __shfl(cum, 63);
      const float wj = __expf(cum_last - cum);
      if (w == 0) cumS[cur * 64 + lane] = cum;
#pragma unroll
      for (int r = 0; r < 2; ++r) {
        const int p8 = (w + 4 * r) * 8;
#pragma unroll
        for (int q = 0; q < 4; ++q) {
          const unsigned u = u4get(sx[r], q);
          XTd[(p8 + 2 * q) * XT_STR + lane] = f2bf(sdt * lo2f(u));
          XTd[(p8 + 2 * q + 1) * XT_STR + lane] = f2bf(sdt * hi2f(u));
        }
      }
#pragma unroll
      for (int r = 0; r < 4; ++r) {
        const int n8 = (w + 4 * r) * 8;
#pragma unroll
        for (int q = 0; q < 4; ++q) {
          const unsigned u = u4get(sb[r], q);
          BTs[(n8 + 2 * q) * XT_STR + lane] = f2bf(wj * lo2f(u));
          BTs[(n8 + 2 * q + 1) * XT_STR + lane] = f2bf(wj * hi2f(u));
        }
      }
      __builtin_amdgcn_sched_barrier(0);
      f32x16 cb;
#pragma unroll
      for (int r = 0; r < 16; ++r) cb[r] = 0.f;
      if (jt <= it) {
#pragma unroll
        for (int kk = 0; kk < 8; ++kk) cb = __builtin_amdgcn_mfma_f32_32x32x16_bf16(cfr[kk], bfr[kk], cb, 0, 0, 0);
      }
      __builtin_amdgcn_sched_barrier(0);
      f32x16 yo;
#pragma unroll
      for (int r = 0; r < 16; ++r) yo[r] = 0.f;
      {
        const bf16_t* hp = Hb + cur * 64 * HB_STR + (32 * pt + l31) * HB_STR + 8 * h5;
#pragma unroll
        for (int kk = 0; kk < 8; ++kk) {
          const bf16x8 hf = *(const bf16x8*)(hp + 16 * kk);
          yo = __builtin_amdgcn_mfma_f32_32x32x16_bf16(cfr[kk], hf, yo, 0, 0, 0);
        }
      }
      __syncthreads();
      __builtin_amdgcn_sched_barrier(0);
      const float dec = __expf(cum_last);
      bf16x8 xf[4];
#pragma unroll
      for (int kk = 0; kk < 4; ++kk) xf[kk] = *(const bf16x8*)(XTd + (32 * pt + l31) * XT_STR + 16 * kk + 8 * h5);
#pragma unroll
      for (int q = 0; q < 2; ++q) {
#pragma unroll
        for (int r = 0; r < 16; ++r) st[q][r] *= dec;
#pragma unroll
        for (int kk = 0; kk < 4; ++kk) {
          const bf16x8 bt = *(const bf16x8*)(BTs + (32 * (nt0 + q) + l31) * XT_STR + 16 * kk + 8 * h5);
          st[q] = __builtin_amdgcn_mfma_f32_32x32x16_bf16(xf[kk], bt, st[q], 0, 0, 0);
        }
        {
          bf16_t* hbw = Hb + (cur ^ 1) * 64 * HB_STR + (32 * pt + 4 * h5) * HB_STR + 32 * (nt0 + q) + l31;
#pragma unroll
          for (int r = 0; r < 16; ++r) hbw[((r & 3) + 8 * (r >> 2)) * HB_STR] = f2bf(st[q][r]);
        }
      }
      __builtin_amdgcn_sched_barrier(0);
      if (jt <= it) {
        const int jj = 32 * jt + l31;
        const float cj = cumS[cur * 64 + jj];
        const int ib = 32 * it + 4 * h5;
        const float* cs = cumS + cur * 64 + ib;
        bf16_t* mw = Ms + ib * XT_STR + jj;
#pragma unroll
        for (int r = 0; r < 16; ++r) {
          const int ro = (r & 3) + 8 * (r >> 2);
          const float m = (jj <= ib + ro) ? cb[r] * __expf(cs[ro] - cj) : 0.f;
          mw[ro * XT_STR] = f2bf(m);
        }
      }
      __syncthreads();
      if (c + 1 < nchunks) {
        const int t = (c + 1) * 64 + lane;
        const int tok = tok0 + (dir ? L - 1 - t : t);
        const bf16_t* rowp = BIG + (size_t)tok * 6144;
#pragma unroll
        for (int r = 0; r < 2; ++r) sx[r] = *(const uint4*)(rowp + 2048 + head * 64 + (w + 4 * r) * 8);
#pragma unroll
        for (int r = 0; r < 4; ++r) sb[r] = *(const uint4*)(rowp + 4096 + g * 128 + (w + 4 * r) * 8);
        sdt = DT[(size_t)tok * 64 + dir * 32 + head];
      }
      __builtin_amdgcn_sched_barrier(0);
      f32x16 yd;
#pragma unroll
      for (int r = 0; r < 16; ++r) yd[r] = 0.f;
#pragma unroll
      for (int kk = 0; kk < 4; ++kk) {
        if (kk < 2 * (it + 1)) {
          const bf16x8 mf = *(const bf16x8*)(Ms + (32 * it + l31) * XT_STR + 16 * kk + 8 * h5);
          yd = __builtin_amdgcn_mfma_f32_32x32x16_bf16(mf, xf[kk], yd, 0, 0, 0);
        }
      }
      {
        const int t0c = c * 64 + 32 * it + 4 * h5;
        const int tokb = tok0 + (dir ? L - 1 - t0c : t0c);
        const int rs = dir ? -2048 : 2048;
        bf16_t* yp = Y + (size_t)tokb * 2048 + head * 64 + 32 * pt + l31;
        const float* cs = cumS + cur * 64 + 32 * it + 4 * h5;
#pragma unroll
        for (int r = 0; r < 16; ++r) {
          const int ro = (r & 3) + 8 * (r >> 2);
          const float yv = yd[r] + __expf(cs[ro]) * yo[r];
          yp[(ptrdiff_t)rs * ro] = f2bf(yv);
        }
      }
    }
    if (!latent) {
      float* sp = p.out + (size_t)NT * 1024 + sbase + loff;
#pragma unroll
      for (int q = 0; q < 2; ++q)
#pragma unroll
        for (int r = 0; r < 16; ++r) sp[((r & 3) + 8 * (r >> 2)) * 128 + 32 * q] = st[q][r];
    }
    __syncthreads();
  }
}

__device__ __forceinline__ void gate_norm_phase(const Params& p) {
  const bf16_t* BIG = (const bf16_t*)(p.ws + OFF_BIG);
  bf16_t* YF = (bf16_t*)(p.ws + OFF_YF);
  const bf16_t* YB = (const bf16_t*)(p.ws + OFF_YB);
  const int lane = threadIdx.x & 63, w = threadIdx.x >> 6;
  for (int tok = blockIdx.x * 4 + w; tok < NT; tok += gridDim.x * 4) {
    float v[32];
    float ss = 0.f;
#pragma unroll
    for (int i = 0; i < 4; ++i) {
      const int col = lane * 8 + 512 * i;
      const int head = col >> 6;
      const float dtot = p.ssd_d[head] + p.ssd_d[32 + head];
      uint4 a = *(const uint4*)(YF + (size_t)tok * 2048 + col);
      uint4 b = *(const uint4*)(YB + (size_t)tok * 2048 + col);
      uint4 x = *(const uint4*)(BIG + (size_t)tok * 6144 + 2048 + col);
      uint4 z = *(const uint4*)(BIG + (size_t)tok * 6144 + col);
      const unsigned* ap = (const unsigned*)&a; const unsigned* bp = (const unsigned*)&b;
      const unsigned* xp = (const unsigned*)&x; const unsigned* zp = (const unsigned*)&z;
#pragma unroll
      for (int q = 0; q < 4; ++q) {
        float y0 = lo2f(ap[q]) + lo2f(bp[q]) + dtot * lo2f(xp[q]);
        float y1 = hi2f(ap[q]) + hi2f(bp[q]) + dtot * hi2f(xp[q]);
        y0 *= siluf(lo2f(zp[q]));
        y1 *= siluf(hi2f(zp[q]));
        v[8 * i + 2 * q] = y0; v[8 * i + 2 * q + 1] = y1;
        ss += y0 * y0 + y1 * y1;
      }
    }
    ss = wave_sum(ss);
    const float sc = rsqrtf(ss * (1.f / 2048.f) + 1e-6f);
#pragma unroll
    for (int i = 0; i < 4; ++i) {
      const int col = lane * 8 + 512 * i;
      float4 g0 = *(const float4*)(p.ssd_norm_g + col), g1 = *(const float4*)(p.ssd_norm_g + col + 4);
      uint4 o;
      o.x = pack2(v[8 * i] * sc * g0.x, v[8 * i + 1] * sc * g0.y);
      o.y = pack2(v[8 * i + 2] * sc * g0.z, v[8 * i + 3] * sc * g0.w);
      o.z = pack2(v[8 * i + 4] * sc * g1.x, v[8 * i + 5] * sc * g1.y);
      o.w = pack2(v[8 * i + 6] * sc * g1.z, v[8 * i + 7] * sc * g1.w);
      *(uint4*)(YF + (size_t)tok * 2048 + col) = o;
    }
  }
}

__device__ __forceinline__ void final_norm_phase(const Params& p) {
  const int lane = threadIdx.x & 63, w = threadIdx.x >> 6;
  for (int tok = blockIdx.x * 4 + w; tok < NT; tok += gridDim.x * 4) {
    float* xr = p.out + (size_t)tok * 1024;
    float4 v[4];
    float ss = 0.f;
#pragma unroll
    for (int i = 0; i < 4; ++i) {
      v[i] = *(const float4*)(xr + lane * 4 + 256 * i);
      ss += v[i].x * v[i].x + v[i].y * v[i].y + v[i].z * v[i].z + v[i].w * v[i].w;
    }
    ss = wave_sum(ss);
    const float sc = rsqrtf(ss * (1.f / 1024.f) + 1e-6f);
#pragma unroll
    for (int i = 0; i < 4; ++i) {
      const int col = lane * 4 + 256 * i;
      float4 gg = *(const float4*)(p.norm_f_g + col);
      *(float4*)(xr + col) = make_float4(v[i].x * sc * gg.x, v[i].y * sc * gg.y, v[i].z * sc * gg.z, v[i].w * sc * gg.w);
    }
  }
}

#define N_PHASES 20
__global__ void __launch_bounds__(256, 2) mk(Params p, int ph_begin, int ph_end) {
  __shared__ __attribute__((aligned(16))) char smem[SMEM_BYTES];
  bf16_t* WT = (bf16_t*)(p.ws + OFF_WT);
  bf16_t* BIG = (bf16_t*)(p.ws + OFF_BIG);
  bf16_t* Abuf = (bf16_t*)(p.ws + OFF_YF);
  float* MOD = (float*)(p.ws + OFF_MOD);
#define RUN(PH, CALL) if (ph_begin <= PH && PH < ph_end) { CALL; if (PH + 1 < ph_end) cg::this_grid().sync(); }
  RUN(0, prep_phase(p, smem))
  RUN(1, norm_mod_phase(p, 0, 0, true))
  RUN(2, gemm_phase(Abuf, WT + WT_SCIN, NT, 3072, 1024, EpiBf16{BIG, 3072}, smem))
  RUN(3, conv_gate_phase(p))
  RUN(4, gemm_phase((const bf16_t*)(p.ws + OFF_BIG + 120 * MIB), WT + WT_SCOUT, NT, 1024, 1024,
                    EpiRes{p.x_prompt, p.x_sample, p.out, MOD + 0 * 5 * 6144 + 2 * 1024}, smem))
  RUN(5, norm_mod_phase(p, 0, 1, false))
  RUN(6, gemm_phase(Abuf, WT + WT_WQ, NT, 2048, 1024, EpiBf16{BIG, 2048}, smem))
  RUN(7, topk_phase(p, 0, smem))
  RUN(8, peer_phase(p, 0, smem))
  RUN(9, norm_mod_phase(p, 1, 0, false))
  RUN(10, gemm_phase(Abuf, WT + WT_SSDIN, NT, 6208, 1024, EpiSsdIn{BIG, (float*)(p.ws + OFF_DT), p.ssd_dt_bias}, smem))
  RUN(11, ssd_conv_phase(p))
  RUN(12, scan_phase(p, smem))
  RUN(13, gate_norm_phase(p))
  RUN(14, gemm_phase(Abuf, WT + WT_SSDOUT, NT, 1024, 2048,
                     EpiRes{p.out, p.out + (size_t)NCTX * 1024, p.out, MOD + 1 * 5 * 6144 + 2 * 1024}, smem))
  RUN(15, norm_mod_phase(p, 1, 1, false))
  RUN(16, gemm_phase(Abuf, WT + WT_WQ + (size_t)2048 * 1024, NT, 2048, 1024, EpiBf16{BIG, 2048}, smem))
  RUN(17, topk_phase(p, 1, smem))
  RUN(18, peer_phase(p, 1, smem))
  RUN(19, final_norm_phase(p))
}

extern "C" void kernel_launch(void* const* d_in, const int* in_sizes, int n_in, void* d_out, int out_size, void* d_ws, size_t ws_size,
                              hipStream_t stream) {
  static int grid_blocks = 0;
  if (!grid_blocks) {
    int dev = 0, cus = 0, per_cu = 0;
    hipGetDevice(&dev);
    hipDeviceGetAttribute(&cus, hipDeviceAttributeMultiprocessorCount, dev);
    hipOccupancyMaxActiveBlocksPerMultiprocessor(&per_cu, mk, 256, 0);
    if (per_cu < 1) per_cu = 1;
    if (per_cu > 2) per_cu = 2;
    grid_blocks = cus * per_cu;
  }
  if (ws_size < WS_NEEDED) { fprintf(stderr, "workspace too small: %zu\n", ws_size); return; }
  Params p{};
  const float** pf = (const float**)&p;
  for (int i = 0; i < 25; ++i) pf[i] = (const float*)d_in[i];
  p.out = (float*)d_out;
  p.ws = (char*)d_ws;
#if COOP
  int b = 0, e = N_PHASES;
  void* args[] = {&p, &b, &e};
  hipError_t err = hipLaunchCooperativeKernel((void*)mk, dim3(grid_blocks), dim3(256), args, 0, stream);
  if (err != hipSuccess) fprintf(stderr, "cooperative launch failed: %s (grid %d)\n", hipGetErrorString(err), grid_blocks);
#else
  for (int ph = 0; ph < N_PHASES; ++ph) {
    hipLaunchKernelGGL(mk, dim3(grid_blocks), dim3(256), 0, stream, p, ph, ph + 1);
    if ((DUP_MASK >> ph) & 1) hipLaunchKernelGGL(mk, dim3(grid_blocks), dim3(256), 0, stream, p, ph, ph + 1);
  }
#endif
}
```

```cpp
#include <hip/hip_runtime.h>
#include <hip/hip_cooperative_groups.h>
#include <cstdio>
namespace cg = cooperative_groups;

#ifndef COOP
#define COOP 1
#endif
#ifndef DUP_MASK
#define DUP_MASK 0
#endif

typedef unsigned short bf16_t;
typedef __attribute__((ext_vector_type(8))) short bf16x8;
typedef __attribute__((ext_vector_type(16))) float f32x16;

#define NT 20480
#define NCTX 4096
#define DM 1024
#define MIB ((size_t)1 << 20)
#define OFF_BIG   ((size_t)0)
#define OFF_YF    (240 * MIB)
#define OFF_YB    (320 * MIB)
#define OFF_WT    (400 * MIB)
#define OFF_KEYSB (433 * MIB)
#define OFF_DT    (434 * MIB)
#define OFF_MOD   (439 * MIB)
#define OFF_IDX   (440 * MIB)
#define OFF_GATE  (450 * MIB)
#define OFF_TAB1  (460 * MIB)
#define OFF_SCALE (492 * MIB)
#define OFF_BAR   (493 * MIB)
#define WS_NEEDED (494 * MIB)
#define WT_SCIN   ((size_t)0)
#define WT_SCOUT  (WT_SCIN + (size_t)3072 * 1024)
#define WT_SSDIN  (WT_SCOUT + (size_t)1024 * 1024)
#define WT_SSDOUT (WT_SSDIN + (size_t)6208 * 1024)
#define WT_WQ     (WT_SSDOUT + (size_t)1024 * 2048)

#define SMEM_BYTES 75776

struct Params {
  const float *x_prompt, *x_sample, *state_ssm, *c, *c_ctx, *norm_mix_g, *norm_ffn_g, *norm_f_g, *ada_w, *ada_b;
  const float *sc_w_in, *sc_conv_w, *sc_w_out, *ssd_w_in, *ssd_conv_w, *ssd_conv_b, *ssd_dt_bias, *ssd_a_log, *ssd_d;
  const float *ssd_norm_g, *ssd_w_out, *peer_wq, *peer_keys, *peer_u, *peer_v;
  float* out;
  char* ws;
};

__device__ __forceinline__ float bf2f(bf16_t h) { return __uint_as_float(((unsigned)h) << 16); }
__device__ __forceinline__ bf16_t f2bf(float f) {
  unsigned u = __float_as_uint(f);
  u += 0x7FFFu + ((u >> 16) & 1u);
  return (bf16_t)(u >> 16);
}
__device__ __forceinline__ unsigned pack2(float a, float b) { return (unsigned)f2bf(a) | ((unsigned)f2bf(b) << 16); }
__device__ __forceinline__ float lo2f(unsigned u) { return __uint_as_float(u << 16); }
__device__ __forceinline__ float hi2f(unsigned u) { return __uint_as_float(u & 0xffff0000u); }
__device__ __forceinline__ unsigned u4get(const uint4 v, const int q) { return q == 0 ? v.x : (q == 1 ? v.y : (q == 2 ? v.z : v.w)); }
__device__ __forceinline__ float siluf(float x) { return x / (1.f + __expf(-x)); }
__device__ __forceinline__ int cidx(int tok) { return tok < NCTX ? 0 : 1 + ((tok - NCTX) >> 12); }

template <int CTRL>
__device__ __forceinline__ unsigned dpp_u(unsigned v) {
  return (unsigned)__builtin_amdgcn_update_dpp(0, (int)v, CTRL, 0xF, 0xF, true);
}
template <int CTRL>
__device__ __forceinline__ float dpp_f(float v) {
  return __int_as_float(__builtin_amdgcn_update_dpp(0, __float_as_int(v), CTRL, 0xF, 0xF, true));
}
__device__ __forceinline__ float row16_sum(float v) {
  v += dpp_f<0xB1>(v);
  v += dpp_f<0x4E>(v);
  v += dpp_f<0x141>(v);
  v += dpp_f<0x140>(v);
  return v;
}
__device__ __forceinline__ unsigned umax_(unsigned a, unsigned b) { return a > b ? a : b; }
__device__ __forceinline__ unsigned wave_max_u32(unsigned v) {
  v = umax_(v, dpp_u<0xB1>(v));
  v = umax_(v, dpp_u<0x4E>(v));
  v = umax_(v, dpp_u<0x141>(v));
  v = umax_(v, dpp_u<0x140>(v));
  unsigned a = (unsigned)__builtin_amdgcn_readlane((int)v, 0);
  unsigned b = (unsigned)__builtin_amdgcn_readlane((int)v, 16);
  unsigned c = (unsigned)__builtin_amdgcn_readlane((int)v, 32);
  unsigned d = (unsigned)__builtin_amdgcn_readlane((int)v, 48);
  return umax_(umax_(a, b), umax_(c, d));
}
__device__ __forceinline__ float wave_sum(float v) {
  v = row16_sum(v);
  float a, b, c, d;
  a = __int_as_float(__builtin_amdgcn_readlane(__float_as_int(v), 0));
  b = __int_as_float(__builtin_amdgcn_readlane(__float_as_int(v), 16));
  c = __int_as_float(__builtin_amdgcn_readlane(__float_as_int(v), 32));
  d = __int_as_float(__builtin_amdgcn_readlane(__float_as_int(v), 48));
  return (a + b) + (c + d);
}
__device__ __forceinline__ unsigned fkey(float f) {
  unsigned u = __float_as_uint(f);
  return (u & 0x80000000u) ? ~u : (u | 0x80000000u);
}
__device__ __forceinline__ float keyf(unsigned k) {
  unsigned u = (k & 0x80000000u) ? (k & 0x7fffffffu) : ~k;
  return __uint_as_float(u);
}

__device__ __forceinline__ void transpose_tile(const float* __restrict__ src, int K, int N, bf16_t* __restrict__ dst, int tile, float* tb) {
  const int tid = threadIdx.x;
  const int ntn = N >> 6;
  const int kt = tile / ntn, nt = tile % ntn;
  {
    const int n = tid & 63, kb = tid >> 6;
#pragma unroll
    for (int i = 0; i < 16; ++i) {
      int k = kb + 4 * i;
      tb[k * 65 + n] = src[(size_t)(kt * 64 + k) * N + nt * 64 + n];
    }
  }
  __syncthreads();
  {
    const int k8 = (tid & 7) * 8;
#pragma unroll
    for (int pass = 0; pass < 2; ++pass) {
      int n = (tid >> 3) + 32 * pass;
      uint4 o;
      o.x = pack2(tb[(k8 + 0) * 65 + n], tb[(k8 + 1) * 65 + n]);
      o.y = pack2(tb[(k8 + 2) * 65 + n], tb[(k8 + 3) * 65 + n]);
      o.z = pack2(tb[(k8 + 4) * 65 + n], tb[(k8 + 5) * 65 + n]);
      o.w = pack2(tb[(k8 + 6) * 65 + n], tb[(k8 + 7) * 65 + n]);
      *(uint4*)(dst + (size_t)(nt * 64 + n) * K + kt * 64 + k8) = o;
    }
  }
  __syncthreads();
}

__device__ __forceinline__ void prep_phase(const Params& p, char* smem) {
  const int tid = threadIdx.x;
  bf16_t* WT = (bf16_t*)(p.ws + OFF_WT);
  float* MOD = (float*)(p.ws + OFF_MOD);
  bf16_t* KEYSB = (bf16_t*)(p.ws + OFF_KEYSB);
  const int U_MOD = 192, U_T0 = 768, U_T1 = 256, U_T2 = 1552, U_T3 = 512, U_T4 = 1024, U_KEYS = 256, U_TAB = 16384;
  const int total = U_MOD + U_T0 + U_T1 + U_T2 + U_T3 + U_T4 + U_KEYS + U_TAB;
  for (int u = blockIdx.x; u < total; u += gridDim.x) {
    int v = u;
    if (v < U_MOD) {
      float* scond = (float*)smem;
      float* red = scond + 5 * 1024;
      for (int i = tid; i < 5 * 1024; i += 256) {
        int r = i >> 10, k = i & 1023;
        float cv = (r == 0) ? p.c_ctx[k] : p.c[(r - 1) * 1024 + k];
        scond[i] = siluf(cv);
      }
      __syncthreads();
      const int l = v / 96, jc = v % 96;
      const int jj = tid & 63, kq = tid >> 6;
      const int j = jc * 64 + jj;
      float acc[5] = {0.f, 0.f, 0.f, 0.f, 0.f};
      const float* wp = p.ada_w + ((size_t)l * 1024 + kq * 256) * 6144 + j;
#pragma unroll 8
      for (int k = 0; k < 256; ++k) {
        float wv = wp[(size_t)k * 6144];
#pragma unroll
        for (int r = 0; r < 5; ++r) acc[r] += scond[r * 1024 + kq * 256 + k] * wv;
      }
#pragma unroll
      for (int r = 0; r < 5; ++r) red[(kq * 5 + r) * 64 + jj] = acc[r];
      __syncthreads();
      for (int i = tid; i < 320; i += 256) {
        int r = i >> 6, j2 = i & 63;
        float s = red[(0 * 5 + r) * 64 + j2] + red[(1 * 5 + r) * 64 + j2] + red[(2 * 5 + r) * 64 + j2] + red[(3 * 5 + r) * 64 + j2];
        MOD[(size_t)(l * 5 + r) * 6144 + jc * 64 + j2] = s + p.ada_b[l * 6144 + jc * 64 + j2];
      }
      __syncthreads();
      continue;
    }
    v -= U_MOD;
    float* tb = (float*)smem;
    if (v < U_T0) { transpose_tile(p.sc_w_in, 1024, 3072, WT + WT_SCIN, v, tb); continue; }
    v -= U_T0;
    if (v < U_T1) { transpose_tile(p.sc_w_out, 1024, 1024, WT + WT_SCOUT, v, tb); continue; }
    v -= U_T1;
    if (v < U_T2) { transpose_tile(p.ssd_w_in, 1024, 6208, WT + WT_SSDIN, v, tb); continue; }
    v -= U_T2;
    if (v < U_T3) { transpose_tile(p.ssd_w_out, 2048, 1024, WT + WT_SSDOUT, v, tb); continue; }
    v -= U_T3;
    if (v < U_T4) {
      int l = v >> 9, t = v & 511;
      transpose_tile(p.peer_wq + (size_t)l * 1024 * 2048, 1024, 2048, WT + WT_WQ + (size_t)l * 2048 * 1024, t, tb);
      continue;
    }
    v -= U_T4;
    if (v < U_KEYS) {
      size_t base = (size_t)v * 2048 + tid * 8;
      float4 a = *(const float4*)(p.peer_keys + base);
      float4 b = *(const float4*)(p.peer_keys + base + 4);
      uint4 o;
      o.x = pack2(a.x, a.y); o.y = pack2(a.z, a.w); o.z = pack2(b.x, b.y); o.w = pack2(b.z, b.w);
      *(uint4*)(KEYSB + base) = o;
      continue;
    }
    v -= U_KEYS;
    {
      const int lane = tid & 63;
      const int gr = v * 4 + (tid >> 6);
      const int l = gr >> 15, tab = (gr >> 14) & 1, row = gr & 16383;
      const float* src = (tab ? p.peer_v : p.peer_u) + ((size_t)l * 16384 + row) * 1024 + lane * 16;
      float4 x[4];
      float am = 0.f;
#pragma unroll
      for (int j = 0; j < 4; ++j) {
        x[j] = *(const float4*)(src + 4 * j);
        am = fmaxf(am, fmaxf(fmaxf(fabsf(x[j].x), fabsf(x[j].y)), fmaxf(fabsf(x[j].z), fabsf(x[j].w))));
      }
      am = __uint_as_float(wave_max_u32(__float_as_uint(am)));
      const float inv = am > 0.f ? 440.f / am : 0.f;
      const float scale = am > 0.f ? am / 440.f : 0.f;
      unsigned o[4];
#pragma unroll
      for (int j = 0; j < 4; ++j) {
        int wv = __builtin_amdgcn_cvt_pk_fp8_f32(x[j].x * inv, x[j].y * inv, 0, false);
        wv = __builtin_amdgcn_cvt_pk_fp8_f32(x[j].z * inv, x[j].w * inv, wv, true);
        o[j] = (unsigned)wv;
      }
      unsigned char* dst = (unsigned char*)(p.ws + (l ? OFF_TAB1 : OFF_YB)) + ((size_t)tab * 16384 + row) * 1024 + lane * 16;
      *(uint4*)dst = make_uint4(o[0], o[1], o[2], o[3]);
      if (lane == 0) ((float*)(p.ws + OFF_SCALE))[gr] = scale;
    }
  }
}

__device__ __forceinline__ void norm_mod_phase(const Params& p, int layer, int which, bool from_input) {
  const float* g = (which == 0 ? p.norm_mix_g : p.norm_ffn_g) + layer * 1024;
  const float* MOD = (const float*)(p.ws + OFF_MOD);
  bf16_t* A = (bf16_t*)(p.ws + OFF_YF);
  const int lane = threadIdx.x & 63, w = threadIdx.x >> 6;
  for (int tok = blockIdx.x * 4 + w; tok < NT; tok += gridDim.x * 4) {
    const float* xr = from_input ? (tok < NCTX ? p.x_prompt + (size_t)tok * 1024 : p.x_sample + (size_t)(tok - NCTX) * 1024)
                                 : p.out + (size_t)tok * 1024;
    const float* md = MOD + (size_t)(layer * 5 + cidx(tok)) * 6144 + (which ? 3 * 1024 : 0);
    float4 v[4];
    float ss = 0.f;
#pragma unroll
    for (int i = 0; i < 4; ++i) {
      v[i] = *(const float4*)(xr + lane * 4 + 256 * i);
      ss += v[i].x * v[i].x + v[i].y * v[i].y + v[i].z * v[i].z + v[i].w * v[i].w;
    }
    ss = wave_sum(ss);
    const float sc = rsqrtf(ss * (1.f / 1024.f) + 1e-6f);
#pragma unroll
    for (int i = 0; i < 4; ++i) {
      const int col = lane * 4 + 256 * i;
      float4 gg = *(const float4*)(g + col);
      float4 sh = *(const float4*)(md + col);
      float4 sl = *(const float4*)(md + 1024 + col);
      float o0 = v[i].x * sc * gg.x * (1.f + sl.x) + sh.x;
      float o1 = v[i].y * sc * gg.y * (1.f + sl.y) + sh.y;
      float o2 = v[i].z * sc * gg.z * (1.f + sl.z) + sh.z;
      float o3 = v[i].w * sc * gg.w * (1.f + sl.w) + sh.w;
      uint2 o;
      o.x = pack2(o0, o1);
      o.y = pack2(o2, o3);
      *(uint2*)(A + (size_t)tok * 1024 + col) = o;
    }
  }
}

#define LSTR 72
template <class Epi>
__device__ __forceinline__ void gemm_phase(const bf16_t* __restrict__ A, const bf16_t* __restrict__ Bt, int M, int N, int K, Epi epi, char* smem) {
  bf16_t* sA = (bf16_t*)smem;
  bf16_t* sB = sA + 2 * 128 * LSTR;
  const int tid = threadIdx.x, lane = tid & 63, w = tid >> 6;
  const int wm = w >> 1, wn = w & 1;
  const int ntn = (N + 127) >> 7, ntm = M >> 7;
  const int ntiles = ntm * ntn;
  const int KT = K >> 6;
  const int lrow = tid >> 3, lkc = (tid & 7) * 8;
  for (int tile = blockIdx.x; tile < ntiles; tile += gridDim.x) {
    const int m0 = (tile / ntn) << 7, n0 = (tile % ntn) << 7;
    f32x16 acc[2][2];
#pragma unroll
    for (int i = 0; i < 2; ++i)
#pragma unroll
      for (int j = 0; j < 2; ++j)
#pragma unroll
        for (int r = 0; r < 16; ++r) acc[i][j][r] = 0.f;
    const bf16_t* ap[4];
    const bf16_t* bp[4];
#pragma unroll
    for (int i = 0; i < 4; ++i) {
      int row = lrow + 32 * i;
      ap[i] = A + (size_t)(m0 + row) * K + lkc;
      int br = n0 + row;
      br = br < N ? br : N - 1;
      bp[i] = Bt + (size_t)br * K + lkc;
    }
    uint4 ra[4], rb[4];
#pragma unroll
    for (int i = 0; i < 4; ++i) { ra[i] = *(const uint4*)(ap[i]); rb[i] = *(const uint4*)(bp[i]); }
#pragma unroll
    for (int i = 0; i < 4; ++i) {
      *(uint4*)(sA + (lrow + 32 * i) * LSTR + lkc) = ra[i];
      *(uint4*)(sB + (lrow + 32 * i) * LSTR + lkc) = rb[i];
    }
    __syncthreads();
    for (int kt = 0; kt < KT; ++kt) {
      const int buf = kt & 1;
      if (kt + 1 < KT) {
#pragma unroll
        for (int i = 0; i < 4; ++i) { ra[i] = *(const uint4*)(ap[i] + (kt + 1) * 64); rb[i] = *(const uint4*)(bp[i] + (kt + 1) * 64); }
      }
      const bf16_t* cA = sA + buf * 128 * LSTR + (wm * 64 + (lane & 31)) * LSTR + (lane >> 5) * 8;
      const bf16_t* cB = sB + buf * 128 * LSTR + (wn * 64 + (lane & 31)) * LSTR + (lane >> 5) * 8;
#pragma unroll
      for (int kk = 0; kk < 4; ++kk) {
        bf16x8 a0 = *(const bf16x8*)(cA + kk * 16);
        bf16x8 a1 = *(const bf16x8*)(cA + 32 * LSTR + kk * 16);
        bf16x8 b0 = *(const bf16x8*)(cB + kk * 16);
        bf16x8 b1 = *(const bf16x8*)(cB + 32 * LSTR + kk * 16);
        acc[0][0] = __builtin_amdgcn_mfma_f32_32x32x16_bf16(a0, b0, acc[0][0], 0, 0, 0);
        acc[0][1] = __builtin_amdgcn_mfma_f32_32x32x16_bf16(a0, b1, acc[0][1], 0, 0, 0);
        acc[1][0] = __builtin_amdgcn_mfma_f32_32x32x16_bf16(a1, b0, acc[1][0], 0, 0, 0);
        acc[1][1] = __builtin_amdgcn_mfma_f32_32x32x16_bf16(a1, b1, acc[1][1], 0, 0, 0);
      }
      if (kt + 1 < KT) {
        bf16_t* dA = sA + (buf ^ 1) * 128 * LSTR;
        bf16_t* dB = sB + (buf ^ 1) * 128 * LSTR;
#pragma unroll
        for (int i = 0; i < 4; ++i) {
          *(uint4*)(dA + (lrow + 32 * i) * LSTR + lkc) = ra[i];
          *(uint4*)(dB + (lrow + 32 * i) * LSTR + lkc) = rb[i];
        }
      }
      __syncthreads();
    }
#pragma unroll
    for (int mi = 0; mi < 2; ++mi)
#pragma unroll
      for (int ni = 0; ni < 2; ++ni) {
        const int n = n0 + wn * 64 + ni * 32 + (lane & 31);
#pragma unroll
        for (int r = 0; r < 16; ++r) {
          const int m = m0 + wm * 64 + mi * 32 + (r & 3) + 8 * (r >> 2) + 4 * (lane >> 5);
          if (n < N) epi(m, n, acc[mi][ni][r]);
        }
      }
  }
}

struct EpiBf16 {
  bf16_t* C; int ldc;
  __device__ __forceinline__ void operator()(int m, int n, float v) const { C[(size_t)m * ldc + n] = f2bf(v); }
};
struct EpiSsdIn {
  bf16_t* C; float* DT; const float* dt_bias;
  __device__ __forceinline__ void operator()(int m, int n, float v) const {
    if (n < 6144) C[(size_t)m * 6144 + n] = f2bf(v);
    else {
      float x = v + dt_bias[n - 6144];
      float sp = x > 20.f ? x : log1pf(expf(x));
      DT[(size_t)m * 64 + (n - 6144)] = sp;
    }
  }
};
struct EpiRes {
  const float* xin_ctx; const float* xin_lat; float* X; const float* gate;
  __device__ __forceinline__ void operator()(int m, int n, float v) const {
    const float* xr = m < NCTX ? xin_ctx + (size_t)m * 1024 : xin_lat + (size_t)(m - NCTX) * 1024;
    X[(size_t)m * 1024 + n] = xr[n] + gate[(size_t)cidx(m) * 6144 + n] * v;
  }
};

__device__ __forceinline__ void conv_gate_phase(const Params& p) {
  const bf16_t* P = (const bf16_t*)(p.ws + OFF_BIG);
  bf16_t* G = (bf16_t*)(p.ws + OFF_BIG + 120 * MIB);
  const float* cw = p.sc_conv_w;
  const int total = NT * 128;
  for (int it = blockIdx.x * 256 + threadIdx.x; it < total; it += gridDim.x * 256) {
    const int tok = it >> 7, c = (it & 127) * 8;
    const int rowlen = tok < NCTX ? 256 : 64;
    const int pos = tok & (rowlen - 1);
    const bf16_t* pr = P + (size_t)tok * 3072;
    uint4 bg = *(const uint4*)(pr + c);
    uint4 cg = *(const uint4*)(pr + 1024 + c);
    uint4 xv = *(const uint4*)(pr + 2048 + c);
    uint4 cgl = make_uint4(0, 0, 0, 0), xvl = cgl, cgr = cgl, xvr = cgl;
    if (pos > 0) { cgl = *(const uint4*)(pr - 3072 + 1024 + c); xvl = *(const uint4*)(pr - 3072 + 2048 + c); }
    if (pos < rowlen - 1) { cgr = *(const uint4*)(pr + 3072 + 1024 + c); xvr = *(const uint4*)(pr + 3072 + 2048 + c); }
    const unsigned* bgp = (const unsigned*)&bg; const unsigned* cgp = (const unsigned*)&cg; const unsigned* xvp = (const unsigned*)&xv;
    const unsigned* cglp = (const unsigned*)&cgl; const unsigned* xvlp = (const unsigned*)&xvl;
    const unsigned* cgrp = (const unsigned*)&cgr; const unsigned* xvrp = (const unsigned*)&xvr;
    float4 w0a = *(const float4*)(cw + c), w0b = *(const float4*)(cw + c + 4);
    float4 w1a = *(const float4*)(cw + 1024 + c), w1b = *(const float4*)(cw + 1024 + c + 4);
    float4 w2a = *(const float4*)(cw + 2048 + c), w2b = *(const float4*)(cw + 2048 + c + 4);
    const float w0[8] = {w0a.x, w0a.y, w0a.z, w0a.w, w0b.x, w0b.y, w0b.z, w0b.w};
    const float w1[8] = {w1a.x, w1a.y, w1a.z, w1a.w, w1b.x, w1b.y, w1b.z, w1b.w};
    const float w2[8] = {w2a.x, w2a.y, w2a.z, w2a.w, w2b.x, w2b.y, w2b.z, w2b.w};
    unsigned o[4];
#pragma unroll
    for (int q = 0; q < 4; ++q) {
      float r0 = lo2f(bgp[q]) * (w0[2 * q] * lo2f(cglp[q]) * lo2f(xvlp[q]) + w1[2 * q] * lo2f(cgp[q]) * lo2f(xvp[q]) + w2[2 * q] * lo2f(cgrp[q]) * lo2f(xvrp[q]));
      float r1 = hi2f(bgp[q]) * (w0[2 * q + 1] * hi2f(cglp[q]) * hi2f(xvlp[q]) + w1[2 * q + 1] * hi2f(cgp[q]) * hi2f(xvp[q]) + w2[2 * q + 1] * hi2f(cgrp[q]) * hi2f(xvrp[q]));
      o[q] = pack2(r0, r1);
    }
    *(uint4*)(G + (size_t)tok * 1024 + c) = make_uint4(o[0], o[1], o[2], o[3]);
  }
}

#define SSTR 272
__device__ __forceinline__ unsigned row_max_u32(unsigned v) {
  v = umax_(v, dpp_u<0xB1>(v));
  v = umax_(v, dpp_u<0x4E>(v));
  v = umax_(v, dpp_u<0x141>(v));
  v = umax_(v, dpp_u<0x140>(v));
  return v;
}
#define CE_(a, b) { unsigned hi_ = umax_(key[a], key[b]); unsigned lo_ = key[a] < key[b] ? key[a] : key[b]; key[a] = hi_; key[b] = lo_; }
__device__ __forceinline__ unsigned top16_row(const float* Sr, int j) {
  unsigned key[8];
#pragma unroll
  for (int m = 0; m < 8; ++m) key[m] = (fkey(Sr[j + 16 * m]) & ~0x7Fu) | (unsigned)(127 - (j + 16 * m));
  CE_(0, 1) CE_(2, 3) CE_(4, 5) CE_(6, 7)
  CE_(0, 2) CE_(1, 3) CE_(4, 6) CE_(5, 7)
  CE_(1, 2) CE_(5, 6)
  CE_(0, 4) CE_(1, 5) CE_(2, 6) CE_(3, 7)
  CE_(2, 4) CE_(3, 5)
  CE_(1, 2) CE_(3, 4) CE_(5, 6)
  unsigned res = 0;
#pragma unroll 1
  for (int it = 0; it < 16; ++it) {
    const unsigned wm = row_max_u32(key[0]);
    const bool win = key[0] == wm;
#pragma unroll
    for (int m = 0; m < 7; ++m) key[m] = win ? key[m + 1] : key[m];
    key[7] = win ? 0u : key[7];
    res = (j == it) ? wm : res;
  }
  return res;
}

__device__ __forceinline__ void topk_phase(const Params& p, int layer, char* smem) {
  float* S = (float*)smem;
  const bf16_t* Q = (const bf16_t*)(p.ws + OFF_BIG);
  const bf16_t* KB = (const bf16_t*)(p.ws + OFF_KEYSB) + (size_t)layer * (8 * 2 * 128 * 128);
  int* IDX = (int*)(p.ws + OFF_IDX);
  float* GATE = (float*)(p.ws + OFF_GATE);
  const int tid = threadIdx.x, lane = tid & 63;
  const int w = __builtin_amdgcn_readfirstlane(tid >> 6);
  const int G = gridDim.x;
  const int per = (5120 + G - 1) / G;
  const int start = blockIdx.x * per;
  const int end = (start + per < 5120) ? start + per : 5120;
  const int pp = w >> 1, nt0 = (w & 1) * 2;
  const int j = lane & 15, rowbase = lane & 48;
  int ca[4], cb[4];
  bool cvalid3;
  ca[0] = 0; cb[0] = j;
  if (j < 8) { ca[1] = 1; cb[1] = j; } else { ca[1] = j; cb[1] = 0; }
  if (j < 5) { ca[2] = 2; cb[2] = j; } else if (j < 9) { ca[2] = 3; cb[2] = j - 5; } else if (j < 12) { ca[2] = 4; cb[2] = j - 9; }
  else if (j < 14) { ca[2] = 5; cb[2] = j - 12; } else { ca[2] = 6; cb[2] = j - 14; }
  ca[3] = 7; cb[3] = j & 1; cvalid3 = j < 2;
  int curh = -1;
  bf16x8 kf[2][8];
  for (int pr = start; pr < end; ++pr) {
    const int h = pr / 640, tile = pr % 640;
    const int t0 = tile * 32;
    if (h != curh) {
#pragma unroll
      for (int jj = 0; jj < 2; ++jj)
#pragma unroll
        for (int kk = 0; kk < 8; ++kk)
          kf[jj][kk] = *(const bf16x8*)(KB + ((size_t)((h * 2 + pp) * 128 + (nt0 + jj) * 32 + (lane & 31))) * 128 + kk * 16 + (lane >> 5) * 8);
      curh = h;
    }
    f32x16 acc[2];
#pragma unroll
    for (int jj = 0; jj < 2; ++jj)
#pragma unroll
      for (int r = 0; r < 16; ++r) acc[jj][r] = 0.f;
    const bf16_t* qp = Q + (size_t)(t0 + (lane & 31)) * 2048 + h * 256 + pp * 128 + (lane >> 5) * 8;
#pragma unroll
    for (int kk = 0; kk < 8; ++kk) {
      bf16x8 a = *(const bf16x8*)(qp + kk * 16);
      acc[0] = __builtin_amdgcn_mfma_f32_32x32x16_bf16(a, kf[0][kk], acc[0], 0, 0, 0);
      acc[1] = __builtin_amdgcn_mfma_f32_32x32x16_bf16(a, kf[1][kk], acc[1], 0, 0, 0);
    }
#pragma unroll
    for (int jj = 0; jj < 2; ++jj)
#pragma unroll
      for (int r = 0; r < 16; ++r) {
        const int tl = (r & 3) + 8 * (r >> 2) + 4 * (lane >> 5);
        S[tl * SSTR + pp * 128 + (nt0 + jj) * 32 + (lane & 31)] = acc[jj][r];
      }
    __syncthreads();
#pragma unroll 1
    for (int rnd = 0; rnd < 2; ++rnd) {
      const int tl = w * 8 + rnd * 4 + (lane >> 4);
      const float* Sr = S + tl * SSTR;
      const unsigned res1 = top16_row(Sr, j);
      const unsigned res2 = top16_row(Sr + 128, j);
      unsigned ck[4];
#pragma unroll
      for (int sl = 0; sl < 4; ++sl) {
        const float v1 = keyf((unsigned)__shfl((int)res1, rowbase + ca[sl]) & ~0x7Fu);
        const float v2 = keyf((unsigned)__shfl((int)res2, rowbase + cb[sl]) & ~0x7Fu);
        ck[sl] = (fkey(v1 + v2) & ~0xFFu) | (unsigned)(255 - (ca[sl] * 16 + cb[sl]));
      }
      ck[3] = cvalid3 ? ck[3] : 0u;
      unsigned resc = 0;
#pragma unroll 1
      for (int it = 0; it < 16; ++it) {
        const unsigned wm = row_max_u32(umax_(umax_(ck[0], ck[1]), umax_(ck[2], ck[3])));
#pragma unroll
        for (int sl = 0; sl < 4; ++sl) ck[sl] = (ck[sl] == wm) ? 0u : ck[sl];
        resc = (j == it) ? wm : resc;
      }
      const int code = 255 - (int)(resc & 0xFFu);
      const int wa = code >> 4, wb = code & 15;
      const float val = keyf(resc & ~0xFFu);
      const unsigned r1 = (unsigned)__shfl((int)res1, rowbase + wa);
      const unsigned r2 = (unsigned)__shfl((int)res2, rowbase + wb);
      const int i1 = 127 - (int)(r1 & 0x7Fu), i2 = 127 - (int)(r2 & 0x7Fu);
      const float vmax = __shfl(val, rowbase);
      const float e = __expf(val - vmax);
      const float ssum = row16_sum(e);
      const size_t ob = ((size_t)(t0 + tl) * 8 + h) * 16 + j;
      IDX[ob] = i1 * 128 + i2;
      GATE[ob] = e / ssum;
    }
    __syncthreads();
  }
}

typedef __attribute__((ext_vector_type(2))) float f32x2;
__device__ __forceinline__ void peer_phase(const Params& p, int layer, char* smem) {
  float* coefs = (float*)smem;
  int* idxs = (int*)(smem + 2048);
  const unsigned char* U8 = (const unsigned char*)(p.ws + (layer ? OFF_TAB1 : OFF_YB));
  const unsigned char* V8 = U8 + (size_t)16384 * 1024;
  const float* SCU = (const float*)(p.ws + OFF_SCALE) + (size_t)layer * 32768;
  const float* SCV = SCU + 16384;
  const bf16_t* A = (const bf16_t*)(p.ws + OFF_YF);
  const int* IDX = (const int*)(p.ws + OFF_IDX);
  const float* GATE = (const float*)(p.ws + OFF_GATE);
  const float* MOD = (const float*)(p.ws + OFF_MOD);
  float* X = p.out;
  const int lane = threadIdx.x & 63;
  const int w = __builtin_amdgcn_readfirstlane(threadIdx.x >> 6);
  const int sub = lane & 15, rg = lane >> 4;
  for (int tok = blockIdx.x * 4 + w; tok < NT; tok += gridDim.x * 4) {
    float t[64];
#pragma unroll
    for (int i = 0; i < 4; ++i) {
      const uint4* ap = (const uint4*)(A + (size_t)tok * 1024 + sub * 16 + 256 * i);
      const uint4 r0 = ap[0], r1 = ap[1];
#pragma unroll
      for (int q = 0; q < 4; ++q) {
        t[16 * i + 2 * q] = lo2f(u4get(r0, q)); t[16 * i + 2 * q + 1] = hi2f(u4get(r0, q));
        t[16 * i + 8 + 2 * q] = lo2f(u4get(r1, q)); t[16 * i + 8 + 2 * q + 1] = hi2f(u4get(r1, q));
      }
    }
#pragma unroll 2
    for (int it = 0; it < 32; ++it) {
      const int k = it * 4 + rg;
      const int e = IDX[(size_t)tok * 128 + k];
      const float gk = GATE[(size_t)tok * 128 + k];
      const float su = SCU[e];
      const float sv = SCV[e];
      const uint4* row = (const uint4*)(U8 + (size_t)e * 1024) + sub;
      uint4 r[4];
#pragma unroll
      for (int i = 0; i < 4; ++i) r[i] = row[16 * i];
      float acc0 = 0.f, acc1 = 0.f;
#pragma unroll
      for (int i = 0; i < 4; ++i) {
#pragma unroll
        for (int q = 0; q < 4; ++q) {
          const int rw = (int)u4get(r[i], q);
          f32x2 lo = __builtin_amdgcn_cvt_pk_f32_fp8(rw, false);
          f32x2 hi = __builtin_amdgcn_cvt_pk_f32_fp8(rw, true);
          acc0 += lo[0] * t[16 * i + 4 * q] + hi[0] * t[16 * i + 4 * q + 2];
          acc1 += lo[1] * t[16 * i + 4 * q + 1] + hi[1] * t[16 * i + 4 * q + 3];
        }
      }
      float acc = row16_sum(acc0 + acc1) * su;
      const float co = 0.5f * acc * (1.f + erff(acc * 0.70710678118654752f)) * gk * sv;
      if (sub == 0) { coefs[w * 128 + k] = co; idxs[w * 128 + k] = e; }
    }
    float o[16];
#pragma unroll
    for (int i = 0; i < 16; ++i) o[i] = 0.f;
#pragma unroll 1
    for (int k = 0; k < 128; k += 16) {
      uint4 r[16]; float c[16];
#pragma unroll
      for (int j = 0; j < 16; ++j) {
        const int e = __builtin_amdgcn_readfirstlane(idxs[w * 128 + k + j]);
        c[j] = coefs[w * 128 + k + j];
        r[j] = *((const uint4*)(V8 + (size_t)e * 1024) + lane);
      }
#pragma unroll
      for (int j = 0; j < 16; ++j) {
#pragma unroll
        for (int q = 0; q < 4; ++q) {
          const int rw = (int)u4get(r[j], q);
          f32x2 lo = __builtin_amdgcn_cvt_pk_f32_fp8(rw, false);
          f32x2 hi = __builtin_amdgcn_cvt_pk_f32_fp8(rw, true);
          o[4 * q] += c[j] * lo[0]; o[4 * q + 1] += c[j] * lo[1];
          o[4 * q + 2] += c[j] * hi[0]; o[4 * q + 3] += c[j] * hi[1];
        }
      }
    }
    const float* gate = MOD + (size_t)(layer * 5 + cidx(tok)) * 6144 + 5 * 1024;
#pragma unroll
    for (int i = 0; i < 4; ++i) {
      const int col = lane * 16 + 4 * i;
      float4 xv = *(const float4*)(X + (size_t)tok * 1024 + col);
      float4 gt = *(const float4*)(gate + col);
      xv.x += gt.x * o[4 * i]; xv.y += gt.y * o[4 * i + 1]; xv.z += gt.z * o[4 * i + 2]; xv.w += gt.w * o[4 * i + 3];
      *(float4*)(X + (size_t)tok * 1024 + col) = xv;
    }
  }
}

__device__ __forceinline__ void ssd_conv_phase(const Params& p) {
  bf16_t* BIG = (bf16_t*)(p.ws + OFF_BIG);
  const float* cw = p.ssd_conv_w;
  const float* cb = p.ssd_conv_b;
  const int total = 272 * 512;
  for (int it = blockIdx.x * 256 + threadIdx.x; it < total; it += gridDim.x * 256) {
    const int c8 = it & 511, r = it >> 9;
    const int c = c8 * 8;
    int tok0, len;
    if (r < 16) { tok0 = r * 256; len = 256; } else { tok0 = NCTX + (r - 16) * 64; len = 64; }
    float w0[8], w1[8], w2[8], bb[8];
#pragma unroll
    for (int j = 0; j < 8; ++j) { w0[j] = cw[c + j]; w1[j] = cw[4096 + c + j]; w2[j] = cw[8192 + c + j]; bb[j] = cb[c + j]; }
    bf16_t* base = BIG + (size_t)tok0 * 6144 + 2048 + c;
    uint4 buf[8], nxt[8];
#pragma unroll
    for (int j = 0; j < 8; ++j) buf[j] = *(const uint4*)(base + (size_t)j * 6144);
    uint4 prev = make_uint4(0, 0, 0, 0);
    for (int t0 = 0; t0 < len; t0 += 8) {
      const bool more = (t0 + 8) < len;
#pragma unroll
      for (int j = 0; j < 8; ++j) nxt[j] = more ? *(const uint4*)(base + (size_t)(t0 + 8 + j) * 6144) : make_uint4(0, 0, 0, 0);
#pragma unroll
      for (int j = 0; j < 8; ++j) {
        const uint4 cur = buf[j];
        const uint4 nx = (j < 7) ? buf[j + 1] : nxt[0];
        const unsigned* pp = (const unsigned*)&prev; const unsigned* cp = (const unsigned*)&cur; const unsigned* np = (const unsigned*)&nx;
        unsigned o[4];
#pragma unroll
        for (int q = 0; q < 4; ++q) {
          float a0 = w0[2 * q] * lo2f(pp[q]) + w1[2 * q] * lo2f(cp[q]) + w2[2 * q] * lo2f(np[q]) + bb[2 * q];
          float a1 = w0[2 * q + 1] * hi2f(pp[q]) + w1[2 * q + 1] * hi2f(cp[q]) + w2[2 * q + 1] * hi2f(np[q]) + bb[2 * q + 1];
          o[q] = pack2(siluf(a0), siluf(a1));
        }
        *(uint4*)(base + (size_t)(t0 + j) * 6144) = make_uint4(o[0], o[1], o[2], o[3]);
        prev = cur;
      }
#pragma unroll
      for (int j = 0; j < 8; ++j) buf[j] = nxt[j];
    }
  }
}

#define XT_STR 72
#define HB_STR 136
#define SCAN_LOAD_FRAGS(CC) { \
      { const int t_ = (CC) * 64 + 32 * it + l31; const int tok_ = tok0 + (dir ? L - 1 - t_ : t_); \
        const bf16_t* cp_ = BIG + (size_t)tok_ * 6144 + 5120 + g * 128 + 8 * h5; \
        _Pragma("unroll") for (int kk = 0; kk < 8; ++kk) cfr[kk] = *(const bf16x8*)(cp_ + 16 * kk); } \
      if (jt <= it) { const int t_ = (CC) * 64 + 32 * jt + l31; const int tok_ = tok0 + (dir ? L - 1 - t_ : t_); \
        const bf16_t* bp_ = BIG + (size_t)tok_ * 6144 + 4096 + g * 128 + 8 * h5; \
        _Pragma("unroll") for (int kk = 0; kk < 8; ++kk) bfr[kk] = *(const bf16x8*)(bp_ + 16 * kk); } }
#define SCAN_LOAD_STAGE(CC) { \
      const int t_ = (CC) * 64 + lane; const int tok_ = tok0 + (dir ? L - 1 - t_ : t_); \
      const bf16_t* rowp_ = BIG + (size_t)tok_ * 6144; \
      _Pragma("unroll") for (int r = 0; r < 2; ++r) sx[r] = *(const uint4*)(rowp_ + 2048 + head * 64 + (w + 4 * r) * 8); \
      _Pragma("unroll") for (int r = 0; r < 4; ++r) sb[r] = *(const uint4*)(rowp_ + 4096 + g * 128 + (w + 4 * r) * 8); \
      sdt = DT[(size_t)tok_ * 64 + dir * 32 + head]; }
__device__ __forceinline__ void scan_phase(const Params& p, char* smem) {
  bf16_t* XTd = (bf16_t*)smem;
  bf16_t* BTs = XTd + 64 * XT_STR;
  bf16_t* Ms = BTs + 128 * XT_STR;
  bf16_t* Hb = Ms + 64 * XT_STR;
  float* cumS = (float*)(Hb + 2 * 64 * HB_STR);
  const bf16_t* BIG = (const bf16_t*)(p.ws + OFF_BIG);
  const float* DT = (const float*)(p.ws + OFF_DT);
  const int tid = threadIdx.x, lane = tid & 63;
  const int w = __builtin_amdgcn_readfirstlane(tid >> 6);
  const int h5 = lane >> 5, l31 = lane & 31;
  const int it = w >> 1, jt = w & 1, pt = w & 1, nt0 = (w >> 1) * 2;
  for (int item = blockIdx.x; item < 1280; item += gridDim.x) {
    int b, head, dir, L, tok0;
    const bool latent = item < 256;
    if (latent) { b = item >> 6; head = (item >> 1) & 31; dir = item & 1; L = 4096; tok0 = NCTX + b * 4096; }
    else { int jj = item - 256; b = jj >> 6; head = (jj >> 1) & 31; dir = jj & 1; L = 256; tok0 = b * 256; }
    const int g = head >> 2;
    const float a = -expf(p.ssd_a_log[dir * 32 + head]);
    bf16_t* Y = (bf16_t*)(p.ws + (dir ? OFF_YB : OFF_YF));
    f32x16 st[2];
    const size_t sbase = ((size_t)((b * 2 + dir) * 32 + head)) * 8192;
    const int loff = (32 * pt + 4 * h5) * 128 + 32 * nt0 + l31;
    if (latent) {
      const float* sp = p.state_ssm + sbase + loff;
#pragma unroll
      for (int q = 0; q < 2; ++q)
#pragma unroll
        for (int r = 0; r < 16; ++r) st[q][r] = sp[((r & 3) + 8 * (r >> 2)) * 128 + 32 * q];
    } else {
#pragma unroll
      for (int q = 0; q < 2; ++q)
#pragma unroll
        for (int r = 0; r < 16; ++r) st[q][r] = 0.f;
    }
    {
      bf16_t* hb0 = Hb + (32 * pt + 4 * h5) * HB_STR + 32 * nt0 + l31;
#pragma unroll
      for (int q = 0; q < 2; ++q)
#pragma unroll
        for (int r = 0; r < 16; ++r) hb0[((r & 3) + 8 * (r >> 2)) * HB_STR + 32 * q] = f2bf(st[q][r]);
    }
    __syncthreads();
    const int nchunks = L >> 6;
    uint4 sx[2], sb[4];
    float sdt;
    SCAN_LOAD_STAGE(0)
    bf16x8 cfr[8], bfr[8];
    SCAN_LOAD_FRAGS(0)
#pragma nounroll
    for (int c = 0; c < nchunks; ++c) {
      const int cur = c & 1;
      __builtin_amdgcn_sched_barrier(0);
      float cum = sdt * a;
#pragma unroll
      for (int off = 1; off < 64; off <<= 1) {
        const float tv = __shfl_up(cum, off);
        cum += (lane >= off) ? tv : 0.f;
      }
      const float cum_last = __shfl(cum, 63);
      const float wj = __expf(cum_last - cum);
      if (w == 0) cumS[cur * 64 + lane] = cum;
#pragma unroll
      for (int r = 0; r < 2; ++r) {
        const int p8 = (w + 4 * r) * 8;
#pragma unroll
        for (int q = 0; q < 4; ++q) {
          const unsigned u = u4get(sx[r], q);
          XTd[(p8 + 2 * q) * XT_STR + lane] = f2bf(sdt * lo2f(u));
          XTd[(p8 + 2 * q + 1) * XT_STR + lane] = f2bf(sdt * hi2f(u));
        }
      }
#pragma unroll
      for (int r = 0; r < 4; ++r) {
        const int n8 = (w + 4 * r) * 8;
#pragma unroll
        for (int q = 0; q < 4; ++q) {
          const unsigned u = u4get(sb[r], q);
          BTs[(n8 + 2 * q) * XT_STR + lane] = f2bf(wj * lo2f(u));
          BTs[(n8 + 2 * q + 1) * XT_STR + lane] = f2bf(wj * hi2f(u));
        }
      }
      if (c + 1 < nchunks) SCAN_LOAD_STAGE(c + 1)
      __builtin_amdgcn_sched_barrier(0);
      f32x16 cb;
#pragma unroll
      for (int r = 0; r < 16; ++r) cb[r] = 0.f;
      if (jt <= it) {
#pragma unroll
        for (int kk = 0; kk < 8; ++kk) cb = __builtin_amdgcn_mfma_f32_32x32x16_bf16(cfr[kk], bfr[kk], cb, 0, 0, 0);
      }
      __builtin_amdgcn_sched_barrier(0);
      f32x16 yo;
#pragma unroll
      for (int r = 0; r < 16; ++r) yo[r] = 0.f;
      {
        const bf16_t* hp = Hb + cur * 64 * HB_STR + (32 * pt + l31) * HB_STR + 8 * h5;
#pragma unroll
        for (int kk = 0; kk < 8; ++kk) {
          const bf16x8 hf = *(const bf16x8*)(hp + 16 * kk);
          yo = __builtin_amdgcn_mfma_f32_32x32x16_bf16(cfr[kk], hf, yo, 0, 0, 0);
        }
      }
      __builtin_amdgcn_sched_barrier(0);
      if (c + 1 < nchunks) SCAN_LOAD_FRAGS(c + 1)
      __syncthreads();
      __builtin_amdgcn_sched_barrier(0);
      const float dec = __expf(cum_last);
      bf16x8 xf[4];
#pragma unroll
      for (int kk = 0; kk < 4; ++kk) xf[kk] = *(const bf16x8*)(XTd + (32 * pt + l31) * XT_STR + 16 * kk + 8 * h5);
#pragma unroll
      for (int q = 0; q < 2; ++q) {
#pragma unroll
        for (int r = 0; r < 16; ++r) st[q][r] *= dec;
#pragma unroll
        for (int kk = 0; kk < 4; ++kk) {
          const bf16x8 bt = *(const bf16x8*)(BTs + (32 * (nt0 + q) + l31) * XT_STR + 16 * kk + 8 * h5);
          st[q] = __builtin_amdgcn_mfma_f32_32x32x16_bf16(xf[kk], bt, st[q], 0, 0, 0);
        }
        {
          bf16_t* hbw = Hb + (cur ^ 1) * 64 * HB_STR + (32 * pt + 4 * h5) * HB_STR + 32 * (nt0 + q) + l31;
#pragma unroll
          for (int r = 0; r < 16; ++r) hbw[((r & 3) + 8 * (r >> 2)) * HB_STR] = f2bf(st[q][r]);
        }
      }
      __builtin_amdgcn_sched_barrier(0);
      if (jt <= it) {
        const int jj = 32 * jt + l31;
        const float cj = cumS[cur * 64 + jj];
        const int ib = 32 * it + 4 * h5;
        const float* cs = cumS + cur * 64 + ib;
        bf16_t* mw = Ms + ib * XT_STR + jj;
#pragma unroll
        for (int r = 0; r < 16; ++r) {
          const int ro = (r & 3) + 8 * (r >> 2);
          const float m = (jj <= ib + ro) ? cb[r] * __expf(cs[ro] - cj) : 0.f;
          mw[ro * XT_STR] = f2bf(m);
        }
      }
      __syncthreads();
      __builtin_amdgcn_sched_barrier(0);
      f32x16 yd;
#pragma unroll
      for (int r = 0; r < 16; ++r) yd[r] = 0.f;
#pragma unroll
      for (int kk = 0; kk < 4; ++kk) {
        if (kk < 2 * (it + 1)) {
          const bf16x8 mf = *(const bf16x8*)(Ms + (32 * it + l31) * XT_STR + 16 * kk + 8 * h5);
          yd = __builtin_amdgcn_mfma_f32_32x32x16_bf16(mf, xf[kk], yd, 0, 0, 0);
        }
      }
      {
        const int t0c = c * 64 + 32 * it + 4 * h5;
        const int tokb = tok0 + (dir ? L - 1 - t0c : t0c);
        const int rs = dir ? -2048 : 2048;
        bf16_t* yp = Y + (size_t)tokb * 2048 + head * 64 + 32 * pt + l31;
        const float* cs = cumS + cur * 64 + 32 * it + 4 * h5;
#pragma unroll
        for (int r = 0; r < 16; ++r) {
          const int ro = (r & 3) + 8 * (r >> 2);
          const float yv = yd[r] + __expf(cs[ro]) * yo[r];
          yp[(ptrdiff_t)rs * ro] = f2bf(yv);
        }
      }
    }
    if (!latent) {
      float* sp = p.out + (size_t)NT * 1024 + sbase + loff;
#pragma unroll
      for (int q = 0; q < 2; ++q)
#pragma unroll
        for (int r = 0; r < 16; ++r) sp[((r & 3) + 8 * (r >> 2)) * 128 + 32 * q] = st[q][r];
    }
    __syncthreads();
  }
}

__device__ __forceinline__ void gate_norm_phase(const Params& p) {
  const bf16_t* BIG = (const bf16_t*)(p.ws + OFF_BIG);
  bf16_t* YF = (bf16_t*)(p.ws + OFF_YF);
  const bf16_t* YB = (const bf16_t*)(p.ws + OFF_YB);
  const int lane = threadIdx.x & 63, w = threadIdx.x >> 6;
  for (int tok = blockIdx.x * 4 + w; tok < NT; tok += gridDim.x * 4) {
    float v[32];
    float ss = 0.f;
#pragma unroll
    for (int i = 0; i < 4; ++i) {
      const int col = lane * 8 + 512 * i;
      const int head = col >> 6;
      const float dtot = p.ssd_d[head] + p.ssd_d[32 + head];
      uint4 a = *(const uint4*)(YF + (size_t)tok * 2048 + col);
      uint4 b = *(const uint4*)(YB + (size_t)tok * 2048 + col);
      uint4 x = *(const uint4*)(BIG + (size_t)tok * 6144 + 2048 + col);
      uint4 z = *(const uint4*)(BIG + (size_t)tok * 6144 + col);
      const unsigned* ap = (const unsigned*)&a; const unsigned* bp = (const unsigned*)&b;
      const unsigned* xp = (const unsigned*)&x; const unsigned* zp = (const unsigned*)&z;
#pragma unroll
      for (int q = 0; q < 4; ++q) {
        float y0 = lo2f(ap[q]) + lo2f(bp[q]) + dtot * lo2f(xp[q]);
        float y1 = hi2f(ap[q]) + hi2f(bp[q]) + dtot * hi2f(xp[q]);
        y0 *= siluf(lo2f(zp[q]));
        y1 *= siluf(hi2f(zp[q]));
        v[8 * i + 2 * q] = y0; v[8 * i + 2 * q + 1] = y1;
        ss += y0 * y0 + y1 * y1;
      }
    }
    ss = wave_sum(ss);
    const float sc = rsqrtf(ss * (1.f / 2048.f) + 1e-6f);
#pragma unroll
    for (int i = 0; i < 4; ++i) {
      const int col = lane * 8 + 512 * i;
      float4 g0 = *(const float4*)(p.ssd_norm_g + col), g1 = *(const float4*)(p.ssd_norm_g + col + 4);
      uint4 o;
      o.x = pack2(v[8 * i] * sc * g0.x, v[8 * i + 1] * sc * g0.y);
      o.y = pack2(v[8 * i + 2] * sc * g0.z, v[8 * i + 3] * sc * g0.w);
      o.z = pack2(v[8 * i + 4] * sc * g1.x, v[8 * i + 5] * sc * g1.y);
      o.w = pack2(v[8 * i + 6] * sc * g1.z, v[8 * i + 7] * sc * g1.w);
      *(uint4*)(YF + (size_t)tok * 2048 + col) = o;
    }
  }
}

__device__ __forceinline__ void final_norm_phase(const Params& p) {
  const int lane = threadIdx.x & 63, w = threadIdx.x >> 6;
  for (int tok = blockIdx.x * 4 + w; tok < NT; tok += gridDim.x * 4) {
    float* xr = p.out + (size_t)tok * 1024;
    float4 v[4];
    float ss = 0.f;
#pragma unroll
    for (int i = 0; i < 4; ++i) {
      v[i] = *(const float4*)(xr + lane * 4 + 256 * i);
      ss += v[i].x * v[i].x + v[i].y * v[i].y + v[i].z * v[i].z + v[i].w * v[i].w;
    }
    ss = wave_sum(ss);
    const float sc = rsqrtf(ss * (1.f / 1024.f) + 1e-6f);
#pragma unroll
    for (int i = 0; i < 4; ++i) {
      const int col = lane * 4 + 256 * i;
      float4 gg = *(const float4*)(p.norm_f_g + col);
      *(float4*)(xr + col) = make_float4(v[i].x * sc * gg.x, v[i].y * sc * gg.y, v[i].z * sc * gg.z, v[i].w * sc * gg.w);
    }
  }
}


#define XB_TMO      128
#define XB_XCNT(j)  (256  + 64 * (j))
#define XB_XSUB(j)  (1280 + 64 * (j))
#define XB_XGEN(j)  (2304 + 64 * (j))
#define XB_TOP      3328
#define XB_TOPGEN   3392
#define XCD_BAR_WORDS 3456
#define XB_SPIN_CAP (1u << 22)
#define LAS __attribute__((address_space(3)))
__device__ __forceinline__ unsigned xb_ld(unsigned* p) { return __hip_atomic_load(p, __ATOMIC_RELAXED, __HIP_MEMORY_SCOPE_AGENT); }
__device__ __forceinline__ unsigned xb_add(unsigned* p, unsigned v) { return __hip_atomic_fetch_add(p, v, __ATOMIC_RELAXED, __HIP_MEMORY_SCOPE_AGENT); }
__device__ __forceinline__ unsigned xb_xcc_id() { return (unsigned)__builtin_amdgcn_s_getreg((3 << 11) | 20) & 0xFu; }
#define XB_SPIN(cond, bar) do { unsigned _sp = 0; while (cond) { __builtin_amdgcn_s_sleep(1); \
    if ((++_sp & 255u) == 0u) { if (xb_ld(&(bar)[XB_TMO])) break; if (_sp > XB_SPIN_CAP) { atomicAdd(&(bar)[XB_TMO], 1u); break; } } } } while (0)
struct XcdBarrier { unsigned* bar; unsigned x; volatile LAS unsigned* st; };
__device__ __forceinline__ XcdBarrier xcd_barrier_post(unsigned* bar, volatile LAS unsigned* st) {
  XcdBarrier b; b.bar = bar; b.x = xb_xcc_id(); b.st = st;
  if (threadIdx.x == 0) (void)xb_add(&bar[XB_XCNT(b.x)], 1u);
  return b;
}
__device__ __forceinline__ void xcd_barrier_complete(unsigned* bar, unsigned x, unsigned& nloc, unsigned& nx) {
  const unsigned G = gridDim.x * gridDim.y * gridDim.z;
  unsigned sum, cnt, mine, sp = 0u;
  for (;;) {
    sum = 0u; cnt = 0u; mine = 0u;
#pragma unroll
    for (unsigned j = 0; j < 16; ++j) { const unsigned c = xb_ld(&bar[XB_XCNT(j)]); sum += c; cnt += (c > 0u) ? 1u : 0u; mine = (j == x) ? c : mine; }
    if (sum == G) break;
    __builtin_amdgcn_s_sleep(1);
    if ((++sp & 255u) == 0u) { if (xb_ld(&bar[XB_TMO])) break; if (sp > XB_SPIN_CAP) { atomicAdd(&bar[XB_TMO], 1u); break; } }
  }
  nloc = mine > 0u ? mine : 1u; nx = cnt > 0u ? cnt : 1u;
}
__device__ __forceinline__ void xcd_barrier(const XcdBarrier& b) {
  asm volatile("s_waitcnt vmcnt(0)" ::: "memory");
  __syncthreads();
  if (threadIdx.x == 0) {
    unsigned* bar = b.bar;
    __builtin_amdgcn_s_waitcnt(0);
    unsigned nloc = b.st[0], nx = b.st[1];
    if (nloc == 0u) { xcd_barrier_complete(bar, b.x, nloc, nx); b.st[0] = nloc; b.st[1] = nx; }
    const unsigned old = xb_add(&bar[XB_XSUB(b.x)], 1u);
    const unsigned gen = old / nloc;
    if (old + 1u == (gen + 1u) * nloc) {
      __builtin_amdgcn_fence(__ATOMIC_RELEASE, "agent");
      asm volatile("s_waitcnt vmcnt(0)" ::: "memory");
      const unsigned og = xb_add(&bar[XB_TOP], 1u);
      const unsigned tg = og / nx;
      if (og + 1u == (tg + 1u) * nx) xb_add(&bar[XB_TOPGEN], 1u);
      else XB_SPIN(xb_ld(&bar[XB_TOPGEN]) == tg, bar);
      __builtin_amdgcn_fence(__ATOMIC_ACQUIRE, "agent");
      xb_add(&bar[XB_XGEN(b.x)], 1u);
      asm volatile("s_waitcnt vmcnt(0)" ::: "memory");
    } else {
      XB_SPIN(xb_ld(&bar[XB_XGEN(b.x)]) == gen, bar);
      __builtin_amdgcn_fence(__ATOMIC_ACQUIRE, "agent");
      asm volatile("s_waitcnt vmcnt(0)" ::: "memory");
    }
  }
  __syncthreads();
}

#define N_PHASES 20
__global__ void __launch_bounds__(256, 2) mk(Params p, int ph_begin, int ph_end) {
  __shared__ __attribute__((aligned(16))) char smem[SMEM_BYTES];
  __shared__ uint4 xb_words;
  const bool multi = (ph_end - ph_begin) > 1;
  if (threadIdx.x == 0) xb_words = make_uint4(0u, 0u, 0u, 0u);
  __syncthreads();
  XcdBarrier xb;
  xb.bar = (unsigned*)(p.ws + OFF_BAR); xb.x = 0; xb.st = (volatile LAS unsigned*)&xb_words;
  if (multi) xb = xcd_barrier_post((unsigned*)(p.ws + OFF_BAR), (volatile LAS unsigned*)&xb_words);
  bf16_t* WT = (bf16_t*)(p.ws + OFF_WT);
  bf16_t* BIG = (bf16_t*)(p.ws + OFF_BIG);
  bf16_t* Abuf = (bf16_t*)(p.ws + OFF_YF);
  float* MOD = (float*)(p.ws + OFF_MOD);
#define RUN(PH, CALL) if (ph_begin <= PH && PH < ph_end) { CALL; if (PH + 1 < ph_end) { if (PH == 0) cg::this_grid().sync(); else xcd_barrier(xb); } }
  RUN(0, prep_phase(p, smem))
  RUN(1, norm_mod_phase(p, 0, 0, true))
  RUN(2, gemm_phase(Abuf, WT + WT_SCIN, NT, 3072, 1024, EpiBf16{BIG, 3072}, smem))
  RUN(3, conv_gate_phase(p))
  RUN(4, gemm_phase((const bf16_t*)(p.ws + OFF_BIG + 120 * MIB), WT + WT_SCOUT, NT, 1024, 1024,
                    EpiRes{p.x_prompt, p.x_sample, p.out, MOD + 0 * 5 * 6144 + 2 * 1024}, smem))
  RUN(5, norm_mod_phase(p, 0, 1, false))
  RUN(6, gemm_phase(Abuf, WT + WT_WQ, NT, 2048, 1024, EpiBf16{BIG, 2048}, smem))
  RUN(7, topk_phase(p, 0, smem))
  RUN(8, peer_phase(p, 0, smem))
  RUN(9, norm_mod_phase(p, 1, 0, false))
  RUN(10, gemm_phase(Abuf, WT + WT_SSDIN, NT, 6208, 1024, EpiSsdIn{BIG, (float*)(p.ws + OFF_DT), p.ssd_dt_bias}, smem))
  RUN(11, ssd_conv_phase(p))
  RUN(12, scan_phase(p, smem))
  RUN(13, gate_norm_phase(p))
  RUN(14, gemm_phase(Abuf, WT + WT_SSDOUT, NT, 1024, 2048,
                     EpiRes{p.out, p.out + (size_t)NCTX * 1024, p.out, MOD + 1 * 5 * 6144 + 2 * 1024}, smem))
  RUN(15, norm_mod_phase(p, 1, 1, false))
  RUN(16, gemm_phase(Abuf, WT + WT_WQ + (size_t)2048 * 1024, NT, 2048, 1024, EpiBf16{BIG, 2048}, smem))
  RUN(17, topk_phase(p, 1, smem))
  RUN(18, peer_phase(p, 1, smem))
  RUN(19, final_norm_phase(p))
}

extern "C" void kernel_launch(void* const* d_in, const int* in_sizes, int n_in, void* d_out, int out_size, void* d_ws, size_t ws_size,
                              hipStream_t stream) {
  static int grid_blocks = 0;
  if (!grid_blocks) {
    int dev = 0, cus = 0, per_cu = 0;
    hipGetDevice(&dev);
    hipDeviceGetAttribute(&cus, hipDeviceAttributeMultiprocessorCount, dev);
    hipOccupancyMaxActiveBlocksPerMultiprocessor(&per_cu, mk, 256, 0);
    if (per_cu < 1) per_cu = 1;
    if (per_cu > 2) per_cu = 2;
    grid_blocks = cus * per_cu;
  }
  if (ws_size < WS_NEEDED) { fprintf(stderr, "workspace too small: %zu\n", ws_size); return; }
  Params p{};
  const float** pf = (const float**)&p;
  for (int i = 0; i < 25; ++i) pf[i] = (const float*)d_in[i];
  p.out = (float*)d_out;
  p.ws = (char*)d_ws;
#if COOP
  hipMemsetAsync((char*)d_ws + OFF_BAR, 0, 16384, stream);
  int b = 0, e = N_PHASES;
  void* args[] = {&p, &b, &e};
  hipError_t err = hipLaunchCooperativeKernel((void*)mk, dim3(grid_blocks), dim3(256), args, 0, stream);
  if (err != hipSuccess) fprintf(stderr, "cooperative launch failed: %s (grid %d)\n", hipGetErrorString(err), grid_blocks);
#else
  for (int ph = 0; ph < N_PHASES; ++ph) {
    hipLaunchKernelGGL(mk, dim3(grid_blocks), dim3(256), 0, stream, p, ph, ph + 1);
    if ((DUP_MASK >> ph) & 1) hipLaunchKernelGGL(mk, dim3(grid_blocks), dim3(256), 0, stream, p, ph, ph + 1);
  }
#endif
}
```

```cpp
#include <hip/hip_runtime.h>
#include <hip/hip_cooperative_groups.h>
#include <cstdio>
namespace cg = cooperative_groups;

#ifndef COOP
#define COOP 1
#endif
#ifndef DUP_MASK
#define DUP_MASK 0
#endif

typedef unsigned short bf16_t;
typedef __attribute__((ext_vector_type(8))) short bf16x8;
typedef __attribute__((ext_vector_type(16))) float f32x16;

#define NT 20480
#define NCTX 4096
#define DM 1024
#define MIB ((size_t)1 << 20)
#define OFF_BIG   ((size_t)0)
#define OFF_YF    (240 * MIB)
#define OFF_YB    (320 * MIB)
#define OFF_WT    (400 * MIB)
#define OFF_KEYSB (433 * MIB)
#define OFF_DT    (434 * MIB)
#define OFF_MOD   (439 * MIB)
#define OFF_IDX   (440 * MIB)
#define OFF_GATE  (450 * MIB)
#define OFF_TAB1  (460 * MIB)
#define OFF_SCALE (492 * MIB)
#define OFF_BAR   (493 * MIB)
#define WS_NEEDED (494 * MIB)
#define WT_SCIN   ((size_t)0)
#define WT_SCOUT  (WT_SCIN + (size_t)3072 * 1024)
#define WT_SSDIN  (WT_SCOUT + (size_t)1024 * 1024)
#define WT_SSDOUT (WT_SSDIN + (size_t)6208 * 1024)
#define WT_WQ     (WT_SSDOUT + (size_t)1024 * 2048)

#define SMEM_BYTES 75776

struct Params {
  const float *x_prompt, *x_sample, *state_ssm, *c, *c_ctx, *norm_mix_g, *norm_ffn_g, *norm_f_g, *ada_w, *ada_b;
  const float *sc_w_in, *sc_conv_w, *sc_w_out, *ssd_w_in, *ssd_conv_w, *ssd_conv_b, *ssd_dt_bias, *ssd_a_log, *ssd_d;
  const float *ssd_norm_g, *ssd_w_out, *peer_wq, *peer_keys, *peer_u, *peer_v;
  float* out;
  char* ws;
};

__device__ __forceinline__ float bf2f(bf16_t h) { return __uint_as_float(((unsigned)h) << 16); }
__device__ __forceinline__ bf16_t f2bf(float f) {
  unsigned u = __float_as_uint(f);
  u += 0x7FFFu + ((u >> 16) & 1u);
  return (bf16_t)(u >> 16);
}
__device__ __forceinline__ unsigned pack2(float a, float b) { return (unsigned)f2bf(a) | ((unsigned)f2bf(b) << 16); }
__device__ __forceinline__ float lo2f(unsigned u) { return __uint_as_float(u << 16); }
__device__ __forceinline__ float hi2f(unsigned u) { return __uint_as_float(u & 0xffff0000u); }
__device__ __forceinline__ unsigned u4get(const uint4 v, const int q) { return q == 0 ? v.x : (q == 1 ? v.y : (q == 2 ? v.z : v.w)); }
__device__ __forceinline__ float siluf(float x) { return x / (1.f + __expf(-x)); }
__device__ __forceinline__ int cidx(int tok) { return tok < NCTX ? 0 : 1 + ((tok - NCTX) >> 12); }

template <int CTRL>
__device__ __forceinline__ unsigned dpp_u(unsigned v) {
  return (unsigned)__builtin_amdgcn_update_dpp(0, (int)v, CTRL, 0xF, 0xF, true);
}
template <int CTRL>
__device__ __forceinline__ float dpp_f(float v) {
  return __int_as_float(__builtin_amdgcn_update_dpp(0, __float_as_int(v), CTRL, 0xF, 0xF, true));
}
__device__ __forceinline__ float row16_sum(float v) {
  v += dpp_f<0xB1>(v);
  v += dpp_f<0x4E>(v);
  v += dpp_f<0x141>(v);
  v += dpp_f<0x140>(v);
  return v;
}
__device__ __forceinline__ unsigned umax_(unsigned a, unsigned b) { return a > b ? a : b; }
__device__ __forceinline__ unsigned wave_max_u32(unsigned v) {
  v = umax_(v, dpp_u<0xB1>(v));
  v = umax_(v, dpp_u<0x4E>(v));
  v = umax_(v, dpp_u<0x141>(v));
  v = umax_(v, dpp_u<0x140>(v));
  unsigned a = (unsigned)__builtin_amdgcn_readlane((int)v, 0);
  unsigned b = (unsigned)__builtin_amdgcn_readlane((int)v, 16);
  unsigned c = (unsigned)__builtin_amdgcn_readlane((int)v, 32);
  unsigned d = (unsigned)__builtin_amdgcn_readlane((int)v, 48);
  return umax_(umax_(a, b), umax_(c, d));
}
__device__ __forceinline__ float wave_sum(float v) {
  v = row16_sum(v);
  float a, b, c, d;
  a = __int_as_float(__builtin_amdgcn_readlane(__float_as_int(v), 0));
  b = __int_as_float(__builtin_amdgcn_readlane(__float_as_int(v), 16));
  c = __int_as_float(__builtin_amdgcn_readlane(__float_as_int(v), 32));
  d = __int_as_float(__builtin_amdgcn_readlane(__float_as_int(v), 48));
  return (a + b) + (c + d);
}
__device__ __forceinline__ unsigned fkey(float f) {
  unsigned u = __float_as_uint(f);
  return (u & 0x80000000u) ? ~u : (u | 0x80000000u);
}
__device__ __forceinline__ float keyf(unsigned k) {
  unsigned u = (k & 0x80000000u) ? (k & 0x7fffffffu) : ~k;
  return __uint_as_float(u);
}

__device__ __forceinline__ void transpose_tile(const float* __restrict__ src, int K, int N, bf16_t* __restrict__ dst, int tile, float* tb) {
  const int tid = threadIdx.x;
  const int ntn = N >> 6;
  const int kt = tile / ntn, nt = tile % ntn;
  {
    const int n = tid & 63, kb = tid >> 6;
#pragma unroll
    for (int i = 0; i < 16; ++i) {
      int k = kb + 4 * i;
      tb[k * 65 + n] = src[(size_t)(kt * 64 + k) * N + nt * 64 + n];
    }
  }
  __syncthreads();
  {
    const int k8 = (tid & 7) * 8;
#pragma unroll
    for (int pass = 0; pass < 2; ++pass) {
      int n = (tid >> 3) + 32 * pass;
      uint4 o;
      o.x = pack2(tb[(k8 + 0) * 65 + n], tb[(k8 + 1) * 65 + n]);
      o.y = pack2(tb[(k8 + 2) * 65 + n], tb[(k8 + 3) * 65 + n]);
      o.z = pack2(tb[(k8 + 4) * 65 + n], tb[(k8 + 5) * 65 + n]);
      o.w = pack2(tb[(k8 + 6) * 65 + n], tb[(k8 + 7) * 65 + n]);
      *(uint4*)(dst + (size_t)(nt * 64 + n) * K + kt * 64 + k8) = o;
    }
  }
  __syncthreads();
}

__device__ __forceinline__ void prep_phase(const Params& p, char* smem) {
  const int tid = threadIdx.x;
  bf16_t* WT = (bf16_t*)(p.ws + OFF_WT);
  float* MOD = (float*)(p.ws + OFF_MOD);
  bf16_t* KEYSB = (bf16_t*)(p.ws + OFF_KEYSB);
  const int U_MOD = 192, U_T0 = 768, U_T1 = 256, U_T2 = 1552, U_T3 = 512, U_T4 = 1024, U_KEYS = 256, U_TAB = 16384;
  const int total = U_MOD + U_T0 + U_T1 + U_T2 + U_T3 + U_T4 + U_KEYS + U_TAB;
  for (int u = blockIdx.x; u < total; u += gridDim.x) {
    int v = u;
    if (v < U_MOD) {
      float* scond = (float*)smem;
      float* red = scond + 5 * 1024;
      for (int i = tid; i < 5 * 1024; i += 256) {
        int r = i >> 10, k = i & 1023;
        float cv = (r == 0) ? p.c_ctx[k] : p.c[(r - 1) * 1024 + k];
        scond[i] = siluf(cv);
      }
      __syncthreads();
      const int l = v / 96, jc = v % 96;
      const int jj = tid & 63, kq = tid >> 6;
      const int j = jc * 64 + jj;
      float acc[5] = {0.f, 0.f, 0.f, 0.f, 0.f};
      const float* wp = p.ada_w + ((size_t)l * 1024 + kq * 256) * 6144 + j;
#pragma unroll 8
      for (int k = 0; k < 256; ++k) {
        float wv = wp[(size_t)k * 6144];
#pragma unroll
        for (int r = 0; r < 5; ++r) acc[r] += scond[r * 1024 + kq * 256 + k] * wv;
      }
#pragma unroll
      for (int r = 0; r < 5; ++r) red[(kq * 5 + r) * 64 + jj] = acc[r];
      __syncthreads();
      for (int i = tid; i < 320; i += 256) {
        int r = i >> 6, j2 = i & 63;
        float s = red[(0 * 5 + r) * 64 + j2] + red[(1 * 5 + r) * 64 + j2] + red[(2 * 5 + r) * 64 + j2] + red[(3 * 5 + r) * 64 + j2];
        MOD[(size_t)(l * 5 + r) * 6144 + jc * 64 + j2] = s + p.ada_b[l * 6144 + jc * 64 + j2];
      }
      __syncthreads();
      continue;
    }
    v -= U_MOD;
    float* tb = (float*)smem;
    if (v < U_T0) { transpose_tile(p.sc_w_in, 1024, 3072, WT + WT_SCIN, v, tb); continue; }
    v -= U_T0;
    if (v < U_T1) { transpose_tile(p.sc_w_out, 1024, 1024, WT + WT_SCOUT, v, tb); continue; }
    v -= U_T1;
    if (v < U_T2) { transpose_tile(p.ssd_w_in, 1024, 6208, WT + WT_SSDIN, v, tb); continue; }
    v -= U_T2;
    if (v < U_T3) { transpose_tile(p.ssd_w_out, 2048, 1024, WT + WT_SSDOUT, v, tb); continue; }
    v -= U_T3;
    if (v < U_T4) {
      int l = v >> 9, t = v & 511;
      transpose_tile(p.peer_wq + (size_t)l * 1024 * 2048, 1024, 2048, WT + WT_WQ + (size_t)l * 2048 * 1024, t, tb);
      continue;
    }
    v -= U_T4;
    if (v < U_KEYS) {
      size_t base = (size_t)v * 2048 + tid * 8;
      float4 a = *(const float4*)(p.peer_keys + base);
      float4 b = *(const float4*)(p.peer_keys + base + 4);
      uint4 o;
      o.x = pack2(a.x, a.y); o.y = pack2(a.z, a.w); o.z = pack2(b.x, b.y); o.w = pack2(b.z, b.w);
      *(uint4*)(KEYSB + base) = o;
      continue;
    }
    v -= U_KEYS;
    {
      const int lane = tid & 63;
      const int gr = v * 4 + (tid >> 6);
      const int l = gr >> 15, tab = (gr >> 14) & 1, row = gr & 16383;
      const float* src = (tab ? p.peer_v : p.peer_u) + ((size_t)l * 16384 + row) * 1024 + lane * 16;
      float4 x[4];
      float am = 0.f;
#pragma unroll
      for (int j = 0; j < 4; ++j) {
        x[j] = *(const float4*)(src + 4 * j);
        am = fmaxf(am, fmaxf(fmaxf(fabsf(x[j].x), fabsf(x[j].y)), fmaxf(fabsf(x[j].z), fabsf(x[j].w))));
      }
      am = __uint_as_float(wave_max_u32(__float_as_uint(am)));
      const float inv = am > 0.f ? 440.f / am : 0.f;
      const float scale = am > 0.f ? am / 440.f : 0.f;
      unsigned o[4];
#pragma unroll
      for (int j = 0; j < 4; ++j) {
        int wv = __builtin_amdgcn_cvt_pk_fp8_f32(x[j].x * inv, x[j].y * inv, 0, false);
        wv = __builtin_amdgcn_cvt_pk_fp8_f32(x[j].z * inv, x[j].w * inv, wv, true);
        o[j] = (unsigned)wv;
      }
      unsigned char* dst = (unsigned char*)(p.ws + (l ? OFF_TAB1 : OFF_YB)) + ((size_t)tab * 16384 + row) * 1024 + lane * 16;
      *(uint4*)dst = make_uint4(o[0], o[1], o[2], o[3]);
      if (lane == 0) ((float*)(p.ws + OFF_SCALE))[gr] = scale;
    }
  }
}

__device__ __forceinline__ void norm_mod_phase(const Params& p, int layer, int which, bool from_input) {
  const float* g = (which == 0 ? p.norm_mix_g : p.norm_ffn_g) + layer * 1024;
  const float* MOD = (const float*)(p.ws + OFF_MOD);
  bf16_t* A = (bf16_t*)(p.ws + OFF_YF);
  const int lane = threadIdx.x & 63, w = threadIdx.x >> 6;
  for (int tok = blockIdx.x * 4 + w; tok < NT; tok += gridDim.x * 4) {
    const float* xr = from_input ? (tok < NCTX ? p.x_prompt + (size_t)tok * 1024 : p.x_sample + (size_t)(tok - NCTX) * 1024)
                                 : p.out + (size_t)tok * 1024;
    const float* md = MOD + (size_t)(layer * 5 + cidx(tok)) * 6144 + (which ? 3 * 1024 : 0);
    float4 v[4];
    float ss = 0.f;
#pragma unroll
    for (int i = 0; i < 4; ++i) {
      v[i] = *(const float4*)(xr + lane * 4 + 256 * i);
      ss += v[i].x * v[i].x + v[i].y * v[i].y + v[i].z * v[i].z + v[i].w * v[i].w;
    }
    ss = wave_sum(ss);
    const float sc = rsqrtf(ss * (1.f / 1024.f) + 1e-6f);
#pragma unroll
    for (int i = 0; i < 4; ++i) {
      const int col = lane * 4 + 256 * i;
      float4 gg = *(const float4*)(g + col);
      float4 sh = *(const float4*)(md + col);
      float4 sl = *(const float4*)(md + 1024 + col);
      float o0 = v[i].x * sc * gg.x * (1.f + sl.x) + sh.x;
      float o1 = v[i].y * sc * gg.y * (1.f + sl.y) + sh.y;
      float o2 = v[i].z * sc * gg.z * (1.f + sl.z) + sh.z;
      float o3 = v[i].w * sc * gg.w * (1.f + sl.w) + sh.w;
      uint2 o;
      o.x = pack2(o0, o1);
      o.y = pack2(o2, o3);
      *(uint2*)(A + (size_t)tok * 1024 + col) = o;
    }
  }
}

#define LSTR 72
template <class Epi>
__device__ __forceinline__ void gemm_phase(const bf16_t* __restrict__ A, const bf16_t* __restrict__ Bt, int M, int N, int K, Epi epi, char* smem) {
  bf16_t* sA = (bf16_t*)smem;
  bf16_t* sB = sA + 2 * 128 * LSTR;
  float* sC = (float*)smem;
  const int tid = threadIdx.x, lane = tid & 63, w = tid >> 6;
  const int wm = w >> 1, wn = w & 1;
  const int ntn = (N + 127) >> 7, ntm = M >> 7;
  const int ntiles = ntm * ntn;
  const int KT = K >> 6;
  const int lrow = tid >> 3, lkc = (tid & 7) * 8;
  const bf16_t* ap[4];
  const bf16_t* bp[4];
  uint4 ra0_0, ra0_1, ra0_2, ra0_3, rb0_0, rb0_1, rb0_2, rb0_3, ra1_0, ra1_1, ra1_2, ra1_3, rb1_0, rb1_1, rb1_2, rb1_3;
#define G_PTRS(TILE_) { const int m0_ = ((TILE_) / ntn) << 7, n0_ = ((TILE_) % ntn) << 7; \
    _Pragma("unroll") for (int i = 0; i < 4; ++i) { const int row_ = lrow + 32 * i; ap[i] = A + (size_t)(m0_ + row_) * K + lkc; \
      int br_ = n0_ + row_; br_ = br_ < N ? br_ : N - 1; bp[i] = Bt + (size_t)br_ * K + lkc; } }
#define G_LOAD1(S, I, KT_) { ra##S##_##I = *(const uint4*)(ap[I] + (KT_) * 64); rb##S##_##I = *(const uint4*)(bp[I] + (KT_) * 64); }
#define G_LOAD(S, KT_) { G_LOAD1(S, 0, KT_) G_LOAD1(S, 1, KT_) G_LOAD1(S, 2, KT_) G_LOAD1(S, 3, KT_) }
#define G_WRITE1(S, I, BUF_) { *(uint4*)(sA + (BUF_) * 128 * LSTR + (lrow + 32 * I) * LSTR + lkc) = ra##S##_##I; *(uint4*)(sB + (BUF_) * 128 * LSTR + (lrow + 32 * I) * LSTR + lkc) = rb##S##_##I; }
#define G_WRITE(S, BUF_) { G_WRITE1(S, 0, BUF_) G_WRITE1(S, 1, BUF_) G_WRITE1(S, 2, BUF_) G_WRITE1(S, 3, BUF_) }
#define G_MMA(KK, BUF_) { \
        bf16x8 a0 = *(const bf16x8*)(cA + KK * 16); \
        bf16x8 a1 = *(const bf16x8*)(cA + 32 * LSTR + KK * 16); \
        bf16x8 b0 = *(const bf16x8*)(cB + KK * 16); \
        bf16x8 b1 = *(const bf16x8*)(cB + 32 * LSTR + KK * 16); \
        acc[0][0] = __builtin_amdgcn_mfma_f32_32x32x16_bf16(a0, b0, acc[0][0], 0, 0, 0); \
        acc[0][1] = __builtin_amdgcn_mfma_f32_32x32x16_bf16(a0, b1, acc[0][1], 0, 0, 0); \
        acc[1][0] = __builtin_amdgcn_mfma_f32_32x32x16_bf16(a1, b0, acc[1][0], 0, 0, 0); \
        acc[1][1] = __builtin_amdgcn_mfma_f32_32x32x16_bf16(a1, b1, acc[1][1], 0, 0, 0); }
#define G_COMPUTE(BUF_) { \
      const bf16_t* cA = sA + (BUF_) * 128 * LSTR + (wm * 64 + (lane & 31)) * LSTR + (lane >> 5) * 8; \
      const bf16_t* cB = sB + (BUF_) * 128 * LSTR + (wn * 64 + (lane & 31)) * LSTR + (lane >> 5) * 8; \
      G_MMA(0, BUF_) G_MMA(1, BUF_) G_MMA(2, BUF_) G_MMA(3, BUF_) }
  int tile = blockIdx.x;
  if (tile < ntiles) { G_PTRS(tile) G_LOAD(0, 0) G_LOAD(1, 1) }
  while (tile < ntiles) {
    const int m0 = (tile / ntn) << 7, n0 = (tile % ntn) << 7;
    f32x16 acc[2][2];
#pragma unroll
    for (int i = 0; i < 2; ++i)
#pragma unroll
      for (int j = 0; j < 2; ++j)
#pragma unroll
        for (int r = 0; r < 16; ++r) acc[i][j][r] = 0.f;
    G_WRITE(0, 0)
    __syncthreads();
    for (int kt = 0; kt < KT; kt += 2) {
      if (kt + 2 < KT) G_LOAD(0, kt + 2)
      G_COMPUTE(0)
      G_WRITE(1, 1)
      __syncthreads();
      if (kt + 3 < KT) G_LOAD(1, kt + 3)
      G_COMPUTE(1)
      if (kt + 2 < KT) G_WRITE(0, 0)
      __syncthreads();
    }
    const int next = tile + gridDim.x;
    if (next < ntiles) { G_PTRS(next) G_LOAD(0, 0) G_LOAD(1, 1) }
#pragma unroll
    for (int mi = 0; mi < 2; ++mi)
#pragma unroll
      for (int ni = 0; ni < 2; ++ni) {
        float* cw = sC + (wm * 64 + mi * 32 + 4 * (lane >> 5)) * 132 + wn * 64 + ni * 32 + (lane & 31);
#pragma unroll
        for (int r = 0; r < 16; ++r) cw[((r & 3) + 8 * (r >> 2)) * 132] = acc[mi][ni][r];
      }
    __syncthreads();
#pragma unroll 4
    for (int i = 0; i < 16; ++i) {
      const int ch = tid + 256 * i;
      const int row = ch >> 5, c4 = (ch & 31) * 4;
      const float4 v = *(const float4*)(sC + row * 132 + c4);
      if (n0 + c4 < N) epi(m0 + row, n0 + c4, v);
    }
    __syncthreads();
    tile = next;
  }
}

struct EpiBf16 {
  bf16_t* C; int ldc;
  __device__ __forceinline__ void operator()(int m, int n, float4 v) const {
    uint2 o; o.x = pack2(v.x, v.y); o.y = pack2(v.z, v.w);
    *(uint2*)(C + (size_t)m * ldc + n) = o;
  }
};
__device__ __forceinline__ float softplusf(float x) { return x > 20.f ? x : log1pf(expf(x)); }
struct EpiSsdIn {
  bf16_t* C; float* DT; const float* dt_bias;
  __device__ __forceinline__ void operator()(int m, int n, float4 v) const {
    if (n < 6144) {
      uint2 o; o.x = pack2(v.x, v.y); o.y = pack2(v.z, v.w);
      *(uint2*)(C + (size_t)m * 6144 + n) = o;
    } else {
      const int c = n - 6144;
      const float4 bb = *(const float4*)(dt_bias + c);
      *(float4*)(DT + (size_t)m * 64 + c) = make_float4(softplusf(v.x + bb.x), softplusf(v.y + bb.y), softplusf(v.z + bb.z), softplusf(v.w + bb.w));
    }
  }
};
struct EpiRes {
  const float* xin_ctx; const float* xin_lat; float* X; const float* gate;
  __device__ __forceinline__ void operator()(int m, int n, float4 v) const {
    const float* xr = m < NCTX ? xin_ctx + (size_t)m * 1024 : xin_lat + (size_t)(m - NCTX) * 1024;
    const float4 xv = *(const float4*)(xr + n);
    const float4 gt = *(const float4*)(gate + (size_t)cidx(m) * 6144 + n);
    *(float4*)(X + (size_t)m * 1024 + n) = make_float4(xv.x + gt.x * v.x, xv.y + gt.y * v.y, xv.z + gt.z * v.z, xv.w + gt.w * v.w);
  }
};

__device__ __forceinline__ void conv_gate_phase(const Params& p) {
  const bf16_t* P = (const bf16_t*)(p.ws + OFF_BIG);
  bf16_t* G = (bf16_t*)(p.ws + OFF_BIG + 120 * MIB);
  const float* cw = p.sc_conv_w;
  const int total = NT * 128;
  for (int it = blockIdx.x * 256 + threadIdx.x; it < total; it += gridDim.x * 256) {
    const int tok = it >> 7, c = (it & 127) * 8;
    const int rowlen = tok < NCTX ? 256 : 64;
    const int pos = tok & (rowlen - 1);
    const bf16_t* pr = P + (size_t)tok * 3072;
    uint4 bg = *(const uint4*)(pr + c);
    uint4 cg = *(const uint4*)(pr + 1024 + c);
    uint4 xv = *(const uint4*)(pr + 2048 + c);
    uint4 cgl = make_uint4(0, 0, 0, 0), xvl = cgl, cgr = cgl, xvr = cgl;
    if (pos > 0) { cgl = *(const uint4*)(pr - 3072 + 1024 + c); xvl = *(const uint4*)(pr - 3072 + 2048 + c); }
    if (pos < rowlen - 1) { cgr = *(const uint4*)(pr + 3072 + 1024 + c); xvr = *(const uint4*)(pr + 3072 + 2048 + c); }
    const unsigned* bgp = (const unsigned*)&bg; const unsigned* cgp = (const unsigned*)&cg; const unsigned* xvp = (const unsigned*)&xv;
    const unsigned* cglp = (const unsigned*)&cgl; const unsigned* xvlp = (const unsigned*)&xvl;
    const unsigned* cgrp = (const unsigned*)&cgr; const unsigned* xvrp = (const unsigned*)&xvr;
    float4 w0a = *(const float4*)(cw + c), w0b = *(const float4*)(cw + c + 4);
    float4 w1a = *(const float4*)(cw + 1024 + c), w1b = *(const float4*)(cw + 1024 + c + 4);
    float4 w2a = *(const float4*)(cw + 2048 + c), w2b = *(const float4*)(cw + 2048 + c + 4);
    const float w0[8] = {w0a.x, w0a.y, w0a.z, w0a.w, w0b.x, w0b.y, w0b.z, w0b.w};
    const float w1[8] = {w1a.x, w1a.y, w1a.z, w1a.w, w1b.x, w1b.y, w1b.z, w1b.w};
    const float w2[8] = {w2a.x, w2a.y, w2a.z, w2a.w, w2b.x, w2b.y, w2b.z, w2b.w};
    unsigned o[4];
#pragma unroll
    for (int q = 0; q < 4; ++q) {
      float r0 = lo2f(bgp[q]) * (w0[2 * q] * lo2f(cglp[q]) * lo2f(xvlp[q]) + w1[2 * q] * lo2f(cgp[q]) * lo2f(xvp[q]) + w2[2 * q] * lo2f(cgrp[q]) * lo2f(xvrp[q]));
      float r1 = hi2f(bgp[q]) * (w0[2 * q + 1] * hi2f(cglp[q]) * hi2f(xvlp[q]) + w1[2 * q + 1] * hi2f(cgp[q]) * hi2f(xvp[q]) + w2[2 * q + 1] * hi2f(cgrp[q]) * hi2f(xvrp[q]));
      o[q] = pack2(r0, r1);
    }
    *(uint4*)(G + (size_t)tok * 1024 + c) = make_uint4(o[0], o[1], o[2], o[3]);
  }
}

#define SSTR 272
__device__ __forceinline__ unsigned row_max_u32(unsigned v) {
  v = umax_(v, dpp_u<0xB1>(v));
  v = umax_(v, dpp_u<0x4E>(v));
  v = umax_(v, dpp_u<0x141>(v));
  v = umax_(v, dpp_u<0x140>(v));
  return v;
}
#define CE_(a, b) { unsigned hi_ = umax_(key[a], key[b]); unsigned lo_ = key[a] < key[b] ? key[a] : key[b]; key[a] = hi_; key[b] = lo_; }
__device__ __forceinline__ unsigned top16_row(const float* Sr, int j) {
  unsigned key[8];
#pragma unroll
  for (int m = 0; m < 8; ++m) key[m] = (fkey(Sr[j + 16 * m]) & ~0x7Fu) | (unsigned)(127 - (j + 16 * m));
  CE_(0, 1) CE_(2, 3) CE_(4, 5) CE_(6, 7)
  CE_(0, 2) CE_(1, 3) CE_(4, 6) CE_(5, 7)
  CE_(1, 2) CE_(5, 6)
  CE_(0, 4) CE_(1, 5) CE_(2, 6) CE_(3, 7)
  CE_(2, 4) CE_(3, 5)
  CE_(1, 2) CE_(3, 4) CE_(5, 6)
  unsigned res = 0;
#pragma unroll 1
  for (int it = 0; it < 16; ++it) {
    const unsigned wm = row_max_u32(key[0]);
    const bool win = key[0] == wm;
#pragma unroll
    for (int m = 0; m < 7; ++m) key[m] = win ? key[m + 1] : key[m];
    key[7] = win ? 0u : key[7];
    res = (j == it) ? wm : res;
  }
  return res;
}

__device__ __forceinline__ void topk_phase(const Params& p, int layer, char* smem) {
  float* S = (float*)smem;
  const bf16_t* Q = (const bf16_t*)(p.ws + OFF_BIG);
  const bf16_t* KB = (const bf16_t*)(p.ws + OFF_KEYSB) + (size_t)layer * (8 * 2 * 128 * 128);
  int* IDX = (int*)(p.ws + OFF_IDX);
  float* GATE = (float*)(p.ws + OFF_GATE);
  const int tid = threadIdx.x, lane = tid & 63;
  const int w = __builtin_amdgcn_readfirstlane(tid >> 6);
  const int G = gridDim.x;
  const int per = (5120 + G - 1) / G;
  const int start = blockIdx.x * per;
  const int end = (start + per < 5120) ? start + per : 5120;
  const int pp = w >> 1, nt0 = (w & 1) * 2;
  const int j = lane & 15, rowbase = lane & 48;
  int ca[4], cb[4];
  bool cvalid3;
  ca[0] = 0; cb[0] = j;
  if (j < 8) { ca[1] = 1; cb[1] = j; } else { ca[1] = j; cb[1] = 0; }
  if (j < 5) { ca[2] = 2; cb[2] = j; } else if (j < 9) { ca[2] = 3; cb[2] = j - 5; } else if (j < 12) { ca[2] = 4; cb[2] = j - 9; }
  else if (j < 14) { ca[2] = 5; cb[2] = j - 12; } else { ca[2] = 6; cb[2] = j - 14; }
  ca[3] = 7; cb[3] = j & 1; cvalid3 = j < 2;
  int curh = -1;
  bf16x8 kf[2][8];
  for (int pr = start; pr < end; ++pr) {
    const int h = pr / 640, tile = pr % 640;
    const int t0 = tile * 32;
    if (h != curh) {
#pragma unroll
      for (int jj = 0; jj < 2; ++jj)
#pragma unroll
        for (int kk = 0; kk < 8; ++kk)
          kf[jj][kk] = *(const bf16x8*)(KB + ((size_t)((h * 2 + pp) * 128 + (nt0 + jj) * 32 + (lane & 31))) * 128 + kk * 16 + (lane >> 5) * 8);
      curh = h;
    }
    f32x16 acc[2];
#pragma unroll
    for (int jj = 0; jj < 2; ++jj)
#pragma unroll
      for (int r = 0; r < 16; ++r) acc[jj][r] = 0.f;
    const bf16_t* qp = Q + (size_t)(t0 + (lane & 31)) * 2048 + h * 256 + pp * 128 + (lane >> 5) * 8;
#pragma unroll
    for (int kk = 0; kk < 8; ++kk) {
      bf16x8 a = *(const bf16x8*)(qp + kk * 16);
      acc[0] = __builtin_amdgcn_mfma_f32_32x32x16_bf16(a, kf[0][kk], acc[0], 0, 0, 0);
      acc[1] = __builtin_amdgcn_mfma_f32_32x32x16_bf16(a, kf[1][kk], acc[1], 0, 0, 0);
    }
#pragma unroll
    for (int jj = 0; jj < 2; ++jj)
#pragma unroll
      for (int r = 0; r < 16; ++r) {
        const int tl = (r & 3) + 8 * (r >> 2) + 4 * (lane >> 5);
        S[tl * SSTR + pp * 128 + (nt0 + jj) * 32 + (lane & 31)] = acc[jj][r];
      }
    __syncthreads();
#pragma unroll 1
    for (int rnd = 0; rnd < 2; ++rnd) {
      const int tl = w * 8 + rnd * 4 + (lane >> 4);
      const float* Sr = S + tl * SSTR;
      const unsigned res1 = top16_row(Sr, j);
      const unsigned res2 = top16_row(Sr + 128, j);
      unsigned ck[4];
#pragma unroll
      for (int sl = 0; sl < 4; ++sl) {
        const float v1 = keyf((unsigned)__shfl((int)res1, rowbase + ca[sl]) & ~0x7Fu);
        const float v2 = keyf((unsigned)__shfl((int)res2, rowbase + cb[sl]) & ~0x7Fu);
        ck[sl] = (fkey(v1 + v2) & ~0xFFu) | (unsigned)(255 - (ca[sl] * 16 + cb[sl]));
      }
      ck[3] = cvalid3 ? ck[3] : 0u;
      unsigned resc = 0;
#pragma unroll 1
      for (int it = 0; it < 16; ++it) {
        const unsigned wm = row_max_u32(umax_(umax_(ck[0], ck[1]), umax_(ck[2], ck[3])));
#pragma unroll
        for (int sl = 0; sl < 4; ++sl) ck[sl] = (ck[sl] == wm) ? 0u : ck[sl];
        resc = (j == it) ? wm : resc;
      }
      const int code = 255 - (int)(resc & 0xFFu);
      const int wa = code >> 4, wb = code & 15;
      const float val = keyf(resc & ~0xFFu);
      const unsigned r1 = (unsigned)__shfl((int)res1, rowbase + wa);
      const unsigned r2 = (unsigned)__shfl((int)res2, rowbase + wb);
      const int i1 = 127 - (int)(r1 & 0x7Fu), i2 = 127 - (int)(r2 & 0x7Fu);
      const float vmax = __shfl(val, rowbase);
      const float e = __expf(val - vmax);
      const float ssum = row16_sum(e);
      const size_t ob = ((size_t)(t0 + tl) * 8 + h) * 16 + j;
      IDX[ob] = i1 * 128 + i2;
      GATE[ob] = e / ssum;
    }
    __syncthreads();
  }
}

typedef __attribute__((ext_vector_type(2))) float f32x2;
__device__ __forceinline__ void peer_phase(const Params& p, int layer, char* smem) {
  float* coefs = (float*)smem;
  int* idxs = (int*)(smem + 2048);
  const unsigned char* U8 = (const unsigned char*)(p.ws + (layer ? OFF_TAB1 : OFF_YB));
  const unsigned char* V8 = U8 + (size_t)16384 * 1024;
  const float* SCU = (const float*)(p.ws + OFF_SCALE) + (size_t)layer * 32768;
  const float* SCV = SCU + 16384;
  const bf16_t* A = (const bf16_t*)(p.ws + OFF_YF);
  const int* IDX = (const int*)(p.ws + OFF_IDX);
  const float* GATE = (const float*)(p.ws + OFF_GATE);
  const float* MOD = (const float*)(p.ws + OFF_MOD);
  float* X = p.out;
  const int lane = threadIdx.x & 63;
  const int w = __builtin_amdgcn_readfirstlane(threadIdx.x >> 6);
  const int sub = lane & 15, rg = lane >> 4;
  for (int tok = blockIdx.x * 4 + w; tok < NT; tok += gridDim.x * 4) {
    float t[64];
#pragma unroll
    for (int i = 0; i < 4; ++i) {
      const uint4* ap = (const uint4*)(A + (size_t)tok * 1024 + sub * 16 + 256 * i);
      const uint4 r0 = ap[0], r1 = ap[1];
#pragma unroll
      for (int q = 0; q < 4; ++q) {
        t[16 * i + 2 * q] = lo2f(u4get(r0, q)); t[16 * i + 2 * q + 1] = hi2f(u4get(r0, q));
        t[16 * i + 8 + 2 * q] = lo2f(u4get(r1, q)); t[16 * i + 8 + 2 * q + 1] = hi2f(u4get(r1, q));
      }
    }
#pragma unroll 2
    for (int it = 0; it < 32; ++it) {
      const int k = it * 4 + rg;
      const int e = IDX[(size_t)tok * 128 + k];
      const float gk = GATE[(size_t)tok * 128 + k];
      const float su = SCU[e];
      const float sv = SCV[e];
      const uint4* row = (const uint4*)(U8 + (size_t)e * 1024) + sub;
      uint4 r[4];
#pragma unroll
      for (int i = 0; i < 4; ++i) r[i] = row[16 * i];
      float acc0 = 0.f, acc1 = 0.f;
#pragma unroll
      for (int i = 0; i < 4; ++i) {
#pragma unroll
        for (int q = 0; q < 4; ++q) {
          const int rw = (int)u4get(r[i], q);
          f32x2 lo = __builtin_amdgcn_cvt_pk_f32_fp8(rw, false);
          f32x2 hi = __builtin_amdgcn_cvt_pk_f32_fp8(rw, true);
          acc0 += lo[0] * t[16 * i + 4 * q] + hi[0] * t[16 * i + 4 * q + 2];
          acc1 += lo[1] * t[16 * i + 4 * q + 1] + hi[1] * t[16 * i + 4 * q + 3];
        }
      }
      float acc = row16_sum(acc0 + acc1) * su;
      const float co = 0.5f * acc * (1.f + erff(acc * 0.70710678118654752f)) * gk * sv;
      if (sub == 0) { coefs[w * 128 + k] = co; idxs[w * 128 + k] = e; }
    }
    float o[16];
#pragma unroll
    for (int i = 0; i < 16; ++i) o[i] = 0.f;
#pragma unroll 1
    for (int k = 0; k < 128; k += 16) {
      uint4 r[16]; float c[16];
#pragma unroll
      for (int j = 0; j < 16; ++j) {
        const int e = __builtin_amdgcn_readfirstlane(idxs[w * 128 + k + j]);
        c[j] = coefs[w * 128 + k + j];
        r[j] = *((const uint4*)(V8 + (size_t)e * 1024) + lane);
      }
#pragma unroll
      for (int j = 0; j < 16; ++j) {
#pragma unroll
        for (int q = 0; q < 4; ++q) {
          const int rw = (int)u4get(r[j], q);
          f32x2 lo = __builtin_amdgcn_cvt_pk_f32_fp8(rw, false);
          f32x2 hi = __builtin_amdgcn_cvt_pk_f32_fp8(rw, true);
          o[4 * q] += c[j] * lo[0]; o[4 * q + 1] += c[j] * lo[1];
          o[4 * q + 2] += c[j] * hi[0]; o[4 * q + 3] += c[j] * hi[1];
        }
      }
    }
    const float* gate = MOD + (size_t)(layer * 5 + cidx(tok)) * 6144 + 5 * 1024;
#pragma unroll
    for (int i = 0; i < 4; ++i) {
      const int col = lane * 16 + 4 * i;
      float4 xv = *(const float4*)(X + (size_t)tok * 1024 + col);
      float4 gt = *(const float4*)(gate + col);
      xv.x += gt.x * o[4 * i]; xv.y += gt.y * o[4 * i + 1]; xv.z += gt.z * o[4 * i + 2]; xv.w += gt.w * o[4 * i + 3];
      *(float4*)(X + (size_t)tok * 1024 + col) = xv;
    }
  }
}

__device__ __forceinline__ void ssd_conv_phase(const Params& p) {
  bf16_t* BIG = (bf16_t*)(p.ws + OFF_BIG);
  const float* cw = p.ssd_conv_w;
  const float* cb = p.ssd_conv_b;
  const int total = 272 * 512;
  for (int it = blockIdx.x * 256 + threadIdx.x; it < total; it += gridDim.x * 256) {
    const int c8 = it & 511, r = it >> 9;
    const int c = c8 * 8;
    int tok0, len;
    if (r < 16) { tok0 = r * 256; len = 256; } else { tok0 = NCTX + (r - 16) * 64; len = 64; }
    float w0[8], w1[8], w2[8], bb[8];
#pragma unroll
    for (int j = 0; j < 8; ++j) { w0[j] = cw[c + j]; w1[j] = cw[4096 + c + j]; w2[j] = cw[8192 + c + j]; bb[j] = cb[c + j]; }
    bf16_t* base = BIG + (size_t)tok0 * 6144 + 2048 + c;
    uint4 buf[8], nxt[8];
#pragma unroll
    for (int j = 0; j < 8; ++j) buf[j] = *(const uint4*)(base + (size_t)j * 6144);
    uint4 prev = make_uint4(0, 0, 0, 0);
    for (int t0 = 0; t0 < len; t0 += 8) {
      const bool more = (t0 + 8) < len;
#pragma unroll
      for (int j = 0; j < 8; ++j) nxt[j] = more ? *(const uint4*)(base + (size_t)(t0 + 8 + j) * 6144) : make_uint4(0, 0, 0, 0);
#pragma unroll
      for (int j = 0; j < 8; ++j) {
        const uint4 cur = buf[j];
        const uint4 nx = (j < 7) ? buf[j + 1] : nxt[0];
        const unsigned* pp = (const unsigned*)&prev; const unsigned* cp = (const unsigned*)&cur; const unsigned* np = (const unsigned*)&nx;
        unsigned o[4];
#pragma unroll
        for (int q = 0; q < 4; ++q) {
          float a0 = w0[2 * q] * lo2f(pp[q]) + w1[2 * q] * lo2f(cp[q]) + w2[2 * q] * lo2f(np[q]) + bb[2 * q];
          float a1 = w0[2 * q + 1] * hi2f(pp[q]) + w1[2 * q + 1] * hi2f(cp[q]) + w2[2 * q + 1] * hi2f(np[q]) + bb[2 * q + 1];
          o[q] = pack2(siluf(a0), siluf(a1));
        }
        *(uint4*)(base + (size_t)(t0 + j) * 6144) = make_uint4(o[0], o[1], o[2], o[3]);
        prev = cur;
      }
#pragma unroll
      for (int j = 0; j < 8; ++j) buf[j] = nxt[j];
    }
  }
}

#define XT_STR 72
#define HB_STR 136
#define SCAN_LOAD_FRAGS(CC) { \
      { const int t_ = (CC) * 64 + 32 * it + l31; const int tok_ = tok0 + (dir ? L - 1 - t_ : t_); \
        const bf16_t* cp_ = BIG + (size_t)tok_ * 6144 + 5120 + g * 128 + 8 * h5; \
        _Pragma("unroll") for (int kk = 0; kk < 8; ++kk) cfr[kk] = *(const bf16x8*)(cp_ + 16 * kk); } \
      if (jt <= it) { const int t_ = (CC) * 64 + 32 * jt + l31; const int tok_ = tok0 + (dir ? L - 1 - t_ : t_); \
        const bf16_t* bp_ = BIG + (size_t)tok_ * 6144 + 4096 + g * 128 + 8 * h5; \
        _Pragma("unroll") for (int kk = 0; kk < 8; ++kk) bfr[kk] = *(const bf16x8*)(bp_ + 16 * kk); } }
#define SCAN_LOAD_STAGE(CC) { \
      const int t_ = (CC) * 64 + lane; const int tok_ = tok0 + (dir ? L - 1 - t_ : t_); \
      const bf16_t* rowp_ = BIG + (size_t)tok_ * 6144; \
      _Pragma("unroll") for (int r = 0; r < 2; ++r) sx[r] = *(const uint4*)(rowp_ + 2048 + head * 64 + (w + 4 * r) * 8); \
      _Pragma("unroll") for (int r = 0; r < 4; ++r) sb[r] = *(const uint4*)(rowp_ + 4096 + g * 128 + (w + 4 * r) * 8); \
      sdt = DT[(size_t)tok_ * 64 + dir * 32 + head]; }
__device__ __forceinline__ void scan_phase(const Params& p, char* smem) {
  bf16_t* XTd = (bf16_t*)smem;
  bf16_t* BTs = XTd + 64 * XT_STR;
  bf16_t* Ms = BTs + 128 * XT_STR;
  bf16_t* Hb = Ms + 64 * XT_STR;
  float* cumS = (float*)(Hb + 2 * 64 * HB_STR);
  const bf16_t* BIG = (const bf16_t*)(p.ws + OFF_BIG);
  const float* DT = (const float*)(p.ws + OFF_DT);
  const int tid = threadIdx.x, lane = tid & 63;
  const int w = __builtin_amdgcn_readfirstlane(tid >> 6);
  const int h5 = lane >> 5, l31 = lane & 31;
  const int it = w >> 1, jt = w & 1, pt = w & 1, nt0 = (w >> 1) * 2;
  for (int item = blockIdx.x; item < 1280; item += gridDim.x) {
    int b, head, dir, L, tok0;
    const bool latent = item < 256;
    if (latent) { b = item >> 6; head = (item >> 1) & 31; dir = item & 1; L = 4096; tok0 = NCTX + b * 4096; }
    else { int jj = item - 256; b = jj >> 6; head = (jj >> 1) & 31; dir = jj & 1; L = 256; tok0 = b * 256; }
    const int g = head >> 2;
    const float a = -expf(p.ssd_a_log[dir * 32 + head]);
    bf16_t* Y = (bf16_t*)(p.ws + (dir ? OFF_YB : OFF_YF));
    f32x16 st[2];
    const size_t sbase = ((size_t)((b * 2 + dir) * 32 + head)) * 8192;
    const int loff = (32 * pt + 4 * h5) * 128 + 32 * nt0 + l31;
    if (latent) {
      const float* sp = p.state_ssm + sbase + loff;
#pragma unroll
      for (int q = 0; q < 2; ++q)
#pragma unroll
        for (int r = 0; r < 16; ++r) st[q][r] = sp[((r & 3) + 8 * (r >> 2)) * 128 + 32 * q];
    } else {
#pragma unroll
      for (int q = 0; q < 2; ++q)
#pragma unroll
        for (int r = 0; r < 16; ++r) st[q][r] = 0.f;
    }
    {
      bf16_t* hb0 = Hb + (32 * pt + 4 * h5) * HB_STR + 32 * nt0 + l31;
#pragma unroll
      for (int q = 0; q < 2; ++q)
#pragma unroll
        for (int r = 0; r < 16; ++r) hb0[((r & 3) + 8 * (r >> 2)) * HB_STR + 32 * q] = f2bf(st[q][r]);
    }
    __syncthreads();
    const int nchunks = L >> 6;
    uint4 sx[2], sb[4];
    float sdt;
    SCAN_LOAD_STAGE(0)
    bf16x8 cfr[8], bfr[8];
    SCAN_LOAD_FRAGS(0)
#pragma nounroll
    for (int c = 0; c < nchunks; ++c) {
      const int cur = c & 1;
      __builtin_amdgcn_sched_barrier(0);
      float cum = sdt * a;
#pragma unroll
      for (int off = 1; off < 64; off <<= 1) {
        const float tv = __shfl_up(cum, off);
        cum += (lane >= off) ? tv : 0.f;
      }
      const float cum_last = __shfl(cum, 63);
      const float wj = __expf(cum_last - cum);
      if (w == 0) cumS[cur * 64 + lane] = cum;
#pragma unroll
      for (int r = 0; r < 2; ++r) {
        const int p8 = (w + 4 * r) * 8;
#pragma unroll
        for (int q = 0; q < 4; ++q) {
          const unsigned u = u4get(sx[r], q);
          XTd[(p8 + 2 * q) * XT_STR + lane] = f2bf(sdt * lo2f(u));
          XTd[(p8 + 2 * q + 1) * XT_STR + lane] = f2bf(sdt * hi2f(u));
        }
      }
#pragma unroll
      for (int r = 0; r < 4; ++r) {
        const int n8 = (w + 4 * r) * 8;
#pragma unroll
        for (int q = 0; q < 4; ++q) {
          const unsigned u = u4get(sb[r], q);
          BTs[(n8 + 2 * q) * XT_STR + lane] = f2bf(wj * lo2f(u));
          BTs[(n8 + 2 * q + 1) * XT_STR + lane] = f2bf(wj * hi2f(u));
        }
      }
      if (c + 1 < nchunks) SCAN_LOAD_STAGE(c + 1)
      __builtin_amdgcn_sched_barrier(0);
      f32x16 cb;
#pragma unroll
      for (int r = 0; r < 16; ++r) cb[r] = 0.f;
      if (jt <= it) {
#pragma unroll
        for (int kk = 0; kk < 8; ++kk) cb = __builtin_amdgcn_mfma_f32_32x32x16_bf16(cfr[kk], bfr[kk], cb, 0, 0, 0);
      }
      __builtin_amdgcn_sched_barrier(0);
      f32x16 yo;
#pragma unroll
      for (int r = 0; r < 16; ++r) yo[r] = 0.f;
      {
        const bf16_t* hp = Hb + cur * 64 * HB_STR + (32 * pt + l31) * HB_STR + 8 * h5;
#pragma unroll
        for (int kk = 0; kk < 8; ++kk) {
          const bf16x8 hf = *(const bf16x8*)(hp + 16 * kk);
          yo = __builtin_amdgcn_mfma_f32_32x32x16_bf16(cfr[kk], hf, yo, 0, 0, 0);
        }
      }
      __builtin_amdgcn_sched_barrier(0);
      if (c + 1 < nchunks) SCAN_LOAD_FRAGS(c + 1)
      __syncthreads();
      __builtin_amdgcn_sched_barrier(0);
      const float dec = __expf(cum_last);
      bf16x8 xf[4];
#pragma unroll
      for (int kk = 0; kk < 4; ++kk) xf[kk] = *(const bf16x8*)(XTd + (32 * pt + l31) * XT_STR + 16 * kk + 8 * h5);
#pragma unroll
      for (int q = 0; q < 2; ++q) {
#pragma unroll
        for (int r = 0; r < 16; ++r) st[q][r] *= dec;
#pragma unroll
        for (int kk = 0; kk < 4; ++kk) {
          const bf16x8 bt = *(const bf16x8*)(BTs + (32 * (nt0 + q) + l31) * XT_STR + 16 * kk + 8 * h5);
          st[q] = __builtin_amdgcn_mfma_f32_32x32x16_bf16(xf[kk], bt, st[q], 0, 0, 0);
        }
        {
          bf16_t* hbw = Hb + (cur ^ 1) * 64 * HB_STR + (32 * pt + 4 * h5) * HB_STR + 32 * (nt0 + q) + l31;
#pragma unroll
          for (int r = 0; r < 16; ++r) hbw[((r & 3) + 8 * (r >> 2)) * HB_STR] = f2bf(st[q][r]);
        }
      }
      __builtin_amdgcn_sched_barrier(0);
      if (jt <= it) {
        const int jj = 32 * jt + l31;
        const float cj = cumS[cur * 64 + jj];
        const int ib = 32 * it + 4 * h5;
        const float* cs = cumS + cur * 64 + ib;
        bf16_t* mw = Ms + ib * XT_STR + jj;
#pragma unroll
        for (int r = 0; r < 16; ++r) {
          const int ro = (r & 3) + 8 * (r >> 2);
          const float m = (jj <= ib + ro) ? cb[r] * __expf(cs[ro] - cj) : 0.f;
          mw[ro * XT_STR] = f2bf(m);
        }
      }
      __syncthreads();
      __builtin_amdgcn_sched_barrier(0);
      f32x16 yd;
#pragma unroll
      for (int r = 0; r < 16; ++r) yd[r] = 0.f;
#pragma unroll
      for (int kk = 0; kk < 4; ++kk) {
        if (kk < 2 * (it + 1)) {
          const bf16x8 mf = *(const bf16x8*)(Ms + (32 * it + l31) * XT_STR + 16 * kk + 8 * h5);
          yd = __builtin_amdgcn_mfma_f32_32x32x16_bf16(mf, xf[kk], yd, 0, 0, 0);
        }
      }
      {
        const int t0c = c * 64 + 32 * it + 4 * h5;
        const int tokb = tok0 + (dir ? L - 1 - t0c : t0c);
        const int rs = dir ? -2048 : 2048;
        bf16_t* yp = Y + (size_t)tokb * 2048 + head * 64 + 32 * pt + l31;
        const float* cs = cumS + cur * 64 + 32 * it + 4 * h5;
#pragma unroll
        for (int r = 0; r < 16; ++r) {
          const int ro = (r & 3) + 8 * (r >> 2);
          const float yv = yd[r] + __expf(cs[ro]) * yo[r];
          yp[(ptrdiff_t)rs * ro] = f2bf(yv);
        }
      }
    }
    if (!latent) {
      float* sp = p.out + (size_t)NT * 1024 + sbase + loff;
#pragma unroll
      for (int q = 0; q < 2; ++q)
#pragma unroll
        for (int r = 0; r < 16; ++r) sp[((r & 3) + 8 * (r >> 2)) * 128 + 32 * q] = st[q][r];
    }
    __syncthreads();
  }
}

__device__ __forceinline__ void gate_norm_phase(const Params& p) {
  const bf16_t* BIG = (const bf16_t*)(p.ws + OFF_BIG);
  bf16_t* YF = (bf16_t*)(p.ws + OFF_YF);
  const bf16_t* YB = (const bf16_t*)(p.ws + OFF_YB);
  const int lane = threadIdx.x & 63, w = threadIdx.x >> 6;
  for (int tok = blockIdx.x * 4 + w; tok < NT; tok += gridDim.x * 4) {
    float v[32];
    float ss = 0.f;
#pragma unroll
    for (int i = 0; i < 4; ++i) {
      const int col = lane * 8 + 512 * i;
      const int head = col >> 6;
      const float dtot = p.ssd_d[head] + p.ssd_d[32 + head];
      uint4 a = *(const uint4*)(YF + (size_t)tok * 2048 + col);
      uint4 b = *(const uint4*)(YB + (size_t)tok * 2048 + col);
      uint4 x = *(const uint4*)(BIG + (size_t)tok * 6144 + 2048 + col);
      uint4 z = *(const uint4*)(BIG + (size_t)tok * 6144 + col);
      const unsigned* ap = (const unsigned*)&a; const unsigned* bp = (const unsigned*)&b;
      const unsigned* xp = (const unsigned*)&x; const unsigned* zp = (const unsigned*)&z;
#pragma unroll
      for (int q = 0; q < 4; ++q) {
        float y0 = lo2f(ap[q]) + lo2f(bp[q]) + dtot * lo2f(xp[q]);
        float y1 = hi2f(ap[q]) + hi2f(bp[q]) + dtot * hi2f(xp[q]);
        y0 *= siluf(lo2f(zp[q]));
        y1 *= siluf(hi2f(zp[q]));
        v[8 * i + 2 * q] = y0; v[8 * i + 2 * q + 1] = y1;
        ss += y0 * y0 + y1 * y1;
      }
    }
    ss = wave_sum(ss);
    const float sc = rsqrtf(ss * (1.f / 2048.f) + 1e-6f);
#pragma unroll
    for (int i = 0; i < 4; ++i) {
      const int col = lane * 8 + 512 * i;
      float4 g0 = *(const float4*)(p.ssd_norm_g + col), g1 = *(const float4*)(p.ssd_norm_g + col + 4);
      uint4 o;
      o.x = pack2(v[8 * i] * sc * g0.x, v[8 * i + 1] * sc * g0.y);
      o.y = pack2(v[8 * i + 2] * sc * g0.z, v[8 * i + 3] * sc * g0.w);
      o.z = pack2(v[8 * i + 4] * sc * g1.x, v[8 * i + 5] * sc * g1.y);
      o.w = pack2(v[8 * i + 6] * sc * g1.z, v[8 * i + 7] * sc * g1.w);
      *(uint4*)(YF + (size_t)tok * 2048 + col) = o;
    }
  }
}

__device__ __forceinline__ void final_norm_phase(const Params& p) {
  const int lane = threadIdx.x & 63, w = threadIdx.x >> 6;
  for (int tok = blockIdx.x * 4 + w; tok < NT; tok += gridDim.x * 4) {
    float* xr = p.out + (size_t)tok * 1024;
    float4 v[4];
    float ss = 0.f;
#pragma unroll
    for (int i = 0; i < 4; ++i) {
      v[i] = *(const float4*)(xr + lane * 4 + 256 * i);
      ss += v[i].x * v[i].x + v[i].y * v[i].y + v[i].z * v[i].z + v[i].w * v[i].w;
    }
    ss = wave_sum(ss);
    const float sc = rsqrtf(ss * (1.f / 1024.f) + 1e-6f);
#pragma unroll
    for (int i = 0; i < 4; ++i) {
      const int col = lane * 4 + 256 * i;
      float4 gg = *(const float4*)(p.norm_f_g + col);
      *(float4*)(xr + col) = make_float4(v[i].x * sc * gg.x, v[i].y * sc * gg.y, v[i].z * sc * gg.z, v[i].w * sc * gg.w);
    }
  }
}


#define XB_TMO      128
#define XB_XCNT(j)  (256  + 64 * (j))
#define XB_XSUB(j)  (1280 + 64 * (j))
#define XB_XGEN(j)  (2304 + 64 * (j))
#define XB_TOP      3328
#define XB_TOPGEN   3392
#define XCD_BAR_WORDS 3456
#define XB_SPIN_CAP (1u << 22)
#define LAS __attribute__((address_space(3)))
__device__ __forceinline__ unsigned xb_ld(unsigned* p) { return __hip_atomic_load(p, __ATOMIC_RELAXED, __HIP_MEMORY_SCOPE_AGENT); }
__device__ __forceinline__ unsigned xb_add(unsigned* p, unsigned v) { return __hip_atomic_fetch_add(p, v, __ATOMIC_RELAXED, __HIP_MEMORY_SCOPE_AGENT); }
__device__ __forceinline__ unsigned xb_xcc_id() { return (unsigned)__builtin_amdgcn_s_getreg((3 << 11) | 20) & 0xFu; }
#define XB_SPIN(cond, bar) do { unsigned _sp = 0; while (cond) { __builtin_amdgcn_s_sleep(1); \
    if ((++_sp & 255u) == 0u) { if (xb_ld(&(bar)[XB_TMO])) break; if (_sp > XB_SPIN_CAP) { atomicAdd(&(bar)[XB_TMO], 1u); break; } } } } while (0)
struct XcdBarrier { unsigned* bar; unsigned x; volatile LAS unsigned* st; };
__device__ __forceinline__ XcdBarrier xcd_barrier_post(unsigned* bar, volatile LAS unsigned* st) {
  XcdBarrier b; b.bar = bar; b.x = xb_xcc_id(); b.st = st;
  if (threadIdx.x == 0) (void)xb_add(&bar[XB_XCNT(b.x)], 1u);
  return b;
}
__device__ __forceinline__ void xcd_barrier_complete(unsigned* bar, unsigned x, unsigned& nloc, unsigned& nx) {
  const unsigned G = gridDim.x * gridDim.y * gridDim.z;
  unsigned sum, cnt, mine, sp = 0u;
  for (;;) {
    sum = 0u; cnt = 0u; mine = 0u;
#pragma unroll
    for (unsigned j = 0; j < 16; ++j) { const unsigned c = xb_ld(&bar[XB_XCNT(j)]); sum += c; cnt += (c > 0u) ? 1u : 0u; mine = (j == x) ? c : mine; }
    if (sum == G) break;
    __builtin_amdgcn_s_sleep(1);
    if ((++sp & 255u) == 0u) { if (xb_ld(&bar[XB_TMO])) break; if (sp > XB_SPIN_CAP) { atomicAdd(&bar[XB_TMO], 1u); break; } }
  }
  nloc = mine > 0u ? mine : 1u; nx = cnt > 0u ? cnt : 1u;
}
__device__ __forceinline__ void xcd_barrier(const XcdBarrier& b) {
  asm volatile("s_waitcnt vmcnt(0)" ::: "memory");
  __syncthreads();
  if (threadIdx.x == 0) {
    unsigned* bar = b.bar;
    __builtin_amdgcn_s_waitcnt(0);
    unsigned nloc = b.st[0], nx = b.st[1];
    if (nloc == 0u) { xcd_barrier_complete(bar, b.x, nloc, nx); b.st[0] = nloc; b.st[1] = nx; }
    const unsigned old = xb_add(&bar[XB_XSUB(b.x)], 1u);
    const unsigned gen = old / nloc;
    if (old + 1u == (gen + 1u) * nloc) {
      __builtin_amdgcn_fence(__ATOMIC_RELEASE, "agent");
      asm volatile("s_waitcnt vmcnt(0)" ::: "memory");
      const unsigned og = xb_add(&bar[XB_TOP], 1u);
      const unsigned tg = og / nx;
      if (og + 1u == (tg + 1u) * nx) xb_add(&bar[XB_TOPGEN], 1u);
      else XB_SPIN(xb_ld(&bar[XB_TOPGEN]) == tg, bar);
      __builtin_amdgcn_fence(__ATOMIC_ACQUIRE, "agent");
      xb_add(&bar[XB_XGEN(b.x)], 1u);
      asm volatile("s_waitcnt vmcnt(0)" ::: "memory");
    } else {
      XB_SPIN(xb_ld(&bar[XB_XGEN(b.x)]) == gen, bar);
      __builtin_amdgcn_fence(__ATOMIC_ACQUIRE, "agent");
      asm volatile("s_waitcnt vmcnt(0)" ::: "memory");
    }
  }
  __syncthreads();
}

#define N_PHASES 20
__global__ void __launch_bounds__(256, 2) mk(Params p, int ph_begin, int ph_end) {
  __shared__ __attribute__((aligned(16))) char smem[SMEM_BYTES];
  __shared__ uint4 xb_words;
  const bool multi = (ph_end - ph_begin) > 1;
  if (threadIdx.x == 0) xb_words = make_uint4(0u, 0u, 0u, 0u);
  __syncthreads();
  XcdBarrier xb;
  xb.bar = (unsigned*)(p.ws + OFF_BAR); xb.x = 0; xb.st = (volatile LAS unsigned*)&xb_words;
  if (multi) xb = xcd_barrier_post((unsigned*)(p.ws + OFF_BAR), (volatile LAS unsigned*)&xb_words);
  bf16_t* WT = (bf16_t*)(p.ws + OFF_WT);
  bf16_t* BIG = (bf16_t*)(p.ws + OFF_BIG);
  bf16_t* Abuf = (bf16_t*)(p.ws + OFF_YF);
  float* MOD = (float*)(p.ws + OFF_MOD);
#define RUN(PH, CALL) if (ph_begin <= PH && PH < ph_end) { CALL; if (PH + 1 < ph_end) { if (PH == 0) cg::this_grid().sync(); else xcd_barrier(xb); } }
  RUN(0, prep_phase(p, smem))
  RUN(1, norm_mod_phase(p, 0, 0, true))
  RUN(2, gemm_phase(Abuf, WT + WT_SCIN, NT, 3072, 1024, EpiBf16{BIG, 3072}, smem))
  RUN(3, conv_gate_phase(p))
  RUN(4, gemm_phase((const bf16_t*)(p.ws + OFF_BIG + 120 * MIB), WT + WT_SCOUT, NT, 1024, 1024,
                    EpiRes{p.x_prompt, p.x_sample, p.out, MOD + 0 * 5 * 6144 + 2 * 1024}, smem))
  RUN(5, norm_mod_phase(p, 0, 1, false))
  RUN(6, gemm_phase(Abuf, WT + WT_WQ, NT, 2048, 1024, EpiBf16{BIG, 2048}, smem))
  RUN(7, topk_phase(p, 0, smem))
  RUN(8, peer_phase(p, 0, smem))
  RUN(9, norm_mod_phase(p, 1, 0, false))
  RUN(10, gemm_phase(Abuf, WT + WT_SSDIN, NT, 6208, 1024, EpiSsdIn{BIG, (float*)(p.ws + OFF_DT), p.ssd_dt_bias}, smem))
  RUN(11, ssd_conv_phase(p))
  RUN(12, scan_phase(p, smem))
  RUN(13, gate_norm_phase(p))
  RUN(14, gemm_phase(Abuf, WT + WT_SSDOUT, NT, 1024, 2048,
                     EpiRes{p.out, p.out + (size_t)NCTX * 1024, p.out, MOD + 1 * 5 * 6144 + 2 * 1024}, smem))
  RUN(15, norm_mod_phase(p, 1, 1, false))
  RUN(16, gemm_phase(Abuf, WT + WT_WQ + (size_t)2048 * 1024, NT, 2048, 1024, EpiBf16{BIG, 2048}, smem))
  RUN(17, topk_phase(p, 1, smem))
  RUN(18, peer_phase(p, 1, smem))
  RUN(19, final_norm_phase(p))
}

extern "C" void kernel_launch(void* const* d_in, const int* in_sizes, int n_in, void* d_out, int out_size, void* d_ws, size_t ws_size,
                              hipStream_t stream) {
  static int grid_blocks = 0;
  if (!grid_blocks) {
    int dev = 0, cus = 0, per_cu = 0;
    hipGetDevice(&dev);
    hipDeviceGetAttribute(&cus, hipDeviceAttributeMultiprocessorCount, dev);
    hipOccupancyMaxActiveBlocksPerMultiprocessor(&per_cu, mk, 256, 0);
    if (per_cu < 1) per_cu = 1;
    if (per_cu > 2) per_cu = 2;
    grid_blocks = cus * per_cu;
  }
  if (ws_size < WS_NEEDED) { fprintf(stderr, "workspace too small: %zu\n", ws_size); return; }
  Params p{};
  const float** pf = (const float**)&p;
  for (int i = 0; i < 25; ++i) pf[i] = (const float*)d_in[i];
  p.out = (float*)d_out;
  p.ws = (char*)d_ws;
#if COOP
  hipMemsetAsync((char*)d_ws + OFF_BAR, 0, 16384, stream);
  int b = 0, e = N_PHASES;
  void* args[] = {&p, &b, &e};
  hipError_t err = hipLaunchCooperativeKernel((void*)mk, dim3(grid_blocks), dim3(256), args, 0, stream);
  if (err != hipSuccess) fprintf(stderr, "cooperative launch failed: %s (grid %d)\n", hipGetErrorString(err), grid_blocks);
#else
  for (int ph = 0; ph < N_PHASES; ++ph) {
    hipLaunchKernelGGL(mk, dim3(grid_blocks), dim3(256), 0, stream, p, ph, ph + 1);
    if ((DUP_MASK >> ph) & 1) hipLaunchKernelGGL(mk, dim3(grid_blocks), dim3(256), 0, stream, p, ph, ph + 1);
  }
#endif
}
```

```cpp
#include <hip/hip_runtime.h>
#include <hip/hip_cooperative_groups.h>
#include <cstdio>
namespace cg = cooperative_groups;

#ifndef COOP
#define COOP 1
#endif
#ifndef DUP_MASK
#define DUP_MASK 0
#endif

typedef unsigned short bf16_t;
typedef __attribute__((ext_vector_type(8))) short bf16x8;
typedef __attribute__((ext_vector_type(16))) float f32x16;
typedef __attribute__((ext_vector_type(32))) float f32x32;
typedef __attribute__((ext_vector_type(6))) unsigned u32x6;

#define NT 20480
#define NCTX 4096
#define DM 1024
#define MIB ((size_t)1 << 20)
#define OFF_BIG   ((size_t)0)
#define OFF_YF    (240 * MIB)
#define OFF_YB    (320 * MIB)
#define OFF_WT    (400 * MIB)
#define OFF_KEYSB (433 * MIB)
#define OFF_DT    (434 * MIB)
#define OFF_MOD   (439 * MIB)
#define OFF_IDX   (440 * MIB)
#define OFF_GATE  (450 * MIB)
#define OFF_TAB1  (460 * MIB)
#define OFF_SCALE (492 * MIB)
#define OFF_BAR   (493 * MIB)
#define WS_NEEDED (494 * MIB)
#define WT_SCIN   ((size_t)0)
#define WT_SCOUT  (WT_SCIN + (size_t)3072 * 1024)
#define WT_SSDIN  (WT_SCOUT + (size_t)1024 * 1024)
#define WT_SSDOUT (WT_SSDIN + (size_t)6272 * 1024)
#define WT_WQ     (WT_SSDOUT + (size_t)1024 * 2048)

#define SMEM_BYTES 75776

struct Params {
  const float *x_prompt, *x_sample, *state_ssm, *c, *c_ctx, *norm_mix_g, *norm_ffn_g, *norm_f_g, *ada_w, *ada_b;
  const float *sc_w_in, *sc_conv_w, *sc_w_out, *ssd_w_in, *ssd_conv_w, *ssd_conv_b, *ssd_dt_bias, *ssd_a_log, *ssd_d;
  const float *ssd_norm_g, *ssd_w_out, *peer_wq, *peer_keys, *peer_u, *peer_v;
  float* out;
  char* ws;
};

__device__ __forceinline__ float bf2f(bf16_t h) { return __uint_as_float(((unsigned)h) << 16); }
__device__ __forceinline__ bf16_t f2bf(float f) {
  unsigned u = __float_as_uint(f);
  u += 0x7FFFu + ((u >> 16) & 1u);
  return (bf16_t)(u >> 16);
}
__device__ __forceinline__ unsigned pack2(float a, float b) { return (unsigned)f2bf(a) | ((unsigned)f2bf(b) << 16); }
__device__ __forceinline__ float lo2f(unsigned u) { return __uint_as_float(u << 16); }
__device__ __forceinline__ float hi2f(unsigned u) { return __uint_as_float(u & 0xffff0000u); }
__device__ __forceinline__ unsigned u4get(const uint4 v, const int q) { return q == 0 ? v.x : (q == 1 ? v.y : (q == 2 ? v.z : v.w)); }
__device__ __forceinline__ int opaque_tid() { int t = threadIdx.x; asm volatile("" : "+v"(t)); return t; }
__device__ __forceinline__ size_t tiled(int row, int col, int KT) { return ((size_t)(row >> 7) * KT + (col >> 6)) * 8192 + (row & 127) * 64 + (col & 63); }
__device__ __forceinline__ float siluf(float x) { return x / (1.f + __expf(-x)); }
__device__ __forceinline__ int cidx(int tok) { return tok < NCTX ? 0 : 1 + ((tok - NCTX) >> 12); }

template <int CTRL>
__device__ __forceinline__ unsigned dpp_u(unsigned v) {
  return (unsigned)__builtin_amdgcn_update_dpp(0, (int)v, CTRL, 0xF, 0xF, true);
}
template <int CTRL>
__device__ __forceinline__ float dpp_f(float v) {
  return __int_as_float(__builtin_amdgcn_update_dpp(0, __float_as_int(v), CTRL, 0xF, 0xF, true));
}
__device__ __forceinline__ float row16_sum(float v) {
  v += dpp_f<0xB1>(v);
  v += dpp_f<0x4E>(v);
  v += dpp_f<0x141>(v);
  v += dpp_f<0x140>(v);
  return v;
}
__device__ __forceinline__ unsigned umax_(unsigned a, unsigned b) { return a > b ? a : b; }
__device__ __forceinline__ unsigned row_max_u32(unsigned v) {
  v = umax_(v, dpp_u<0xB1>(v));
  v = umax_(v, dpp_u<0x4E>(v));
  v = umax_(v, dpp_u<0x141>(v));
  v = umax_(v, dpp_u<0x140>(v));
  return v;
}
__device__ __forceinline__ unsigned wave_max_u32(unsigned v) {
  v = umax_(v, dpp_u<0xB1>(v));
  v = umax_(v, dpp_u<0x4E>(v));
  v = umax_(v, dpp_u<0x141>(v));
  v = umax_(v, dpp_u<0x140>(v));
  unsigned a = (unsigned)__builtin_amdgcn_readlane((int)v, 0);
  unsigned b = (unsigned)__builtin_amdgcn_readlane((int)v, 16);
  unsigned c = (unsigned)__builtin_amdgcn_readlane((int)v, 32);
  unsigned d = (unsigned)__builtin_amdgcn_readlane((int)v, 48);
  return umax_(umax_(a, b), umax_(c, d));
}
__device__ __forceinline__ float wave_sum(float v) {
  v = row16_sum(v);
  float a, b, c, d;
  a = __int_as_float(__builtin_amdgcn_readlane(__float_as_int(v), 0));
  b = __int_as_float(__builtin_amdgcn_readlane(__float_as_int(v), 16));
  c = __int_as_float(__builtin_amdgcn_readlane(__float_as_int(v), 32));
  d = __int_as_float(__builtin_amdgcn_readlane(__float_as_int(v), 48));
  return (a + b) + (c + d);
}
__device__ __forceinline__ unsigned fkey(float f) {
  unsigned u = __float_as_uint(f);
  return (u & 0x80000000u) ? ~u : (u | 0x80000000u);
}
__device__ __forceinline__ float keyf(unsigned k) {
  unsigned u = (k & 0x80000000u) ? (k & 0x7fffffffu) : ~k;
  return __uint_as_float(u);
}

__device__ __forceinline__ void transpose_tile(const float* __restrict__ src, int K, int N, bf16_t* __restrict__ dst, int tile, float* tb) {
  const int tid = threadIdx.x;
  const int ntn = N >> 6;
  const int kt = tile / ntn, nt = tile % ntn;
  {
    const int n = tid & 63, kb = tid >> 6;
#pragma unroll
    for (int i = 0; i < 16; ++i) {
      int k = kb + 4 * i;
      tb[k * 65 + n] = src[(size_t)(kt * 64 + k) * N + nt * 64 + n];
    }
  }
  __syncthreads();
  {
    const int k8 = (tid & 7) * 8;
#pragma unroll
    for (int pass = 0; pass < 2; ++pass) {
      int n = (tid >> 3) + 32 * pass;
      uint4 o;
      o.x = pack2(tb[(k8 + 0) * 65 + n], tb[(k8 + 1) * 65 + n]);
      o.y = pack2(tb[(k8 + 2) * 65 + n], tb[(k8 + 3) * 65 + n]);
      o.z = pack2(tb[(k8 + 4) * 65 + n], tb[(k8 + 5) * 65 + n]);
      o.w = pack2(tb[(k8 + 6) * 65 + n], tb[(k8 + 7) * 65 + n]);
      *(uint4*)(dst + tiled(nt * 64 + n, kt * 64 + k8, K >> 6)) = o;
    }
  }
  __syncthreads();
}

__device__ __forceinline__ void prep_phase(const Params& p, char* smem) {
  const int otid = opaque_tid();
  const int tid = otid;
  bf16_t* WT = (bf16_t*)(p.ws + OFF_WT);
  float* MOD = (float*)(p.ws + OFF_MOD);
  bf16_t* KEYSB = (bf16_t*)(p.ws + OFF_KEYSB);
  const int U_MOD = 192, U_T0 = 768, U_T1 = 256, U_T2 = 1552, U_T3 = 512, U_T4 = 1024, U_KEYS = 256, U_TAB = 8192;
  const int total = U_MOD + U_T0 + U_T1 + U_T2 + U_T3 + U_T4 + U_KEYS + U_TAB;
  for (int u = blockIdx.x; u < total; u += gridDim.x) {
    int v = u;
    if (v < U_MOD) {
      float* scond = (float*)smem;
      float* red = scond + 5 * 1024;
      for (int i = tid; i < 5 * 1024; i += 256) {
        int r = i >> 10, k = i & 1023;
        float cv = (r == 0) ? p.c_ctx[k] : p.c[(r - 1) * 1024 + k];
        scond[i] = siluf(cv);
      }
      __syncthreads();
      const int l = v / 96, jc = v % 96;
      const int jj = tid & 63, kq = tid >> 6;
      const int j = jc * 64 + jj;
      float acc[5] = {0.f, 0.f, 0.f, 0.f, 0.f};
      const float* wp = p.ada_w + ((size_t)l * 1024 + kq * 256) * 6144 + j;
#pragma unroll 8
      for (int k = 0; k < 256; ++k) {
        float wv = wp[(size_t)k * 6144];
#pragma unroll
        for (int r = 0; r < 5; ++r) acc[r] += scond[r * 1024 + kq * 256 + k] * wv;
      }
#pragma unroll
      for (int r = 0; r < 5; ++r) red[(kq * 5 + r) * 64 + jj] = acc[r];
      __syncthreads();
      for (int i = tid; i < 320; i += 256) {
        int r = i >> 6, j2 = i & 63;
        float s = red[(0 * 5 + r) * 64 + j2] + red[(1 * 5 + r) * 64 + j2] + red[(2 * 5 + r) * 64 + j2] + red[(3 * 5 + r) * 64 + j2];
        MOD[(size_t)(l * 5 + r) * 6144 + jc * 64 + j2] = s + p.ada_b[l * 6144 + jc * 64 + j2];
      }
      __syncthreads();
      continue;
    }
    v -= U_MOD;
    float* tb = (float*)smem;
    if (v < U_T0) { transpose_tile(p.sc_w_in, 1024, 3072, WT + WT_SCIN, v, tb); continue; }
    v -= U_T0;
    if (v < U_T1) { transpose_tile(p.sc_w_out, 1024, 1024, WT + WT_SCOUT, v, tb); continue; }
    v -= U_T1;
    if (v < U_T2) { transpose_tile(p.ssd_w_in, 1024, 6208, WT + WT_SSDIN, v, tb); continue; }
    v -= U_T2;
    if (v < U_T3) { transpose_tile(p.ssd_w_out, 2048, 1024, WT + WT_SSDOUT, v, tb); continue; }
    v -= U_T3;
    if (v < U_T4) {
      int l = v >> 9, t = v & 511;
      transpose_tile(p.peer_wq + (size_t)l * 1024 * 2048, 1024, 2048, WT + WT_WQ + (size_t)l * 2048 * 1024, t, tb);
      continue;
    }
    v -= U_T4;
    if (v < U_KEYS) {
      size_t base = (size_t)v * 2048 + tid * 8;
      float4 a = *(const float4*)(p.peer_keys + base);
      float4 b = *(const float4*)(p.peer_keys + base + 4);
      uint4 o;
      o.x = pack2(a.x, a.y); o.y = pack2(a.z, a.w); o.z = pack2(b.x, b.y); o.w = pack2(b.z, b.w);
      *(uint4*)(KEYSB + base) = o;
      continue;
    }
    v -= U_KEYS;
    {
      const int lane = tid & 63, l31 = lane & 31;
      const int gr = v * 8 + (tid >> 6) * 2 + (lane >> 5);
      const int l = gr >> 15, tab = (gr >> 14) & 1, row = gr & 16383;
      const float* src = (tab ? p.peer_v : p.peer_u) + ((size_t)l * 16384 + row) * 1024 + l31 * 32;
      float4 x[8];
      float am = 0.f;
#pragma unroll
      for (int j = 0; j < 8; ++j) {
        x[j] = *(const float4*)(src + 4 * j);
        am = fmaxf(am, fmaxf(fmaxf(fabsf(x[j].x), fabsf(x[j].y)), fmaxf(fabsf(x[j].z), fabsf(x[j].w))));
      }
      {
        unsigned au = row_max_u32(__float_as_uint(am));
        const unsigned ao = (unsigned)__shfl_xor((int)au, 16);
        am = __uint_as_float(umax_(au, ao));
      }
      const float inv = am > 0.f ? 7.0f / am : 0.f;
      const float scale = am > 0.f ? am / 7.0f : 0.f;
      f32x16 fa, fb;
#pragma unroll
      for (int j = 0; j < 8; ++j) {
        fa[2 * j] = x[j].x * inv; fb[2 * j] = x[j].y * inv; fa[2 * j + 1] = x[j].z * inv; fb[2 * j + 1] = x[j].w * inv;
      }
      const u32x6 pk = __builtin_amdgcn_cvt_scalef32_2xpk16_fp6_f32(fa, fb, 1.0f);
      unsigned char* dst = (unsigned char*)(p.ws + (l ? OFF_TAB1 : OFF_YB)) + ((size_t)tab * 16384 + row) * 768 + l31 * 24;
      *(uint2*)(dst) = make_uint2(pk[0], pk[1]);
      *(uint2*)(dst + 8) = make_uint2(pk[2], pk[3]);
      *(uint2*)(dst + 16) = make_uint2(pk[4], pk[5]);
      if (l31 == 0) ((float*)(p.ws + OFF_SCALE))[gr] = scale;
    }
  }
}

__device__ __forceinline__ void norm_mod_phase(const Params& p, int layer, int which, bool from_input) {
  const int otid = opaque_tid();
  const float* g = (which == 0 ? p.norm_mix_g : p.norm_ffn_g) + layer * 1024;
  const float* MOD = (const float*)(p.ws + OFF_MOD);
  bf16_t* A = (bf16_t*)(p.ws + OFF_YF);
  const int lane = otid & 63, w = otid >> 6;
  for (int tok = blockIdx.x * 4 + w; tok < NT; tok += gridDim.x * 4) {
    const float* xr = from_input ? (tok < NCTX ? p.x_prompt + (size_t)tok * 1024 : p.x_sample + (size_t)(tok - NCTX) * 1024)
                                 : p.out + (size_t)tok * 1024;
    const float* md = MOD + (size_t)(layer * 5 + cidx(tok)) * 6144 + (which ? 3 * 1024 : 0);
    float4 v[4];
    float ss = 0.f;
#pragma unroll
    for (int i = 0; i < 4; ++i) {
      v[i] = *(const float4*)(xr + lane * 4 + 256 * i);
      ss += v[i].x * v[i].x + v[i].y * v[i].y + v[i].z * v[i].z + v[i].w * v[i].w;
    }
    ss = wave_sum(ss);
    const float sc = rsqrtf(ss * (1.f / 1024.f) + 1e-6f);
#pragma unroll
    for (int i = 0; i < 4; ++i) {
      const int col = lane * 4 + 256 * i;
      float4 gg = *(const float4*)(g + col);
      float4 sh = *(const float4*)(md + col);
      float4 sl = *(const float4*)(md + 1024 + col);
      float o0 = v[i].x * sc * gg.x * (1.f + sl.x) + sh.x;
      float o1 = v[i].y * sc * gg.y * (1.f + sl.y) + sh.y;
      float o2 = v[i].z * sc * gg.z * (1.f + sl.z) + sh.z;
      float o3 = v[i].w * sc * gg.w * (1.f + sl.w) + sh.w;
      uint2 o;
      o.x = pack2(o0, o1);
      o.y = pack2(o2, o3);
      *(uint2*)(A + tiled(tok, col, 16)) = o;
    }
  }
}

#define LSTR 72
template <class Epi>
__device__ __forceinline__ void gemm_phase(const bf16_t* __restrict__ A, const bf16_t* __restrict__ Bt, int M, int N, int K, Epi epi, char* smem) {
  const int otid = opaque_tid();
  bf16_t* sA = (bf16_t*)smem;
  bf16_t* sB = sA + 2 * 128 * LSTR;
  float* sC = (float*)smem;
  const int tid = otid, lane = tid & 63, w = tid >> 6;
  const int wm = w >> 1, wn = w & 1;
  const int ntn = (N + 127) >> 7, ntm = M >> 7;
  const int ntiles = ntm * ntn;
  const int KT = K >> 6;
  const int lrow = tid >> 3, lkc = (tid & 7) * 8;
  const bf16_t* apb;
  const bf16_t* bpb;
  uint4 ra0_0, ra0_1, ra0_2, ra0_3, rb0_0, rb0_1, rb0_2, rb0_3, ra1_0, ra1_1, ra1_2, ra1_3, rb1_0, rb1_1, rb1_2, rb1_3;
#define G_PTRS(TILE_) { const int m0_ = ((TILE_) / ntn) << 7, n0_ = ((TILE_) % ntn) << 7; \
    apb = A + (size_t)(m0_ >> 7) * KT * 8192 + lrow * 64 + lkc; bpb = Bt + (size_t)(n0_ >> 7) * KT * 8192 + lrow * 64 + lkc; }
#define G_LOAD1(S, I, KT_) { ra##S##_##I = *(const uint4*)(apb + (KT_) * 8192 + I * 2048); rb##S##_##I = *(const uint4*)(bpb + (KT_) * 8192 + I * 2048); }
#define G_LOAD(S, KT_) { G_LOAD1(S, 0, KT_) G_LOAD1(S, 1, KT_) G_LOAD1(S, 2, KT_) G_LOAD1(S, 3, KT_) }
#define G_WRITE1(S, I, BUF_) { *(uint4*)(sA + (BUF_) * 128 * LSTR + (lrow + 32 * I) * LSTR + lkc) = ra##S##_##I; *(uint4*)(sB + (BUF_) * 128 * LSTR + (lrow + 32 * I) * LSTR + lkc) = rb##S##_##I; }
#define G_WRITE(S, BUF_) { G_WRITE1(S, 0, BUF_) G_WRITE1(S, 1, BUF_) G_WRITE1(S, 2, BUF_) G_WRITE1(S, 3, BUF_) }
#define G_MMA(KK, BUF_) { \
        bf16x8 a0 = *(const bf16x8*)(cA + KK * 16); \
        bf16x8 a1 = *(const bf16x8*)(cA + 32 * LSTR + KK * 16); \
        bf16x8 b0 = *(const bf16x8*)(cB + KK * 16); \
        bf16x8 b1 = *(const bf16x8*)(cB + 32 * LSTR + KK * 16); \
        acc[0][0] = __builtin_amdgcn_mfma_f32_32x32x16_bf16(a0, b0, acc[0][0], 0, 0, 0); \
        acc[0][1] = __builtin_amdgcn_mfma_f32_32x32x16_bf16(a0, b1, acc[0][1], 0, 0, 0); \
        acc[1][0] = __builtin_amdgcn_mfma_f32_32x32x16_bf16(a1, b0, acc[1][0], 0, 0, 0); \
        acc[1][1] = __builtin_amdgcn_mfma_f32_32x32x16_bf16(a1, b1, acc[1][1], 0, 0, 0); }
#define G_COMPUTE(BUF_) { \
      const bf16_t* cA = sA + (BUF_) * 128 * LSTR + (wm * 64 + (lane & 31)) * LSTR + (lane >> 5) * 8; \
      const bf16_t* cB = sB + (BUF_) * 128 * LSTR + (wn * 64 + (lane & 31)) * LSTR + (lane >> 5) * 8; \
      G_MMA(0, BUF_) G_MMA(1, BUF_) G_MMA(2, BUF_) G_MMA(3, BUF_) }
  int tile = blockIdx.x;
  if (tile < ntiles) { G_PTRS(tile) G_LOAD(0, 0) G_LOAD(1, 1) }
  while (tile < ntiles) {
    const int m0 = (tile / ntn) << 7, n0 = (tile % ntn) << 7;
    f32x16 acc[2][2];
#pragma unroll
    for (int i = 0; i < 2; ++i)
#pragma unroll
      for (int j = 0; j < 2; ++j)
#pragma unroll
        for (int r = 0; r < 16; ++r) acc[i][j][r] = 0.f;
    G_WRITE(0, 0)
    __syncthreads();
    for (int kt = 0; kt < KT; kt += 2) {
      if (kt + 2 < KT) G_LOAD(0, kt + 2)
      G_COMPUTE(0)
      G_WRITE(1, 1)
      __syncthreads();
      if (kt + 3 < KT) G_LOAD(1, kt + 3)
      G_COMPUTE(1)
      if (kt + 2 < KT) G_WRITE(0, 0)
      __syncthreads();
    }
    const int next = tile + gridDim.x;
    if (next < ntiles) { G_PTRS(next) G_LOAD(0, 0) G_LOAD(1, 1) }
#pragma unroll
    for (int mi = 0; mi < 2; ++mi)
#pragma unroll
      for (int ni = 0; ni < 2; ++ni) {
        float* cw = sC + (wm * 64 + mi * 32 + 4 * (lane >> 5)) * 132 + wn * 64 + ni * 32 + (lane & 31);
#pragma unroll
        for (int r = 0; r < 16; ++r) cw[((r & 3) + 8 * (r >> 2)) * 132] = acc[mi][ni][r];
      }
    __syncthreads();
#pragma unroll 4
    for (int i = 0; i < 16; ++i) {
      const int ch = tid + 256 * i;
      const int row = ch >> 5, c4 = (ch & 31) * 4;
      const float4 v = *(const float4*)(sC + row * 132 + c4);
      if (n0 + c4 < N) epi(m0 + row, n0 + c4, v);
    }
    __syncthreads();
    tile = next;
  }
}

struct EpiBf16 {
  bf16_t* C; int ldc;
  __device__ __forceinline__ void operator()(int m, int n, float4 v) const {
    uint2 o; o.x = pack2(v.x, v.y); o.y = pack2(v.z, v.w);
    *(uint2*)(C + (size_t)m * ldc + n) = o;
  }
};
__device__ __forceinline__ float softplusf(float x) { return x > 20.f ? x : log1pf(expf(x)); }
struct EpiSsdIn {
  bf16_t* C; float* DT; const float* dt_bias;
  __device__ __forceinline__ void operator()(int m, int n, float4 v) const {
    if (n < 6144) {
      uint2 o; o.x = pack2(v.x, v.y); o.y = pack2(v.z, v.w);
      *(uint2*)(C + (size_t)m * 6144 + n) = o;
    } else {
      const int c = n - 6144;
      const float4 bb = *(const float4*)(dt_bias + c);
      *(float4*)(DT + (size_t)m * 64 + c) = make_float4(softplusf(v.x + bb.x), softplusf(v.y + bb.y), softplusf(v.z + bb.z), softplusf(v.w + bb.w));
    }
  }
};
struct EpiRes {
  const float* xin_ctx; const float* xin_lat; float* X; const float* gate;
  __device__ __forceinline__ void operator()(int m, int n, float4 v) const {
    const float* xr = m < NCTX ? xin_ctx + (size_t)m * 1024 : xin_lat + (size_t)(m - NCTX) * 1024;
    const float4 xv = *(const float4*)(xr + n);
    const float4 gt = *(const float4*)(gate + (size_t)cidx(m) * 6144 + n);
    *(float4*)(X + (size_t)m * 1024 + n) = make_float4(xv.x + gt.x * v.x, xv.y + gt.y * v.y, xv.z + gt.z * v.z, xv.w + gt.w * v.w);
  }
};

__device__ __forceinline__ void conv_gate_phase(const Params& p) {
  const int otid = opaque_tid();
  const bf16_t* P = (const bf16_t*)(p.ws + OFF_BIG);
  bf16_t* G = (bf16_t*)(p.ws + OFF_BIG + 120 * MIB);
  const float* cw = p.sc_conv_w;
  const int total = NT * 128;
  for (int it = blockIdx.x * 256 + otid; it < total; it += gridDim.x * 256) {
    const int tok = it >> 7, c = (it & 127) * 8;
    const int rowlen = tok < NCTX ? 256 : 64;
    const int pos = tok & (rowlen - 1);
    const bf16_t* pr = P + (size_t)tok * 3072;
    uint4 bg = *(const uint4*)(pr + c);
    uint4 cg = *(const uint4*)(pr + 1024 + c);
    uint4 xv = *(const uint4*)(pr + 2048 + c);
    uint4 cgl = make_uint4(0, 0, 0, 0), xvl = cgl, cgr = cgl, xvr = cgl;
    if (pos > 0) { cgl = *(const uint4*)(pr - 3072 + 1024 + c); xvl = *(const uint4*)(pr - 3072 + 2048 + c); }
    if (pos < rowlen - 1) { cgr = *(const uint4*)(pr + 3072 + 1024 + c); xvr = *(const uint4*)(pr + 3072 + 2048 + c); }
    const unsigned* bgp = (const unsigned*)&bg; const unsigned* cgp = (const unsigned*)&cg; const unsigned* xvp = (const unsigned*)&xv;
    const unsigned* cglp = (const unsigned*)&cgl; const unsigned* xvlp = (const unsigned*)&xvl;
    const unsigned* cgrp = (const unsigned*)&cgr; const unsigned* xvrp = (const unsigned*)&xvr;
    float4 w0a = *(const float4*)(cw + c), w0b = *(const float4*)(cw + c + 4);
    float4 w1a = *(const float4*)(cw + 1024 + c), w1b = *(const float4*)(cw + 1024 + c + 4);
    float4 w2a = *(const float4*)(cw + 2048 + c), w2b = *(const float4*)(cw + 2048 + c + 4);
    const float w0[8] = {w0a.x, w0a.y, w0a.z, w0a.w, w0b.x, w0b.y, w0b.z, w0b.w};
    const float w1[8] = {w1a.x, w1a.y, w1a.z, w1a.w, w1b.x, w1b.y, w1b.z, w1b.w};
    const float w2[8] = {w2a.x, w2a.y, w2a.z, w2a.w, w2b.x, w2b.y, w2b.z, w2b.w};
    unsigned o[4];
#pragma unroll
    for (int q = 0; q < 4; ++q) {
      float r0 = lo2f(bgp[q]) * (w0[2 * q] * lo2f(cglp[q]) * lo2f(xvlp[q]) + w1[2 * q] * lo2f(cgp[q]) * lo2f(xvp[q]) + w2[2 * q] * lo2f(cgrp[q]) * lo2f(xvrp[q]));
      float r1 = hi2f(bgp[q]) * (w0[2 * q + 1] * hi2f(cglp[q]) * hi2f(xvlp[q]) + w1[2 * q + 1] * hi2f(cgp[q]) * hi2f(xvp[q]) + w2[2 * q + 1] * hi2f(cgrp[q]) * hi2f(xvrp[q]));
      o[q] = pack2(r0, r1);
    }
    *(uint4*)(G + tiled(tok, c, 16)) = make_uint4(o[0], o[1], o[2], o[3]);
  }
}

#define SSTR 272
#define CE_(a, b) { unsigned hi_ = umax_(key[a], key[b]); unsigned lo_ = key[a] < key[b] ? key[a] : key[b]; key[a] = hi_; key[b] = lo_; }
__device__ __forceinline__ unsigned top16_row(const float* Sr, int j) {
  unsigned key[8];
#pragma unroll
  for (int m = 0; m < 8; ++m) key[m] = (fkey(Sr[j + 16 * m]) & ~0x7Fu) | (unsigned)(127 - (j + 16 * m));
  CE_(0, 1) CE_(2, 3) CE_(4, 5) CE_(6, 7)
  CE_(0, 2) CE_(1, 3) CE_(4, 6) CE_(5, 7)
  CE_(1, 2) CE_(5, 6)
  CE_(0, 4) CE_(1, 5) CE_(2, 6) CE_(3, 7)
  CE_(2, 4) CE_(3, 5)
  CE_(1, 2) CE_(3, 4) CE_(5, 6)
  unsigned res = 0;
#pragma unroll 1
  for (int it = 0; it < 16; ++it) {
    const unsigned wm = row_max_u32(key[0]);
    const bool win = key[0] == wm;
#pragma unroll
    for (int m = 0; m < 7; ++m) key[m] = win ? key[m + 1] : key[m];
    key[7] = win ? 0u : key[7];
    res = (j == it) ? wm : res;
  }
  return res;
}

__device__ __forceinline__ void topk_phase(const Params& p, int layer, char* smem) {
  const int otid = opaque_tid();
  float* S = (float*)smem;
  const bf16_t* Q = (const bf16_t*)(p.ws + OFF_BIG);
  const bf16_t* KB = (const bf16_t*)(p.ws + OFF_KEYSB) + (size_t)layer * (8 * 2 * 128 * 128);
  int* IDX = (int*)(p.ws + OFF_IDX);
  float* GATE = (float*)(p.ws + OFF_GATE);
  const int tid = otid, lane = tid & 63;
  const int w = __builtin_amdgcn_readfirstlane(tid >> 6);
  const int G = gridDim.x;
  const int per = (5120 + G - 1) / G;
  const int start = blockIdx.x * per;
  const int end = (start + per < 5120) ? start + per : 5120;
  const int pp = w >> 1, nt0 = (w & 1) * 2;
  const int j = lane & 15, rowbase = lane & 48;
  int ca[4], cb[4];
  bool cvalid3;
  ca[0] = 0; cb[0] = j;
  if (j < 8) { ca[1] = 1; cb[1] = j; } else { ca[1] = j; cb[1] = 0; }
  if (j < 5) { ca[2] = 2; cb[2] = j; } else if (j < 9) { ca[2] = 3; cb[2] = j - 5; } else if (j < 12) { ca[2] = 4; cb[2] = j - 9; }
  else if (j < 14) { ca[2] = 5; cb[2] = j - 12; } else { ca[2] = 6; cb[2] = j - 14; }
  ca[3] = 7; cb[3] = j & 1; cvalid3 = j < 2;
  int curh = -1;
  bf16x8 kf[2][8];
  for (int pr = start; pr < end; ++pr) {
    const int h = pr / 640, tile = pr % 640;
    const int t0 = tile * 32;
    if (h != curh) {
#pragma unroll
      for (int jj = 0; jj < 2; ++jj)
#pragma unroll
        for (int kk = 0; kk < 8; ++kk)
          kf[jj][kk] = *(const bf16x8*)(KB + ((size_t)((h * 2 + pp) * 128 + (nt0 + jj) * 32 + (lane & 31))) * 128 + kk * 16 + (lane >> 5) * 8);
      curh = h;
    }
    f32x16 acc[2];
#pragma unroll
    for (int jj = 0; jj < 2; ++jj)
#pragma unroll
      for (int r = 0; r < 16; ++r) acc[jj][r] = 0.f;
    const bf16_t* qp = Q + (size_t)(t0 + (lane & 31)) * 2048 + h * 256 + pp * 128 + (lane >> 5) * 8;
#pragma unroll
    for (int kk = 0; kk < 8; ++kk) {
      bf16x8 a = *(const bf16x8*)(qp + kk * 16);
      acc[0] = __builtin_amdgcn_mfma_f32_32x32x16_bf16(a, kf[0][kk], acc[0], 0, 0, 0);
      acc[1] = __builtin_amdgcn_mfma_f32_32x32x16_bf16(a, kf[1][kk], acc[1], 0, 0, 0);
    }
#pragma unroll
    for (int jj = 0; jj < 2; ++jj)
#pragma unroll
      for (int r = 0; r < 16; ++r) {
        const int tl = (r & 3) + 8 * (r >> 2) + 4 * (lane >> 5);
        S[tl * SSTR + pp * 128 + (nt0 + jj) * 32 + (lane & 31)] = acc[jj][r];
      }
    __syncthreads();
#pragma unroll 1
    for (int rnd = 0; rnd < 2; ++rnd) {
      const int tl = w * 8 + rnd * 4 + (lane >> 4);
      const float* Sr = S + tl * SSTR;
      const unsigned res1 = top16_row(Sr, j);
      const unsigned res2 = top16_row(Sr + 128, j);
      unsigned ck[4];
#pragma unroll
      for (int sl = 0; sl < 4; ++sl) {
        const float v1 = keyf((unsigned)__shfl((int)res1, rowbase + ca[sl]) & ~0x7Fu);
        const float v2 = keyf((unsigned)__shfl((int)res2, rowbase + cb[sl]) & ~0x7Fu);
        ck[sl] = (fkey(v1 + v2) & ~0xFFu) | (unsigned)(255 - (ca[sl] * 16 + cb[sl]));
      }
      ck[3] = cvalid3 ? ck[3] : 0u;
      unsigned resc = 0;
#pragma unroll 1
      for (int it = 0; it < 16; ++it) {
        const unsigned wm = row_max_u32(umax_(umax_(ck[0], ck[1]), umax_(ck[2], ck[3])));
#pragma unroll
        for (int sl = 0; sl < 4; ++sl) ck[sl] = (ck[sl] == wm) ? 0u : ck[sl];
        resc = (j == it) ? wm : resc;
      }
      const int code = 255 - (int)(resc & 0xFFu);
      const int wa = code >> 4, wb = code & 15;
      const float val = keyf(resc & ~0xFFu);
      const unsigned r1 = (unsigned)__shfl((int)res1, rowbase + wa);
      const unsigned r2 = (unsigned)__shfl((int)res2, rowbase + wb);
      const int i1 = 127 - (int)(r1 & 0x7Fu), i2 = 127 - (int)(r2 & 0x7Fu);
      const float vmax = __shfl(val, rowbase);
      const float e = __expf(val - vmax);
      const float ssum = row16_sum(e);
      const size_t ob = ((size_t)(t0 + tl) * 8 + h) * 16 + j;
      IDX[ob] = i1 * 128 + i2;
      GATE[ob] = e / ssum;
    }
    __syncthreads();
  }
}

typedef __attribute__((ext_vector_type(2))) float f32x2;
__device__ __forceinline__ void peer_phase(const Params& p, int layer, char* smem) {
  const int otid = opaque_tid();
  float* coefs = (float*)smem;
  int* idxs = (int*)(smem + 2048);
  float* sus = (float*)(smem + 4096);
  float* gsv = (float*)(smem + 6144);
  const unsigned char* U6 = (const unsigned char*)(p.ws + (layer ? OFF_TAB1 : OFF_YB));
  const unsigned char* V6 = U6 + (size_t)16384 * 768;
  const float* SCU = (const float*)(p.ws + OFF_SCALE) + (size_t)layer * 32768;
  const float* SCV = SCU + 16384;
  const bf16_t* A = (const bf16_t*)(p.ws + OFF_YF);
  const int* IDX = (const int*)(p.ws + OFF_IDX);
  const float* GATE = (const float*)(p.ws + OFF_GATE);
  const float* MOD = (const float*)(p.ws + OFF_MOD);
  float* X = p.out;
  const int lane = otid & 63;
  const int w = __builtin_amdgcn_readfirstlane(otid >> 6);
  const int sub = lane & 15, rg = lane >> 4;
  const int half = lane >> 5, l31 = lane & 31;
  for (int tok = blockIdx.x * 4 + w; tok < NT; tok += gridDim.x * 4) {
#pragma unroll
    for (int hh = 0; hh < 2; ++hh) {
      const int kk = lane + 64 * hh;
      const int e = IDX[(size_t)tok * 128 + kk];
      const float gk = GATE[(size_t)tok * 128 + kk];
      idxs[w * 128 + kk] = e;
      sus[w * 128 + kk] = SCU[e];
      gsv[w * 128 + kk] = gk * SCV[e];
    }
    float t[64];
    {
      const uint4* ap = (const uint4*)(A + tiled(tok, 64 * sub, 16));
#pragma unroll
      for (int i = 0; i < 8; ++i) {
        const uint4 r0 = ap[i];
#pragma unroll
        for (int q = 0; q < 4; ++q) { t[8 * i + 2 * q] = lo2f(u4get(r0, q)); t[8 * i + 2 * q + 1] = hi2f(u4get(r0, q)); }
      }
    }
    float chain = 0.f;
#pragma unroll 4
    for (int it = 0; it < 32; ++it) {
      const int k = it * 4 + rg;
      const int e = idxs[w * 128 + k];
      const uint4* row = (const uint4*)(U6 + (size_t)e * 768 + sub * 48);
      const uint4 r0 = row[0], r1 = row[1], r2 = row[2];
      u32x6 g0, g1;
      g0[0] = r0.x; g0[1] = r0.y; g0[2] = r0.z; g0[3] = r0.w; g0[4] = r1.x; g0[5] = r1.y;
      g1[0] = r1.z; g1[1] = r1.w; g1[2] = r2.x; g1[3] = r2.y; g1[4] = r2.z; g1[5] = r2.w;
      float acc0 = 0.f, acc1 = 0.f;
      asm volatile("" : "+v"(g0), "+v"(chain));
      {
        const f32x32 d0 = __builtin_amdgcn_cvt_scalef32_pk32_f32_fp6(g0, 1.0f);
#pragma unroll
        for (int j = 0; j < 32; j += 2) { acc0 += d0[j] * t[j]; acc1 += d0[j + 1] * t[j + 1]; }
      }
      asm volatile("" : "+v"(g1), "+v"(acc0), "+v"(acc1));
      {
        const f32x32 d1 = __builtin_amdgcn_cvt_scalef32_pk32_f32_fp6(g1, 1.0f);
#pragma unroll
        for (int j = 0; j < 32; j += 2) { acc0 += d1[j] * t[32 + j]; acc1 += d1[j + 1] * t[32 + j + 1]; }
      }
      chain = acc0 + acc1;
      float acc = row16_sum(chain) * sus[w * 128 + k];
      const float co = 0.5f * acc * (1.f + erff(acc * 0.70710678118654752f)) * gsv[w * 128 + k];
      if (sub == 0) coefs[w * 128 + k] = co;
    }
    f32x32 ov;
#pragma unroll
    for (int i = 0; i < 32; ++i) ov[i] = 0.f;
#pragma unroll 1
    for (int k = 0; k < 128; k += 16) {
      uint2 ra[8], rb[8], rc[8]; float c[8];
#pragma unroll
      for (int j = 0; j < 8; ++j) {
        const int kk = k + 2 * j + half;
        const int e = idxs[w * 128 + kk];
        c[j] = coefs[w * 128 + kk];
        const uint2* rp = (const uint2*)(V6 + (size_t)e * 768 + l31 * 24);
        ra[j] = rp[0]; rb[j] = rp[1]; rc[j] = rp[2];
      }
#pragma unroll
      for (int j = 0; j < 8; ++j) {
        u32x6 g;
        g[0] = ra[j].x; g[1] = ra[j].y; g[2] = rb[j].x; g[3] = rb[j].y; g[4] = rc[j].x; g[5] = rc[j].y;
        asm volatile("" : "+v"(g), "+v"(ov));
        const f32x32 d = __builtin_amdgcn_cvt_scalef32_pk32_f32_fp6(g, 1.0f);
        ov += d * c[j];
      }
    }
    float o[16];
#pragma unroll
    for (int i = 0; i < 16; ++i) {
      const float lo = ov[i] + __shfl_xor(ov[i], 32);
      const float hi = ov[16 + i] + __shfl_xor(ov[16 + i], 32);
      o[i] = half ? hi : lo;
    }
    const int col0 = 32 * l31 + 16 * half;
    const float* gate = MOD + (size_t)(layer * 5 + cidx(tok)) * 6144 + 5 * 1024;
    float xr[16];
    float ss = 0.f;
#pragma unroll
    for (int i = 0; i < 4; ++i) {
      const int col = col0 + 4 * i;
      const float4 xv = *(const float4*)(X + (size_t)tok * 1024 + col);
      const float4 gt = *(const float4*)(gate + col);
      xr[4 * i] = xv.x + gt.x * o[4 * i]; xr[4 * i + 1] = xv.y + gt.y * o[4 * i + 1];
      xr[4 * i + 2] = xv.z + gt.z * o[4 * i + 2]; xr[4 * i + 3] = xv.w + gt.w * o[4 * i + 3];
      ss += xr[4 * i] * xr[4 * i] + xr[4 * i + 1] * xr[4 * i + 1] + xr[4 * i + 2] * xr[4 * i + 2] + xr[4 * i + 3] * xr[4 * i + 3];
    }
    ss = wave_sum(ss);
    const float sc = rsqrtf(ss * (1.f / 1024.f) + 1e-6f);
    if (layer == 0) {
      const float* g1 = p.norm_mix_g + 1024;
      const float* md = MOD + (size_t)(5 + cidx(tok)) * 6144;
      unsigned pk[8];
#pragma unroll
      for (int i = 0; i < 4; ++i) {
        const int col = col0 + 4 * i;
        *(float4*)(X + (size_t)tok * 1024 + col) = make_float4(xr[4 * i], xr[4 * i + 1], xr[4 * i + 2], xr[4 * i + 3]);
        const float4 gg = *(const float4*)(g1 + col);
        const float4 sh = *(const float4*)(md + col);
        const float4 sl = *(const float4*)(md + 1024 + col);
        pk[2 * i] = pack2(xr[4 * i] * sc * gg.x * (1.f + sl.x) + sh.x, xr[4 * i + 1] * sc * gg.y * (1.f + sl.y) + sh.y);
        pk[2 * i + 1] = pack2(xr[4 * i + 2] * sc * gg.z * (1.f + sl.z) + sh.z, xr[4 * i + 3] * sc * gg.w * (1.f + sl.w) + sh.w);
      }
      bf16_t* An = (bf16_t*)(p.ws + OFF_YF) + tiled(tok, col0, 16);
      *(uint4*)(An) = make_uint4(pk[0], pk[1], pk[2], pk[3]);
      *(uint4*)(An + 8) = make_uint4(pk[4], pk[5], pk[6], pk[7]);
    } else {
#pragma unroll
      for (int i = 0; i < 4; ++i) {
        const int col = col0 + 4 * i;
        const float4 gg = *(const float4*)(p.norm_f_g + col);
        *(float4*)(X + (size_t)tok * 1024 + col) = make_float4(xr[4 * i] * sc * gg.x, xr[4 * i + 1] * sc * gg.y, xr[4 * i + 2] * sc * gg.z, xr[4 * i + 3] * sc * gg.w);
      }
    }
  }
}

__device__ __forceinline__ void ssd_conv_phase(const Params& p) {
  const int otid = opaque_tid();
  bf16_t* BIG = (bf16_t*)(p.ws + OFF_BIG);
  const float* cw = p.ssd_conv_w;
  const float* cb = p.ssd_conv_b;
  const int total = 272 * 512;
  for (int it = blockIdx.x * 256 + otid; it < total; it += gridDim.x * 256) {
    const int c8 = it & 511, r = it >> 9;
    const int c = c8 * 8;
    int tok0, len;
    if (r < 16) { tok0 = r * 256; len = 256; } else { tok0 = NCTX + (r - 16) * 64; len = 64; }
    float w0[8], w1[8], w2[8], bb[8];
#pragma unroll
    for (int j = 0; j < 8; ++j) { w0[j] = cw[c + j]; w1[j] = cw[4096 + c + j]; w2[j] = cw[8192 + c + j]; bb[j] = cb[c + j]; }
    bf16_t* base = BIG + (size_t)tok0 * 6144 + 2048 + c;
    uint4 buf[8], nxt[8];
#pragma unroll
    for (int j = 0; j < 8; ++j) buf[j] = *(const uint4*)(base + (size_t)j * 6144);
    uint4 prev = make_uint4(0, 0, 0, 0);
    for (int t0 = 0; t0 < len; t0 += 8) {
      const bool more = (t0 + 8) < len;
#pragma unroll
      for (int j = 0; j < 8; ++j) nxt[j] = more ? *(const uint4*)(base + (size_t)(t0 + 8 + j) * 6144) : make_uint4(0, 0, 0, 0);
#pragma unroll
      for (int j = 0; j < 8; ++j) {
        const uint4 cur = buf[j];
        const uint4 nx = (j < 7) ? buf[j + 1] : nxt[0];
        const unsigned* pp = (const unsigned*)&prev; const unsigned* cp = (const unsigned*)&cur; const unsigned* np = (const unsigned*)&nx;
        unsigned o[4];
#pragma unroll
        for (int q = 0; q < 4; ++q) {
          float a0 = w0[2 * q] * lo2f(pp[q]) + w1[2 * q] * lo2f(cp[q]) + w2[2 * q] * lo2f(np[q]) + bb[2 * q];
          float a1 = w0[2 * q + 1] * hi2f(pp[q]) + w1[2 * q + 1] * hi2f(cp[q]) + w2[2 * q + 1] * hi2f(np[q]) + bb[2 * q + 1];
          o[q] = pack2(siluf(a0), siluf(a1));
        }
        *(uint4*)(base + (size_t)(t0 + j) * 6144) = make_uint4(o[0], o[1], o[2], o[3]);
        prev = cur;
      }
#pragma unroll
      for (int j = 0; j < 8; ++j) buf[j] = nxt[j];
    }
  }
}

#define XT_STR 72
#define HB_STR 136
__device__ __forceinline__ void scan_phase(const Params& p, char* smem) {
  const int otid = opaque_tid();
  bf16_t* XTd = (bf16_t*)smem;
  bf16_t* BTs = XTd + 64 * XT_STR;
  bf16_t* Ms = BTs + 128 * XT_STR;
  bf16_t* Hb = Ms + 64 * XT_STR;
  float* cumS = (float*)(Hb + 2 * 64 * HB_STR);
  const bf16_t* BIG = (const bf16_t*)(p.ws + OFF_BIG);
  const float* DT = (const float*)(p.ws + OFF_DT);
  const int tid = otid, lane = tid & 63;
  const int w = __builtin_amdgcn_readfirstlane(tid >> 6);
  const int h5 = lane >> 5, l31 = lane & 31;
  const int it = w >> 1, jt = w & 1, pt = w & 1, nt0 = (w >> 1) * 2;
  int item0, istride;
  if (gridDim.x >= 512) { if (blockIdx.x < 256) { item0 = blockIdx.x; istride = 1 << 28; } else { item0 = blockIdx.x; istride = gridDim.x - 256; } }
  else { item0 = blockIdx.x; istride = gridDim.x; }
  for (int item = item0; item < 1280; item += istride) {
    int b, head, dir, L, tok0;
    const bool latent = item < 256;
    if (latent) { b = item >> 6; head = (item >> 1) & 31; dir = item & 1; L = 4096; tok0 = NCTX + b * 4096; }
    else { int jj = item - 256; b = jj >> 6; head = (jj >> 1) & 31; dir = jj & 1; L = 256; tok0 = b * 256; }
    const int g = head >> 2;
    const float a = -expf(p.ssd_a_log[dir * 32 + head]);
    bf16_t* Y = (bf16_t*)(p.ws + (dir ? OFF_YB : OFF_YF));
    f32x16 st[2];
    const size_t sbase = ((size_t)((b * 2 + dir) * 32 + head)) * 8192;
    const int loff = (32 * pt + 4 * h5) * 128 + 32 * nt0 + l31;
    if (latent) {
      const float* sp = p.state_ssm + sbase + loff;
#pragma unroll
      for (int q = 0; q < 2; ++q)
#pragma unroll
        for (int r = 0; r < 16; ++r) st[q][r] = sp[((r & 3) + 8 * (r >> 2)) * 128 + 32 * q];
    } else {
#pragma unroll
      for (int q = 0; q < 2; ++q)
#pragma unroll
        for (int r = 0; r < 16; ++r) st[q][r] = 0.f;
    }
    {
      bf16_t* hb0 = Hb + (32 * pt + 4 * h5) * HB_STR + 32 * nt0 + l31;
#pragma unroll
      for (int q = 0; q < 2; ++q)
#pragma unroll
        for (int r = 0; r < 16; ++r) hb0[((r & 3) + 8 * (r >> 2)) * HB_STR + 32 * q] = f2bf(st[q][r]);
    }
    __syncthreads();
    const int nchunks = L >> 6;
    uint4 sx[2], sb[4];
    float sdt;
    {
      const int t = lane;
      const int tok = tok0 + (dir ? L - 1 - t : t);
      const bf16_t* rowp = BIG + (size_t)tok * 6144;
#pragma unroll
      for (int r = 0; r < 2; ++r) sx[r] = *(const uint4*)(rowp + 2048 + head * 64 + (w + 4 * r) * 8);
#pragma unroll
      for (int r = 0; r < 4; ++r) sb[r] = *(const uint4*)(rowp + 4096 + g * 128 + (w + 4 * r) * 8);
      sdt = DT[(size_t)tok * 64 + dir * 32 + head];
    }
#pragma nounroll
    for (int c = 0; c < nchunks; ++c) {
      const int cur = c & 1;
      bf16x8 cfr[8], bfr[8];
      {
        const int t = c * 64 + 32 * it + l31;
        const int tok = tok0 + (dir ? L - 1 - t : t);
        const bf16_t* cp = BIG + (size_t)tok * 6144 + 5120 + g * 128 + 8 * h5;
#pragma unroll
        for (int kk = 0; kk < 8; ++kk) cfr[kk] = *(const bf16x8*)(cp + 16 * kk);
      }
      if (jt <= it) {
        const int t = c * 64 + 32 * jt + l31;
        const int tok = tok0 + (dir ? L - 1 - t : t);
        const bf16_t* bp = BIG + (size_t)tok * 6144 + 4096 + g * 128 + 8 * h5;
#pragma unroll
        for (int kk = 0; kk < 8; ++kk) bfr[kk] = *(const bf16x8*)(bp + 16 * kk);
      }
      __builtin_amdgcn_sched_barrier(0);
      float cum = sdt * a;
#pragma unroll
      for (int off = 1; off < 64; off <<= 1) {
        const float tv = __shfl_up(cum, off);
        cum += (lane >= off) ? tv : 0.f;
      }
      const float cum_last = __shfl(cum, 63);
      const float wj = __expf(cum_last - cum);
      if (w == 0) cumS[cur * 64 + lane] = cum;
#pragma unroll
      for (int r = 0; r < 2; ++r) {
        const int p8 = (w + 4 * r) * 8;
#pragma unroll
        for (int q = 0; q < 4; ++q) {
          const unsigned u = u4get(sx[r], q);
          XTd[(p8 + 2 * q) * XT_STR + lane] = f2bf(sdt * lo2f(u));
          XTd[(p8 + 2 * q + 1) * XT_STR + lane] = f2bf(sdt * hi2f(u));
        }
      }
#pragma unroll
      for (int r = 0; r < 4; ++r) {
        const int n8 = (w + 4 * r) * 8;
#pragma unroll
        for (int q = 0; q < 4; ++q) {
          const unsigned u = u4get(sb[r], q);
          BTs[(n8 + 2 * q) * XT_STR + lane] = f2bf(wj * lo2f(u));
          BTs[(n8 + 2 * q + 1) * XT_STR + lane] = f2bf(wj * hi2f(u));
        }
      }
      __builtin_amdgcn_sched_barrier(0);
      f32x16 cb;
#pragma unroll
      for (int r = 0; r < 16; ++r) cb[r] = 0.f;
      if (jt <= it) {
#pragma unroll
        for (int kk = 0; kk < 8; ++kk) cb = __builtin_amdgcn_mfma_f32_32x32x16_bf16(cfr[kk], bfr[kk], cb, 0, 0, 0);
      }
      __builtin_amdgcn_sched_barrier(0);
      f32x16 yo;
#pragma unroll
      for (int r = 0; r < 16; ++r) yo[r] = 0.f;
      {
        const bf16_t* hp = Hb + cur * 64 * HB_STR + (32 * pt + l31) * HB_STR + 8 * h5;
#pragma unroll
        for (int kk = 0; kk < 8; ++kk) {
          const bf16x8 hf = *(const bf16x8*)(hp + 16 * kk);
          yo = __builtin_amdgcn_mfma_f32_32x32x16_bf16(cfr[kk], hf, yo, 0, 0, 0);
        }
      }
      __syncthreads();
      __builtin_amdgcn_sched_barrier(0);
      const float dec = __expf(cum_last);
      bf16x8 xf[4];
#pragma unroll
      for (int kk = 0; kk < 4; ++kk) xf[kk] = *(const bf16x8*)(XTd + (32 * pt + l31) * XT_STR + 16 * kk + 8 * h5);
#pragma unroll
      for (int q = 0; q < 2; ++q) {
#pragma unroll
        for (int r = 0; r < 16; ++r) st[q][r] *= dec;
#pragma unroll
        for (int kk = 0; kk < 4; ++kk) {
          const bf16x8 bt = *(const bf16x8*)(BTs + (32 * (nt0 + q) + l31) * XT_STR + 16 * kk + 8 * h5);
          st[q] = __builtin_amdgcn_mfma_f32_32x32x16_bf16(xf[kk], bt, st[q], 0, 0, 0);
        }
        {
          bf16_t* hbw = Hb + (cur ^ 1) * 64 * HB_STR + (32 * pt + 4 * h5) * HB_STR + 32 * (nt0 + q) + l31;
#pragma unroll
          for (int r = 0; r < 16; ++r) hbw[((r & 3) + 8 * (r >> 2)) * HB_STR] = f2bf(st[q][r]);
        }
      }
      __builtin_amdgcn_sched_barrier(0);
      if (jt <= it) {
        const int jj = 32 * jt + l31;
        const float cj = cumS[cur * 64 + jj];
        const int ib = 32 * it + 4 * h5;
        const float* cs = cumS + cur * 64 + ib;
        bf16_t* mw = Ms + ib * XT_STR + jj;
#pragma unroll
        for (int r = 0; r < 16; ++r) {
          const int ro = (r & 3) + 8 * (r >> 2);
          const float m = (jj <= ib + ro) ? cb[r] * __expf(cs[ro] - cj) : 0.f;
          mw[ro * XT_STR] = f2bf(m);
        }
      }
      __syncthreads();
      if (c + 1 < nchunks) {
        const int t = (c + 1) * 64 + lane;
        const int tok = tok0 + (dir ? L - 1 - t : t);
        const bf16_t* rowp = BIG + (size_t)tok * 6144;
#pragma unroll
        for (int r = 0; r < 2; ++r) sx[r] = *(const uint4*)(rowp + 2048 + head * 64 + (w + 4 * r) * 8);
#pragma unroll
        for (int r = 0; r < 4; ++r) sb[r] = *(const uint4*)(rowp + 4096 + g * 128 + (w + 4 * r) * 8);
        sdt = DT[(size_t)tok * 64 + dir * 32 + head];
      }
      __builtin_amdgcn_sched_barrier(0);
      f32x16 yd;
#pragma unroll
      for (int r = 0; r < 16; ++r) yd[r] = 0.f;
#pragma unroll
      for (int kk = 0; kk < 4; ++kk) {
        if (kk < 2 * (it + 1)) {
          const bf16x8 mf = *(const bf16x8*)(Ms + (32 * it + l31) * XT_STR + 16 * kk + 8 * h5);
          yd = __builtin_amdgcn_mfma_f32_32x32x16_bf16(mf, xf[kk], yd, 0, 0, 0);
        }
      }
      {
        const int t0c = c * 64 + 32 * it + 4 * h5;
        const int tokb = tok0 + (dir ? L - 1 - t0c : t0c);
        const int rs = dir ? -64 : 64;
        bf16_t* yp = Y + ((size_t)(tokb >> 7) * 32 + head) * 8192 + (tokb & 127) * 64 + 32 * pt + l31;
        const float* cs = cumS + cur * 64 + 32 * it + 4 * h5;
#pragma unroll
        for (int r = 0; r < 16; ++r) {
          const int ro = (r & 3) + 8 * (r >> 2);
          const float yv = yd[r] + __expf(cs[ro]) * yo[r];
          yp[(ptrdiff_t)rs * ro] = f2bf(yv);
        }
      }
    }
    if (!latent) {
      float* sp = p.out + (size_t)NT * 1024 + sbase + loff;
#pragma unroll
      for (int q = 0; q < 2; ++q)
#pragma unroll
        for (int r = 0; r < 16; ++r) sp[((r & 3) + 8 * (r >> 2)) * 128 + 32 * q] = st[q][r];
    }
    __syncthreads();
  }
}

__device__ __forceinline__ void gate_norm_phase(const Params& p) {
  const int otid = opaque_tid();
  const bf16_t* BIG = (const bf16_t*)(p.ws + OFF_BIG);
  bf16_t* YF = (bf16_t*)(p.ws + OFF_YF);
  const bf16_t* YB = (const bf16_t*)(p.ws + OFF_YB);
  const int lane = otid & 63, w = otid >> 6;
  for (int tok = blockIdx.x * 4 + w; tok < NT; tok += gridDim.x * 4) {
    float v[32];
    float ss = 0.f;
#pragma unroll
    for (int i = 0; i < 4; ++i) {
      const int col = lane * 8 + 512 * i;
      const int head = col >> 6;
      const float dtot = p.ssd_d[head] + p.ssd_d[32 + head];
      uint4 a = *(const uint4*)(YF + tiled(tok, col, 32));
      uint4 b = *(const uint4*)(YB + tiled(tok, col, 32));
      uint4 x = *(const uint4*)(BIG + (size_t)tok * 6144 + 2048 + col);
      uint4 z = *(const uint4*)(BIG + (size_t)tok * 6144 + col);
#pragma unroll
      for (int q = 0; q < 4; ++q) {
        const unsigned aq = u4get(a, q), bq = u4get(b, q), xq = u4get(x, q), zq = u4get(z, q);
        float y0 = lo2f(aq) + lo2f(bq) + dtot * lo2f(xq);
        float y1 = hi2f(aq) + hi2f(bq) + dtot * hi2f(xq);
        y0 *= siluf(lo2f(zq));
        y1 *= siluf(hi2f(zq));
        v[8 * i + 2 * q] = y0; v[8 * i + 2 * q + 1] = y1;
        ss += y0 * y0 + y1 * y1;
      }
      __builtin_amdgcn_sched_barrier(0);
    }
    ss = wave_sum(ss);
    const float sc = rsqrtf(ss * (1.f / 2048.f) + 1e-6f);
#pragma unroll
    for (int i = 0; i < 4; ++i) {
      const int col = lane * 8 + 512 * i;
      float4 g0 = *(const float4*)(p.ssd_norm_g + col), g1 = *(const float4*)(p.ssd_norm_g + col + 4);
      uint4 o;
      o.x = pack2(v[8 * i] * sc * g0.x, v[8 * i + 1] * sc * g0.y);
      o.y = pack2(v[8 * i + 2] * sc * g0.z, v[8 * i + 3] * sc * g0.w);
      o.z = pack2(v[8 * i + 4] * sc * g1.x, v[8 * i + 5] * sc * g1.y);
      o.w = pack2(v[8 * i + 6] * sc * g1.z, v[8 * i + 7] * sc * g1.w);
      *(uint4*)(YF + tiled(tok, col, 32)) = o;
    }
  }
}

__device__ __forceinline__ void final_norm_phase(const Params& p) {
  const int otid = opaque_tid();
  const int lane = otid & 63, w = otid >> 6;
  for (int tok = blockIdx.x * 4 + w; tok < NT; tok += gridDim.x * 4) {
    float* xr = p.out + (size_t)tok * 1024;
    float4 v[4];
    float ss = 0.f;
#pragma unroll
    for (int i = 0; i < 4; ++i) {
      v[i] = *(const float4*)(xr + lane * 4 + 256 * i);
      ss += v[i].x * v[i].x + v[i].y * v[i].y + v[i].z * v[i].z + v[i].w * v[i].w;
    }
    ss = wave_sum(ss);
    const float sc = rsqrtf(ss * (1.f / 1024.f) + 1e-6f);
#pragma unroll
    for (int i = 0; i < 4; ++i) {
      const int col = lane * 4 + 256 * i;
      float4 gg = *(const float4*)(p.norm_f_g + col);
      *(float4*)(xr + col) = make_float4(v[i].x * sc * gg.x, v[i].y * sc * gg.y, v[i].z * sc * gg.z, v[i].w * sc * gg.w);
    }
  }
}


#define XB_TMO      128
#define XB_XCNT(j)  (256  + 64 * (j))
#define XB_XSUB(j)  (1280 + 64 * (j))
#define XB_XGEN(j)  (2304 + 64 * (j))
#define XB_TOP      3328
#define XB_TOPGEN   3392
#define XCD_BAR_WORDS 3456
#define XB_SPIN_CAP (1u << 22)
#define LAS __attribute__((address_space(3)))
__device__ __forceinline__ unsigned xb_ld(unsigned* p) { return __hip_atomic_load(p, __ATOMIC_RELAXED, __HIP_MEMORY_SCOPE_AGENT); }
__device__ __forceinline__ unsigned xb_add(unsigned* p, unsigned v) { return __hip_atomic_fetch_add(p, v, __ATOMIC_RELAXED, __HIP_MEMORY_SCOPE_AGENT); }
__device__ __forceinline__ unsigned xb_xcc_id() { return (unsigned)__builtin_amdgcn_s_getreg((3 << 11) | 20) & 0xFu; }
#define XB_SPIN(cond, bar) do { unsigned _sp = 0; while (cond) { __builtin_amdgcn_s_sleep(1); \
    if ((++_sp & 255u) == 0u) { if (xb_ld(&(bar)[XB_TMO])) break; if (_sp > XB_SPIN_CAP) { atomicAdd(&(bar)[XB_TMO], 1u); break; } } } } while (0)
struct XcdBarrier { unsigned* bar; unsigned x; volatile LAS unsigned* st; };
__device__ __forceinline__ XcdBarrier xcd_barrier_post(unsigned* bar, volatile LAS unsigned* st) {
  XcdBarrier b; b.bar = bar; b.x = xb_xcc_id(); b.st = st;
  if (threadIdx.x == 0) (void)xb_add(&bar[XB_XCNT(b.x)], 1u);
  return b;
}
__device__ __forceinline__ void xcd_barrier_complete(unsigned* bar, unsigned x, unsigned& nloc, unsigned& nx) {
  const unsigned G = gridDim.x * gridDim.y * gridDim.z;
  unsigned sum, cnt, mine, sp = 0u;
  for (;;) {
    sum = 0u; cnt = 0u; mine = 0u;
#pragma unroll
    for (unsigned j = 0; j < 16; ++j) { const unsigned c = xb_ld(&bar[XB_XCNT(j)]); sum += c; cnt += (c > 0u) ? 1u : 0u; mine = (j == x) ? c : mine; }
    if (sum == G) break;
    __builtin_amdgcn_s_sleep(1);
    if ((++sp & 255u) == 0u) { if (xb_ld(&bar[XB_TMO])) break; if (sp > XB_SPIN_CAP) { atomicAdd(&bar[XB_TMO], 1u); break; } }
  }
  nloc = mine > 0u ? mine : 1u; nx = cnt > 0u ? cnt : 1u;
}
__device__ __forceinline__ void xcd_barrier(const XcdBarrier& b) {
  asm volatile("s_waitcnt vmcnt(0)" ::: "memory");
  __syncthreads();
  if (threadIdx.x == 0) {
    unsigned* bar = b.bar;
    __builtin_amdgcn_s_waitcnt(0);
    unsigned nloc = b.st[0], nx = b.st[1];
    if (nloc == 0u) { xcd_barrier_complete(bar, b.x, nloc, nx); b.st[0] = nloc; b.st[1] = nx; }
    const unsigned old = xb_add(&bar[XB_XSUB(b.x)], 1u);
    const unsigned gen = old / nloc;
    if (old + 1u == (gen + 1u) * nloc) {
      __builtin_amdgcn_fence(__ATOMIC_RELEASE, "agent");
      asm volatile("s_waitcnt vmcnt(0)" ::: "memory");
      const unsigned og = xb_add(&bar[XB_TOP], 1u);
      const unsigned tg = og / nx;
      if (og + 1u == (tg + 1u) * nx) xb_add(&bar[XB_TOPGEN], 1u);
      else XB_SPIN(xb_ld(&bar[XB_TOPGEN]) == tg, bar);
      __builtin_amdgcn_fence(__ATOMIC_ACQUIRE, "agent");
      xb_add(&bar[XB_XGEN(b.x)], 1u);
      asm volatile("s_waitcnt vmcnt(0)" ::: "memory");
    } else {
      XB_SPIN(xb_ld(&bar[XB_XGEN(b.x)]) == gen, bar);
      __builtin_amdgcn_fence(__ATOMIC_ACQUIRE, "agent");
      asm volatile("s_waitcnt vmcnt(0)" ::: "memory");
    }
  }
  __syncthreads();
}

#define N_PHASES 19
__global__ void __launch_bounds__(256, 2) mk(Params p, int ph_begin, int ph_end) {
  __shared__ __attribute__((aligned(16))) char smem[SMEM_BYTES];
  __shared__ uint4 xb_words;
  const bool multi = (ph_end - ph_begin) > 1;
  if (threadIdx.x == 0) xb_words = make_uint4(0u, 0u, 0u, 0u);
  __syncthreads();
  XcdBarrier xb;
  xb.bar = (unsigned*)(p.ws + OFF_BAR); xb.x = 0; xb.st = (volatile LAS unsigned*)&xb_words;
  if (multi) xb = xcd_barrier_post((unsigned*)(p.ws + OFF_BAR), (volatile LAS unsigned*)&xb_words);
  bf16_t* WT = (bf16_t*)(p.ws + OFF_WT);
  bf16_t* BIG = (bf16_t*)(p.ws + OFF_BIG);
  bf16_t* Abuf = (bf16_t*)(p.ws + OFF_YF);
  float* MOD = (float*)(p.ws + OFF_MOD);
#define RUN(PH, CALL) if (ph_begin <= PH && PH < ph_end) { CALL; if (PH + 1 < ph_end) { if (PH == 0) cg::this_grid().sync(); else xcd_barrier(xb); } }
  RUN(0, prep_phase(p, smem))
  RUN(1, norm_mod_phase(p, 0, 0, true))
  RUN(2, gemm_phase(Abuf, WT + WT_SCIN, NT, 3072, 1024, EpiBf16{BIG, 3072}, smem))
  RUN(3, conv_gate_phase(p))
  RUN(4, gemm_phase((const bf16_t*)(p.ws + OFF_BIG + 120 * MIB), WT + WT_SCOUT, NT, 1024, 1024,
                    EpiRes{p.x_prompt, p.x_sample, p.out, MOD + 0 * 5 * 6144 + 2 * 1024}, smem))
  RUN(5, norm_mod_phase(p, 0, 1, false))
  RUN(6, gemm_phase(Abuf, WT + WT_WQ, NT, 2048, 1024, EpiBf16{BIG, 2048}, smem))
  RUN(7, topk_phase(p, 0, smem))
  RUN(8, peer_phase(p, 0, smem))
  RUN(10, gemm_phase(Abuf, WT + WT_SSDIN, NT, 6208, 1024, EpiSsdIn{BIG, (float*)(p.ws + OFF_DT), p.ssd_dt_bias}, smem))
  RUN(11, ssd_conv_phase(p))
  RUN(12, scan_phase(p, smem))
  RUN(13, gate_norm_phase(p))
  RUN(14, gemm_phase(Abuf, WT + WT_SSDOUT, NT, 1024, 2048,
                     EpiRes{p.out, p.out + (size_t)NCTX * 1024, p.out, MOD + 1 * 5 * 6144 + 2 * 1024}, smem))
  RUN(15, norm_mod_phase(p, 1, 1, false))
  RUN(16, gemm_phase(Abuf, WT + WT_WQ + (size_t)2048 * 1024, NT, 2048, 1024, EpiBf16{BIG, 2048}, smem))
  RUN(17, topk_phase(p, 1, smem))
  RUN(18, peer_phase(p, 1, smem))
}

extern "C" void kernel_launch(void* const* d_in, const int* in_sizes, int n_in, void* d_out, int out_size, void* d_ws, size_t ws_size,
                              hipStream_t stream) {
  static int grid_blocks = 0;
  if (!grid_blocks) {
    int dev = 0, cus = 0, per_cu = 0;
    hipGetDevice(&dev);
    hipDeviceGetAttribute(&cus, hipDeviceAttributeMultiprocessorCount, dev);
    hipOccupancyMaxActiveBlocksPerMultiprocessor(&per_cu, mk, 256, 0);
    if (per_cu < 1) per_cu = 1;
    if (per_cu > 2) per_cu = 2;
    grid_blocks = cus * per_cu;
  }
  if (ws_size < WS_NEEDED) { fprintf(stderr, "workspace too small: %zu\n", ws_size); return; }
  Params p{};
  const float** pf = (const float**)&p;
  for (int i = 0; i < 25; ++i) pf[i] = (const float*)d_in[i];
  p.out = (float*)d_out;
  p.ws = (char*)d_ws;
#if COOP
  hipMemsetAsync((char*)d_ws + OFF_BAR, 0, 16384, stream);
  int b = 0, e = N_PHASES;
  void* args[] = {&p, &b, &e};
  hipError_t err = hipLaunchCooperativeKernel((void*)mk, dim3(grid_blocks), dim3(256), args, 0, stream);
  if (err != hipSuccess) fprintf(stderr, "cooperative launch failed: %s (grid %d)\n", hipGetErrorString(err), grid_blocks);
#else
  for (int ph = 0; ph < N_PHASES; ++ph) {
    hipLaunchKernelGGL(mk, dim3(grid_blocks), dim3(256), 0, stream, p, ph, ph + 1);
    if ((DUP_MASK >> ph) & 1) hipLaunchKernelGGL(mk, dim3(grid_blocks), dim3(256), 0, stream, p, ph, ph + 1);
  }
#endif
}
```

```cpp
#include <hip/hip_runtime.h>
#include <hip/hip_cooperative_groups.h>
#include <cstdio>
namespace cg = cooperative_groups;

#ifndef COOP
#define COOP 1
#endif
#ifndef DUP_MASK
#define DUP_MASK 0
#endif

typedef unsigned short bf16_t;
typedef __attribute__((ext_vector_type(8))) short bf16x8;
typedef __attribute__((ext_vector_type(16))) float f32x16;
typedef __attribute__((ext_vector_type(32))) float f32x32;
typedef __attribute__((ext_vector_type(6))) unsigned u32x6;

#define NT 20480
#define NCTX 4096
#define DM 1024
#define MIB ((size_t)1 << 20)
#define OFF_BIG   ((size_t)0)
#define OFF_YF    (240 * MIB)
#define OFF_YB    (320 * MIB)
#define OFF_WT    (400 * MIB)
#define OFF_KEYSB (433 * MIB)
#define OFF_DT    (434 * MIB)
#define OFF_MOD   (439 * MIB)
#define OFF_IDX   (440 * MIB)
#define OFF_GATE  (450 * MIB)
#define OFF_TAB1  (460 * MIB)
#define OFF_SCALE (492 * MIB)
#define OFF_BAR   (493 * MIB)
#define WS_NEEDED (494 * MIB)
#define WT_SCIN   ((size_t)0)
#define WT_SCOUT  (WT_SCIN + (size_t)3072 * 1024)
#define WT_SSDIN  (WT_SCOUT + (size_t)1024 * 1024)
#define WT_SSDOUT (WT_SSDIN + (size_t)6272 * 1024)
#define WT_WQ     (WT_SSDOUT + (size_t)1024 * 2048)

#define SMEM_BYTES 75776

struct Params {
  const float *x_prompt, *x_sample, *state_ssm, *c, *c_ctx, *norm_mix_g, *norm_ffn_g, *norm_f_g, *ada_w, *ada_b;
  const float *sc_w_in, *sc_conv_w, *sc_w_out, *ssd_w_in, *ssd_conv_w, *ssd_conv_b, *ssd_dt_bias, *ssd_a_log, *ssd_d;
  const float *ssd_norm_g, *ssd_w_out, *peer_wq, *peer_keys, *peer_u, *peer_v;
  float* out;
  char* ws;
};

__device__ __forceinline__ float bf2f(bf16_t h) { return __uint_as_float(((unsigned)h) << 16); }
__device__ __forceinline__ bf16_t f2bf(float f) {
  unsigned u = __float_as_uint(f);
  u += 0x7FFFu + ((u >> 16) & 1u);
  return (bf16_t)(u >> 16);
}
__device__ __forceinline__ unsigned pack2(float a, float b) { return (unsigned)f2bf(a) | ((unsigned)f2bf(b) << 16); }
__device__ __forceinline__ float lo2f(unsigned u) { return __uint_as_float(u << 16); }
__device__ __forceinline__ float hi2f(unsigned u) { return __uint_as_float(u & 0xffff0000u); }
__device__ __forceinline__ unsigned u4get(const uint4 v, const int q) { return q == 0 ? v.x : (q == 1 ? v.y : (q == 2 ? v.z : v.w)); }
__device__ __forceinline__ int opaque_tid() { int t = threadIdx.x; asm volatile("" : "+v"(t)); return t; }
__device__ __forceinline__ size_t tiled(int row, int col, int KT) { return ((size_t)(row >> 7) * KT + (col >> 6)) * 8192 + (row & 127) * 64 + (col & 63); }
__device__ __forceinline__ float siluf(float x) { return x / (1.f + __expf(-x)); }
__device__ __forceinline__ int cidx(int tok) { return tok < NCTX ? 0 : 1 + ((tok - NCTX) >> 12); }

template <int CTRL>
__device__ __forceinline__ unsigned dpp_u(unsigned v) {
  return (unsigned)__builtin_amdgcn_update_dpp(0, (int)v, CTRL, 0xF, 0xF, true);
}
template <int CTRL>
__device__ __forceinline__ float dpp_f(float v) {
  return __int_as_float(__builtin_amdgcn_update_dpp(0, __float_as_int(v), CTRL, 0xF, 0xF, true));
}
__device__ __forceinline__ float row16_sum(float v) {
  v += dpp_f<0xB1>(v);
  v += dpp_f<0x4E>(v);
  v += dpp_f<0x141>(v);
  v += dpp_f<0x140>(v);
  return v;
}
__device__ __forceinline__ unsigned umax_(unsigned a, unsigned b) { return a > b ? a : b; }
__device__ __forceinline__ unsigned row_max_u32(unsigned v) {
  v = umax_(v, dpp_u<0xB1>(v));
  v = umax_(v, dpp_u<0x4E>(v));
  v = umax_(v, dpp_u<0x141>(v));
  v = umax_(v, dpp_u<0x140>(v));
  return v;
}
__device__ __forceinline__ unsigned wave_max_u32(unsigned v) {
  v = umax_(v, dpp_u<0xB1>(v));
  v = umax_(v, dpp_u<0x4E>(v));
  v = umax_(v, dpp_u<0x141>(v));
  v = umax_(v, dpp_u<0x140>(v));
  unsigned a = (unsigned)__builtin_amdgcn_readlane((int)v, 0);
  unsigned b = (unsigned)__builtin_amdgcn_readlane((int)v, 16);
  unsigned c = (unsigned)__builtin_amdgcn_readlane((int)v, 32);
  unsigned d = (unsigned)__builtin_amdgcn_readlane((int)v, 48);
  return umax_(umax_(a, b), umax_(c, d));
}
__device__ __forceinline__ float wave_sum(float v) {
  v = row16_sum(v);
  float a, b, c, d;
  a = __int_as_float(__builtin_amdgcn_readlane(__float_as_int(v), 0));
  b = __int_as_float(__builtin_amdgcn_readlane(__float_as_int(v), 16));
  c = __int_as_float(__builtin_amdgcn_readlane(__float_as_int(v), 32));
  d = __int_as_float(__builtin_amdgcn_readlane(__float_as_int(v), 48));
  return (a + b) + (c + d);
}
__device__ __forceinline__ unsigned fkey(float f) {
  unsigned u = __float_as_uint(f);
  return (u & 0x80000000u) ? ~u : (u | 0x80000000u);
}
__device__ __forceinline__ float keyf(unsigned k) {
  unsigned u = (k & 0x80000000u) ? (k & 0x7fffffffu) : ~k;
  return __uint_as_float(u);
}

__device__ __forceinline__ void transpose_tile(const float* __restrict__ src, int K, int N, bf16_t* __restrict__ dst, int tile, float* tb) {
  const int tid = threadIdx.x;
  const int ntn = N >> 6;
  const int kt = tile / ntn, nt = tile % ntn;
  {
    const int n = tid & 63, kb = tid >> 6;
#pragma unroll
    for (int i = 0; i < 16; ++i) {
      int k = kb + 4 * i;
      tb[k * 65 + n] = src[(size_t)(kt * 64 + k) * N + nt * 64 + n];
    }
  }
  __syncthreads();
  {
    const int k8 = (tid & 7) * 8;
#pragma unroll
    for (int pass = 0; pass < 2; ++pass) {
      int n = (tid >> 3) + 32 * pass;
      uint4 o;
      o.x = pack2(tb[(k8 + 0) * 65 + n], tb[(k8 + 1) * 65 + n]);
      o.y = pack2(tb[(k8 + 2) * 65 + n], tb[(k8 + 3) * 65 + n]);
      o.z = pack2(tb[(k8 + 4) * 65 + n], tb[(k8 + 5) * 65 + n]);
      o.w = pack2(tb[(k8 + 6) * 65 + n], tb[(k8 + 7) * 65 + n]);
      *(uint4*)(dst + tiled(nt * 64 + n, kt * 64 + k8, K >> 6)) = o;
    }
  }
  __syncthreads();
}

__device__ __forceinline__ void prep_phase(const Params& p, char* smem) {
  const int otid = opaque_tid();
  const int tid = otid;
  bf16_t* WT = (bf16_t*)(p.ws + OFF_WT);
  float* MOD = (float*)(p.ws + OFF_MOD);
  bf16_t* KEYSB = (bf16_t*)(p.ws + OFF_KEYSB);
  const int U_MOD = 192, U_T0 = 768, U_T1 = 256, U_T2 = 1552, U_T3 = 512, U_T4 = 1024, U_KEYS = 256, U_TAB = 8192;
  const int total = U_MOD + U_T0 + U_T1 + U_T2 + U_T3 + U_T4 + U_KEYS + U_TAB;
  for (int u = blockIdx.x; u < total; u += gridDim.x) {
    int v = u;
    if (v < U_MOD) {
      float* scond = (float*)smem;
      float* red = scond + 5 * 1024;
      for (int i = tid; i < 5 * 1024; i += 256) {
        int r = i >> 10, k = i & 1023;
        float cv = (r == 0) ? p.c_ctx[k] : p.c[(r - 1) * 1024 + k];
        scond[i] = siluf(cv);
      }
      __syncthreads();
      const int l = v / 96, jc = v % 96;
      const int jj = tid & 63, kq = tid >> 6;
      const int j = jc * 64 + jj;
      float acc[5] = {0.f, 0.f, 0.f, 0.f, 0.f};
      const float* wp = p.ada_w + ((size_t)l * 1024 + kq * 256) * 6144 + j;
#pragma unroll 8
      for (int k = 0; k < 256; ++k) {
        float wv = wp[(size_t)k * 6144];
#pragma unroll
        for (int r = 0; r < 5; ++r) acc[r] += scond[r * 1024 + kq * 256 + k] * wv;
      }
#pragma unroll
      for (int r = 0; r < 5; ++r) red[(kq * 5 + r) * 64 + jj] = acc[r];
      __syncthreads();
      for (int i = tid; i < 320; i += 256) {
        int r = i >> 6, j2 = i & 63;
        float s = red[(0 * 5 + r) * 64 + j2] + red[(1 * 5 + r) * 64 + j2] + red[(2 * 5 + r) * 64 + j2] + red[(3 * 5 + r) * 64 + j2];
        MOD[(size_t)(l * 5 + r) * 6144 + jc * 64 + j2] = s + p.ada_b[l * 6144 + jc * 64 + j2];
      }
      __syncthreads();
      continue;
    }
    v -= U_MOD;
    float* tb = (float*)smem;
    if (v < U_T0) { transpose_tile(p.sc_w_in, 1024, 3072, WT + WT_SCIN, v, tb); continue; }
    v -= U_T0;
    if (v < U_T1) { transpose_tile(p.sc_w_out, 1024, 1024, WT + WT_SCOUT, v, tb); continue; }
    v -= U_T1;
    if (v < U_T2) { transpose_tile(p.ssd_w_in, 1024, 6208, WT + WT_SSDIN, v, tb); continue; }
    v -= U_T2;
    if (v < U_T3) { transpose_tile(p.ssd_w_out, 2048, 1024, WT + WT_SSDOUT, v, tb); continue; }
    v -= U_T3;
    if (v < U_T4) {
      int l = v >> 9, t = v & 511;
      transpose_tile(p.peer_wq + (size_t)l * 1024 * 2048, 1024, 2048, WT + WT_WQ + (size_t)l * 2048 * 1024, t, tb);
      continue;
    }
    v -= U_T4;
    if (v < U_KEYS) {
      size_t base = (size_t)v * 2048 + tid * 8;
      float4 a = *(const float4*)(p.peer_keys + base);
      float4 b = *(const float4*)(p.peer_keys + base + 4);
      uint4 o;
      o.x = pack2(a.x, a.y); o.y = pack2(a.z, a.w); o.z = pack2(b.x, b.y); o.w = pack2(b.z, b.w);
      *(uint4*)(KEYSB + base) = o;
      continue;
    }
    v -= U_KEYS;
    {
      const int lane = tid & 63, l31 = lane & 31;
      const int gr = v * 8 + (tid >> 6) * 2 + (lane >> 5);
      const int l = gr >> 15, tab = (gr >> 14) & 1, row = gr & 16383;
      const float* src = (tab ? p.peer_v : p.peer_u) + ((size_t)l * 16384 + row) * 1024 + l31 * 32;
      float4 x[8];
      float am = 0.f;
#pragma unroll
      for (int j = 0; j < 8; ++j) {
        x[j] = *(const float4*)(src + 4 * j);
        am = fmaxf(am, fmaxf(fmaxf(fabsf(x[j].x), fabsf(x[j].y)), fmaxf(fabsf(x[j].z), fabsf(x[j].w))));
      }
      {
        unsigned au = row_max_u32(__float_as_uint(am));
        const unsigned ao = (unsigned)__shfl_xor((int)au, 16);
        am = __uint_as_float(umax_(au, ao));
      }
      const float inv = am > 0.f ? 7.0f / am : 0.f;
      const float scale = am > 0.f ? am / 7.0f : 0.f;
      f32x16 fa, fb;
#pragma unroll
      for (int j = 0; j < 8; ++j) {
        fa[2 * j] = x[j].x * inv; fb[2 * j] = x[j].y * inv; fa[2 * j + 1] = x[j].z * inv; fb[2 * j + 1] = x[j].w * inv;
      }
      const u32x6 pk = __builtin_amdgcn_cvt_scalef32_2xpk16_fp6_f32(fa, fb, 1.0f);
      unsigned char* dst = (unsigned char*)(p.ws + (l ? OFF_TAB1 : OFF_YB)) + ((size_t)tab * 16384 + row) * 768 + l31 * 24;
      *(uint2*)(dst) = make_uint2(pk[0], pk[1]);
      *(uint2*)(dst + 8) = make_uint2(pk[2], pk[3]);
      *(uint2*)(dst + 16) = make_uint2(pk[4], pk[5]);
      if (l31 == 0) ((float*)(p.ws + OFF_SCALE))[gr] = scale;
    }
  }
}

__device__ __forceinline__ void norm_mod_phase(const Params& p, int layer, int which, bool from_input) {
  const int otid = opaque_tid();
  const float* g = (which == 0 ? p.norm_mix_g : p.norm_ffn_g) + layer * 1024;
  const float* MOD = (const float*)(p.ws + OFF_MOD);
  bf16_t* A = (bf16_t*)(p.ws + OFF_YF);
  const int lane = otid & 63, w = otid >> 6;
  for (int tok = blockIdx.x * 4 + w; tok < NT; tok += gridDim.x * 4) {
    const float* xr = from_input ? (tok < NCTX ? p.x_prompt + (size_t)tok * 1024 : p.x_sample + (size_t)(tok - NCTX) * 1024)
                                 : p.out + (size_t)tok * 1024;
    const float* md = MOD + (size_t)(layer * 5 + cidx(tok)) * 6144 + (which ? 3 * 1024 : 0);
    float4 v[4];
    float ss = 0.f;
#pragma unroll
    for (int i = 0; i < 4; ++i) {
      v[i] = *(const float4*)(xr + lane * 4 + 256 * i);
      ss += v[i].x * v[i].x + v[i].y * v[i].y + v[i].z * v[i].z + v[i].w * v[i].w;
    }
    ss = wave_sum(ss);
    const float sc = rsqrtf(ss * (1.f / 1024.f) + 1e-6f);
#pragma unroll
    for (int i = 0; i < 4; ++i) {
      const int col = lane * 4 + 256 * i;
      float4 gg = *(const float4*)(g + col);
      float4 sh = *(const float4*)(md + col);
      float4 sl = *(const float4*)(md + 1024 + col);
      float o0 = v[i].x * sc * gg.x * (1.f + sl.x) + sh.x;
      float o1 = v[i].y * sc * gg.y * (1.f + sl.y) + sh.y;
      float o2 = v[i].z * sc * gg.z * (1.f + sl.z) + sh.z;
      float o3 = v[i].w * sc * gg.w * (1.f + sl.w) + sh.w;
      uint2 o;
      o.x = pack2(o0, o1);
      o.y = pack2(o2, o3);
      *(uint2*)(A + tiled(tok, col, 16)) = o;
    }
  }
}

#define LSTR 72
template <class Epi>
__device__ __forceinline__ void gemm_phase(const bf16_t* __restrict__ A, const bf16_t* __restrict__ Bt, int M, int N, int K, Epi epi, char* smem) {
  const int otid = opaque_tid();
  bf16_t* sA = (bf16_t*)smem;
  bf16_t* sB = sA + 2 * 128 * LSTR;
  float* sC = (float*)smem;
  const int tid = otid, lane = tid & 63, w = tid >> 6;
  const int wm = w >> 1, wn = w & 1;
  const int ntn = (N + 127) >> 7, ntm = M >> 7;
  const int ntiles = ntm * ntn;
  const int KT = K >> 6;
  const int lrow = tid >> 3, lkc = (tid & 7) * 8;
  const bf16_t* apb;
  const bf16_t* bpb;
  uint4 ra0_0, ra0_1, ra0_2, ra0_3, rb0_0, rb0_1, rb0_2, rb0_3, ra1_0, ra1_1, ra1_2, ra1_3, rb1_0, rb1_1, rb1_2, rb1_3;
  const int G_ = gridDim.x;
  const int RN = (ntn % 8 == 0) ? 8 : ((ntn % 7 == 0) ? 7 : ((ntn % 6 == 0) ? 6 : ((ntn % 5 == 0) ? 5 : 4)));
  const int RM = ((G_ >> 3) / RN) > 0 ? ((G_ >> 3) / RN) : 1;
  const int nrn = (ntn + RN - 1) / RN, nrm = (ntm + RM - 1) / RM;
  const int nrects = nrn * nrm;
  const int nslots = ((nrects + 7) >> 3) * G_;
#define G_MAP(T_, VALID_, MT_, NT_) { const int i_ = (T_) / G_, b_ = (T_) - i_ * G_; const int R_ = i_ * 8 + (b_ & 7); const int s_ = b_ >> 3; \
    const int rm_ = R_ / nrn, rn_ = R_ - rm_ * nrn; const int dm_ = s_ / RN, dn_ = s_ - dm_ * RN; MT_ = rm_ * RM + dm_; NT_ = rn_ * RN + dn_; \
    VALID_ = (dm_ < RM) && (R_ < nrects) && (MT_ < ntm) && (NT_ < ntn); }
#define G_NEXT(T_, MT_, NT_) { bool ok_ = false; while ((T_) < nslots) { G_MAP(T_, ok_, MT_, NT_) if (ok_) break; (T_) += G_; } }
#define G_PTRS(MT_, NT_) { apb = A + (size_t)(MT_) * KT * 8192 + lrow * 64 + lkc; bpb = Bt + (size_t)(NT_) * KT * 8192 + lrow * 64 + lkc; }
#define G_LOAD1(S, I, KT_) { ra##S##_##I = *(const uint4*)(apb + (KT_) * 8192 + I * 2048); rb##S##_##I = *(const uint4*)(bpb + (KT_) * 8192 + I * 2048); }
#define G_LOAD(S, KT_) { G_LOAD1(S, 0, KT_) G_LOAD1(S, 1, KT_) G_LOAD1(S, 2, KT_) G_LOAD1(S, 3, KT_) }
#define G_WRITE1(S, I, BUF_) { *(uint4*)(sA + (BUF_) * 128 * LSTR + (lrow + 32 * I) * LSTR + lkc) = ra##S##_##I; *(uint4*)(sB + (BUF_) * 128 * LSTR + (lrow + 32 * I) * LSTR + lkc) = rb##S##_##I; }
#define G_WRITE(S, BUF_) { G_WRITE1(S, 0, BUF_) G_WRITE1(S, 1, BUF_) G_WRITE1(S, 2, BUF_) G_WRITE1(S, 3, BUF_) }
#define G_MMA(KK, BUF_) { \
        bf16x8 a0 = *(const bf16x8*)(cA + KK * 16); \
        bf16x8 a1 = *(const bf16x8*)(cA + 32 * LSTR + KK * 16); \
        bf16x8 b0 = *(const bf16x8*)(cB + KK * 16); \
        bf16x8 b1 = *(const bf16x8*)(cB + 32 * LSTR + KK * 16); \
        acc[0][0] = __builtin_amdgcn_mfma_f32_32x32x16_bf16(a0, b0, acc[0][0], 0, 0, 0); \
        acc[0][1] = __builtin_amdgcn_mfma_f32_32x32x16_bf16(a0, b1, acc[0][1], 0, 0, 0); \
        acc[1][0] = __builtin_amdgcn_mfma_f32_32x32x16_bf16(a1, b0, acc[1][0], 0, 0, 0); \
        acc[1][1] = __builtin_amdgcn_mfma_f32_32x32x16_bf16(a1, b1, acc[1][1], 0, 0, 0); }
#define G_COMPUTE(BUF_) { \
      const bf16_t* cA = sA + (BUF_) * 128 * LSTR + (wm * 64 + (lane & 31)) * LSTR + (lane >> 5) * 8; \
      const bf16_t* cB = sB + (BUF_) * 128 * LSTR + (wn * 64 + (lane & 31)) * LSTR + (lane >> 5) * 8; \
      G_MMA(0, BUF_) G_MMA(1, BUF_) G_MMA(2, BUF_) G_MMA(3, BUF_) }
  int tile = blockIdx.x, mt = 0, nt = 0;
  G_NEXT(tile, mt, nt)
  if (tile < nslots) { G_PTRS(mt, nt) G_LOAD(0, 0) G_LOAD(1, 1) }
  while (tile < nslots) {
    const int m0 = mt << 7, n0 = nt << 7;
    f32x16 acc[2][2];
#pragma unroll
    for (int i = 0; i < 2; ++i)
#pragma unroll
      for (int j = 0; j < 2; ++j)
#pragma unroll
        for (int r = 0; r < 16; ++r) acc[i][j][r] = 0.f;
    G_WRITE(0, 0)
    __syncthreads();
    for (int kt = 0; kt < KT; kt += 2) {
      if (kt + 2 < KT) G_LOAD(0, kt + 2)
      G_COMPUTE(0)
      G_WRITE(1, 1)
      __syncthreads();
      if (kt + 3 < KT) G_LOAD(1, kt + 3)
      G_COMPUTE(1)
      if (kt + 2 < KT) G_WRITE(0, 0)
      __syncthreads();
    }
    int next = tile + G_;
    G_NEXT(next, mt, nt)
    if (next < nslots) { G_PTRS(mt, nt) G_LOAD(0, 0) G_LOAD(1, 1) }
#pragma unroll
    for (int mi = 0; mi < 2; ++mi)
#pragma unroll
      for (int ni = 0; ni < 2; ++ni) {
        float* cw = sC + (wm * 64 + mi * 32 + 4 * (lane >> 5)) * 132 + wn * 64 + ni * 32 + (lane & 31);
#pragma unroll
        for (int r = 0; r < 16; ++r) cw[((r & 3) + 8 * (r >> 2)) * 132] = acc[mi][ni][r];
      }
    __syncthreads();
#pragma unroll 4
    for (int i = 0; i < 16; ++i) {
      const int ch = tid + 256 * i;
      const int row = ch >> 5, c4 = (ch & 31) * 4;
      const float4 v = *(const float4*)(sC + row * 132 + c4);
      if (n0 + c4 < N) epi(m0 + row, n0 + c4, v);
    }
    __syncthreads();
    tile = next;
  }
}

struct EpiBf16 {
  bf16_t* C; int ldc;
  __device__ __forceinline__ void operator()(int m, int n, float4 v) const {
    uint2 o; o.x = pack2(v.x, v.y); o.y = pack2(v.z, v.w);
    *(uint2*)(C + (size_t)m * ldc + n) = o;
  }
};
__device__ __forceinline__ float softplusf(float x) { return x > 20.f ? x : log1pf(expf(x)); }
struct EpiSsdIn {
  bf16_t* C; float* DT; const float* dt_bias;
  __device__ __forceinline__ void operator()(int m, int n, float4 v) const {
    if (n < 6144) {
      uint2 o; o.x = pack2(v.x, v.y); o.y = pack2(v.z, v.w);
      *(uint2*)(C + (size_t)m * 6144 + n) = o;
    } else {
      const int c = n - 6144;
      const float4 bb = *(const float4*)(dt_bias + c);
      *(float4*)(DT + (size_t)m * 64 + c) = make_float4(softplusf(v.x + bb.x), softplusf(v.y + bb.y), softplusf(v.z + bb.z), softplusf(v.w + bb.w));
    }
  }
};
struct EpiRes {
  const float* xin_ctx; const float* xin_lat; float* X; const float* gate;
  __device__ __forceinline__ void operator()(int m, int n, float4 v) const {
    const float* xr = m < NCTX ? xin_ctx + (size_t)m * 1024 : xin_lat + (size_t)(m - NCTX) * 1024;
    const float4 xv = *(const float4*)(xr + n);
    const float4 gt = *(const float4*)(gate + (size_t)cidx(m) * 6144 + n);
    *(float4*)(X + (size_t)m * 1024 + n) = make_float4(xv.x + gt.x * v.x, xv.y + gt.y * v.y, xv.z + gt.z * v.z, xv.w + gt.w * v.w);
  }
};

__device__ __forceinline__ void conv_gate_phase(const Params& p) {
  const int otid = opaque_tid();
  const bf16_t* P = (const bf16_t*)(p.ws + OFF_BIG);
  bf16_t* G = (bf16_t*)(p.ws + OFF_BIG + 120 * MIB);
  const float* cw = p.sc_conv_w;
  const int total = NT * 128;
  for (int it = blockIdx.x * 256 + otid; it < total; it += gridDim.x * 256) {
    const int tok = it >> 7, c = (it & 127) * 8;
    const int rowlen = tok < NCTX ? 256 : 64;
    const int pos = tok & (rowlen - 1);
    const bf16_t* pr = P + (size_t)tok * 3072;
    uint4 bg = *(const uint4*)(pr + c);
    uint4 cg = *(const uint4*)(pr + 1024 + c);
    uint4 xv = *(const uint4*)(pr + 2048 + c);
    uint4 cgl = make_uint4(0, 0, 0, 0), xvl = cgl, cgr = cgl, xvr = cgl;
    if (pos > 0) { cgl = *(const uint4*)(pr - 3072 + 1024 + c); xvl = *(const uint4*)(pr - 3072 + 2048 + c); }
    if (pos < rowlen - 1) { cgr = *(const uint4*)(pr + 3072 + 1024 + c); xvr = *(const uint4*)(pr + 3072 + 2048 + c); }
    const unsigned* bgp = (const unsigned*)&bg; const unsigned* cgp = (const unsigned*)&cg; const unsigned* xvp = (const unsigned*)&xv;
    const unsigned* cglp = (const unsigned*)&cgl; const unsigned* xvlp = (const unsigned*)&xvl;
    const unsigned* cgrp = (const unsigned*)&cgr; const unsigned* xvrp = (const unsigned*)&xvr;
    float4 w0a = *(const float4*)(cw + c), w0b = *(const float4*)(cw + c + 4);
    float4 w1a = *(const float4*)(cw + 1024 + c), w1b = *(const float4*)(cw + 1024 + c + 4);
    float4 w2a = *(const float4*)(cw + 2048 + c), w2b = *(const float4*)(cw + 2048 + c + 4);
    const float w0[8] = {w0a.x, w0a.y, w0a.z, w0a.w, w0b.x, w0b.y, w0b.z, w0b.w};
    const float w1[8] = {w1a.x, w1a.y, w1a.z, w1a.w, w1b.x, w1b.y, w1b.z, w1b.w};
    const float w2[8] = {w2a.x, w2a.y, w2a.z, w2a.w, w2b.x, w2b.y, w2b.z, w2b.w};
    unsigned o[4];
#pragma unroll
    for (int q = 0; q < 4; ++q) {
      float r0 = lo2f(bgp[q]) * (w0[2 * q] * lo2f(cglp[q]) * lo2f(xvlp[q]) + w1[2 * q] * lo2f(cgp[q]) * lo2f(xvp[q]) + w2[2 * q] * lo2f(cgrp[q]) * lo2f(xvrp[q]));
      float r1 = hi2f(bgp[q]) * (w0[2 * q + 1] * hi2f(cglp[q]) * hi2f(xvlp[q]) + w1[2 * q + 1] * hi2f(cgp[q]) * hi2f(xvp[q]) + w2[2 * q + 1] * hi2f(cgrp[q]) * hi2f(xvrp[q]));
      o[q] = pack2(r0, r1);
    }
    *(uint4*)(G + tiled(tok, c, 16)) = make_uint4(o[0], o[1], o[2], o[3]);
  }
}

#define SSTR 272
#define CE2_(K, a, b) { unsigned hi_ = umax_(K[a], K[b]); unsigned lo_ = K[a] < K[b] ? K[a] : K[b]; K[a] = hi_; K[b] = lo_; }
#define SORT8_(K) CE2_(K, 0, 1) CE2_(K, 2, 3) CE2_(K, 4, 5) CE2_(K, 6, 7) CE2_(K, 0, 2) CE2_(K, 1, 3) CE2_(K, 4, 6) CE2_(K, 5, 7) \
  CE2_(K, 1, 2) CE2_(K, 5, 6) CE2_(K, 0, 4) CE2_(K, 1, 5) CE2_(K, 2, 6) CE2_(K, 3, 7) CE2_(K, 2, 4) CE2_(K, 3, 5) CE2_(K, 1, 2) CE2_(K, 3, 4) CE2_(K, 5, 6)
__device__ __forceinline__ void top16_row2(const float* Sr, int j, unsigned& res1, unsigned& res2) {
  unsigned ka[8], kb[8];
#pragma unroll
  for (int m = 0; m < 8; ++m) {
    ka[m] = (fkey(Sr[j + 16 * m]) & ~0x7Fu) | (unsigned)(127 - (j + 16 * m));
    kb[m] = (fkey(Sr[128 + j + 16 * m]) & ~0x7Fu) | (unsigned)(127 - (j + 16 * m));
  }
  SORT8_(ka)
  SORT8_(kb)
  unsigned r1 = 0, r2 = 0;
#pragma unroll 2
  for (int it = 0; it < 16; ++it) {
    const unsigned wa = row_max_u32(ka[0]);
    const unsigned wb = row_max_u32(kb[0]);
    const bool wina = ka[0] == wa;
    const bool winb = kb[0] == wb;
#pragma unroll
    for (int m = 0; m < 7; ++m) { ka[m] = wina ? ka[m + 1] : ka[m]; kb[m] = winb ? kb[m + 1] : kb[m]; }
    ka[7] = wina ? 0u : ka[7];
    kb[7] = winb ? 0u : kb[7];
    r1 = (j == it) ? wa : r1;
    r2 = (j == it) ? wb : r2;
  }
  res1 = r1; res2 = r2;
}

__device__ __forceinline__ void topk_phase(const Params& p, int layer, char* smem) {
  const int otid = opaque_tid();
  float* S = (float*)smem;
  const bf16_t* Q = (const bf16_t*)(p.ws + OFF_BIG);
  const bf16_t* KB = (const bf16_t*)(p.ws + OFF_KEYSB) + (size_t)layer * (8 * 2 * 128 * 128);
  int* IDX = (int*)(p.ws + OFF_IDX);
  float* GATE = (float*)(p.ws + OFF_GATE);
  const int tid = otid, lane = tid & 63;
  const int w = __builtin_amdgcn_readfirstlane(tid >> 6);
  const int G = gridDim.x;
  const int per = (5120 + G - 1) / G;
  const int start = blockIdx.x * per;
  const int end = (start + per < 5120) ? start + per : 5120;
  const int pp = w >> 1, nt0 = (w & 1) * 2;
  const int j = lane & 15, rowbase = lane & 48;
  int ca[4], cb[4];
  bool cvalid3;
  ca[0] = 0; cb[0] = j;
  if (j < 8) { ca[1] = 1; cb[1] = j; } else { ca[1] = j; cb[1] = 0; }
  if (j < 5) { ca[2] = 2; cb[2] = j; } else if (j < 9) { ca[2] = 3; cb[2] = j - 5; } else if (j < 12) { ca[2] = 4; cb[2] = j - 9; }
  else if (j < 14) { ca[2] = 5; cb[2] = j - 12; } else { ca[2] = 6; cb[2] = j - 14; }
  ca[3] = 7; cb[3] = j & 1; cvalid3 = j < 2;
  int curh = -1;
  bf16x8 kf[2][8];
  for (int pr = start; pr < end; ++pr) {
    const int h = pr / 640, tile = pr % 640;
    const int t0 = tile * 32;
    if (h != curh) {
#pragma unroll
      for (int jj = 0; jj < 2; ++jj)
#pragma unroll
        for (int kk = 0; kk < 8; ++kk)
          kf[jj][kk] = *(const bf16x8*)(KB + ((size_t)((h * 2 + pp) * 128 + (nt0 + jj) * 32 + (lane & 31))) * 128 + kk * 16 + (lane >> 5) * 8);
      curh = h;
    }
    f32x16 acc[2];
#pragma unroll
    for (int jj = 0; jj < 2; ++jj)
#pragma unroll
      for (int r = 0; r < 16; ++r) acc[jj][r] = 0.f;
    const bf16_t* qp = Q + (size_t)(t0 + (lane & 31)) * 2048 + h * 256 + pp * 128 + (lane >> 5) * 8;
#pragma unroll
    for (int kk = 0; kk < 8; ++kk) {
      bf16x8 a = *(const bf16x8*)(qp + kk * 16);
      acc[0] = __builtin_amdgcn_mfma_f32_32x32x16_bf16(a, kf[0][kk], acc[0], 0, 0, 0);
      acc[1] = __builtin_amdgcn_mfma_f32_32x32x16_bf16(a, kf[1][kk], acc[1], 0, 0, 0);
    }
#pragma unroll
    for (int jj = 0; jj < 2; ++jj)
#pragma unroll
      for (int r = 0; r < 16; ++r) {
        const int tl = (r & 3) + 8 * (r >> 2) + 4 * (lane >> 5);
        S[tl * SSTR + pp * 128 + (nt0 + jj) * 32 + (lane & 31)] = acc[jj][r];
      }
    __syncthreads();
#pragma unroll 1
    for (int rnd = 0; rnd < 2; ++rnd) {
      const int tl = w * 8 + rnd * 4 + (lane >> 4);
      const float* Sr = S + tl * SSTR;
      unsigned res1, res2;
      top16_row2(Sr, j, res1, res2);
      unsigned ck[4];
#pragma unroll
      for (int sl = 0; sl < 4; ++sl) {
        const float v1 = keyf((unsigned)__shfl((int)res1, rowbase + ca[sl]) & ~0x7Fu);
        const float v2 = keyf((unsigned)__shfl((int)res2, rowbase + cb[sl]) & ~0x7Fu);
        ck[sl] = (fkey(v1 + v2) & ~0xFFu) | (unsigned)(255 - (ca[sl] * 16 + cb[sl]));
      }
      ck[3] = cvalid3 ? ck[3] : 0u;
      unsigned resc = 0;
#pragma unroll 1
      for (int it = 0; it < 16; ++it) {
        const unsigned wm = row_max_u32(umax_(umax_(ck[0], ck[1]), umax_(ck[2], ck[3])));
#pragma unroll
        for (int sl = 0; sl < 4; ++sl) ck[sl] = (ck[sl] == wm) ? 0u : ck[sl];
        resc = (j == it) ? wm : resc;
      }
      const int code = 255 - (int)(resc & 0xFFu);
      const int wa = code >> 4, wb = code & 15;
      const float val = keyf(resc & ~0xFFu);
      const unsigned r1 = (unsigned)__shfl((int)res1, rowbase + wa);
      const unsigned r2 = (unsigned)__shfl((int)res2, rowbase + wb);
      const int i1 = 127 - (int)(r1 & 0x7Fu), i2 = 127 - (int)(r2 & 0x7Fu);
      const float vmax = __shfl(val, rowbase);
      const float e = __expf(val - vmax);
      const float ssum = row16_sum(e);
      const size_t ob = ((size_t)(t0 + tl) * 8 + h) * 16 + j;
      IDX[ob] = i1 * 128 + i2;
      GATE[ob] = e / ssum;
    }
    __syncthreads();
  }
}

typedef __attribute__((ext_vector_type(2))) float f32x2;
__device__ __forceinline__ void peer_phase(const Params& p, int layer, char* smem) {
  const int otid = opaque_tid();
  float* coefs = (float*)smem;
  int* idxs = (int*)(smem + 2048);
  float* sus = (float*)(smem + 4096);
  float* gsv = (float*)(smem + 6144);
  const unsigned char* U6 = (const unsigned char*)(p.ws + (layer ? OFF_TAB1 : OFF_YB));
  const unsigned char* V6 = U6 + (size_t)16384 * 768;
  const float* SCU = (const float*)(p.ws + OFF_SCALE) + (size_t)layer * 32768;
  const float* SCV = SCU + 16384;
  const bf16_t* A = (const bf16_t*)(p.ws + OFF_YF);
  const int* IDX = (const int*)(p.ws + OFF_IDX);
  const float* GATE = (const float*)(p.ws + OFF_GATE);
  const float* MOD = (const float*)(p.ws + OFF_MOD);
  float* X = p.out;
  const int lane = otid & 63;
  const int w = __builtin_amdgcn_readfirstlane(otid >> 6);
  const int sub = lane & 15, rg = lane >> 4;
  const int half = lane >> 5, l31 = lane & 31;
  for (int tok = blockIdx.x * 4 + w; tok < NT; tok += gridDim.x * 4) {
#pragma unroll
    for (int hh = 0; hh < 2; ++hh) {
      const int kk = lane + 64 * hh;
      const int e = IDX[(size_t)tok * 128 + kk];
      const float gk = GATE[(size_t)tok * 128 + kk];
      idxs[w * 128 + kk] = e;
      sus[w * 128 + kk] = SCU[e];
      gsv[w * 128 + kk] = gk * SCV[e];
    }
    float t[64];
    {
      const uint4* ap = (const uint4*)(A + tiled(tok, 64 * sub, 16));
#pragma unroll
      for (int i = 0; i < 8; ++i) {
        const uint4 r0 = ap[i];
#pragma unroll
        for (int q = 0; q < 4; ++q) { t[8 * i + 2 * q] = lo2f(u4get(r0, q)); t[8 * i + 2 * q + 1] = hi2f(u4get(r0, q)); }
      }
    }
    float chain = 0.f;
#pragma unroll 4
    for (int it = 0; it < 32; ++it) {
      const int k = it * 4 + rg;
      const int e = idxs[w * 128 + k];
      const uint4* row = (const uint4*)(U6 + (size_t)e * 768 + sub * 48);
      const uint4 r0 = row[0], r1 = row[1], r2 = row[2];
      u32x6 g0, g1;
      g0[0] = r0.x; g0[1] = r0.y; g0[2] = r0.z; g0[3] = r0.w; g0[4] = r1.x; g0[5] = r1.y;
      g1[0] = r1.z; g1[1] = r1.w; g1[2] = r2.x; g1[3] = r2.y; g1[4] = r2.z; g1[5] = r2.w;
      float acc0 = 0.f, acc1 = 0.f;
      asm volatile("" : "+v"(g0), "+v"(chain));
      {
        const f32x32 d0 = __builtin_amdgcn_cvt_scalef32_pk32_f32_fp6(g0, 1.0f);
#pragma unroll
        for (int j = 0; j < 32; j += 2) { acc0 += d0[j] * t[j]; acc1 += d0[j + 1] * t[j + 1]; }
      }
      asm volatile("" : "+v"(g1), "+v"(acc0), "+v"(acc1));
      {
        const f32x32 d1 = __builtin_amdgcn_cvt_scalef32_pk32_f32_fp6(g1, 1.0f);
#pragma unroll
        for (int j = 0; j < 32; j += 2) { acc0 += d1[j] * t[32 + j]; acc1 += d1[j + 1] * t[32 + j + 1]; }
      }
      chain = acc0 + acc1;
      float acc = row16_sum(chain) * sus[w * 128 + k];
      const float co = 0.5f * acc * (1.f + erff(acc * 0.70710678118654752f)) * gsv[w * 128 + k];
      if (sub == 0) coefs[w * 128 + k] = co;
    }
    f32x32 ov;
#pragma unroll
    for (int i = 0; i < 32; ++i) ov[i] = 0.f;
#pragma unroll 1
    for (int k = 0; k < 128; k += 16) {
      uint2 ra[8], rb[8], rc[8]; float c[8];
#pragma unroll
      for (int j = 0; j < 8; ++j) {
        const int kk = k + 2 * j + half;
        const int e = idxs[w * 128 + kk];
        c[j] = coefs[w * 128 + kk];
        const uint2* rp = (const uint2*)(V6 + (size_t)e * 768 + l31 * 24);
        ra[j] = rp[0]; rb[j] = rp[1]; rc[j] = rp[2];
      }
#pragma unroll
      for (int j = 0; j < 8; ++j) {
        u32x6 g;
        g[0] = ra[j].x; g[1] = ra[j].y; g[2] = rb[j].x; g[3] = rb[j].y; g[4] = rc[j].x; g[5] = rc[j].y;
        asm volatile("" : "+v"(g), "+v"(ov));
        const f32x32 d = __builtin_amdgcn_cvt_scalef32_pk32_f32_fp6(g, 1.0f);
        ov += d * c[j];
      }
    }
    float o[16];
#pragma unroll
    for (int i = 0; i < 16; ++i) {
      const float lo = ov[i] + __shfl_xor(ov[i], 32);
      const float hi = ov[16 + i] + __shfl_xor(ov[16 + i], 32);
      o[i] = half ? hi : lo;
    }
    const int col0 = 32 * l31 + 16 * half;
    const float* gate = MOD + (size_t)(layer * 5 + cidx(tok)) * 6144 + 5 * 1024;
    float xr[16];
    float ss = 0.f;
#pragma unroll
    for (int i = 0; i < 4; ++i) {
      const int col = col0 + 4 * i;
      const float4 xv = *(const float4*)(X + (size_t)tok * 1024 + col);
      const float4 gt = *(const float4*)(gate + col);
      xr[4 * i] = xv.x + gt.x * o[4 * i]; xr[4 * i + 1] = xv.y + gt.y * o[4 * i + 1];
      xr[4 * i + 2] = xv.z + gt.z * o[4 * i + 2]; xr[4 * i + 3] = xv.w + gt.w * o[4 * i + 3];
      ss += xr[4 * i] * xr[4 * i] + xr[4 * i + 1] * xr[4 * i + 1] + xr[4 * i + 2] * xr[4 * i + 2] + xr[4 * i + 3] * xr[4 * i + 3];
    }
    ss = wave_sum(ss);
    const float sc = rsqrtf(ss * (1.f / 1024.f) + 1e-6f);
    if (layer == 0) {
      const float* g1 = p.norm_mix_g + 1024;
      const float* md = MOD + (size_t)(5 + cidx(tok)) * 6144;
      unsigned pk[8];
#pragma unroll
      for (int i = 0; i < 4; ++i) {
        const int col = col0 + 4 * i;
        *(float4*)(X + (size_t)tok * 1024 + col) = make_float4(xr[4 * i], xr[4 * i + 1], xr[4 * i + 2], xr[4 * i + 3]);
        const float4 gg = *(const float4*)(g1 + col);
        const float4 sh = *(const float4*)(md + col);
        const float4 sl = *(const float4*)(md + 1024 + col);
        pk[2 * i] = pack2(xr[4 * i] * sc * gg.x * (1.f + sl.x) + sh.x, xr[4 * i + 1] * sc * gg.y * (1.f + sl.y) + sh.y);
        pk[2 * i + 1] = pack2(xr[4 * i + 2] * sc * gg.z * (1.f + sl.z) + sh.z, xr[4 * i + 3] * sc * gg.w * (1.f + sl.w) + sh.w);
      }
      bf16_t* An = (bf16_t*)(p.ws + OFF_YF) + tiled(tok, col0, 16);
      *(uint4*)(An) = make_uint4(pk[0], pk[1], pk[2], pk[3]);
      *(uint4*)(An + 8) = make_uint4(pk[4], pk[5], pk[6], pk[7]);
    } else {
#pragma unroll
      for (int i = 0; i < 4; ++i) {
        const int col = col0 + 4 * i;
        const float4 gg = *(const float4*)(p.norm_f_g + col);
        *(float4*)(X + (size_t)tok * 1024 + col) = make_float4(xr[4 * i] * sc * gg.x, xr[4 * i + 1] * sc * gg.y, xr[4 * i + 2] * sc * gg.z, xr[4 * i + 3] * sc * gg.w);
      }
    }
  }
}

__device__ __forceinline__ void ssd_conv_phase(const Params& p) {
  const int otid = opaque_tid();
  bf16_t* BIG = (bf16_t*)(p.ws + OFF_BIG);
  const float* cw = p.ssd_conv_w;
  const float* cb = p.ssd_conv_b;
  const int total = 272 * 512;
  for (int it = blockIdx.x * 256 + otid; it < total; it += gridDim.x * 256) {
    const int c8 = it & 511, r = it >> 9;
    const int c = c8 * 8;
    int tok0, len;
    if (r < 16) { tok0 = r * 256; len = 256; } else { tok0 = NCTX + (r - 16) * 64; len = 64; }
    float w0[8], w1[8], w2[8], bb[8];
#pragma unroll
    for (int j = 0; j < 8; ++j) { w0[j] = cw[c + j]; w1[j] = cw[4096 + c + j]; w2[j] = cw[8192 + c + j]; bb[j] = cb[c + j]; }
    bf16_t* base = BIG + (size_t)tok0 * 6144 + 2048 + c;
    uint4 buf[8], nxt[8];
#pragma unroll
    for (int j = 0; j < 8; ++j) buf[j] = *(const uint4*)(base + (size_t)j * 6144);
    uint4 prev = make_uint4(0, 0, 0, 0);
    for (int t0 = 0; t0 < len; t0 += 8) {
      const bool more = (t0 + 8) < len;
#pragma unroll
      for (int j = 0; j < 8; ++j) nxt[j] = more ? *(const uint4*)(base + (size_t)(t0 + 8 + j) * 6144) : make_uint4(0, 0, 0, 0);
#pragma unroll
      for (int j = 0; j < 8; ++j) {
        const uint4 cur = buf[j];
        const uint4 nx = (j < 7) ? buf[j + 1] : nxt[0];
        const unsigned* pp = (const unsigned*)&prev; const unsigned* cp = (const unsigned*)&cur; const unsigned* np = (const unsigned*)&nx;
        unsigned o[4];
#pragma unroll
        for (int q = 0; q < 4; ++q) {
          float a0 = w0[2 * q] * lo2f(pp[q]) + w1[2 * q] * lo2f(cp[q]) + w2[2 * q] * lo2f(np[q]) + bb[2 * q];
          float a1 = w0[2 * q + 1] * hi2f(pp[q]) + w1[2 * q + 1] * hi2f(cp[q]) + w2[2 * q + 1] * hi2f(np[q]) + bb[2 * q + 1];
          o[q] = pack2(siluf(a0), siluf(a1));
        }
        *(uint4*)(base + (size_t)(t0 + j) * 6144) = make_uint4(o[0], o[1], o[2], o[3]);
        prev = cur;
      }
#pragma unroll
      for (int j = 0; j < 8; ++j) buf[j] = nxt[j];
    }
  }
}

#define XT_STR 72
#define HB_STR 136
__device__ __forceinline__ void scan_phase(const Params& p, char* smem) {
  const int otid = opaque_tid();
  bf16_t* XTd = (bf16_t*)smem;
  bf16_t* BTs = XTd + 64 * XT_STR;
  bf16_t* Ms = BTs + 128 * XT_STR;
  bf16_t* Hb = Ms + 64 * XT_STR;
  float* cumS = (float*)(Hb + 2 * 64 * HB_STR);
  const bf16_t* BIG = (const bf16_t*)(p.ws + OFF_BIG);
  const float* DT = (const float*)(p.ws + OFF_DT);
  const int tid = otid, lane = tid & 63;
  const int w = __builtin_amdgcn_readfirstlane(tid >> 6);
  const int h5 = lane >> 5, l31 = lane & 31;
  const int it = w >> 1, jt = w & 1, pt = w & 1, nt0 = (w >> 1) * 2;
  int item0, istride;
  if (gridDim.x >= 512) { if (blockIdx.x < 256) { item0 = blockIdx.x; istride = 1 << 28; } else { item0 = blockIdx.x; istride = gridDim.x - 256; } }
  else { item0 = blockIdx.x; istride = gridDim.x; }
  for (int item = item0; item < 1280; item += istride) {
    int b, head, dir, L, tok0;
    const bool latent = item < 256;
    if (latent) { b = item >> 6; head = (item >> 1) & 31; dir = item & 1; L = 4096; tok0 = NCTX + b * 4096; }
    else { int jj = item - 256; b = jj >> 6; head = (jj >> 1) & 31; dir = jj & 1; L = 256; tok0 = b * 256; }
    const int g = head >> 2;
    const float a = -expf(p.ssd_a_log[dir * 32 + head]);
    bf16_t* Y = (bf16_t*)(p.ws + (dir ? OFF_YB : OFF_YF));
    f32x16 st[2];
    const size_t sbase = ((size_t)((b * 2 + dir) * 32 + head)) * 8192;
    const int loff = (32 * pt + 4 * h5) * 128 + 32 * nt0 + l31;
    if (latent) {
      const float* sp = p.state_ssm + sbase + loff;
#pragma unroll
      for (int q = 0; q < 2; ++q)
#pragma unroll
        for (int r = 0; r < 16; ++r) st[q][r] = sp[((r & 3) + 8 * (r >> 2)) * 128 + 32 * q];
    } else {
#pragma unroll
      for (int q = 0; q < 2; ++q)
#pragma unroll
        for (int r = 0; r < 16; ++r) st[q][r] = 0.f;
    }
    {
      bf16_t* hb0 = Hb + (32 * pt + 4 * h5) * HB_STR + 32 * nt0 + l31;
#pragma unroll
      for (int q = 0; q < 2; ++q)
#pragma unroll
        for (int r = 0; r < 16; ++r) hb0[((r & 3) + 8 * (r >> 2)) * HB_STR + 32 * q] = f2bf(st[q][r]);
    }
    __syncthreads();
    const int nchunks = L >> 6;
    uint4 sx[2], sb[4];
    float sdt;
    {
      const int t = lane;
      const int tok = tok0 + (dir ? L - 1 - t : t);
      const bf16_t* rowp = BIG + (size_t)tok * 6144;
#pragma unroll
      for (int r = 0; r < 2; ++r) sx[r] = *(const uint4*)(rowp + 2048 + head * 64 + (w + 4 * r) * 8);
#pragma unroll
      for (int r = 0; r < 4; ++r) sb[r] = *(const uint4*)(rowp + 4096 + g * 128 + (w + 4 * r) * 8);
      sdt = DT[(size_t)tok * 64 + dir * 32 + head];
    }
#pragma nounroll
    for (int c = 0; c < nchunks; ++c) {
      const int cur = c & 1;
      bf16x8 cfr[8], bfr[8];
      {
        const int t = c * 64 + 32 * it + l31;
        const int tok = tok0 + (dir ? L - 1 - t : t);
        const bf16_t* cp = BIG + (size_t)tok * 6144 + 5120 + g * 128 + 8 * h5;
#pragma unroll
        for (int kk = 0; kk < 8; ++kk) cfr[kk] = *(const bf16x8*)(cp + 16 * kk);
      }
      if (jt <= it) {
        const int t = c * 64 + 32 * jt + l31;
        const int tok = tok0 + (dir ? L - 1 - t : t);
        const bf16_t* bp = BIG + (size_t)tok * 6144 + 4096 + g * 128 + 8 * h5;
#pragma unroll
        for (int kk = 0; kk < 8; ++kk) bfr[kk] = *(const bf16x8*)(bp + 16 * kk);
      }
      __builtin_amdgcn_sched_barrier(0);
      float cum = sdt * a;
#pragma unroll
      for (int off = 1; off < 64; off <<= 1) {
        const float tv = __shfl_up(cum, off);
        cum += (lane >= off) ? tv : 0.f;
      }
      const float cum_last = __shfl(cum, 63);
      const float wj = __expf(cum_last - cum);
      if (w == 0) cumS[cur * 64 + lane] = cum;
#pragma unroll
      for (int r = 0; r < 2; ++r) {
        const int p8 = (w + 4 * r) * 8;
#pragma unroll
        for (int q = 0; q < 4; ++q) {
          const unsigned u = u4get(sx[r], q);
          XTd[(p8 + 2 * q) * XT_STR + lane] = f2bf(sdt * lo2f(u));
          XTd[(p8 + 2 * q + 1) * XT_STR + lane] = f2bf(sdt * hi2f(u));
        }
      }
#pragma unroll
      for (int r = 0; r < 4; ++r) {
        const int n8 = (w + 4 * r) * 8;
#pragma unroll
        for (int q = 0; q < 4; ++q) {
          const unsigned u = u4get(sb[r], q);
          BTs[(n8 + 2 * q) * XT_STR + lane] = f2bf(wj * lo2f(u));
          BTs[(n8 + 2 * q + 1) * XT_STR + lane] = f2bf(wj * hi2f(u));
        }
      }
      __builtin_amdgcn_sched_barrier(0);
      f32x16 cb;
#pragma unroll
      for (int r = 0; r < 16; ++r) cb[r] = 0.f;
      if (jt <= it) {
#pragma unroll
        for (int kk = 0; kk < 8; ++kk) cb = __builtin_amdgcn_mfma_f32_32x32x16_bf16(cfr[kk], bfr[kk], cb, 0, 0, 0);
      }
      __builtin_amdgcn_sched_barrier(0);
      f32x16 yo;
#pragma unroll
      for (int r = 0; r < 16; ++r) yo[r] = 0.f;
      {
        const bf16_t* hp = Hb + cur * 64 * HB_STR + (32 * pt + l31) * HB_STR + 8 * h5;
#pragma unroll
        for (int kk = 0; kk < 8; ++kk) {
          const bf16x8 hf = *(const bf16x8*)(hp + 16 * kk);
          yo = __builtin_amdgcn_mfma_f32_32x32x16_bf16(cfr[kk], hf, yo, 0, 0, 0);
        }
      }
      __syncthreads();
      __builtin_amdgcn_sched_barrier(0);
      const float dec = __expf(cum_last);
      bf16x8 xf[4];
#pragma unroll
      for (int kk = 0; kk < 4; ++kk) xf[kk] = *(const bf16x8*)(XTd + (32 * pt + l31) * XT_STR + 16 * kk + 8 * h5);
#pragma unroll
      for (int q = 0; q < 2; ++q) {
#pragma unroll
        for (int r = 0; r < 16; ++r) st[q][r] *= dec;
#pragma unroll
        for (int kk = 0; kk < 4; ++kk) {
          const bf16x8 bt = *(const bf16x8*)(BTs + (32 * (nt0 + q) + l31) * XT_STR + 16 * kk + 8 * h5);
          st[q] = __builtin_amdgcn_mfma_f32_32x32x16_bf16(xf[kk], bt, st[q], 0, 0, 0);
        }
        {
          bf16_t* hbw = Hb + (cur ^ 1) * 64 * HB_STR + (32 * pt + 4 * h5) * HB_STR + 32 * (nt0 + q) + l31;
#pragma unroll
          for (int r = 0; r < 16; ++r) hbw[((r & 3) + 8 * (r >> 2)) * HB_STR] = f2bf(st[q][r]);
        }
      }
      __builtin_amdgcn_sched_barrier(0);
      if (jt <= it) {
        const int jj = 32 * jt + l31;
        const float cj = cumS[cur * 64 + jj];
        const int ib = 32 * it + 4 * h5;
        const float* cs = cumS + cur * 64 + ib;
        bf16_t* mw = Ms + ib * XT_STR + jj;
#pragma unroll
        for (int r = 0; r < 16; ++r) {
          const int ro = (r & 3) + 8 * (r >> 2);
          const float m = (jj <= ib + ro) ? cb[r] * __expf(cs[ro] - cj) : 0.f;
          mw[ro * XT_STR] = f2bf(m);
        }
      }
      __syncthreads();
      if (c + 1 < nchunks) {
        const int t = (c + 1) * 64 + lane;
        const int tok = tok0 + (dir ? L - 1 - t : t);
        const bf16_t* rowp = BIG + (size_t)tok * 6144;
#pragma unroll
        for (int r = 0; r < 2; ++r) sx[r] = *(const uint4*)(rowp + 2048 + head * 64 + (w + 4 * r) * 8);
#pragma unroll
        for (int r = 0; r < 4; ++r) sb[r] = *(const uint4*)(rowp + 4096 + g * 128 + (w + 4 * r) * 8);
        sdt = DT[(size_t)tok * 64 + dir * 32 + head];
      }
      __builtin_amdgcn_sched_barrier(0);
      f32x16 yd;
#pragma unroll
      for (int r = 0; r < 16; ++r) yd[r] = 0.f;
#pragma unroll
      for (int kk = 0; kk < 4; ++kk) {
        if (kk < 2 * (it + 1)) {
          const bf16x8 mf = *(const bf16x8*)(Ms + (32 * it + l31) * XT_STR + 16 * kk + 8 * h5);
          yd = __builtin_amdgcn_mfma_f32_32x32x16_bf16(mf, xf[kk], yd, 0, 0, 0);
        }
      }
      {
        const int t0c = c * 64 + 32 * it + 4 * h5;
        const int tokb = tok0 + (dir ? L - 1 - t0c : t0c);
        const int rs = dir ? -64 : 64;
        bf16_t* yp = Y + ((size_t)(tokb >> 7) * 32 + head) * 8192 + (tokb & 127) * 64 + 32 * pt + l31;
        const float* cs = cumS + cur * 64 + 32 * it + 4 * h5;
#pragma unroll
        for (int r = 0; r < 16; ++r) {
          const int ro = (r & 3) + 8 * (r >> 2);
          const float yv = yd[r] + __expf(cs[ro]) * yo[r];
          yp[(ptrdiff_t)rs * ro] = f2bf(yv);
        }
      }
    }
    if (!latent) {
      float* sp = p.out + (size_t)NT * 1024 + sbase + loff;
#pragma unroll
      for (int q = 0; q < 2; ++q)
#pragma unroll
        for (int r = 0; r < 16; ++r) sp[((r & 3) + 8 * (r >> 2)) * 128 + 32 * q] = st[q][r];
    }
    __syncthreads();
  }
}

__device__ __forceinline__ void gate_norm_phase(const Params& p) {
  const int otid = opaque_tid();
  const bf16_t* BIG = (const bf16_t*)(p.ws + OFF_BIG);
  bf16_t* YF = (bf16_t*)(p.ws + OFF_YF);
  const bf16_t* YB = (const bf16_t*)(p.ws + OFF_YB);
  const int lane = otid & 63, w = otid >> 6;
  for (int tok = blockIdx.x * 4 + w; tok < NT; tok += gridDim.x * 4) {
    float v[32];
    float ss = 0.f;
#pragma unroll
    for (int i = 0; i < 4; ++i) {
      const int col = lane * 8 + 512 * i;
      const int head = col >> 6;
      const float dtot = p.ssd_d[head] + p.ssd_d[32 + head];
      uint4 a = *(const uint4*)(YF + tiled(tok, col, 32));
      uint4 b = *(const uint4*)(YB + tiled(tok, col, 32));
      uint4 x = *(const uint4*)(BIG + (size_t)tok * 6144 + 2048 + col);
      uint4 z = *(const uint4*)(BIG + (size_t)tok * 6144 + col);
#pragma unroll
      for (int q = 0; q < 4; ++q) {
        const unsigned aq = u4get(a, q), bq = u4get(b, q), xq = u4get(x, q), zq = u4get(z, q);
        float y0 = lo2f(aq) + lo2f(bq) + dtot * lo2f(xq);
        float y1 = hi2f(aq) + hi2f(bq) + dtot * hi2f(xq);
        y0 *= siluf(lo2f(zq));
        y1 *= siluf(hi2f(zq));
        v[8 * i + 2 * q] = y0; v[8 * i + 2 * q + 1] = y1;
        ss += y0 * y0 + y1 * y1;
      }
      __builtin_amdgcn_sched_barrier(0);
    }
    ss = wave_sum(ss);
    const float sc = rsqrtf(ss * (1.f / 2048.f) + 1e-6f);
#pragma unroll
    for (int i = 0; i < 4; ++i) {
      const int col = lane * 8 + 512 * i;
      float4 g0 = *(const float4*)(p.ssd_norm_g + col), g1 = *(const float4*)(p.ssd_norm_g + col + 4);
      uint4 o;
      o.x = pack2(v[8 * i] * sc * g0.x, v[8 * i + 1] * sc * g0.y);
      o.y = pack2(v[8 * i + 2] * sc * g0.z, v[8 * i + 3] * sc * g0.w);
      o.z = pack2(v[8 * i + 4] * sc * g1.x, v[8 * i + 5] * sc * g1.y);
      o.w = pack2(v[8 * i + 6] * sc * g1.z, v[8 * i + 7] * sc * g1.w);
      *(uint4*)(YF + tiled(tok, col, 32)) = o;
    }
  }
}

__device__ __forceinline__ void final_norm_phase(const Params& p) {
  const int otid = opaque_tid();
  const int lane = otid & 63, w = otid >> 6;
  for (int tok = blockIdx.x * 4 + w; tok < NT; tok += gridDim.x * 4) {
    float* xr = p.out + (size_t)tok * 1024;
    float4 v[4];
    float ss = 0.f;
#pragma unroll
    for (int i = 0; i < 4; ++i) {
      v[i] = *(const float4*)(xr + lane * 4 + 256 * i);
      ss += v[i].x * v[i].x + v[i].y * v[i].y + v[i].z * v[i].z + v[i].w * v[i].w;
    }
    ss = wave_sum(ss);
    const float sc = rsqrtf(ss * (1.f / 1024.f) + 1e-6f);
#pragma unroll
    for (int i = 0; i < 4; ++i) {
      const int col = lane * 4 + 256 * i;
      float4 gg = *(const float4*)(p.norm_f_g + col);
      *(float4*)(xr + col) = make_float4(v[i].x * sc * gg.x, v[i].y * sc * gg.y, v[i].z * sc * gg.z, v[i].w * sc * gg.w);
    }
  }
}


#define XB_TMO      128
#define XB_XCNT(j)  (256  + 64 * (j))
#define XB_XSUB(j)  (1280 + 64 * (j))
#define XB_XGEN(j)  (2304 + 64 * (j))
#define XB_TOP      3328
#define XB_TOPGEN   3392
#define XCD_BAR_WORDS 3456
#define XB_SPIN_CAP (1u << 22)
#define LAS __attribute__((address_space(3)))
__device__ __forceinline__ unsigned xb_ld(unsigned* p) { return __hip_atomic_load(p, __ATOMIC_RELAXED, __HIP_MEMORY_SCOPE_AGENT); }
__device__ __forceinline__ unsigned xb_add(unsigned* p, unsigned v) { return __hip_atomic_fetch_add(p, v, __ATOMIC_RELAXED, __HIP_MEMORY_SCOPE_AGENT); }
__device__ __forceinline__ unsigned xb_xcc_id() { return (unsigned)__builtin_amdgcn_s_getreg((3 << 11) | 20) & 0xFu; }
#define XB_SPIN(cond, bar) do { unsigned _sp = 0; while (cond) { __builtin_amdgcn_s_sleep(1); \
    if ((++_sp & 255u) == 0u) { if (xb_ld(&(bar)[XB_TMO])) break; if (_sp > XB_SPIN_CAP) { atomicAdd(&(bar)[XB_TMO], 1u); break; } } } } while (0)
struct XcdBarrier { unsigned* bar; unsigned x; volatile LAS unsigned* st; };
__device__ __forceinline__ XcdBarrier xcd_barrier_post(unsigned* bar, volatile LAS unsigned* st) {
  XcdBarrier b; b.bar = bar; b.x = xb_xcc_id(); b.st = st;
  if (threadIdx.x == 0) (void)xb_add(&bar[XB_XCNT(b.x)], 1u);
  return b;
}
__device__ __forceinline__ void xcd_barrier_complete(unsigned* bar, unsigned x, unsigned& nloc, unsigned& nx) {
  const unsigned G = gridDim.x * gridDim.y * gridDim.z;
  unsigned sum, cnt, mine, sp = 0u;
  for (;;) {
    sum = 0u; cnt = 0u; mine = 0u;
#pragma unroll
    for (unsigned j = 0; j < 16; ++j) { const unsigned c = xb_ld(&bar[XB_XCNT(j)]); sum += c; cnt += (c > 0u) ? 1u : 0u; mine = (j == x) ? c : mine; }
    if (sum == G) break;
    __builtin_amdgcn_s_sleep(1);
    if ((++sp & 255u) == 0u) { if (xb_ld(&bar[XB_TMO])) break; if (sp > XB_SPIN_CAP) { atomicAdd(&bar[XB_TMO], 1u); break; } }
  }
  nloc = mine > 0u ? mine : 1u; nx = cnt > 0u ? cnt : 1u;
}
__device__ __forceinline__ void xcd_barrier(const XcdBarrier& b) {
  asm volatile("s_waitcnt vmcnt(0)" ::: "memory");
  __syncthreads();
  if (threadIdx.x == 0) {
    unsigned* bar = b.bar;
    __builtin_amdgcn_s_waitcnt(0);
    unsigned nloc = b.st[0], nx = b.st[1];
    if (nloc == 0u) { xcd_barrier_complete(bar, b.x, nloc, nx); b.st[0] = nloc; b.st[1] = nx; }
    const unsigned old = xb_add(&bar[XB_XSUB(b.x)], 1u);
    const unsigned gen = old / nloc;
    if (old + 1u == (gen + 1u) * nloc) {
      __builtin_amdgcn_fence(__ATOMIC_RELEASE, "agent");
      asm volatile("s_waitcnt vmcnt(0)" ::: "memory");
      const unsigned og = xb_add(&bar[XB_TOP], 1u);
      const unsigned tg = og / nx;
      if (og + 1u == (tg + 1u) * nx) xb_add(&bar[XB_TOPGEN], 1u);
      else XB_SPIN(xb_ld(&bar[XB_TOPGEN]) == tg, bar);
      __builtin_amdgcn_fence(__ATOMIC_ACQUIRE, "agent");
      xb_add(&bar[XB_XGEN(b.x)], 1u);
      asm volatile("s_waitcnt vmcnt(0)" ::: "memory");
    } else {
      XB_SPIN(xb_ld(&bar[XB_XGEN(b.x)]) == gen, bar);
      __builtin_amdgcn_fence(__ATOMIC_ACQUIRE, "agent");
      asm volatile("s_waitcnt vmcnt(0)" ::: "memory");
    }
  }
  __syncthreads();
}

#define N_PHASES 19
__global__ void __launch_bounds__(256, 2) mk(Params p, int ph_begin, int ph_end) {
  __shared__ __attribute__((aligned(16))) char smem[SMEM_BYTES];
  __shared__ uint4 xb_words;
  const bool multi = (ph_end - ph_begin) > 1;
  if (threadIdx.x == 0) xb_words = make_uint4(0u, 0u, 0u, 0u);
  __syncthreads();
  XcdBarrier xb;
  xb.bar = (unsigned*)(p.ws + OFF_BAR); xb.x = 0; xb.st = (volatile LAS unsigned*)&xb_words;
  if (multi) xb = xcd_barrier_post((unsigned*)(p.ws + OFF_BAR), (volatile LAS unsigned*)&xb_words);
  bf16_t* WT = (bf16_t*)(p.ws + OFF_WT);
  bf16_t* BIG = (bf16_t*)(p.ws + OFF_BIG);
  bf16_t* Abuf = (bf16_t*)(p.ws + OFF_YF);
  float* MOD = (float*)(p.ws + OFF_MOD);
#define RUN(PH, CALL) if (ph_begin <= PH && PH < ph_end) { CALL; if (PH + 1 < ph_end) { if (PH == 0) cg::this_grid().sync(); else xcd_barrier(xb); } }
  RUN(0, prep_phase(p, smem))
  RUN(1, norm_mod_phase(p, 0, 0, true))
  RUN(2, gemm_phase(Abuf, WT + WT_SCIN, NT, 3072, 1024, EpiBf16{BIG, 3072}, smem))
  RUN(3, conv_gate_phase(p))
  RUN(4, gemm_phase((const bf16_t*)(p.ws + OFF_BIG + 120 * MIB), WT + WT_SCOUT, NT, 1024, 1024,
                    EpiRes{p.x_prompt, p.x_sample, p.out, MOD + 0 * 5 * 6144 + 2 * 1024}, smem))
  RUN(5, norm_mod_phase(p, 0, 1, false))
  RUN(6, gemm_phase(Abuf, WT + WT_WQ, NT, 2048, 1024, EpiBf16{BIG, 2048}, smem))
  RUN(7, topk_phase(p, 0, smem))
  RUN(8, peer_phase(p, 0, smem))
  RUN(10, gemm_phase(Abuf, WT + WT_SSDIN, NT, 6208, 1024, EpiSsdIn{BIG, (float*)(p.ws + OFF_DT), p.ssd_dt_bias}, smem))
  RUN(11, ssd_conv_phase(p))
  RUN(12, scan_phase(p, smem))
  RUN(13, gate_norm_phase(p))
  RUN(14, gemm_phase(Abuf, WT + WT_SSDOUT, NT, 1024, 2048,
                     EpiRes{p.out, p.out + (size_t)NCTX * 1024, p.out, MOD + 1 * 5 * 6144 + 2 * 1024}, smem))
  RUN(15, norm_mod_phase(p, 1, 1, false))
  RUN(16, gemm_phase(Abuf, WT + WT_WQ + (size_t)2048 * 1024, NT, 2048, 1024, EpiBf16{BIG, 2048}, smem))
  RUN(17, topk_phase(p, 1, smem))
  RUN(18, peer_phase(p, 1, smem))
}

extern "C" void kernel_launch(void* const* d_in, const int* in_sizes, int n_in, void* d_out, int out_size, void* d_ws, size_t ws_size,
                              hipStream_t stream) {
  static int grid_blocks = 0;
  if (!grid_blocks) {
    int dev = 0, cus = 0, per_cu = 0;
    hipGetDevice(&dev);
    hipDeviceGetAttribute(&cus, hipDeviceAttributeMultiprocessorCount, dev);
    hipOccupancyMaxActiveBlocksPerMultiprocessor(&per_cu, mk, 256, 0);
    if (per_cu < 1) per_cu = 1;
    if (per_cu > 2) per_cu = 2;
    grid_blocks = cus * per_cu;
  }
  if (ws_size < WS_NEEDED) { fprintf(stderr, "workspace too small: %zu\n", ws_size); return; }
  Params p{};
  const float** pf = (const float**)&p;
  for (int i = 0; i < 25; ++i) pf[i] = (const float*)d_in[i];
  p.out = (float*)d_out;
  p.ws = (char*)d_ws;
#if COOP
  hipMemsetAsync((char*)d_ws + OFF_BAR, 0, 16384, stream);
  int b = 0, e = N_PHASES;
  void* args[] = {&p, &b, &e};
  hipError_t err = hipLaunchCooperativeKernel((void*)mk, dim3(grid_blocks), dim3(256), args, 0, stream);
  if (err != hipSuccess) fprintf(stderr, "cooperative launch failed: %s (grid %d)\n", hipGetErrorString(err), grid_blocks);
#else
  for (int ph = 0; ph < N_PHASES; ++ph) {
    hipLaunchKernelGGL(mk, dim3(grid_blocks), dim3(256), 0, stream, p, ph, ph + 1);
    if ((DUP_MASK >> ph) & 1) hipLaunchKernelGGL(mk, dim3(grid_blocks), dim3(256), 0, stream, p, ph, ph + 1);
  }
#endif
}
```

```cpp
#include <hip/hip_runtime.h>
#include <hip/hip_cooperative_groups.h>
#include <cstdio>
namespace cg = cooperative_groups;

#ifndef COOP
#define COOP 1
#endif
#ifndef DUP_MASK
#define DUP_MASK 0
#endif

typedef unsigned short bf16_t;
typedef __attribute__((ext_vector_type(8))) short bf16x8;
typedef __attribute__((ext_vector_type(16))) float f32x16;
typedef __attribute__((ext_vector_type(32))) float f32x32;
typedef __attribute__((ext_vector_type(6))) unsigned u32x6;

#define NT 20480
#define NCTX 4096
#define DM 1024
#define MIB ((size_t)1 << 20)
#define OFF_BIG   ((size_t)0)
#define OFF_YF    (240 * MIB)
#define OFF_YB    (320 * MIB)
#define OFF_WT    (400 * MIB)
#define OFF_KEYSB (433 * MIB)
#define OFF_DT    (434 * MIB)
#define OFF_MOD   (439 * MIB)
#define OFF_IDX   (440 * MIB)
#define OFF_GATE  (450 * MIB)
#define OFF_TAB1  (460 * MIB)
#define OFF_SCALE (492 * MIB)
#define OFF_BAR   (493 * MIB)
#define WS_NEEDED (494 * MIB)
#define WT_SCIN   ((size_t)0)
#define WT_SCOUT  (WT_SCIN + (size_t)3072 * 1024)
#define WT_SSDIN  (WT_SCOUT + (size_t)1024 * 1024)
#define WT_SSDOUT (WT_SSDIN + (size_t)6272 * 1024)
#define WT_WQ     (WT_SSDOUT + (size_t)1024 * 2048)

#define SMEM_BYTES 75776

struct Params {
  const float *x_prompt, *x_sample, *state_ssm, *c, *c_ctx, *norm_mix_g, *norm_ffn_g, *norm_f_g, *ada_w, *ada_b;
  const float *sc_w_in, *sc_conv_w, *sc_w_out, *ssd_w_in, *ssd_conv_w, *ssd_conv_b, *ssd_dt_bias, *ssd_a_log, *ssd_d;
  const float *ssd_norm_g, *ssd_w_out, *peer_wq, *peer_keys, *peer_u, *peer_v;
  float* out;
  char* ws;
};

__device__ __forceinline__ float bf2f(bf16_t h) { return __uint_as_float(((unsigned)h) << 16); }
__device__ __forceinline__ bf16_t f2bf(float f) {
  unsigned u = __float_as_uint(f);
  u += 0x7FFFu + ((u >> 16) & 1u);
  return (bf16_t)(u >> 16);
}
__device__ __forceinline__ unsigned pack2(float a, float b) { return (unsigned)f2bf(a) | ((unsigned)f2bf(b) << 16); }
__device__ __forceinline__ float lo2f(unsigned u) { return __uint_as_float(u << 16); }
__device__ __forceinline__ float hi2f(unsigned u) { return __uint_as_float(u & 0xffff0000u); }
__device__ __forceinline__ unsigned u4get(const uint4 v, const int q) { return q == 0 ? v.x : (q == 1 ? v.y : (q == 2 ? v.z : v.w)); }
__device__ __forceinline__ int opaque_tid() { int t = threadIdx.x; asm volatile("" : "+v"(t)); return t; }
__device__ __forceinline__ size_t tiled(int row, int col, int KT) { return ((size_t)(row >> 7) * KT + (col >> 6)) * 8192 + (row & 127) * 64 + (col & 63); }
__device__ __forceinline__ float siluf(float x) { return x / (1.f + __expf(-x)); }
__device__ __forceinline__ int cidx(int tok) { return tok < NCTX ? 0 : 1 + ((tok - NCTX) >> 12); }

template <int CTRL>
__device__ __forceinline__ unsigned dpp_u(unsigned v) {
  return (unsigned)__builtin_amdgcn_update_dpp(0, (int)v, CTRL, 0xF, 0xF, true);
}
template <int CTRL>
__device__ __forceinline__ float dpp_f(float v) {
  return __int_as_float(__builtin_amdgcn_update_dpp(0, __float_as_int(v), CTRL, 0xF, 0xF, true));
}
__device__ __forceinline__ float row16_sum(float v) {
  v += dpp_f<0xB1>(v);
  v += dpp_f<0x4E>(v);
  v += dpp_f<0x141>(v);
  v += dpp_f<0x140>(v);
  return v;
}
__device__ __forceinline__ unsigned umax_(unsigned a, unsigned b) { return a > b ? a : b; }
__device__ __forceinline__ unsigned row_max_u32(unsigned v) {
  v = umax_(v, dpp_u<0xB1>(v));
  v = umax_(v, dpp_u<0x4E>(v));
  v = umax_(v, dpp_u<0x141>(v));
  v = umax_(v, dpp_u<0x140>(v));
  return v;
}
__device__ __forceinline__ unsigned wave_max_u32(unsigned v) {
  v = umax_(v, dpp_u<0xB1>(v));
  v = umax_(v, dpp_u<0x4E>(v));
  v = umax_(v, dpp_u<0x141>(v));
  v = umax_(v, dpp_u<0x140>(v));
  unsigned a = (unsigned)__builtin_amdgcn_readlane((int)v, 0);
  unsigned b = (unsigned)__builtin_amdgcn_readlane((int)v, 16);
  unsigned c = (unsigned)__builtin_amdgcn_readlane((int)v, 32);
  unsigned d = (unsigned)__builtin_amdgcn_readlane((int)v, 48);
  return umax_(umax_(a, b), umax_(c, d));
}
__device__ __forceinline__ float wave_sum(float v) {
  v = row16_sum(v);
  float a, b, c, d;
  a = __int_as_float(__builtin_amdgcn_readlane(__float_as_int(v), 0));
  b = __int_as_float(__builtin_amdgcn_readlane(__float_as_int(v), 16));
  c = __int_as_float(__builtin_amdgcn_readlane(__float_as_int(v), 32));
  d = __int_as_float(__builtin_amdgcn_readlane(__float_as_int(v), 48));
  return (a + b) + (c + d);
}
__device__ __forceinline__ unsigned fkey(float f) {
  unsigned u = __float_as_uint(f);
  return (u & 0x80000000u) ? ~u : (u | 0x80000000u);
}
__device__ __forceinline__ float keyf(unsigned k) {
  unsigned u = (k & 0x80000000u) ? (k & 0x7fffffffu) : ~k;
  return __uint_as_float(u);
}

__device__ __forceinline__ void transpose_tile(const float* __restrict__ src, int K, int N, bf16_t* __restrict__ dst, int tile, float* tb) {
  const int tid = threadIdx.x;
  const int ntn = N >> 6;
  const int kt = tile / ntn, nt = tile % ntn;
  {
    const int n = tid & 63, kb = tid >> 6;
#pragma unroll
    for (int i = 0; i < 16; ++i) {
      int k = kb + 4 * i;
      tb[k * 65 + n] = src[(size_t)(kt * 64 + k) * N + nt * 64 + n];
    }
  }
  __syncthreads();
  {
    const int k8 = (tid & 7) * 8;
#pragma unroll
    for (int pass = 0; pass < 2; ++pass) {
      int n = (tid >> 3) + 32 * pass;
      uint4 o;
      o.x = pack2(tb[(k8 + 0) * 65 + n], tb[(k8 + 1) * 65 + n]);
      o.y = pack2(tb[(k8 + 2) * 65 + n], tb[(k8 + 3) * 65 + n]);
      o.z = pack2(tb[(k8 + 4) * 65 + n], tb[(k8 + 5) * 65 + n]);
      o.w = pack2(tb[(k8 + 6) * 65 + n], tb[(k8 + 7) * 65 + n]);
      *(uint4*)(dst + tiled(nt * 64 + n, kt * 64 + k8, K >> 6)) = o;
    }
  }
  __syncthreads();
}

__device__ __forceinline__ void prep_phase(const Params& p, char* smem) {
  const int otid = opaque_tid();
  const int tid = otid;
  bf16_t* WT = (bf16_t*)(p.ws + OFF_WT);
  float* MOD = (float*)(p.ws + OFF_MOD);
  bf16_t* KEYSB = (bf16_t*)(p.ws + OFF_KEYSB);
  const int U_MOD = 192, U_T0 = 768, U_T1 = 256, U_T2 = 1552, U_T3 = 512, U_T4 = 1024, U_KEYS = 256, U_TAB = 8192;
  const int total = U_MOD + U_T0 + U_T1 + U_T2 + U_T3 + U_T4 + U_KEYS + U_TAB;
  for (int u = blockIdx.x; u < total; u += gridDim.x) {
    int v = u;
    if (v < U_MOD) {
      float* scond = (float*)smem;
      float* red = scond + 5 * 1024;
      for (int i = tid; i < 5 * 1024; i += 256) {
        int r = i >> 10, k = i & 1023;
        float cv = (r == 0) ? p.c_ctx[k] : p.c[(r - 1) * 1024 + k];
        scond[i] = siluf(cv);
      }
      __syncthreads();
      const int l = v / 96, jc = v % 96;
      const int jj = tid & 63, kq = tid >> 6;
      const int j = jc * 64 + jj;
      float acc[5] = {0.f, 0.f, 0.f, 0.f, 0.f};
      const float* wp = p.ada_w + ((size_t)l * 1024 + kq * 256) * 6144 + j;
#pragma unroll 8
      for (int k = 0; k < 256; ++k) {
        float wv = wp[(size_t)k * 6144];
#pragma unroll
        for (int r = 0; r < 5; ++r) acc[r] += scond[r * 1024 + kq * 256 + k] * wv;
      }
#pragma unroll
      for (int r = 0; r < 5; ++r) red[(kq * 5 + r) * 64 + jj] = acc[r];
      __syncthreads();
      for (int i = tid; i < 320; i += 256) {
        int r = i >> 6, j2 = i & 63;
        float s = red[(0 * 5 + r) * 64 + j2] + red[(1 * 5 + r) * 64 + j2] + red[(2 * 5 + r) * 64 + j2] + red[(3 * 5 + r) * 64 + j2];
        MOD[(size_t)(l * 5 + r) * 6144 + jc * 64 + j2] = s + p.ada_b[l * 6144 + jc * 64 + j2];
      }
      __syncthreads();
      continue;
    }
    v -= U_MOD;
    float* tb = (float*)smem;
    if (v < U_T0) { transpose_tile(p.sc_w_in, 1024, 3072, WT + WT_SCIN, v, tb); continue; }
    v -= U_T0;
    if (v < U_T1) { transpose_tile(p.sc_w_out, 1024, 1024, WT + WT_SCOUT, v, tb); continue; }
    v -= U_T1;
    if (v < U_T2) { transpose_tile(p.ssd_w_in, 1024, 6208, WT + WT_SSDIN, v, tb); continue; }
    v -= U_T2;
    if (v < U_T3) { transpose_tile(p.ssd_w_out, 2048, 1024, WT + WT_SSDOUT, v, tb); continue; }
    v -= U_T3;
    if (v < U_T4) {
      int l = v >> 9, t = v & 511;
      transpose_tile(p.peer_wq + (size_t)l * 1024 * 2048, 1024, 2048, WT + WT_WQ + (size_t)l * 2048 * 1024, t, tb);
      continue;
    }
    v -= U_T4;
    if (v < U_KEYS) {
      size_t base = (size_t)v * 2048 + tid * 8;
      float4 a = *(const float4*)(p.peer_keys + base);
      float4 b = *(const float4*)(p.peer_keys + base + 4);
      uint4 o;
      o.x = pack2(a.x, a.y); o.y = pack2(a.z, a.w); o.z = pack2(b.x, b.y); o.w = pack2(b.z, b.w);
      *(uint4*)(KEYSB + base) = o;
      continue;
    }
    v -= U_KEYS;
    {
      const int lane = tid & 63, l31 = lane & 31;
      const int gr = v * 8 + (tid >> 6) * 2 + (lane >> 5);
      const int l = gr >> 15, tab = (gr >> 14) & 1, row = gr & 16383;
      const float* src = (tab ? p.peer_v : p.peer_u) + ((size_t)l * 16384 + row) * 1024 + l31 * 32;
      float4 x[8];
      float am = 0.f;
#pragma unroll
      for (int j = 0; j < 8; ++j) {
        x[j] = *(const float4*)(src + 4 * j);
        am = fmaxf(am, fmaxf(fmaxf(fabsf(x[j].x), fabsf(x[j].y)), fmaxf(fabsf(x[j].z), fabsf(x[j].w))));
      }
      {
        unsigned au = row_max_u32(__float_as_uint(am));
        const unsigned ao = (unsigned)__shfl_xor((int)au, 16);
        am = __uint_as_float(umax_(au, ao));
      }
      const float inv = am > 0.f ? 7.0f / am : 0.f;
      const float scale = am > 0.f ? am / 7.0f : 0.f;
      f32x16 fa, fb;
#pragma unroll
      for (int j = 0; j < 8; ++j) {
        fa[2 * j] = x[j].x * inv; fb[2 * j] = x[j].y * inv; fa[2 * j + 1] = x[j].z * inv; fb[2 * j + 1] = x[j].w * inv;
      }
      const u32x6 pk = __builtin_amdgcn_cvt_scalef32_2xpk16_fp6_f32(fa, fb, 1.0f);
      unsigned char* dst = (unsigned char*)(p.ws + (l ? OFF_TAB1 : OFF_YB)) + ((size_t)tab * 16384 + row) * 768 + l31 * 24;
      *(uint2*)(dst) = make_uint2(pk[0], pk[1]);
      *(uint2*)(dst + 8) = make_uint2(pk[2], pk[3]);
      *(uint2*)(dst + 16) = make_uint2(pk[4], pk[5]);
      if (l31 == 0) ((float*)(p.ws + OFF_SCALE))[gr] = scale;
    }
  }
}

__device__ __forceinline__ void norm_mod_phase(const Params& p, int layer, int which, bool from_input) {
  const int otid = opaque_tid();
  const float* g = (which == 0 ? p.norm_mix_g : p.norm_ffn_g) + layer * 1024;
  const float* MOD = (const float*)(p.ws + OFF_MOD);
  bf16_t* A = (bf16_t*)(p.ws + OFF_YF);
  const int lane = otid & 63, w = otid >> 6;
  for (int tok = blockIdx.x * 4 + w; tok < NT; tok += gridDim.x * 4) {
    const float* xr = from_input ? (tok < NCTX ? p.x_prompt + (size_t)tok * 1024 : p.x_sample + (size_t)(tok - NCTX) * 1024)
                                 : p.out + (size_t)tok * 1024;
    const float* md = MOD + (size_t)(layer * 5 + cidx(tok)) * 6144 + (which ? 3 * 1024 : 0);
    float4 v[4];
    float ss = 0.f;
#pragma unroll
    for (int i = 0; i < 4; ++i) {
      v[i] = *(const float4*)(xr + lane * 4 + 256 * i);
      ss += v[i].x * v[i].x + v[i].y * v[i].y + v[i].z * v[i].z + v[i].w * v[i].w;
    }
    ss = wave_sum(ss);
    const float sc = rsqrtf(ss * (1.f / 1024.f) + 1e-6f);
#pragma unroll
    for (int i = 0; i < 4; ++i) {
      const int col = lane * 4 + 256 * i;
      float4 gg = *(const float4*)(g + col);
      float4 sh = *(const float4*)(md + col);
      float4 sl = *(const float4*)(md + 1024 + col);
      float o0 = v[i].x * sc * gg.x * (1.f + sl.x) + sh.x;
      float o1 = v[i].y * sc * gg.y * (1.f + sl.y) + sh.y;
      float o2 = v[i].z * sc * gg.z * (1.f + sl.z) + sh.z;
      float o3 = v[i].w * sc * gg.w * (1.f + sl.w) + sh.w;
      uint2 o;
      o.x = pack2(o0, o1);
      o.y = pack2(o2, o3);
      *(uint2*)(A + tiled(tok, col, 16)) = o;
    }
  }
}

#define LSTR 72
template <class Epi>
__device__ __forceinline__ void gemm_phase(const bf16_t* __restrict__ A, const bf16_t* __restrict__ Bt, int M, int N, int K, Epi epi, char* smem) {
  const int otid = opaque_tid();
  bf16_t* sA = (bf16_t*)smem;
  bf16_t* sB = sA + 2 * 128 * LSTR;
  float* sC = (float*)smem;
  const int tid = otid, lane = tid & 63, w = tid >> 6;
  const int wm = w >> 1, wn = w & 1;
  const int ntn = (N + 127) >> 7, ntm = M >> 7;
  const int ntiles = ntm * ntn;
  const int KT = K >> 6;
  const int lrow = tid >> 3, lkc = (tid & 7) * 8;
  const bf16_t* apb;
  const bf16_t* bpb;
  uint4 ra0_0, ra0_1, ra0_2, ra0_3, rb0_0, rb0_1, rb0_2, rb0_3, ra1_0, ra1_1, ra1_2, ra1_3, rb1_0, rb1_1, rb1_2, rb1_3;
  const int G_ = gridDim.x;
  const int RN = (ntn % 8 == 0) ? 8 : ((ntn % 7 == 0) ? 7 : ((ntn % 6 == 0) ? 6 : ((ntn % 5 == 0) ? 5 : 4)));
  const int RM = ((G_ >> 3) / RN) > 0 ? ((G_ >> 3) / RN) : 1;
  const int nrn = (ntn + RN - 1) / RN, nrm = (ntm + RM - 1) / RM;
  const int nrects = nrn * nrm;
  const int nslots = ((nrects + 7) >> 3) * G_;
#define G_MAP(T_, VALID_, MT_, NT_) { const int i_ = (T_) / G_, b_ = (T_) - i_ * G_; const int R_ = i_ * 8 + (b_ & 7); const int s_ = b_ >> 3; \
    const int rm_ = R_ / nrn, rn_ = R_ - rm_ * nrn; const int dm_ = s_ / RN, dn_ = s_ - dm_ * RN; MT_ = rm_ * RM + dm_; NT_ = rn_ * RN + dn_; \
    VALID_ = (dm_ < RM) && (R_ < nrects) && (MT_ < ntm) && (NT_ < ntn); }
#define G_NEXT(T_, MT_, NT_) { bool ok_ = false; while ((T_) < nslots) { G_MAP(T_, ok_, MT_, NT_) if (ok_) break; (T_) += G_; } }
#define G_PTRS(MT_, NT_) { apb = A + (size_t)(MT_) * KT * 8192 + lrow * 64 + lkc; bpb = Bt + (size_t)(NT_) * KT * 8192 + lrow * 64 + lkc; }
#define G_LOAD1(S, I, KT_) { ra##S##_##I = *(const uint4*)(apb + (KT_) * 8192 + I * 2048); rb##S##_##I = *(const uint4*)(bpb + (KT_) * 8192 + I * 2048); }
#define G_LOAD(S, KT_) { G_LOAD1(S, 0, KT_) G_LOAD1(S, 1, KT_) G_LOAD1(S, 2, KT_) G_LOAD1(S, 3, KT_) }
#define G_WRITE1(S, I, BUF_) { *(uint4*)(sA + (BUF_) * 128 * LSTR + (lrow + 32 * I) * LSTR + lkc) = ra##S##_##I; *(uint4*)(sB + (BUF_) * 128 * LSTR + (lrow + 32 * I) * LSTR + lkc) = rb##S##_##I; }
#define G_WRITE(S, BUF_) { G_WRITE1(S, 0, BUF_) G_WRITE1(S, 1, BUF_) G_WRITE1(S, 2, BUF_) G_WRITE1(S, 3, BUF_) }
#define G_MMA(KK, BUF_) { \
        bf16x8 a0 = *(const bf16x8*)(cA + KK * 16); \
        bf16x8 a1 = *(const bf16x8*)(cA + 32 * LSTR + KK * 16); \
        bf16x8 b0 = *(const bf16x8*)(cB + KK * 16); \
        bf16x8 b1 = *(const bf16x8*)(cB + 32 * LSTR + KK * 16); \
        acc[0][0] = __builtin_amdgcn_mfma_f32_32x32x16_bf16(a0, b0, acc[0][0], 0, 0, 0); \
        acc[0][1] = __builtin_amdgcn_mfma_f32_32x32x16_bf16(a0, b1, acc[0][1], 0, 0, 0); \
        acc[1][0] = __builtin_amdgcn_mfma_f32_32x32x16_bf16(a1, b0, acc[1][0], 0, 0, 0); \
        acc[1][1] = __builtin_amdgcn_mfma_f32_32x32x16_bf16(a1, b1, acc[1][1], 0, 0, 0); }
#define G_COMPUTE(BUF_) { \
      const bf16_t* cA = sA + (BUF_) * 128 * LSTR + (wm * 64 + (lane & 31)) * LSTR + (lane >> 5) * 8; \
      const bf16_t* cB = sB + (BUF_) * 128 * LSTR + (wn * 64 + (lane & 31)) * LSTR + (lane >> 5) * 8; \
      G_MMA(0, BUF_) G_MMA(1, BUF_) G_MMA(2, BUF_) G_MMA(3, BUF_) }
  int tile = blockIdx.x, mt = 0, nt = 0;
  G_NEXT(tile, mt, nt)
  if (tile < nslots) { G_PTRS(mt, nt) G_LOAD(0, 0) G_LOAD(1, 1) }
  while (tile < nslots) {
    const int m0 = mt << 7, n0 = nt << 7;
    f32x16 acc[2][2];
#pragma unroll
    for (int i = 0; i < 2; ++i)
#pragma unroll
      for (int j = 0; j < 2; ++j)
#pragma unroll
        for (int r = 0; r < 16; ++r) acc[i][j][r] = 0.f;
    G_WRITE(0, 0)
    __syncthreads();
    for (int kt = 0; kt < KT; kt += 2) {
      if (kt + 2 < KT) G_LOAD(0, kt + 2)
      G_COMPUTE(0)
      G_WRITE(1, 1)
      __syncthreads();
      if (kt + 3 < KT) G_LOAD(1, kt + 3)
      G_COMPUTE(1)
      if (kt + 2 < KT) G_WRITE(0, 0)
      __syncthreads();
    }
    int next = tile + G_;
    G_NEXT(next, mt, nt)
    if (next < nslots) { G_PTRS(mt, nt) G_LOAD(0, 0) G_LOAD(1, 1) }
#pragma unroll
    for (int mi = 0; mi < 2; ++mi)
#pragma unroll
      for (int ni = 0; ni < 2; ++ni) {
        float* cw = sC + (wm * 64 + mi * 32 + 4 * (lane >> 5)) * 132 + wn * 64 + ni * 32 + (lane & 31);
#pragma unroll
        for (int r = 0; r < 16; ++r) cw[((r & 3) + 8 * (r >> 2)) * 132] = acc[mi][ni][r];
      }
    __syncthreads();
#pragma unroll 4
    for (int i = 0; i < 16; ++i) {
      const int ch = tid + 256 * i;
      const int row = ch >> 5, c4 = (ch & 31) * 4;
      const float4 v = *(const float4*)(sC + row * 132 + c4);
      if (n0 + c4 < N) epi(m0 + row, n0 + c4, v);
    }
    __syncthreads();
    tile = next;
  }
}

struct EpiBf16 {
  bf16_t* C; int ldc;
  __device__ __forceinline__ void operator()(int m, int n, float4 v) const {
    uint2 o; o.x = pack2(v.x, v.y); o.y = pack2(v.z, v.w);
    *(uint2*)(C + (size_t)m * ldc + n) = o;
  }
};
__device__ __forceinline__ float softplusf(float x) { return x > 20.f ? x : log1pf(expf(x)); }
struct EpiSsdIn {
  bf16_t* C; float* DT; const float* dt_bias;
  __device__ __forceinline__ void operator()(int m, int n, float4 v) const {
    if (n < 6144) {
      uint2 o; o.x = pack2(v.x, v.y); o.y = pack2(v.z, v.w);
      *(uint2*)(C + (size_t)m * 6144 + n) = o;
    } else {
      const int c = n - 6144;
      const float4 bb = *(const float4*)(dt_bias + c);
      *(float4*)(DT + (size_t)m * 64 + c) = make_float4(softplusf(v.x + bb.x), softplusf(v.y + bb.y), softplusf(v.z + bb.z), softplusf(v.w + bb.w));
    }
  }
};
struct EpiRes {
  const float* xin_ctx; const float* xin_lat; float* X; const float* gate;
  __device__ __forceinline__ void operator()(int m, int n, float4 v) const {
    const float* xr = m < NCTX ? xin_ctx + (size_t)m * 1024 : xin_lat + (size_t)(m - NCTX) * 1024;
    const float4 xv = *(const float4*)(xr + n);
    const float4 gt = *(const float4*)(gate + (size_t)cidx(m) * 6144 + n);
    *(float4*)(X + (size_t)m * 1024 + n) = make_float4(xv.x + gt.x * v.x, xv.y + gt.y * v.y, xv.z + gt.z * v.z, xv.w + gt.w * v.w);
  }
};

__device__ __forceinline__ void conv_gate_phase(const Params& p) {
  const int otid = opaque_tid();
  const bf16_t* P = (const bf16_t*)(p.ws + OFF_BIG);
  bf16_t* G = (bf16_t*)(p.ws + OFF_BIG + 120 * MIB);
  const float* cw = p.sc_conv_w;
  const int total = NT * 128;
  for (int it = blockIdx.x * 256 + otid; it < total; it += gridDim.x * 256) {
    const int tok = it >> 7, c = (it & 127) * 8;
    const int rowlen = tok < NCTX ? 256 : 64;
    const int pos = tok & (rowlen - 1);
    const bf16_t* pr = P + (size_t)tok * 3072;
    uint4 bg = *(const uint4*)(pr + c);
    uint4 cg = *(const uint4*)(pr + 1024 + c);
    uint4 xv = *(const uint4*)(pr + 2048 + c);
    uint4 cgl = make_uint4(0, 0, 0, 0), xvl = cgl, cgr = cgl, xvr = cgl;
    if (pos > 0) { cgl = *(const uint4*)(pr - 3072 + 1024 + c); xvl = *(const uint4*)(pr - 3072 + 2048 + c); }
    if (pos < rowlen - 1) { cgr = *(const uint4*)(pr + 3072 + 1024 + c); xvr = *(const uint4*)(pr + 3072 + 2048 + c); }
    const unsigned* bgp = (const unsigned*)&bg; const unsigned* cgp = (const unsigned*)&cg; const unsigned* xvp = (const unsigned*)&xv;
    const unsigned* cglp = (const unsigned*)&cgl; const unsigned* xvlp = (const unsigned*)&xvl;
    const unsigned* cgrp = (const unsigned*)&cgr; const unsigned* xvrp = (const unsigned*)&xvr;
    float4 w0a = *(const float4*)(cw + c), w0b = *(const float4*)(cw + c + 4);
    float4 w1a = *(const float4*)(cw + 1024 + c), w1b = *(const float4*)(cw + 1024 + c + 4);
    float4 w2a = *(const float4*)(cw + 2048 + c), w2b = *(const float4*)(cw + 2048 + c + 4);
    const float w0[8] = {w0a.x, w0a.y, w0a.z, w0a.w, w0b.x, w0b.y, w0b.z, w0b.w};
    const float w1[8] = {w1a.x, w1a.y, w1a.z, w1a.w, w1b.x, w1b.y, w1b.z, w1b.w};
    const float w2[8] = {w2a.x, w2a.y, w2a.z, w2a.w, w2b.x, w2b.y, w2b.z, w2b.w};
    unsigned o[4];
#pragma unroll
    for (int q = 0; q < 4; ++q) {
      float r0 = lo2f(bgp[q]) * (w0[2 * q] * lo2f(cglp[q]) * lo2f(xvlp[q]) + w1[2 * q] * lo2f(cgp[q]) * lo2f(xvp[q]) + w2[2 * q] * lo2f(cgrp[q]) * lo2f(xvrp[q]));
      float r1 = hi2f(bgp[q]) * (w0[2 * q + 1] * hi2f(cglp[q]) * hi2f(xvlp[q]) + w1[2 * q + 1] * hi2f(cgp[q]) * hi2f(xvp[q]) + w2[2 * q + 1] * hi2f(cgrp[q]) * hi2f(xvrp[q]));
      o[q] = pack2(r0, r1);
    }
    *(uint4*)(G + tiled(tok, c, 16)) = make_uint4(o[0], o[1], o[2], o[3]);
  }
}

#define SSTR 272
#define CE2_(K, a, b) { unsigned hi_ = umax_(K[a], K[b]); unsigned lo_ = K[a] < K[b] ? K[a] : K[b]; K[a] = hi_; K[b] = lo_; }
#define SORT8_(K) CE2_(K, 0, 1) CE2_(K, 2, 3) CE2_(K, 4, 5) CE2_(K, 6, 7) CE2_(K, 0, 2) CE2_(K, 1, 3) CE2_(K, 4, 6) CE2_(K, 5, 7) \
  CE2_(K, 1, 2) CE2_(K, 5, 6) CE2_(K, 0, 4) CE2_(K, 1, 5) CE2_(K, 2, 6) CE2_(K, 3, 7) CE2_(K, 2, 4) CE2_(K, 3, 5) CE2_(K, 1, 2) CE2_(K, 3, 4) CE2_(K, 5, 6)
__device__ __forceinline__ void top16_row2(const float* Sr, int j, unsigned& res1, unsigned& res2) {
  unsigned ka[8], kb[8];
#pragma unroll
  for (int m = 0; m < 8; ++m) {
    ka[m] = (fkey(Sr[j + 16 * m]) & ~0x7Fu) | (unsigned)(127 - (j + 16 * m));
    kb[m] = (fkey(Sr[128 + j + 16 * m]) & ~0x7Fu) | (unsigned)(127 - (j + 16 * m));
  }
  SORT8_(ka)
  SORT8_(kb)
  unsigned r1 = 0, r2 = 0;
#pragma unroll 2
  for (int it = 0; it < 16; ++it) {
    const unsigned wa = row_max_u32(ka[0]);
    const unsigned wb = row_max_u32(kb[0]);
    const bool wina = ka[0] == wa;
    const bool winb = kb[0] == wb;
#pragma unroll
    for (int m = 0; m < 7; ++m) { ka[m] = wina ? ka[m + 1] : ka[m]; kb[m] = winb ? kb[m + 1] : kb[m]; }
    ka[7] = wina ? 0u : ka[7];
    kb[7] = winb ? 0u : kb[7];
    r1 = (j == it) ? wa : r1;
    r2 = (j == it) ? wb : r2;
  }
  res1 = r1; res2 = r2;
}

__device__ __forceinline__ void topk_phase(const Params& p, int layer, char* smem) {
  const int otid = opaque_tid();
  float* S = (float*)smem;
  const bf16_t* Q = (const bf16_t*)(p.ws + OFF_BIG);
  const bf16_t* KB = (const bf16_t*)(p.ws + OFF_KEYSB) + (size_t)layer * (8 * 2 * 128 * 128);
  int* IDX = (int*)(p.ws + OFF_IDX);
  float* GATE = (float*)(p.ws + OFF_GATE);
  const int tid = otid, lane = tid & 63;
  const int w = __builtin_amdgcn_readfirstlane(tid >> 6);
  const int G = gridDim.x;
  const int per = (5120 + G - 1) / G;
  const int start = blockIdx.x * per;
  const int end = (start + per < 5120) ? start + per : 5120;
  const int pp = w >> 1, nt0 = (w & 1) * 2;
  const int j = lane & 15, rowbase = lane & 48;
  int ca[4], cb[4];
  bool cvalid3;
  ca[0] = 0; cb[0] = j;
  if (j < 8) { ca[1] = 1; cb[1] = j; } else { ca[1] = j; cb[1] = 0; }
  if (j < 5) { ca[2] = 2; cb[2] = j; } else if (j < 9) { ca[2] = 3; cb[2] = j - 5; } else if (j < 12) { ca[2] = 4; cb[2] = j - 9; }
  else if (j < 14) { ca[2] = 5; cb[2] = j - 12; } else { ca[2] = 6; cb[2] = j - 14; }
  ca[3] = 7; cb[3] = j & 1; cvalid3 = j < 2;
  int curh = -1;
  bf16x8 kf[2][8];
  for (int pr = start; pr < end; ++pr) {
    const int h = pr / 640, tile = pr % 640;
    const int t0 = tile * 32;
    if (h != curh) {
#pragma unroll
      for (int jj = 0; jj < 2; ++jj)
#pragma unroll
        for (int kk = 0; kk < 8; ++kk)
          kf[jj][kk] = *(const bf16x8*)(KB + ((size_t)((h * 2 + pp) * 128 + (nt0 + jj) * 32 + (lane & 31))) * 128 + kk * 16 + (lane >> 5) * 8);
      curh = h;
    }
    f32x16 acc[2];
#pragma unroll
    for (int jj = 0; jj < 2; ++jj)
#pragma unroll
      for (int r = 0; r < 16; ++r) acc[jj][r] = 0.f;
    const bf16_t* qp = Q + (size_t)(t0 + (lane & 31)) * 2048 + h * 256 + pp * 128 + (lane >> 5) * 8;
#pragma unroll
    for (int kk = 0; kk < 8; ++kk) {
      bf16x8 a = *(const bf16x8*)(qp + kk * 16);
      acc[0] = __builtin_amdgcn_mfma_f32_32x32x16_bf16(a, kf[0][kk], acc[0], 0, 0, 0);
      acc[1] = __builtin_amdgcn_mfma_f32_32x32x16_bf16(a, kf[1][kk], acc[1], 0, 0, 0);
    }
#pragma unroll
    for (int jj = 0; jj < 2; ++jj)
#pragma unroll
      for (int r = 0; r < 16; ++r) {
        const int tl = (r & 3) + 8 * (r >> 2) + 4 * (lane >> 5);
        S[tl * SSTR + pp * 128 + (nt0 + jj) * 32 + (lane & 31)] = acc[jj][r];
      }
    __syncthreads();
#pragma unroll 1
    for (int rnd = 0; rnd < 2; ++rnd) {
      const int tl = w * 8 + rnd * 4 + (lane >> 4);
      const float* Sr = S + tl * SSTR;
      unsigned res1, res2;
      top16_row2(Sr, j, res1, res2);
      unsigned ck[4];
#pragma unroll
      for (int sl = 0; sl < 4; ++sl) {
        const float v1 = keyf((unsigned)__shfl((int)res1, rowbase + ca[sl]) & ~0x7Fu);
        const float v2 = keyf((unsigned)__shfl((int)res2, rowbase + cb[sl]) & ~0x7Fu);
        ck[sl] = (fkey(v1 + v2) & ~0xFFu) | (unsigned)(255 - (ca[sl] * 16 + cb[sl]));
      }
      ck[3] = cvalid3 ? ck[3] : 0u;
      unsigned resc = 0;
#pragma unroll 1
      for (int it = 0; it < 16; ++it) {
        const unsigned wm = row_max_u32(umax_(umax_(ck[0], ck[1]), umax_(ck[2], ck[3])));
#pragma unroll
        for (int sl = 0; sl < 4; ++sl) ck[sl] = (ck[sl] == wm) ? 0u : ck[sl];
        resc = (j == it) ? wm : resc;
      }
      const int code = 255 - (int)(resc & 0xFFu);
      const int wa = code >> 4, wb = code & 15;
      const float val = keyf(resc & ~0xFFu);
      const unsigned r1 = (unsigned)__shfl((int)res1, rowbase + wa);
      const unsigned r2 = (unsigned)__shfl((int)res2, rowbase + wb);
      const int i1 = 127 - (int)(r1 & 0x7Fu), i2 = 127 - (int)(r2 & 0x7Fu);
      const float vmax = __shfl(val, rowbase);
      const float e = __expf(val - vmax);
      const float ssum = row16_sum(e);
      const size_t ob = ((size_t)(t0 + tl) * 8 + h) * 16 + j;
      IDX[ob] = i1 * 128 + i2;
      GATE[ob] = e / ssum;
    }
    __syncthreads();
  }
}

typedef __attribute__((ext_vector_type(2))) float f32x2;
__device__ __forceinline__ void peer_phase(const Params& p, int layer, char* smem) {
  const int otid = opaque_tid();
  float* coefs = (float*)smem;
  int* idxs = (int*)(smem + 2048);
  float* sus = (float*)(smem + 4096);
  float* gsv = (float*)(smem + 6144);
  const unsigned char* U6 = (const unsigned char*)(p.ws + (layer ? OFF_TAB1 : OFF_YB));
  const unsigned char* V6 = U6 + (size_t)16384 * 768;
  const float* SCU = (const float*)(p.ws + OFF_SCALE) + (size_t)layer * 32768;
  const float* SCV = SCU + 16384;
  const bf16_t* A = (const bf16_t*)(p.ws + OFF_YF);
  const int* IDX = (const int*)(p.ws + OFF_IDX);
  const float* GATE = (const float*)(p.ws + OFF_GATE);
  const float* MOD = (const float*)(p.ws + OFF_MOD);
  float* X = p.out;
  const int lane = otid & 63;
  const int w = __builtin_amdgcn_readfirstlane(otid >> 6);
  const int sub = lane & 15, rg = lane >> 4;
  const int half = lane >> 5, l31 = lane & 31;
  for (int tok = blockIdx.x * 4 + w; tok < NT; tok += gridDim.x * 4) {
#pragma unroll
    for (int hh = 0; hh < 2; ++hh) {
      const int kk = lane + 64 * hh;
      const int e = IDX[(size_t)tok * 128 + kk];
      const float gk = GATE[(size_t)tok * 128 + kk];
      idxs[w * 128 + kk] = e;
      sus[w * 128 + kk] = SCU[e];
      gsv[w * 128 + kk] = gk * SCV[e];
    }
    float t[64];
    {
      const uint4* ap = (const uint4*)(A + tiled(tok, 64 * sub, 16));
#pragma unroll
      for (int i = 0; i < 8; ++i) {
        const uint4 r0 = ap[i];
#pragma unroll
        for (int q = 0; q < 4; ++q) { t[8 * i + 2 * q] = lo2f(u4get(r0, q)); t[8 * i + 2 * q + 1] = hi2f(u4get(r0, q)); }
      }
    }
    float chain = 0.f;
#pragma unroll 4
    for (int it = 0; it < 32; ++it) {
      const int k = it * 4 + rg;
      const int e = idxs[w * 128 + k];
      const uint4* row = (const uint4*)(U6 + (size_t)e * 768 + sub * 48);
      const uint4 r0 = row[0], r1 = row[1], r2 = row[2];
      u32x6 g0, g1;
      g0[0] = r0.x; g0[1] = r0.y; g0[2] = r0.z; g0[3] = r0.w; g0[4] = r1.x; g0[5] = r1.y;
      g1[0] = r1.z; g1[1] = r1.w; g1[2] = r2.x; g1[3] = r2.y; g1[4] = r2.z; g1[5] = r2.w;
      float acc0 = 0.f, acc1 = 0.f;
      asm volatile("" : "+v"(g0), "+v"(chain));
      {
        const f32x32 d0 = __builtin_amdgcn_cvt_scalef32_pk32_f32_fp6(g0, 1.0f);
#pragma unroll
        for (int j = 0; j < 32; j += 2) { acc0 += d0[j] * t[j]; acc1 += d0[j + 1] * t[j + 1]; }
      }
      asm volatile("" : "+v"(g1), "+v"(acc0), "+v"(acc1));
      {
        const f32x32 d1 = __builtin_amdgcn_cvt_scalef32_pk32_f32_fp6(g1, 1.0f);
#pragma unroll
        for (int j = 0; j < 32; j += 2) { acc0 += d1[j] * t[32 + j]; acc1 += d1[j + 1] * t[32 + j + 1]; }
      }
      chain = acc0 + acc1;
      float acc = row16_sum(chain) * sus[w * 128 + k];
      const float co = 0.5f * acc * (1.f + erff(acc * 0.70710678118654752f)) * gsv[w * 128 + k];
      if (sub == 0) coefs[w * 128 + k] = co;
    }
    f32x32 ov;
#pragma unroll
    for (int i = 0; i < 32; ++i) ov[i] = 0.f;
#pragma unroll 1
    for (int k = 0; k < 128; k += 16) {
      uint2 ra[8], rb[8], rc[8]; float c[8];
#pragma unroll
      for (int j = 0; j < 8; ++j) {
        const int kk = k + 2 * j + half;
        const int e = idxs[w * 128 + kk];
        c[j] = coefs[w * 128 + kk];
        const uint2* rp = (const uint2*)(V6 + (size_t)e * 768 + l31 * 24);
        ra[j] = rp[0]; rb[j] = rp[1]; rc[j] = rp[2];
      }
#pragma unroll
      for (int j = 0; j < 8; ++j) {
        u32x6 g;
        g[0] = ra[j].x; g[1] = ra[j].y; g[2] = rb[j].x; g[3] = rb[j].y; g[4] = rc[j].x; g[5] = rc[j].y;
        asm volatile("" : "+v"(g), "+v"(ov));
        const f32x32 d = __builtin_amdgcn_cvt_scalef32_pk32_f32_fp6(g, 1.0f);
        ov += d * c[j];
      }
    }
    float o[16];
#pragma unroll
    for (int i = 0; i < 16; ++i) {
      const float lo = ov[i] + __shfl_xor(ov[i], 32);
      const float hi = ov[16 + i] + __shfl_xor(ov[16 + i], 32);
      o[i] = half ? hi : lo;
    }
    const int col0 = 32 * l31 + 16 * half;
    const float* gate = MOD + (size_t)(layer * 5 + cidx(tok)) * 6144 + 5 * 1024;
    float xr[16];
    float ss = 0.f;
#pragma unroll
    for (int i = 0; i < 4; ++i) {
      const int col = col0 + 4 * i;
      const float4 xv = *(const float4*)(X + (size_t)tok * 1024 + col);
      const float4 gt = *(const float4*)(gate + col);
      xr[4 * i] = xv.x + gt.x * o[4 * i]; xr[4 * i + 1] = xv.y + gt.y * o[4 * i + 1];
      xr[4 * i + 2] = xv.z + gt.z * o[4 * i + 2]; xr[4 * i + 3] = xv.w + gt.w * o[4 * i + 3];
      ss += xr[4 * i] * xr[4 * i] + xr[4 * i + 1] * xr[4 * i + 1] + xr[4 * i + 2] * xr[4 * i + 2] + xr[4 * i + 3] * xr[4 * i + 3];
    }
    ss = wave_sum(ss);
    const float sc = rsqrtf(ss * (1.f / 1024.f) + 1e-6f);
    if (layer == 0) {
      const float* g1 = p.norm_mix_g + 1024;
      const float* md = MOD + (size_t)(5 + cidx(tok)) * 6144;
      unsigned pk[8];
#pragma unroll
      for (int i = 0; i < 4; ++i) {
        const int col = col0 + 4 * i;
        *(float4*)(X + (size_t)tok * 1024 + col) = make_float4(xr[4 * i], xr[4 * i + 1], xr[4 * i + 2], xr[4 * i + 3]);
        const float4 gg = *(const float4*)(g1 + col);
        const float4 sh = *(const float4*)(md + col);
        const float4 sl = *(const float4*)(md + 1024 + col);
        pk[2 * i] = pack2(xr[4 * i] * sc * gg.x * (1.f + sl.x) + sh.x, xr[4 * i + 1] * sc * gg.y * (1.f + sl.y) + sh.y);
        pk[2 * i + 1] = pack2(xr[4 * i + 2] * sc * gg.z * (1.f + sl.z) + sh.z, xr[4 * i + 3] * sc * gg.w * (1.f + sl.w) + sh.w);
      }
      bf16_t* An = (bf16_t*)(p.ws + OFF_YF) + tiled(tok, col0, 16);
      *(uint4*)(An) = make_uint4(pk[0], pk[1], pk[2], pk[3]);
      *(uint4*)(An + 8) = make_uint4(pk[4], pk[5], pk[6], pk[7]);
    } else {
#pragma unroll
      for (int i = 0; i < 4; ++i) {
        const int col = col0 + 4 * i;
        const float4 gg = *(const float4*)(p.norm_f_g + col);
        *(float4*)(X + (size_t)tok * 1024 + col) = make_float4(xr[4 * i] * sc * gg.x, xr[4 * i + 1] * sc * gg.y, xr[4 * i + 2] * sc * gg.z, xr[4 * i + 3] * sc * gg.w);
      }
    }
  }
}

__device__ __forceinline__ void ssd_conv_phase(const Params& p) {
  const int otid = opaque_tid();
  bf16_t* BIG = (bf16_t*)(p.ws + OFF_BIG);
  const float* cw = p.ssd_conv_w;
  const float* cb = p.ssd_conv_b;
  const int total = 272 * 512;
  for (int it = blockIdx.x * 256 + otid; it < total; it += gridDim.x * 256) {
    const int c8 = it & 511, r = it >> 9;
    const int c = c8 * 8;
    int tok0, len;
    if (r < 16) { tok0 = r * 256; len = 256; } else { tok0 = NCTX + (r - 16) * 64; len = 64; }
    float w0[8], w1[8], w2[8], bb[8];
#pragma unroll
    for (int j = 0; j < 8; ++j) { w0[j] = cw[c + j]; w1[j] = cw[4096 + c + j]; w2[j] = cw[8192 + c + j]; bb[j] = cb[c + j]; }
    bf16_t* base = BIG + (size_t)tok0 * 6144 + 2048 + c;
    uint4 buf[8], nxt[8];
#pragma unroll
    for (int j = 0; j < 8; ++j) buf[j] = *(const uint4*)(base + (size_t)j * 6144);
    uint4 prev = make_uint4(0, 0, 0, 0);
    for (int t0 = 0; t0 < len; t0 += 8) {
      const bool more = (t0 + 8) < len;
#pragma unroll
      for (int j = 0; j < 8; ++j) nxt[j] = more ? *(const uint4*)(base + (size_t)(t0 + 8 + j) * 6144) : make_uint4(0, 0, 0, 0);
#pragma unroll
      for (int j = 0; j < 8; ++j) {
        const uint4 cur = buf[j];
        const uint4 nx = (j < 7) ? buf[j + 1] : nxt[0];
        const unsigned* pp = (const unsigned*)&prev; const unsigned* cp = (const unsigned*)&cur; const unsigned* np = (const unsigned*)&nx;
        unsigned o[4];
#pragma unroll
        for (int q = 0; q < 4; ++q) {
          float a0 = w0[2 * q] * lo2f(pp[q]) + w1[2 * q] * lo2f(cp[q]) + w2[2 * q] * lo2f(np[q]) + bb[2 * q];
          float a1 = w0[2 * q + 1] * hi2f(pp[q]) + w1[2 * q + 1] * hi2f(cp[q]) + w2[2 * q + 1] * hi2f(np[q]) + bb[2 * q + 1];
          o[q] = pack2(siluf(a0), siluf(a1));
        }
        *(uint4*)(base + (size_t)(t0 + j) * 6144) = make_uint4(o[0], o[1], o[2], o[3]);
        prev = cur;
      }
#pragma unroll
      for (int j = 0; j < 8; ++j) buf[j] = nxt[j];
    }
  }
}

#define XT_STR 72
#define HB_STR 136
#define SCAN_LOAD_FRAGS(CC) { \
      { const int t_ = (CC) * 64 + 32 * it + l31; const int tok_ = tok0 + (dir ? L - 1 - t_ : t_); \
        const bf16_t* cp_ = BIG + (size_t)tok_ * 6144 + 5120 + g * 128 + 8 * h5; \
        _Pragma("unroll") for (int kk = 0; kk < 8; ++kk) cfr[kk] = *(const bf16x8*)(cp_ + 16 * kk); } \
      if (jt <= it) { const int t_ = (CC) * 64 + 32 * jt + l31; const int tok_ = tok0 + (dir ? L - 1 - t_ : t_); \
        const bf16_t* bp_ = BIG + (size_t)tok_ * 6144 + 4096 + g * 128 + 8 * h5; \
        _Pragma("unroll") for (int kk = 0; kk < 8; ++kk) bfr[kk] = *(const bf16x8*)(bp_ + 16 * kk); } }
#define SCAN_LOAD_STAGE(CC) { \
      const int t_ = (CC) * 64 + lane; const int tok_ = tok0 + (dir ? L - 1 - t_ : t_); \
      const bf16_t* rowp_ = BIG + (size_t)tok_ * 6144; \
      _Pragma("unroll") for (int r = 0; r < 2; ++r) sx[r] = *(const uint4*)(rowp_ + 2048 + head * 64 + (w + 4 * r) * 8); \
      _Pragma("unroll") for (int r = 0; r < 4; ++r) sb[r] = *(const uint4*)(rowp_ + 4096 + g * 128 + (w + 4 * r) * 8); \
      sdt = DT[(size_t)tok_ * 64 + dir * 32 + head]; }
__device__ __forceinline__ void scan_phase(const Params& p, char* smem) {
  const int otid = opaque_tid();
  bf16_t* XTd = (bf16_t*)smem;
  bf16_t* BTs = XTd + 64 * XT_STR;
  bf16_t* Ms = BTs + 128 * XT_STR;
  bf16_t* Hb = Ms + 64 * XT_STR;
  float* cumS = (float*)(Hb + 2 * 64 * HB_STR);
  const bf16_t* BIG = (const bf16_t*)(p.ws + OFF_BIG);
  const float* DT = (const float*)(p.ws + OFF_DT);
  const int tid = otid, lane = tid & 63;
  const int w = __builtin_amdgcn_readfirstlane(tid >> 6);
  const int h5 = lane >> 5, l31 = lane & 31;
  const int it = w >> 1, jt = w & 1, pt = w & 1, nt0 = (w >> 1) * 2;
  int item0, istride;
  if (gridDim.x >= 512) { if (blockIdx.x < 256) { item0 = blockIdx.x; istride = 1 << 28; } else { item0 = blockIdx.x; istride = gridDim.x - 256; } }
  else { item0 = blockIdx.x; istride = gridDim.x; }
  for (int item = item0; item < 1280; item += istride) {
    int b, head, dir, L, tok0;
    const bool latent = item < 256;
    if (latent) { b = item >> 6; head = (item >> 1) & 31; dir = item & 1; L = 4096; tok0 = NCTX + b * 4096; }
    else { int jj = item - 256; b = jj >> 6; head = (jj >> 1) & 31; dir = jj & 1; L = 256; tok0 = b * 256; }
    const int g = head >> 2;
    const float a = -expf(p.ssd_a_log[dir * 32 + head]);
    bf16_t* Y = (bf16_t*)(p.ws + (dir ? OFF_YB : OFF_YF));
    f32x16 st[2];
    const size_t sbase = ((size_t)((b * 2 + dir) * 32 + head)) * 8192;
    const int loff = (32 * pt + 4 * h5) * 128 + 32 * nt0 + l31;
    if (latent) {
      const float* sp = p.state_ssm + sbase + loff;
#pragma unroll
      for (int q = 0; q < 2; ++q)
#pragma unroll
        for (int r = 0; r < 16; ++r) st[q][r] = sp[((r & 3) + 8 * (r >> 2)) * 128 + 32 * q];
    } else {
#pragma unroll
      for (int q = 0; q < 2; ++q)
#pragma unroll
        for (int r = 0; r < 16; ++r) st[q][r] = 0.f;
    }
    {
      bf16_t* hb0 = Hb + (32 * pt + 4 * h5) * HB_STR + 32 * nt0 + l31;
#pragma unroll
      for (int q = 0; q < 2; ++q)
#pragma unroll
        for (int r = 0; r < 16; ++r) hb0[((r & 3) + 8 * (r >> 2)) * HB_STR + 32 * q] = f2bf(st[q][r]);
    }
    __syncthreads();
    const int nchunks = L >> 6;
    uint4 sx[2], sb[4];
    float sdt;
    SCAN_LOAD_STAGE(0)
    bf16x8 cfr[8], bfr[8];
    SCAN_LOAD_FRAGS(0)
#pragma nounroll
    for (int c = 0; c < nchunks; ++c) {
      const int cur = c & 1;
      __builtin_amdgcn_sched_barrier(0);
      float cum = sdt * a;
#pragma unroll
      for (int off = 1; off < 64; off <<= 1) {
        const float tv = __shfl_up(cum, off);
        cum += (lane >= off) ? tv : 0.f;
      }
      const float cum_last = __shfl(cum, 63);
      const float wj = __expf(cum_last - cum);
      if (w == 0) cumS[cur * 64 + lane] = cum;
#pragma unroll
      for (int r = 0; r < 2; ++r) {
        const int p8 = (w + 4 * r) * 8;
#pragma unroll
        for (int q = 0; q < 4; ++q) {
          const unsigned u = u4get(sx[r], q);
          XTd[(p8 + 2 * q) * XT_STR + lane] = f2bf(sdt * lo2f(u));
          XTd[(p8 + 2 * q + 1) * XT_STR + lane] = f2bf(sdt * hi2f(u));
        }
      }
#pragma unroll
      for (int r = 0; r < 4; ++r) {
        const int n8 = (w + 4 * r) * 8;
#pragma unroll
        for (int q = 0; q < 4; ++q) {
          const unsigned u = u4get(sb[r], q);
          BTs[(n8 + 2 * q) * XT_STR + lane] = f2bf(wj * lo2f(u));
          BTs[(n8 + 2 * q + 1) * XT_STR + lane] = f2bf(wj * hi2f(u));
        }
      }
      if (c + 1 < nchunks) SCAN_LOAD_STAGE(c + 1)
      __builtin_amdgcn_sched_barrier(0);
      f32x16 cb;
#pragma unroll
      for (int r = 0; r < 16; ++r) cb[r] = 0.f;
      if (jt <= it) {
#pragma unroll
        for (int kk = 0; kk < 8; ++kk) cb = __builtin_amdgcn_mfma_f32_32x32x16_bf16(cfr[kk], bfr[kk], cb, 0, 0, 0);
      }
      __builtin_amdgcn_sched_barrier(0);
      f32x16 yo;
#pragma unroll
      for (int r = 0; r < 16; ++r) yo[r] = 0.f;
      {
        const bf16_t* hp = Hb + cur * 64 * HB_STR + (32 * pt + l31) * HB_STR + 8 * h5;
#pragma unroll
        for (int kk = 0; kk < 8; ++kk) {
          const bf16x8 hf = *(const bf16x8*)(hp + 16 * kk);
          yo = __builtin_amdgcn_mfma_f32_32x32x16_bf16(cfr[kk], hf, yo, 0, 0, 0);
        }
      }
      __builtin_amdgcn_sched_barrier(0);
      if (c + 1 < nchunks) SCAN_LOAD_FRAGS(c + 1)
      __syncthreads();
      __builtin_amdgcn_sched_barrier(0);
      const float dec = __expf(cum_last);
      bf16x8 xf[4];
#pragma unroll
      for (int kk = 0; kk < 4; ++kk) xf[kk] = *(const bf16x8*)(XTd + (32 * pt + l31) * XT_STR + 16 * kk + 8 * h5);
#pragma unroll
      for (int q = 0; q < 2; ++q) {
#pragma unroll
        for (int r = 0; r < 16; ++r) st[q][r] *= dec;
#pragma unroll
        for (int kk = 0; kk < 4; ++kk) {
          const bf16x8 bt = *(const bf16x8*)(BTs + (32 * (nt0 + q) + l31) * XT_STR + 16 * kk + 8 * h5);
          st[q] = __builtin_amdgcn_mfma_f32_32x32x16_bf16(xf[kk], bt, st[q], 0, 0, 0);
        }
        {
          bf16_t* hbw = Hb + (cur ^ 1) * 64 * HB_STR + (32 * pt + 4 * h5) * HB_STR + 32 * (nt0 + q) + l31;
#pragma unroll
          for (int r = 0; r < 16; ++r) hbw[((r & 3) + 8 * (r >> 2)) * HB_STR] = f2bf(st[q][r]);
        }
      }
      __builtin_amdgcn_sched_barrier(0);
      if (jt <= it) {
        const int jj = 32 * jt + l31;
        const float cj = cumS[cur * 64 + jj];
        const int ib = 32 * it + 4 * h5;
        const float* cs = cumS + cur * 64 + ib;
        bf16_t* mw = Ms + ib * XT_STR + jj;
#pragma unroll
        for (int r = 0; r < 16; ++r) {
          const int ro = (r & 3) + 8 * (r >> 2);
          const float m = (jj <= ib + ro) ? cb[r] * __expf(cs[ro] - cj) : 0.f;
          mw[ro * XT_STR] = f2bf(m);
        }
      }
      __syncthreads();
      __builtin_amdgcn_sched_barrier(0);
      f32x16 yd;
#pragma unroll
      for (int r = 0; r < 16; ++r) yd[r] = 0.f;
#pragma unroll
      for (int kk = 0; kk < 4; ++kk) {
        if (kk < 2 * (it + 1)) {
          const bf16x8 mf = *(const bf16x8*)(Ms + (32 * it + l31) * XT_STR + 16 * kk + 8 * h5);
          yd = __builtin_amdgcn_mfma_f32_32x32x16_bf16(mf, xf[kk], yd, 0, 0, 0);
        }
      }
      {
        const int t0c = c * 64 + 32 * it + 4 * h5;
        const int tokb = tok0 + (dir ? L - 1 - t0c : t0c);
        const int rs = dir ? -64 : 64;
        bf16_t* yp = Y + ((size_t)(tokb >> 7) * 32 + head) * 8192 + (tokb & 127) * 64 + 32 * pt + l31;
        const float* cs = cumS + cur * 64 + 32 * it + 4 * h5;
#pragma unroll
        for (int r = 0; r < 16; ++r) {
          const int ro = (r & 3) + 8 * (r >> 2);
          const float yv = yd[r] + __expf(cs[ro]) * yo[r];
          yp[(ptrdiff_t)rs * ro] = f2bf(yv);
        }
      }
    }
    if (!latent) {
      float* sp = p.out + (size_t)NT * 1024 + sbase + loff;
#pragma unroll
      for (int q = 0; q < 2; ++q)
#pragma unroll
        for (int r = 0; r < 16; ++r) sp[((r & 3) + 8 * (r >> 2)) * 128 + 32 * q] = st[q][r];
    }
    __syncthreads();
  }
}

__device__ __forceinline__ void gate_norm_phase(const Params& p) {
  const int otid = opaque_tid();
  const bf16_t* BIG = (const bf16_t*)(p.ws + OFF_BIG);
  bf16_t* YF = (bf16_t*)(p.ws + OFF_YF);
  const bf16_t* YB = (const bf16_t*)(p.ws + OFF_YB);
  const int lane = otid & 63, w = otid >> 6;
  for (int tok = blockIdx.x * 4 + w; tok < NT; tok += gridDim.x * 4) {
    float v[32];
    float ss = 0.f;
#pragma unroll
    for (int i = 0; i < 4; ++i) {
      const int col = lane * 8 + 512 * i;
      const int head = col >> 6;
      const float dtot = p.ssd_d[head] + p.ssd_d[32 + head];
      uint4 a = *(const uint4*)(YF + tiled(tok, col, 32));
      uint4 b = *(const uint4*)(YB + tiled(tok, col, 32));
      uint4 x = *(const uint4*)(BIG + (size_t)tok * 6144 + 2048 + col);
      uint4 z = *(const uint4*)(BIG + (size_t)tok * 6144 + col);
#pragma unroll
      for (int q = 0; q < 4; ++q) {
        const unsigned aq = u4get(a, q), bq = u4get(b, q), xq = u4get(x, q), zq = u4get(z, q);
        float y0 = lo2f(aq) + lo2f(bq) + dtot * lo2f(xq);
        float y1 = hi2f(aq) + hi2f(bq) + dtot * hi2f(xq);
        y0 *= siluf(lo2f(zq));
        y1 *= siluf(hi2f(zq));
        v[8 * i + 2 * q] = y0; v[8 * i + 2 * q + 1] = y1;
        ss += y0 * y0 + y1 * y1;
      }
      __builtin_amdgcn_sched_barrier(0);
    }
    ss = wave_sum(ss);
    const float sc = rsqrtf(ss * (1.f / 2048.f) + 1e-6f);
#pragma unroll
    for (int i = 0; i < 4; ++i) {
      const int col = lane * 8 + 512 * i;
      float4 g0 = *(const float4*)(p.ssd_norm_g + col), g1 = *(const float4*)(p.ssd_norm_g + col + 4);
      uint4 o;
      o.x = pack2(v[8 * i] * sc * g0.x, v[8 * i + 1] * sc * g0.y);
      o.y = pack2(v[8 * i + 2] * sc * g0.z, v[8 * i + 3] * sc * g0.w);
      o.z = pack2(v[8 * i + 4] * sc * g1.x, v[8 * i + 5] * sc * g1.y);
      o.w = pack2(v[8 * i + 6] * sc * g1.z, v[8 * i + 7] * sc * g1.w);
      *(uint4*)(YF + tiled(tok, col, 32)) = o;
    }
  }
}

__device__ __forceinline__ void final_norm_phase(const Params& p) {
  const int otid = opaque_tid();
  const int lane = otid & 63, w = otid >> 6;
  for (int tok = blockIdx.x * 4 + w; tok < NT; tok += gridDim.x * 4) {
    float* xr = p.out + (size_t)tok * 1024;
    float4 v[4];
    float ss = 0.f;
#pragma unroll
    for (int i = 0; i < 4; ++i) {
      v[i] = *(const float4*)(xr + lane * 4 + 256 * i);
      ss += v[i].x * v[i].x + v[i].y * v[i].y + v[i].z * v[i].z + v[i].w * v[i].w;
    }
    ss = wave_sum(ss);
    const float sc = rsqrtf(ss * (1.f / 1024.f) + 1e-6f);
#pragma unroll
    for (int i = 0; i < 4; ++i) {
      const int col = lane * 4 + 256 * i;
      float4 gg = *(const float4*)(p.norm_f_g + col);
      *(float4*)(xr + col) = make_float4(v[i].x * sc * gg.x, v[i].y * sc * gg.y, v[i].z * sc * gg.z, v[i].w * sc * gg.w);
    }
  }
}


#define XB_TMO      128
#define XB_XCNT(j)  (256  + 64 * (j))
#define XB_XSUB(j)  (1280 + 64 * (j))
#define XB_XGEN(j)  (2304 + 64 * (j))
#define XB_TOP      3328
#define XB_TOPGEN   3392
#define XCD_BAR_WORDS 3456
#define XB_SPIN_CAP (1u << 22)
#define LAS __attribute__((address_space(3)))
__device__ __forceinline__ unsigned xb_ld(unsigned* p) { return __hip_atomic_load(p, __ATOMIC_RELAXED, __HIP_MEMORY_SCOPE_AGENT); }
__device__ __forceinline__ unsigned xb_add(unsigned* p, unsigned v) { return __hip_atomic_fetch_add(p, v, __ATOMIC_RELAXED, __HIP_MEMORY_SCOPE_AGENT); }
__device__ __forceinline__ unsigned xb_xcc_id() { return (unsigned)__builtin_amdgcn_s_getreg((3 << 11) | 20) & 0xFu; }
#define XB_SPIN(cond, bar) do { unsigned _sp = 0; while (cond) { __builtin_amdgcn_s_sleep(1); \
    if ((++_sp & 255u) == 0u) { if (xb_ld(&(bar)[XB_TMO])) break; if (_sp > XB_SPIN_CAP) { atomicAdd(&(bar)[XB_TMO], 1u); break; } } } } while (0)
struct XcdBarrier { unsigned* bar; unsigned x; volatile LAS unsigned* st; };
__device__ __forceinline__ XcdBarrier xcd_barrier_post(unsigned* bar, volatile LAS unsigned* st) {
  XcdBarrier b; b.bar = bar; b.x = xb_xcc_id(); b.st = st;
  if (threadIdx.x == 0) (void)xb_add(&bar[XB_XCNT(b.x)], 1u);
  return b;
}
__device__ __forceinline__ void xcd_barrier_complete(unsigned* bar, unsigned x, unsigned& nloc, unsigned& nx) {
  const unsigned G = gridDim.x * gridDim.y * gridDim.z;
  unsigned sum, cnt, mine, sp = 0u;
  for (;;) {
    sum = 0u; cnt = 0u; mine = 0u;
#pragma unroll
    for (unsigned j = 0; j < 16; ++j) { const unsigned c = xb_ld(&bar[XB_XCNT(j)]); sum += c; cnt += (c > 0u) ? 1u : 0u; mine = (j == x) ? c : mine; }
    if (sum == G) break;
    __builtin_amdgcn_s_sleep(1);
    if ((++sp & 255u) == 0u) { if (xb_ld(&bar[XB_TMO])) break; if (sp > XB_SPIN_CAP) { atomicAdd(&bar[XB_TMO], 1u); break; } }
  }
  nloc = mine > 0u ? mine : 1u; nx = cnt > 0u ? cnt : 1u;
}
__device__ __forceinline__ void xcd_barrier(const XcdBarrier& b) {
  asm volatile("s_waitcnt vmcnt(0)" ::: "memory");
  __syncthreads();
  if (threadIdx.x == 0) {
    unsigned* bar = b.bar;
    __builtin_amdgcn_s_waitcnt(0);
    unsigned nloc = b.st[0], nx = b.st[1];
    if (nloc == 0u) { xcd_barrier_complete(bar, b.x, nloc, nx); b.st[0] = nloc; b.st[1] = nx; }
    const unsigned old = xb_add(&bar[XB_XSUB(b.x)], 1u);
    const unsigned gen = old / nloc;
    if (old + 1u == (gen + 1u) * nloc) {
      __builtin_amdgcn_fence(__ATOMIC_RELEASE, "agent");
      asm volatile("s_waitcnt vmcnt(0)" ::: "memory");
      const unsigned og = xb_add(&bar[XB_TOP], 1u);
      const unsigned tg = og / nx;
      if (og + 1u == (tg + 1u) * nx) xb_add(&bar[XB_TOPGEN], 1u);
      else XB_SPIN(xb_ld(&bar[XB_TOPGEN]) == tg, bar);
      __builtin_amdgcn_fence(__ATOMIC_ACQUIRE, "agent");
      xb_add(&bar[XB_XGEN(b.x)], 1u);
      asm volatile("s_waitcnt vmcnt(0)" ::: "memory");
    } else {
      XB_SPIN(xb_ld(&bar[XB_XGEN(b.x)]) == gen, bar);
      __builtin_amdgcn_fence(__ATOMIC_ACQUIRE, "agent");
      asm volatile("s_waitcnt vmcnt(0)" ::: "memory");
    }
  }
  __syncthreads();
}

#define N_PHASES 19
__global__ void __launch_bounds__(256, 2) mk(Params p, int ph_begin, int ph_end) {
  __shared__ __attribute__((aligned(16))) char smem[SMEM_BYTES];
  __shared__ uint4 xb_words;
  const bool multi = (ph_end - ph_begin) > 1;
  if (threadIdx.x == 0) xb_words = make_uint4(0u, 0u, 0u, 0u);
  __syncthreads();
  XcdBarrier xb;
  xb.bar = (unsigned*)(p.ws + OFF_BAR); xb.x = 0; xb.st = (volatile LAS unsigned*)&xb_words;
  if (multi) xb = xcd_barrier_post((unsigned*)(p.ws + OFF_BAR), (volatile LAS unsigned*)&xb_words);
  if (ph_begin < 0) cg::this_grid().sync();
  bf16_t* WT = (bf16_t*)(p.ws + OFF_WT);
  bf16_t* BIG = (bf16_t*)(p.ws + OFF_BIG);
  bf16_t* Abuf = (bf16_t*)(p.ws + OFF_YF);
  float* MOD = (float*)(p.ws + OFF_MOD);
#define RUN(PH, CALL) if (ph_begin <= PH && PH < ph_end) { CALL; if (PH + 1 < ph_end) xcd_barrier(xb); }
  RUN(0, prep_phase(p, smem))
  RUN(1, norm_mod_phase(p, 0, 0, true))
  RUN(2, gemm_phase(Abuf, WT + WT_SCIN, NT, 3072, 1024, EpiBf16{BIG, 3072}, smem))
  RUN(3, conv_gate_phase(p))
  RUN(4, gemm_phase((const bf16_t*)(p.ws + OFF_BIG + 120 * MIB), WT + WT_SCOUT, NT, 1024, 1024,
                    EpiRes{p.x_prompt, p.x_sample, p.out, MOD + 0 * 5 * 6144 + 2 * 1024}, smem))
  RUN(5, norm_mod_phase(p, 0, 1, false))
  RUN(6, gemm_phase(Abuf, WT + WT_WQ, NT, 2048, 1024, EpiBf16{BIG, 2048}, smem))
  RUN(7, topk_phase(p, 0, smem))
  RUN(8, peer_phase(p, 0, smem))
  RUN(10, gemm_phase(Abuf, WT + WT_SSDIN, NT, 6208, 1024, EpiSsdIn{BIG, (float*)(p.ws + OFF_DT), p.ssd_dt_bias}, smem))
  RUN(11, ssd_conv_phase(p))
  RUN(12, scan_phase(p, smem))
  RUN(13, gate_norm_phase(p))
  RUN(14, gemm_phase(Abuf, WT + WT_SSDOUT, NT, 1024, 2048,
                     EpiRes{p.out, p.out + (size_t)NCTX * 1024, p.out, MOD + 1 * 5 * 6144 + 2 * 1024}, smem))
  RUN(15, norm_mod_phase(p, 1, 1, false))
  RUN(16, gemm_phase(Abuf, WT + WT_WQ + (size_t)2048 * 1024, NT, 2048, 1024, EpiBf16{BIG, 2048}, smem))
  RUN(17, topk_phase(p, 1, smem))
  RUN(18, peer_phase(p, 1, smem))
}

extern "C" void kernel_launch(void* const* d_in, const int* in_sizes, int n_in, void* d_out, int out_size, void* d_ws, size_t ws_size,
                              hipStream_t stream) {
  static int grid_blocks = 0;
  if (!grid_blocks) {
    int dev = 0, cus = 0, per_cu = 0;
    hipGetDevice(&dev);
    hipDeviceGetAttribute(&cus, hipDeviceAttributeMultiprocessorCount, dev);
    hipOccupancyMaxActiveBlocksPerMultiprocessor(&per_cu, mk, 256, 0);
    if (per_cu < 1) per_cu = 1;
    if (per_cu > 2) per_cu = 2;
    grid_blocks = cus * per_cu;
  }
  if (ws_size < WS_NEEDED) { fprintf(stderr, "workspace too small: %zu\n", ws_size); return; }
  Params p{};
  const float** pf = (const float**)&p;
  for (int i = 0; i < 25; ++i) pf[i] = (const float*)d_in[i];
  p.out = (float*)d_out;
  p.ws = (char*)d_ws;
#if COOP
  hipMemsetAsync((char*)d_ws + OFF_BAR, 0, 16384, stream);
  int b = 0, e = N_PHASES;
  void* args[] = {&p, &b, &e};
  hipError_t err = hipLaunchCooperativeKernel((void*)mk, dim3(grid_blocks), dim3(256), args, 0, stream);
  if (err != hipSuccess) fprintf(stderr, "cooperative launch failed: %s (grid %d)\n", hipGetErrorString(err), grid_blocks);
#else
  for (int ph = 0; ph < N_PHASES; ++ph) {
    hipLaunchKernelGGL(mk, dim3(grid_blocks), dim3(256), 0, stream, p, ph, ph + 1);
    if ((DUP_MASK >> ph) & 1) hipLaunchKernelGGL(mk, dim3(grid_blocks), dim3(256), 0, stream, p, ph, ph + 1);
  }
#endif
}
```

```cpp
#include <hip/hip_runtime.h>
#include <hip/hip_cooperative_groups.h>
#include <cstdio>
namespace cg = cooperative_groups;

#ifndef COOP
#define COOP 1
#endif
#ifndef DUP_MASK
#define DUP_MASK 0
#endif

typedef unsigned short bf16_t;
typedef __attribute__((ext_vector_type(8))) short bf16x8;
typedef __attribute__((ext_vector_type(16))) float f32x16;
typedef __attribute__((ext_vector_type(32))) float f32x32;
typedef __attribute__((ext_vector_type(6))) unsigned u32x6;

#define NT 20480
#define NCTX 4096
#define DM 1024
#define MIB ((size_t)1 << 20)
#define OFF_BIG   ((size_t)0)
#define OFF_YF    (240 * MIB)
#define OFF_YB    (320 * MIB)
#define OFF_WT    (400 * MIB)
#define OFF_KEYSB (433 * MIB)
#define OFF_DT    (434 * MIB)
#define OFF_MOD   (439 * MIB)
#define OFF_IDX   (440 * MIB)
#define OFF_GATE  (450 * MIB)
#define OFF_TAB1  (460 * MIB)
#define OFF_SCALE (492 * MIB)
#define OFF_BAR   (493 * MIB)
#define WS_NEEDED (494 * MIB)
#define WT_SCIN   ((size_t)0)
#define WT_SCOUT  (WT_SCIN + (size_t)3072 * 1024)
#define WT_SSDIN  (WT_SCOUT + (size_t)1024 * 1024)
#define WT_SSDOUT (WT_SSDIN + (size_t)6272 * 1024)
#define WT_WQ     (WT_SSDOUT + (size_t)1024 * 2048)

#define SMEM_BYTES 75776

struct Params {
  const float *x_prompt, *x_sample, *state_ssm, *c, *c_ctx, *norm_mix_g, *norm_ffn_g, *norm_f_g, *ada_w, *ada_b;
  const float *sc_w_in, *sc_conv_w, *sc_w_out, *ssd_w_in, *ssd_conv_w, *ssd_conv_b, *ssd_dt_bias, *ssd_a_log, *ssd_d;
  const float *ssd_norm_g, *ssd_w_out, *peer_wq, *peer_keys, *peer_u, *peer_v;
  float* out;
  char* ws;
};

__device__ __forceinline__ float bf2f(bf16_t h) { return __uint_as_float(((unsigned)h) << 16); }
__device__ __forceinline__ bf16_t f2bf(float f) {
  unsigned u = __float_as_uint(f);
  u += 0x7FFFu + ((u >> 16) & 1u);
  return (bf16_t)(u >> 16);
}
__device__ __forceinline__ unsigned pack2(float a, float b) { return (unsigned)f2bf(a) | ((unsigned)f2bf(b) << 16); }
__device__ __forceinline__ float lo2f(unsigned u) { return __uint_as_float(u << 16); }
__device__ __forceinline__ float hi2f(unsigned u) { return __uint_as_float(u & 0xffff0000u); }
__device__ __forceinline__ unsigned u4get(const uint4 v, const int q) { return q == 0 ? v.x : (q == 1 ? v.y : (q == 2 ? v.z : v.w)); }
__device__ __forceinline__ int opaque_tid() { int t = threadIdx.x; asm volatile("" : "+v"(t)); return t; }
__device__ __forceinline__ size_t tiled(int row, int col, int KT) { return ((size_t)(row >> 7) * KT + (col >> 6)) * 8192 + (row & 127) * 64 + (col & 63); }
__device__ __forceinline__ float siluf(float x) { return x / (1.f + __expf(-x)); }
__device__ __forceinline__ int cidx(int tok) { return tok < NCTX ? 0 : 1 + ((tok - NCTX) >> 12); }

template <int CTRL>
__device__ __forceinline__ unsigned dpp_u(unsigned v) {
  return (unsigned)__builtin_amdgcn_update_dpp(0, (int)v, CTRL, 0xF, 0xF, true);
}
template <int CTRL>
__device__ __forceinline__ float dpp_f(float v) {
  return __int_as_float(__builtin_amdgcn_update_dpp(0, __float_as_int(v), CTRL, 0xF, 0xF, true));
}
__device__ __forceinline__ float row16_sum(float v) {
  v += dpp_f<0xB1>(v);
  v += dpp_f<0x4E>(v);
  v += dpp_f<0x141>(v);
  v += dpp_f<0x140>(v);
  return v;
}
__device__ __forceinline__ unsigned umax_(unsigned a, unsigned b) { return a > b ? a : b; }
__device__ __forceinline__ unsigned row_max_u32(unsigned v) {
  v = umax_(v, dpp_u<0xB1>(v));
  v = umax_(v, dpp_u<0x4E>(v));
  v = umax_(v, dpp_u<0x141>(v));
  v = umax_(v, dpp_u<0x140>(v));
  return v;
}
__device__ __forceinline__ unsigned wave_max_u32(unsigned v) {
  v = umax_(v, dpp_u<0xB1>(v));
  v = umax_(v, dpp_u<0x4E>(v));
  v = umax_(v, dpp_u<0x141>(v));
  v = umax_(v, dpp_u<0x140>(v));
  unsigned a = (unsigned)__builtin_amdgcn_readlane((int)v, 0);
  unsigned b = (unsigned)__builtin_amdgcn_readlane((int)v, 16);
  unsigned c = (unsigned)__builtin_amdgcn_readlane((int)v, 32);
  unsigned d = (unsigned)__builtin_amdgcn_readlane((int)v, 48);
  return umax_(umax_(a, b), umax_(c, d));
}
__device__ __forceinline__ float wave_sum(float v) {
  v = row16_sum(v);
  float a, b, c, d;
  a = __int_as_float(__builtin_amdgcn_readlane(__float_as_int(v), 0));
  b = __int_as_float(__builtin_amdgcn_readlane(__float_as_int(v), 16));
  c = __int_as_float(__builtin_amdgcn_readlane(__float_as_int(v), 32));
  d = __int_as_float(__builtin_amdgcn_readlane(__float_as_int(v), 48));
  return (a + b) + (c + d);
}
__device__ __forceinline__ unsigned fkey(float f) {
  unsigned u = __float_as_uint(f);
  return (u & 0x80000000u) ? ~u : (u | 0x80000000u);
}
__device__ __forceinline__ float keyf(unsigned k) {
  unsigned u = (k & 0x80000000u) ? (k & 0x7fffffffu) : ~k;
  return __uint_as_float(u);
}

__device__ __forceinline__ void transpose_tile(const float* __restrict__ src, int K, int N, bf16_t* __restrict__ dst, int tile, float* tb) {
  const int tid = threadIdx.x;
  const int ntn = N >> 6;
  const int kt = tile / ntn, nt = tile % ntn;
  {
    const int n = tid & 63, kb = tid >> 6;
#pragma unroll
    for (int i = 0; i < 16; ++i) {
      int k = kb + 4 * i;
      tb[k * 65 + n] = src[(size_t)(kt * 64 + k) * N + nt * 64 + n];
    }
  }
  __syncthreads();
  {
    const int k8 = (tid & 7) * 8;
#pragma unroll
    for (int pass = 0; pass < 2; ++pass) {
      int n = (tid >> 3) + 32 * pass;
      uint4 o;
      o.x = pack2(tb[(k8 + 0) * 65 + n], tb[(k8 + 1) * 65 + n]);
      o.y = pack2(tb[(k8 + 2) * 65 + n], tb[(k8 + 3) * 65 + n]);
      o.z = pack2(tb[(k8 + 4) * 65 + n], tb[(k8 + 5) * 65 + n]);
      o.w = pack2(tb[(k8 + 6) * 65 + n], tb[(k8 + 7) * 65 + n]);
      *(uint4*)(dst + tiled(nt * 64 + n, kt * 64 + k8, K >> 6)) = o;
    }
  }
  __syncthreads();
}

__device__ __forceinline__ void prep_phase(const Params& p, char* smem) {
  const int otid = opaque_tid();
  const int tid = otid;
  bf16_t* WT = (bf16_t*)(p.ws + OFF_WT);
  float* MOD = (float*)(p.ws + OFF_MOD);
  bf16_t* KEYSB = (bf16_t*)(p.ws + OFF_KEYSB);
  const int U_MOD = 192, U_T0 = 768, U_T1 = 256, U_T2 = 1552, U_T3 = 512, U_T4 = 1024, U_KEYS = 256, U_TAB = 8192;
  const int total = U_MOD + U_T0 + U_T1 + U_T2 + U_T3 + U_T4 + U_KEYS + U_TAB;
  for (int u = blockIdx.x; u < total; u += gridDim.x) {
    int v = u;
    if (v < U_MOD) {
      float* scond = (float*)smem;
      float* red = scond + 5 * 1024;
      for (int i = tid; i < 5 * 1024; i += 256) {
        int r = i >> 10, k = i & 1023;
        float cv = (r == 0) ? p.c_ctx[k] : p.c[(r - 1) * 1024 + k];
        scond[i] = siluf(cv);
      }
      __syncthreads();
      const int l = v / 96, jc = v % 96;
      const int jj = tid & 63, kq = tid >> 6;
      const int j = jc * 64 + jj;
      float acc[5] = {0.f, 0.f, 0.f, 0.f, 0.f};
      const float* wp = p.ada_w + ((size_t)l * 1024 + kq * 256) * 6144 + j;
#pragma unroll 8
      for (int k = 0; k < 256; ++k) {
        float wv = wp[(size_t)k * 6144];
#pragma unroll
        for (int r = 0; r < 5; ++r) acc[r] += scond[r * 1024 + kq * 256 + k] * wv;
      }
#pragma unroll
      for (int r = 0; r < 5; ++r) red[(kq * 5 + r) * 64 + jj] = acc[r];
      __syncthreads();
      for (int i = tid; i < 320; i += 256) {
        int r = i >> 6, j2 = i & 63;
        float s = red[(0 * 5 + r) * 64 + j2] + red[(1 * 5 + r) * 64 + j2] + red[(2 * 5 + r) * 64 + j2] + red[(3 * 5 + r) * 64 + j2];
        MOD[(size_t)(l * 5 + r) * 6144 + jc * 64 + j2] = s + p.ada_b[l * 6144 + jc * 64 + j2];
      }
      __syncthreads();
      continue;
    }
    v -= U_MOD;
    float* tb = (float*)smem;
    if (v < U_T0) { transpose_tile(p.sc_w_in, 1024, 3072, WT + WT_SCIN, v, tb); continue; }
    v -= U_T0;
    if (v < U_T1) { transpose_tile(p.sc_w_out, 1024, 1024, WT + WT_SCOUT, v, tb); continue; }
    v -= U_T1;
    if (v < U_T2) { transpose_tile(p.ssd_w_in, 1024, 6208, WT + WT_SSDIN, v, tb); continue; }
    v -= U_T2;
    if (v < U_T3) { transpose_tile(p.ssd_w_out, 2048, 1024, WT + WT_SSDOUT, v, tb); continue; }
    v -= U_T3;
    if (v < U_T4) {
      int l = v >> 9, t = v & 511;
      transpose_tile(p.peer_wq + (size_t)l * 1024 * 2048, 1024, 2048, WT + WT_WQ + (size_t)l * 2048 * 1024, t, tb);
      continue;
    }
    v -= U_T4;
    if (v < U_KEYS) {
      size_t base = (size_t)v * 2048 + tid * 8;
      float4 a = *(const float4*)(p.peer_keys + base);
      float4 b = *(const float4*)(p.peer_keys + base + 4);
      uint4 o;
      o.x = pack2(a.x, a.y); o.y = pack2(a.z, a.w); o.z = pack2(b.x, b.y); o.w = pack2(b.z, b.w);
      *(uint4*)(KEYSB + base) = o;
      continue;
    }
    v -= U_KEYS;
    {
      const int lane = tid & 63, l31 = lane & 31;
      const int gr = v * 8 + (tid >> 6) * 2 + (lane >> 5);
      const int l = gr >> 15, tab = (gr >> 14) & 1, row = gr & 16383;
      const float* src = (tab ? p.peer_v : p.peer_u) + ((size_t)l * 16384 + row) * 1024 + l31 * 32;
      float4 x[8];
      float am = 0.f;
#pragma unroll
      for (int j = 0; j < 8; ++j) {
        x[j] = *(const float4*)(src + 4 * j);
        am = fmaxf(am, fmaxf(fmaxf(fabsf(x[j].x), fabsf(x[j].y)), fmaxf(fabsf(x[j].z), fabsf(x[j].w))));
      }
      {
        unsigned au = row_max_u32(__float_as_uint(am));
        const unsigned ao = (unsigned)__shfl_xor((int)au, 16);
        am = __uint_as_float(umax_(au, ao));
      }
      const float inv = am > 0.f ? 7.0f / am : 0.f;
      const float scale = am > 0.f ? am / 7.0f : 0.f;
      f32x16 fa, fb;
#pragma unroll
      for (int j = 0; j < 8; ++j) {
        fa[2 * j] = x[j].x * inv; fb[2 * j] = x[j].y * inv; fa[2 * j + 1] = x[j].z * inv; fb[2 * j + 1] = x[j].w * inv;
      }
      const u32x6 pk = __builtin_amdgcn_cvt_scalef32_2xpk16_fp6_f32(fa, fb, 1.0f);
      unsigned char* dst = (unsigned char*)(p.ws + (l ? OFF_TAB1 : OFF_YB)) + ((size_t)tab * 16384 + row) * 768 + l31 * 24;
      *(uint2*)(dst) = make_uint2(pk[0], pk[1]);
      *(uint2*)(dst + 8) = make_uint2(pk[2], pk[3]);
      *(uint2*)(dst + 16) = make_uint2(pk[4], pk[5]);
      if (l31 == 0) ((float*)(p.ws + OFF_SCALE))[gr] = scale;
    }
  }
}

__device__ __forceinline__ void norm_mod_phase(const Params& p, int layer, int which, bool from_input) {
  const int otid = opaque_tid();
  const float* g = (which == 0 ? p.norm_mix_g : p.norm_ffn_g) + layer * 1024;
  const float* MOD = (const float*)(p.ws + OFF_MOD);
  bf16_t* A = (bf16_t*)(p.ws + OFF_YF);
  const int lane = otid & 63, w = otid >> 6;
  for (int tok = blockIdx.x * 4 + w; tok < NT; tok += gridDim.x * 4) {
    const float* xr = from_input ? (tok < NCTX ? p.x_prompt + (size_t)tok * 1024 : p.x_sample + (size_t)(tok - NCTX) * 1024)
                                 : p.out + (size_t)tok * 1024;
    const float* md = MOD + (size_t)(layer * 5 + cidx(tok)) * 6144 + (which ? 3 * 1024 : 0);
    float4 v[4];
    float ss = 0.f;
#pragma unroll
    for (int i = 0; i < 4; ++i) {
      v[i] = *(const float4*)(xr + lane * 4 + 256 * i);
      ss += v[i].x * v[i].x + v[i].y * v[i].y + v[i].z * v[i].z + v[i].w * v[i].w;
    }
    ss = wave_sum(ss);
    const float sc = rsqrtf(ss * (1.f / 1024.f) + 1e-6f);
#pragma unroll
    for (int i = 0; i < 4; ++i) {
      const int col = lane * 4 + 256 * i;
      float4 gg = *(const float4*)(g + col);
      float4 sh = *(const float4*)(md + col);
      float4 sl = *(const float4*)(md + 1024 + col);
      float o0 = v[i].x * sc * gg.x * (1.f + sl.x) + sh.x;
      float o1 = v[i].y * sc * gg.y * (1.f + sl.y) + sh.y;
      float o2 = v[i].z * sc * gg.z * (1.f + sl.z) + sh.z;
      float o3 = v[i].w * sc * gg.w * (1.f + sl.w) + sh.w;
      uint2 o;
      o.x = pack2(o0, o1);
      o.y = pack2(o2, o3);
      *(uint2*)(A + tiled(tok, col, 16)) = o;
    }
  }
}

#define LSTR 72
template <class Epi>
__device__ __forceinline__ void gemm_phase(const bf16_t* __restrict__ A, const bf16_t* __restrict__ Bt, int M, int N, int K, Epi epi, char* smem) {
  const int otid = opaque_tid();
  bf16_t* sA = (bf16_t*)smem;
  bf16_t* sB = sA + 2 * 128 * LSTR;
  float* sC = (float*)smem;
  const int tid = otid, lane = tid & 63, w = tid >> 6;
  const int wm = w >> 1, wn = w & 1;
  const int ntn = (N + 127) >> 7, ntm = M >> 7;
  const int ntiles = ntm * ntn;
  const int KT = K >> 6;
  const int lrow = tid >> 3, lkc = (tid & 7) * 8;
  const bf16_t* apb;
  const bf16_t* bpb;
  uint4 ra0_0, ra0_1, ra0_2, ra0_3, rb0_0, rb0_1, rb0_2, rb0_3, ra1_0, ra1_1, ra1_2, ra1_3, rb1_0, rb1_1, rb1_2, rb1_3;
  const int G_ = gridDim.x;
  const int RN = (ntn % 8 == 0) ? 8 : ((ntn % 7 == 0) ? 7 : ((ntn % 6 == 0) ? 6 : ((ntn % 5 == 0) ? 5 : 4)));
  const int RM = ((G_ >> 3) / RN) > 0 ? ((G_ >> 3) / RN) : 1;
  const int nrn = (ntn + RN - 1) / RN, nrm = (ntm + RM - 1) / RM;
  const int nrects = nrn * nrm;
  const int nslots = ((nrects + 7) >> 3) * G_;
#define G_MAP(T_, VALID_, MT_, NT_) { const int i_ = (T_) / G_, b_ = (T_) - i_ * G_; const int R_ = i_ * 8 + (b_ & 7); const int s_ = b_ >> 3; \
    const int rm_ = R_ / nrn, rn_ = R_ - rm_ * nrn; const int dm_ = s_ / RN, dn_ = s_ - dm_ * RN; MT_ = rm_ * RM + dm_; NT_ = rn_ * RN + dn_; \
    VALID_ = (dm_ < RM) && (R_ < nrects) && (MT_ < ntm) && (NT_ < ntn); }
#define G_NEXT(T_, MT_, NT_) { bool ok_ = false; while ((T_) < nslots) { G_MAP(T_, ok_, MT_, NT_) if (ok_) break; (T_) += G_; } }
#define G_PTRS(MT_, NT_) { apb = A + (size_t)(MT_) * KT * 8192 + lrow * 64 + lkc; bpb = Bt + (size_t)(NT_) * KT * 8192 + lrow * 64 + lkc; }
#define G_LOAD1(S, I, KT_) { ra##S##_##I = *(const uint4*)(apb + (KT_) * 8192 + I * 2048); rb##S##_##I = *(const uint4*)(bpb + (KT_) * 8192 + I * 2048); }
#define G_LOAD(S, KT_) { G_LOAD1(S, 0, KT_) G_LOAD1(S, 1, KT_) G_LOAD1(S, 2, KT_) G_LOAD1(S, 3, KT_) }
#define G_WRITE1(S, I, BUF_) { *(uint4*)(sA + (BUF_) * 128 * LSTR + (lrow + 32 * I) * LSTR + lkc) = ra##S##_##I; *(uint4*)(sB + (BUF_) * 128 * LSTR + (lrow + 32 * I) * LSTR + lkc) = rb##S##_##I; }
#define G_WRITE(S, BUF_) { G_WRITE1(S, 0, BUF_) G_WRITE1(S, 1, BUF_) G_WRITE1(S, 2, BUF_) G_WRITE1(S, 3, BUF_) }
#define G_FRAG(KK, A0, A1, B0, B1) { A0 = *(const bf16x8*)(cA + KK * 16); A1 = *(const bf16x8*)(cA + 32 * LSTR + KK * 16); \
        B0 = *(const bf16x8*)(cB + KK * 16); B1 = *(const bf16x8*)(cB + 32 * LSTR + KK * 16); }
#define G_MMA4(A0, A1, B0, B1) { \
        acc[0][0] = __builtin_amdgcn_mfma_f32_32x32x16_bf16(A0, B0, acc[0][0], 0, 0, 0); \
        acc[0][1] = __builtin_amdgcn_mfma_f32_32x32x16_bf16(A0, B1, acc[0][1], 0, 0, 0); \
        acc[1][0] = __builtin_amdgcn_mfma_f32_32x32x16_bf16(A1, B0, acc[1][0], 0, 0, 0); \
        acc[1][1] = __builtin_amdgcn_mfma_f32_32x32x16_bf16(A1, B1, acc[1][1], 0, 0, 0); }
#define G_COMPUTE(BUF_) { \
      const bf16_t* cA = sA + (BUF_) * 128 * LSTR + (wm * 64 + (lane & 31)) * LSTR + (lane >> 5) * 8; \
      const bf16_t* cB = sB + (BUF_) * 128 * LSTR + (wn * 64 + (lane & 31)) * LSTR + (lane >> 5) * 8; \
      bf16x8 xa0, xa1, xb0, xb1, ya0, ya1, yb0, yb1; \
      G_FRAG(0, xa0, xa1, xb0, xb1) \
      G_FRAG(1, ya0, ya1, yb0, yb1) \
      __builtin_amdgcn_s_setprio(1); \
      G_MMA4(xa0, xa1, xb0, xb1) \
      __builtin_amdgcn_sched_barrier(0); \
      G_FRAG(2, xa0, xa1, xb0, xb1) \
      G_MMA4(ya0, ya1, yb0, yb1) \
      __builtin_amdgcn_sched_barrier(0); \
      G_FRAG(3, ya0, ya1, yb0, yb1) \
      G_MMA4(xa0, xa1, xb0, xb1) \
      __builtin_amdgcn_sched_barrier(0); \
      G_MMA4(ya0, ya1, yb0, yb1) \
      __builtin_amdgcn_s_setprio(0); }
  int tile = blockIdx.x, mt = 0, nt = 0;
  G_NEXT(tile, mt, nt)
  if (tile < nslots) { G_PTRS(mt, nt) G_LOAD(0, 0) G_LOAD(1, 1) }
  while (tile < nslots) {
    const int m0 = mt << 7, n0 = nt << 7;
    f32x16 acc[2][2];
#pragma unroll
    for (int i = 0; i < 2; ++i)
#pragma unroll
      for (int j = 0; j < 2; ++j)
#pragma unroll
        for (int r = 0; r < 16; ++r) acc[i][j][r] = 0.f;
    G_WRITE(0, 0)
    __syncthreads();
    for (int kt = 0; kt < KT; kt += 2) {
      if (kt + 2 < KT) G_LOAD(0, kt + 2)
      G_COMPUTE(0)
      G_WRITE(1, 1)
      __syncthreads();
      if (kt + 3 < KT) G_LOAD(1, kt + 3)
      G_COMPUTE(1)
      if (kt + 2 < KT) G_WRITE(0, 0)
      __syncthreads();
    }
    int next = tile + G_;
    G_NEXT(next, mt, nt)
    if (next < nslots) { G_PTRS(mt, nt) G_LOAD(0, 0) G_LOAD(1, 1) }
#pragma unroll
    for (int mi = 0; mi < 2; ++mi)
#pragma unroll
      for (int ni = 0; ni < 2; ++ni) {
        float* cw = sC + (wm * 64 + mi * 32 + 4 * (lane >> 5)) * 132 + wn * 64 + ni * 32 + (lane & 31);
#pragma unroll
        for (int r = 0; r < 16; ++r) cw[((r & 3) + 8 * (r >> 2)) * 132] = acc[mi][ni][r];
      }
    __syncthreads();
#pragma unroll 4
    for (int i = 0; i < 16; ++i) {
      const int ch = tid + 256 * i;
      const int row = ch >> 5, c4 = (ch & 31) * 4;
      const float4 v = *(const float4*)(sC + row * 132 + c4);
      if (n0 + c4 < N) epi(m0 + row, n0 + c4, v);
    }
    __syncthreads();
    tile = next;
  }
}

struct EpiBf16 {
  bf16_t* C; int ldc;
  __device__ __forceinline__ void operator()(int m, int n, float4 v) const {
    uint2 o; o.x = pack2(v.x, v.y); o.y = pack2(v.z, v.w);
    *(uint2*)(C + (size_t)m * ldc + n) = o;
  }
};
__device__ __forceinline__ float softplusf(float x) { return x > 20.f ? x : log1pf(expf(x)); }
struct EpiSsdIn {
  bf16_t* C; float* DT; const float* dt_bias;
  __device__ __forceinline__ void operator()(int m, int n, float4 v) const {
    if (n < 6144) {
      uint2 o; o.x = pack2(v.x, v.y); o.y = pack2(v.z, v.w);
      *(uint2*)(C + (size_t)m * 6144 + n) = o;
    } else {
      const int c = n - 6144;
      const float4 bb = *(const float4*)(dt_bias + c);
      *(float4*)(DT + (size_t)m * 64 + c) = make_float4(softplusf(v.x + bb.x), softplusf(v.y + bb.y), softplusf(v.z + bb.z), softplusf(v.w + bb.w));
    }
  }
};
struct EpiRes {
  const float* xin_ctx; const float* xin_lat; float* X; const float* gate;
  __device__ __forceinline__ void operator()(int m, int n, float4 v) const {
    const float* xr = m < NCTX ? xin_ctx + (size_t)m * 1024 : xin_lat + (size_t)(m - NCTX) * 1024;
    const float4 xv = *(const float4*)(xr + n);
    const float4 gt = *(const float4*)(gate + (size_t)cidx(m) * 6144 + n);
    *(float4*)(X + (size_t)m * 1024 + n) = make_float4(xv.x + gt.x * v.x, xv.y + gt.y * v.y, xv.z + gt.z * v.z, xv.w + gt.w * v.w);
  }
};

__device__ __forceinline__ void conv_gate_phase(const Params& p) {
  const int otid = opaque_tid();
  const bf16_t* P = (const bf16_t*)(p.ws + OFF_BIG);
  bf16_t* G = (bf16_t*)(p.ws + OFF_BIG + 120 * MIB);
  const float* cw = p.sc_conv_w;
  const int total = NT * 128;
  for (int it = blockIdx.x * 256 + otid; it < total; it += gridDim.x * 256) {
    const int tok = it >> 7, c = (it & 127) * 8;
    const int rowlen = tok < NCTX ? 256 : 64;
    const int pos = tok & (rowlen - 1);
    const bf16_t* pr = P + (size_t)tok * 3072;
    uint4 bg = *(const uint4*)(pr + c);
    uint4 cg = *(const uint4*)(pr + 1024 + c);
    uint4 xv = *(const uint4*)(pr + 2048 + c);
    uint4 cgl = make_uint4(0, 0, 0, 0), xvl = cgl, cgr = cgl, xvr = cgl;
    if (pos > 0) { cgl = *(const uint4*)(pr - 3072 + 1024 + c); xvl = *(const uint4*)(pr - 3072 + 2048 + c); }
    if (pos < rowlen - 1) { cgr = *(const uint4*)(pr + 3072 + 1024 + c); xvr = *(const uint4*)(pr + 3072 + 2048 + c); }
    const unsigned* bgp = (const unsigned*)&bg; const unsigned* cgp = (const unsigned*)&cg; const unsigned* xvp = (const unsigned*)&xv;
    const unsigned* cglp = (const unsigned*)&cgl; const unsigned* xvlp = (const unsigned*)&xvl;
    const unsigned* cgrp = (const unsigned*)&cgr; const unsigned* xvrp = (const unsigned*)&xvr;
    float4 w0a = *(const float4*)(cw + c), w0b = *(const float4*)(cw + c + 4);
    float4 w1a = *(const float4*)(cw + 1024 + c), w1b = *(const float4*)(cw + 1024 + c + 4);
    float4 w2a = *(const float4*)(cw + 2048 + c), w2b = *(const float4*)(cw + 2048 + c + 4);
    const float w0[8] = {w0a.x, w0a.y, w0a.z, w0a.w, w0b.x, w0b.y, w0b.z, w0b.w};
    const float w1[8] = {w1a.x, w1a.y, w1a.z, w1a.w, w1b.x, w1b.y, w1b.z, w1b.w};
    const float w2[8] = {w2a.x, w2a.y, w2a.z, w2a.w, w2b.x, w2b.y, w2b.z, w2b.w};
    unsigned o[4];
#pragma unroll
    for (int q = 0; q < 4; ++q) {
      float r0 = lo2f(bgp[q]) * (w0[2 * q] * lo2f(cglp[q]) * lo2f(xvlp[q]) + w1[2 * q] * lo2f(cgp[q]) * lo2f(xvp[q]) + w2[2 * q] * lo2f(cgrp[q]) * lo2f(xvrp[q]));
      float r1 = hi2f(bgp[q]) * (w0[2 * q + 1] * hi2f(cglp[q]) * hi2f(xvlp[q]) + w1[2 * q + 1] * hi2f(cgp[q]) * hi2f(xvp[q]) + w2[2 * q + 1] * hi2f(cgrp[q]) * hi2f(xvrp[q]));
      o[q] = pack2(r0, r1);
    }
    *(uint4*)(G + tiled(tok, c, 16)) = make_uint4(o[0], o[1], o[2], o[3]);
  }
}

#define SSTR 272
#define CE2_(K, a, b) { unsigned hi_ = umax_(K[a], K[b]); unsigned lo_ = K[a] < K[b] ? K[a] : K[b]; K[a] = hi_; K[b] = lo_; }
#define SORT8_(K) CE2_(K, 0, 1) CE2_(K, 2, 3) CE2_(K, 4, 5) CE2_(K, 6, 7) CE2_(K, 0, 2) CE2_(K, 1, 3) CE2_(K, 4, 6) CE2_(K, 5, 7) \
  CE2_(K, 1, 2) CE2_(K, 5, 6) CE2_(K, 0, 4) CE2_(K, 1, 5) CE2_(K, 2, 6) CE2_(K, 3, 7) CE2_(K, 2, 4) CE2_(K, 3, 5) CE2_(K, 1, 2) CE2_(K, 3, 4) CE2_(K, 5, 6)
__device__ __forceinline__ void top16_rows(const float* Sr0, const float* Sr1, int j, unsigned (&res)[2][2]) {
  unsigned ka[8], kb[8], kc[8], kd[8];
#pragma unroll
  for (int m = 0; m < 8; ++m) {
    const unsigned tag = (unsigned)(127 - (j + 16 * m));
    ka[m] = (fkey(Sr0[j + 16 * m]) & ~0x7Fu) | tag;
    kb[m] = (fkey(Sr0[128 + j + 16 * m]) & ~0x7Fu) | tag;
    kc[m] = (fkey(Sr1[j + 16 * m]) & ~0x7Fu) | tag;
    kd[m] = (fkey(Sr1[128 + j + 16 * m]) & ~0x7Fu) | tag;
  }
  SORT8_(ka)
  SORT8_(kb)
  SORT8_(kc)
  SORT8_(kd)
  unsigned r0 = 0, r1 = 0, r2 = 0, r3 = 0;
#pragma unroll 2
  for (int it = 0; it < 16; ++it) {
    const unsigned wa = row_max_u32(ka[0]);
    const unsigned wb = row_max_u32(kb[0]);
    const unsigned wc = row_max_u32(kc[0]);
    const unsigned wd = row_max_u32(kd[0]);
    const bool wina = ka[0] == wa, winb = kb[0] == wb, winc = kc[0] == wc, wind = kd[0] == wd;
#pragma unroll
    for (int m = 0; m < 7; ++m) {
      ka[m] = wina ? ka[m + 1] : ka[m]; kb[m] = winb ? kb[m + 1] : kb[m];
      kc[m] = winc ? kc[m + 1] : kc[m]; kd[m] = wind ? kd[m + 1] : kd[m];
    }
    ka[7] = wina ? 0u : ka[7]; kb[7] = winb ? 0u : kb[7]; kc[7] = winc ? 0u : kc[7]; kd[7] = wind ? 0u : kd[7];
    r0 = (j == it) ? wa : r0; r1 = (j == it) ? wb : r1; r2 = (j == it) ? wc : r2; r3 = (j == it) ? wd : r3;
  }
  res[0][0] = r0; res[0][1] = r1; res[1][0] = r2; res[1][1] = r3;
}

__device__ __forceinline__ void topk_phase(const Params& p, int layer, char* smem) {
  const int otid = opaque_tid();
  float* S = (float*)smem;
  const bf16_t* Q = (const bf16_t*)(p.ws + OFF_BIG);
  const bf16_t* KB = (const bf16_t*)(p.ws + OFF_KEYSB) + (size_t)layer * (8 * 2 * 128 * 128);
  int* IDX = (int*)(p.ws + OFF_IDX);
  float* GATE = (float*)(p.ws + OFF_GATE);
  const int tid = otid, lane = tid & 63;
  const int w = __builtin_amdgcn_readfirstlane(tid >> 6);
  const int G = gridDim.x;
  const int per = (5120 + G - 1) / G;
  const int start = blockIdx.x * per;
  const int end = (start + per < 5120) ? start + per : 5120;
  const int pp = w >> 1, nt0 = (w & 1) * 2;
  const int j = lane & 15, rowbase = lane & 48;
  int ca[4], cb[4];
  bool cvalid3;
  ca[0] = 0; cb[0] = j;
  if (j < 8) { ca[1] = 1; cb[1] = j; } else { ca[1] = j; cb[1] = 0; }
  if (j < 5) { ca[2] = 2; cb[2] = j; } else if (j < 9) { ca[2] = 3; cb[2] = j - 5; } else if (j < 12) { ca[2] = 4; cb[2] = j - 9; }
  else if (j < 14) { ca[2] = 5; cb[2] = j - 12; } else { ca[2] = 6; cb[2] = j - 14; }
  ca[3] = 7; cb[3] = j & 1; cvalid3 = j < 2;
  int curh = -1;
  bf16x8 kf[2][8];
  for (int pr = start; pr < end; ++pr) {
    const int h = pr / 640, tile = pr % 640;
    const int t0 = tile * 32;
    if (h != curh) {
#pragma unroll
      for (int jj = 0; jj < 2; ++jj)
#pragma unroll
        for (int kk = 0; kk < 8; ++kk)
          kf[jj][kk] = *(const bf16x8*)(KB + ((size_t)((h * 2 + pp) * 128 + (nt0 + jj) * 32 + (lane & 31))) * 128 + kk * 16 + (lane >> 5) * 8);
      curh = h;
    }
    f32x16 acc[2];
#pragma unroll
    for (int jj = 0; jj < 2; ++jj)
#pragma unroll
      for (int r = 0; r < 16; ++r) acc[jj][r] = 0.f;
    const bf16_t* qp = Q + (size_t)(t0 + (lane & 31)) * 2048 + h * 256 + pp * 128 + (lane >> 5) * 8;
#pragma unroll
    for (int kk = 0; kk < 8; ++kk) {
      bf16x8 a = *(const bf16x8*)(qp + kk * 16);
      acc[0] = __builtin_amdgcn_mfma_f32_32x32x16_bf16(a, kf[0][kk], acc[0], 0, 0, 0);
      acc[1] = __builtin_amdgcn_mfma_f32_32x32x16_bf16(a, kf[1][kk], acc[1], 0, 0, 0);
    }
#pragma unroll
    for (int jj = 0; jj < 2; ++jj)
#pragma unroll
      for (int r = 0; r < 16; ++r) {
        const int tl = (r & 3) + 8 * (r >> 2) + 4 * (lane >> 5);
        S[tl * SSTR + pp * 128 + (nt0 + jj) * 32 + (lane & 31)] = acc[jj][r];
      }
    __syncthreads();
    {
      const int tl0 = w * 8 + (lane >> 4), tl1 = tl0 + 4;
      unsigned res[2][2];
      top16_rows(S + tl0 * SSTR, S + tl1 * SSTR, j, res);
      unsigned ck[2][4];
#pragma unroll
      for (int u = 0; u < 2; ++u) {
#pragma unroll
        for (int sl = 0; sl < 4; ++sl) {
          const float v1 = keyf((unsigned)__shfl((int)res[u][0], rowbase + ca[sl]) & ~0x7Fu);
          const float v2 = keyf((unsigned)__shfl((int)res[u][1], rowbase + cb[sl]) & ~0x7Fu);
          ck[u][sl] = (fkey(v1 + v2) & ~0xFFu) | (unsigned)(255 - (ca[sl] * 16 + cb[sl]));
        }
        ck[u][3] = cvalid3 ? ck[u][3] : 0u;
      }
      unsigned resc0 = 0, resc1 = 0;
#pragma unroll 2
      for (int it = 0; it < 16; ++it) {
        const unsigned wm0 = row_max_u32(umax_(umax_(ck[0][0], ck[0][1]), umax_(ck[0][2], ck[0][3])));
        const unsigned wm1 = row_max_u32(umax_(umax_(ck[1][0], ck[1][1]), umax_(ck[1][2], ck[1][3])));
#pragma unroll
        for (int sl = 0; sl < 4; ++sl) { ck[0][sl] = (ck[0][sl] == wm0) ? 0u : ck[0][sl]; ck[1][sl] = (ck[1][sl] == wm1) ? 0u : ck[1][sl]; }
        resc0 = (j == it) ? wm0 : resc0;
        resc1 = (j == it) ? wm1 : resc1;
      }
#pragma unroll
      for (int u = 0; u < 2; ++u) {
        const unsigned resc = u ? resc1 : resc0;
        const int tl = u ? tl1 : tl0;
        const int code = 255 - (int)(resc & 0xFFu);
        const int wa = code >> 4, wb = code & 15;
        const float val = keyf(resc & ~0xFFu);
        const unsigned r1 = (unsigned)__shfl((int)res[u][0], rowbase + wa);
        const unsigned r2 = (unsigned)__shfl((int)res[u][1], rowbase + wb);
        const int i1 = 127 - (int)(r1 & 0x7Fu), i2 = 127 - (int)(r2 & 0x7Fu);
        const float vmax = __shfl(val, rowbase);
        const float e = __expf(val - vmax);
        const float ssum = row16_sum(e);
        const size_t ob = ((size_t)(t0 + tl) * 8 + h) * 16 + j;
        IDX[ob] = i1 * 128 + i2;
        GATE[ob] = e / ssum;
      }
    }
    __syncthreads();
  }
}

typedef __attribute__((ext_vector_type(2))) float f32x2;
__device__ __forceinline__ void peer_phase(const Params& p, int layer, char* smem) {
  const int otid = opaque_tid();
  float* coefs = (float*)smem;
  int* idxs = (int*)(smem + 2048);
  float* sus = (float*)(smem + 4096);
  float* gsv = (float*)(smem + 6144);
  const unsigned char* U6 = (const unsigned char*)(p.ws + (layer ? OFF_TAB1 : OFF_YB));
  const unsigned char* V6 = U6 + (size_t)16384 * 768;
  const float* SCU = (const float*)(p.ws + OFF_SCALE) + (size_t)layer * 32768;
  const float* SCV = SCU + 16384;
  const bf16_t* A = (const bf16_t*)(p.ws + OFF_YF);
  const int* IDX = (const int*)(p.ws + OFF_IDX);
  const float* GATE = (const float*)(p.ws + OFF_GATE);
  const float* MOD = (const float*)(p.ws + OFF_MOD);
  float* X = p.out;
  const int lane = otid & 63;
  const int w = __builtin_amdgcn_readfirstlane(otid >> 6);
  const int sub = lane & 15, rg = lane >> 4;
  const int half = lane >> 5, l31 = lane & 31;
  for (int tok = blockIdx.x * 4 + w; tok < NT; tok += gridDim.x * 4) {
#pragma unroll
    for (int hh = 0; hh < 2; ++hh) {
      const int kk = lane + 64 * hh;
      const int e = IDX[(size_t)tok * 128 + kk];
      const float gk = GATE[(size_t)tok * 128 + kk];
      idxs[w * 128 + kk] = e;
      sus[w * 128 + kk] = SCU[e];
      gsv[w * 128 + kk] = gk * SCV[e];
    }
    float t[64];
    {
      const uint4* ap = (const uint4*)(A + tiled(tok, 64 * sub, 16));
#pragma unroll
      for (int i = 0; i < 8; ++i) {
        const uint4 r0 = ap[i];
#pragma unroll
        for (int q = 0; q < 4; ++q) { t[8 * i + 2 * q] = lo2f(u4get(r0, q)); t[8 * i + 2 * q + 1] = hi2f(u4get(r0, q)); }
      }
    }
    float chain = 0.f;
#pragma unroll 4
    for (int it = 0; it < 32; ++it) {
      const int k = it * 4 + rg;
      const int e = idxs[w * 128 + k];
      const uint4* row = (const uint4*)(U6 + (size_t)e * 768 + sub * 48);
      const uint4 r0 = row[0], r1 = row[1], r2 = row[2];
      u32x6 g0, g1;
      g0[0] = r0.x; g0[1] = r0.y; g0[2] = r0.z; g0[3] = r0.w; g0[4] = r1.x; g0[5] = r1.y;
      g1[0] = r1.z; g1[1] = r1.w; g1[2] = r2.x; g1[3] = r2.y; g1[4] = r2.z; g1[5] = r2.w;
      float acc0 = 0.f, acc1 = 0.f;
      asm volatile("" : "+v"(g0), "+v"(chain));
      {
        const f32x32 d0 = __builtin_amdgcn_cvt_scalef32_pk32_f32_fp6(g0, 1.0f);
#pragma unroll
        for (int j = 0; j < 32; j += 2) { acc0 += d0[j] * t[j]; acc1 += d0[j + 1] * t[j + 1]; }
      }
      asm volatile("" : "+v"(g1), "+v"(acc0), "+v"(acc1));
      {
        const f32x32 d1 = __builtin_amdgcn_cvt_scalef32_pk32_f32_fp6(g1, 1.0f);
#pragma unroll
        for (int j = 0; j < 32; j += 2) { acc0 += d1[j] * t[32 + j]; acc1 += d1[j + 1] * t[32 + j + 1]; }
      }
      chain = acc0 + acc1;
      float acc = row16_sum(chain) * sus[w * 128 + k];
      const float co = 0.5f * acc * (1.f + erff(acc * 0.70710678118654752f)) * gsv[w * 128 + k];
      if (sub == 0) coefs[w * 128 + k] = co;
    }
    f32x32 ov;
#pragma unroll
    for (int i = 0; i < 32; ++i) ov[i] = 0.f;
#pragma unroll 1
    for (int k = 0; k < 128; k += 16) {
      uint2 ra[8], rb[8], rc[8]; float c[8];
#pragma unroll
      for (int j = 0; j < 8; ++j) {
        const int kk = k + 2 * j + half;
        const int e = idxs[w * 128 + kk];
        c[j] = coefs[w * 128 + kk];
        const uint2* rp = (const uint2*)(V6 + (size_t)e * 768 + l31 * 24);
        ra[j] = rp[0]; rb[j] = rp[1]; rc[j] = rp[2];
      }
#pragma unroll
      for (int j = 0; j < 8; ++j) {
        u32x6 g;
        g[0] = ra[j].x; g[1] = ra[j].y; g[2] = rb[j].x; g[3] = rb[j].y; g[4] = rc[j].x; g[5] = rc[j].y;
        asm volatile("" : "+v"(g), "+v"(ov));
        const f32x32 d = __builtin_amdgcn_cvt_scalef32_pk32_f32_fp6(g, 1.0f);
        ov += d * c[j];
      }
    }
    float o[16];
#pragma unroll
    for (int i = 0; i < 16; ++i) {
      const float lo = ov[i] + __shfl_xor(ov[i], 32);
      const float hi = ov[16 + i] + __shfl_xor(ov[16 + i], 32);
      o[i] = half ? hi : lo;
    }
    const int col0 = 32 * l31 + 16 * half;
    const float* gate = MOD + (size_t)(layer * 5 + cidx(tok)) * 6144 + 5 * 1024;
    float xr[16];
    float ss = 0.f;
#pragma unroll
    for (int i = 0; i < 4; ++i) {
      const int col = col0 + 4 * i;
      const float4 xv = *(const float4*)(X + (size_t)tok * 1024 + col);
      const float4 gt = *(const float4*)(gate + col);
      xr[4 * i] = xv.x + gt.x * o[4 * i]; xr[4 * i + 1] = xv.y + gt.y * o[4 * i + 1];
      xr[4 * i + 2] = xv.z + gt.z * o[4 * i + 2]; xr[4 * i + 3] = xv.w + gt.w * o[4 * i + 3];
      ss += xr[4 * i] * xr[4 * i] + xr[4 * i + 1] * xr[4 * i + 1] + xr[4 * i + 2] * xr[4 * i + 2] + xr[4 * i + 3] * xr[4 * i + 3];
    }
    ss = wave_sum(ss);
    const float sc = rsqrtf(ss * (1.f / 1024.f) + 1e-6f);
    if (layer == 0) {
      const float* g1 = p.norm_mix_g + 1024;
      const float* md = MOD + (size_t)(5 + cidx(tok)) * 6144;
      unsigned pk[8];
#pragma unroll
      for (int i = 0; i < 4; ++i) {
        const int col = col0 + 4 * i;
        *(float4*)(X + (size_t)tok * 1024 + col) = make_float4(xr[4 * i], xr[4 * i + 1], xr[4 * i + 2], xr[4 * i + 3]);
        const float4 gg = *(const float4*)(g1 + col);
        const float4 sh = *(const float4*)(md + col);
        const float4 sl = *(const float4*)(md + 1024 + col);
        pk[2 * i] = pack2(xr[4 * i] * sc * gg.x * (1.f + sl.x) + sh.x, xr[4 * i + 1] * sc * gg.y * (1.f + sl.y) + sh.y);
        pk[2 * i + 1] = pack2(xr[4 * i + 2] * sc * gg.z * (1.f + sl.z) + sh.z, xr[4 * i + 3] * sc * gg.w * (1.f + sl.w) + sh.w);
      }
      bf16_t* An = (bf16_t*)(p.ws + OFF_YF) + tiled(tok, col0, 16);
      *(uint4*)(An) = make_uint4(pk[0], pk[1], pk[2], pk[3]);
      *(uint4*)(An + 8) = make_uint4(pk[4], pk[5], pk[6], pk[7]);
    } else {
#pragma unroll
      for (int i = 0; i < 4; ++i) {
        const int col = col0 + 4 * i;
        const float4 gg = *(const float4*)(p.norm_f_g + col);
        *(float4*)(X + (size_t)tok * 1024 + col) = make_float4(xr[4 * i] * sc * gg.x, xr[4 * i + 1] * sc * gg.y, xr[4 * i + 2] * sc * gg.z, xr[4 * i + 3] * sc * gg.w);
      }
    }
  }
}

__device__ __forceinline__ void ssd_conv_phase(const Params& p) {
  const int otid = opaque_tid();
  bf16_t* BIG = (bf16_t*)(p.ws + OFF_BIG);
  const float* cw = p.ssd_conv_w;
  const float* cb = p.ssd_conv_b;
  const int total = 272 * 512;
  for (int it = blockIdx.x * 256 + otid; it < total; it += gridDim.x * 256) {
    const int c8 = it & 511, r = it >> 9;
    const int c = c8 * 8;
    int tok0, len;
    if (r < 16) { tok0 = r * 256; len = 256; } else { tok0 = NCTX + (r - 16) * 64; len = 64; }
    float w0[8], w1[8], w2[8], bb[8];
#pragma unroll
    for (int j = 0; j < 8; ++j) { w0[j] = cw[c + j]; w1[j] = cw[4096 + c + j]; w2[j] = cw[8192 + c + j]; bb[j] = cb[c + j]; }
    bf16_t* base = BIG + (size_t)tok0 * 6144 + 2048 + c;
    uint4 buf[8], nxt[8];
#pragma unroll
    for (int j = 0; j < 8; ++j) buf[j] = *(const uint4*)(base + (size_t)j * 6144);
    uint4 prev = make_uint4(0, 0, 0, 0);
    for (int t0 = 0; t0 < len; t0 += 8) {
      const bool more = (t0 + 8) < len;
#pragma unroll
      for (int j = 0; j < 8; ++j) nxt[j] = more ? *(const uint4*)(base + (size_t)(t0 + 8 + j) * 6144) : make_uint4(0, 0, 0, 0);
#pragma unroll
      for (int j = 0; j < 8; ++j) {
        const uint4 cur = buf[j];
        const uint4 nx = (j < 7) ? buf[j + 1] : nxt[0];
        const unsigned* pp = (const unsigned*)&prev; const unsigned* cp = (const unsigned*)&cur; const unsigned* np = (const unsigned*)&nx;
        unsigned o[4];
#pragma unroll
        for (int q = 0; q < 4; ++q) {
          float a0 = w0[2 * q] * lo2f(pp[q]) + w1[2 * q] * lo2f(cp[q]) + w2[2 * q] * lo2f(np[q]) + bb[2 * q];
          float a1 = w0[2 * q + 1] * hi2f(pp[q]) + w1[2 * q + 1] * hi2f(cp[q]) + w2[2 * q + 1] * hi2f(np[q]) + bb[2 * q + 1];
          o[q] = pack2(siluf(a0), siluf(a1));
        }
        *(uint4*)(base + (size_t)(t0 + j) * 6144) = make_uint4(o[0], o[1], o[2], o[3]);
        prev = cur;
      }
#pragma unroll
      for (int j = 0; j < 8; ++j) buf[j] = nxt[j];
    }
  }
}

#define XT_STR 72
#define HB_STR 136
#define SCAN_LOAD_FRAGS(CC) { \
      { const int t_ = (CC) * 64 + 32 * it + l31; const int tok_ = tok0 + (dir ? L - 1 - t_ : t_); \
        const bf16_t* cp_ = BIG + (size_t)tok_ * 6144 + 5120 + g * 128 + 8 * h5; \
        _Pragma("unroll") for (int kk = 0; kk < 8; ++kk) cfr[kk] = *(const bf16x8*)(cp_ + 16 * kk); } \
      if (jt <= it) { const int t_ = (CC) * 64 + 32 * jt + l31; const int tok_ = tok0 + (dir ? L - 1 - t_ : t_); \
        const bf16_t* bp_ = BIG + (size_t)tok_ * 6144 + 4096 + g * 128 + 8 * h5; \
        _Pragma("unroll") for (int kk = 0; kk < 8; ++kk) bfr[kk] = *(const bf16x8*)(bp_ + 16 * kk); } }
#define SCAN_LOAD_STAGE(CC) { \
      const int t_ = (CC) * 64 + lane; const int tok_ = tok0 + (dir ? L - 1 - t_ : t_); \
      const bf16_t* rowp_ = BIG + (size_t)tok_ * 6144; \
      _Pragma("unroll") for (int r = 0; r < 2; ++r) sx[r] = *(const uint4*)(rowp_ + 2048 + head * 64 + (w + 4 * r) * 8); \
      _Pragma("unroll") for (int r = 0; r < 4; ++r) sb[r] = *(const uint4*)(rowp_ + 4096 + g * 128 + (w + 4 * r) * 8); \
      sdt = DT[(size_t)tok_ * 64 + dir * 32 + head]; }
__device__ __forceinline__ void scan_phase(const Params& p, char* smem) {
  const int otid = opaque_tid();
  bf16_t* XTd = (bf16_t*)smem;
  bf16_t* BTs = XTd + 64 * XT_STR;
  bf16_t* Ms = BTs + 128 * XT_STR;
  bf16_t* Hb = Ms + 64 * XT_STR;
  float* cumS = (float*)(Hb + 2 * 64 * HB_STR);
  const bf16_t* BIG = (const bf16_t*)(p.ws + OFF_BIG);
  const float* DT = (const float*)(p.ws + OFF_DT);
  const int tid = otid, lane = tid & 63;
  const int w = __builtin_amdgcn_readfirstlane(tid >> 6);
  const int h5 = lane >> 5, l31 = lane & 31;
  const int it = w >> 1, jt = w & 1, pt = w & 1, nt0 = (w >> 1) * 2;
  int item0, istride;
  if (gridDim.x >= 512) { if (blockIdx.x < 256) { item0 = blockIdx.x; istride = 1 << 28; } else { item0 = blockIdx.x; istride = gridDim.x - 256; } }
  else { item0 = blockIdx.x; istride = gridDim.x; }
  for (int item = item0; item < 1280; item += istride) {
    int b, head, dir, L, tok0;
    const bool latent = item < 256;
    if (latent) { b = item >> 6; head = (item >> 1) & 31; dir = item & 1; L = 4096; tok0 = NCTX + b * 4096; }
    else { int jj = item - 256; b = jj >> 6; head = (jj >> 1) & 31; dir = jj & 1; L = 256; tok0 = b * 256; }
    const int g = head >> 2;
    const float a = -expf(p.ssd_a_log[dir * 32 + head]);
    bf16_t* Y = (bf16_t*)(p.ws + (dir ? OFF_YB : OFF_YF));
    f32x16 st[2];
    const size_t sbase = ((size_t)((b * 2 + dir) * 32 + head)) * 8192;
    const int loff = (32 * pt + 4 * h5) * 128 + 32 * nt0 + l31;
    if (latent) {
      const float* sp = p.state_ssm + sbase + loff;
#pragma unroll
      for (int q = 0; q < 2; ++q)
#pragma unroll
        for (int r = 0; r < 16; ++r) st[q][r] = sp[((r & 3) + 8 * (r >> 2)) * 128 + 32 * q];
    } else {
#pragma unroll
      for (int q = 0; q < 2; ++q)
#pragma unroll
        for (int r = 0; r < 16; ++r) st[q][r] = 0.f;
    }
    {
      bf16_t* hb0 = Hb + (32 * pt + 4 * h5) * HB_STR + 32 * nt0 + l31;
#pragma unroll
      for (int q = 0; q < 2; ++q)
#pragma unroll
        for (int r = 0; r < 16; ++r) hb0[((r & 3) + 8 * (r >> 2)) * HB_STR + 32 * q] = f2bf(st[q][r]);
    }
    __syncthreads();
    const int nchunks = L >> 6;
    uint4 sx[2], sb[4];
    float sdt;
    SCAN_LOAD_STAGE(0)
    bf16x8 cfr[8], bfr[8];
    SCAN_LOAD_FRAGS(0)
#pragma nounroll
    for (int c = 0; c < nchunks; ++c) {
      const int cur = c & 1;
      __builtin_amdgcn_sched_barrier(0);
      float cum = sdt * a;
#pragma unroll
      for (int off = 1; off < 64; off <<= 1) {
        const float tv = __shfl_up(cum, off);
        cum += (lane >= off) ? tv : 0.f;
      }
      const float cum_last = __shfl(cum, 63);
      const float wj = __expf(cum_last - cum);
      if (w == 0) cumS[cur * 64 + lane] = cum;
#pragma unroll
      for (int r = 0; r < 2; ++r) {
        const int p8 = (w + 4 * r) * 8;
#pragma unroll
        for (int q = 0; q < 4; ++q) {
          const unsigned u = u4get(sx[r], q);
          XTd[(p8 + 2 * q) * XT_STR + lane] = f2bf(sdt * lo2f(u));
          XTd[(p8 + 2 * q + 1) * XT_STR + lane] = f2bf(sdt * hi2f(u));
        }
      }
#pragma unroll
      for (int r = 0; r < 4; ++r) {
        const int n8 = (w + 4 * r) * 8;
#pragma unroll
        for (int q = 0; q < 4; ++q) {
          const unsigned u = u4get(sb[r], q);
          BTs[(n8 + 2 * q) * XT_STR + lane] = f2bf(wj * lo2f(u));
          BTs[(n8 + 2 * q + 1) * XT_STR + lane] = f2bf(wj * hi2f(u));
        }
      }
      if (c + 1 < nchunks) SCAN_LOAD_STAGE(c + 1)
      __builtin_amdgcn_sched_barrier(0);
      f32x16 cb;
#pragma unroll
      for (int r = 0; r < 16; ++r) cb[r] = 0.f;
      if (jt <= it) {
#pragma unroll
        for (int kk = 0; kk < 8; ++kk) cb = __builtin_amdgcn_mfma_f32_32x32x16_bf16(cfr[kk], bfr[kk], cb, 0, 0, 0);
      }
      __builtin_amdgcn_sched_barrier(0);
      f32x16 yo;
#pragma unroll
      for (int r = 0; r < 16; ++r) yo[r] = 0.f;
      {
        const bf16_t* hp = Hb + cur * 64 * HB_STR + (32 * pt + l31) * HB_STR + 8 * h5;
#pragma unroll
        for (int kk = 0; kk < 8; ++kk) {
          const bf16x8 hf = *(const bf16x8*)(hp + 16 * kk);
          yo = __builtin_amdgcn_mfma_f32_32x32x16_bf16(cfr[kk], hf, yo, 0, 0, 0);
        }
      }
      __builtin_amdgcn_sched_barrier(0);
      if (c + 1 < nchunks) SCAN_LOAD_FRAGS(c + 1)
      __syncthreads();
      __builtin_amdgcn_sched_barrier(0);
      const float dec = __expf(cum_last);
      bf16x8 xf[4];
#pragma unroll
      for (int kk = 0; kk < 4; ++kk) xf[kk] = *(const bf16x8*)(XTd + (32 * pt + l31) * XT_STR + 16 * kk + 8 * h5);
#pragma unroll
      for (int q = 0; q < 2; ++q) {
#pragma unroll
        for (int r = 0; r < 16; ++r) st[q][r] *= dec;
#pragma unroll
        for (int kk = 0; kk < 4; ++kk) {
          const bf16x8 bt = *(const bf16x8*)(BTs + (32 * (nt0 + q) + l31) * XT_STR + 16 * kk + 8 * h5);
          st[q] = __builtin_amdgcn_mfma_f32_32x32x16_bf16(xf[kk], bt, st[q], 0, 0, 0);
        }
        {
          bf16_t* hbw = Hb + (cur ^ 1) * 64 * HB_STR + (32 * pt + 4 * h5) * HB_STR + 32 * (nt0 + q) + l31;
#pragma unroll
          for (int r = 0; r < 16; ++r) hbw[((r & 3) + 8 * (r >> 2)) * HB_STR] = f2bf(st[q][r]);
        }
      }
      __builtin_amdgcn_sched_barrier(0);
      if (jt <= it) {
        const int jj = 32 * jt + l31;
        const float cj = cumS[cur * 64 + jj];
        const int ib = 32 * it + 4 * h5;
        const float* cs = cumS + cur * 64 + ib;
        bf16_t* mw = Ms + ib * XT_STR + jj;
#pragma unroll
        for (int r = 0; r < 16; ++r) {
          const int ro = (r & 3) + 8 * (r >> 2);
          const float m = (jj <= ib + ro) ? cb[r] * __expf(cs[ro] - cj) : 0.f;
          mw[ro * XT_STR] = f2bf(m);
        }
      }
      __syncthreads();
      __builtin_amdgcn_sched_barrier(0);
      f32x16 yd;
#pragma unroll
      for (int r = 0; r < 16; ++r) yd[r] = 0.f;
#pragma unroll
      for (int kk = 0; kk < 4; ++kk) {
        if (kk < 2 * (it + 1)) {
          const bf16x8 mf = *(const bf16x8*)(Ms + (32 * it + l31) * XT_STR + 16 * kk + 8 * h5);
          yd = __builtin_amdgcn_mfma_f32_32x32x16_bf16(mf, xf[kk], yd, 0, 0, 0);
        }
      }
      {
        const int t0c = c * 64 + 32 * it + 4 * h5;
        const int tokb = tok0 + (dir ? L - 1 - t0c : t0c);
        const int rs = dir ? -64 : 64;
        bf16_t* yp = Y + ((size_t)(tokb >> 7) * 32 + head) * 8192 + (tokb & 127) * 64 + 32 * pt + l31;
        const float* cs = cumS + cur * 64 + 32 * it + 4 * h5;
#pragma unroll
        for (int r = 0; r < 16; ++r) {
          const int ro = (r & 3) + 8 * (r >> 2);
          const float yv = yd[r] + __expf(cs[ro]) * yo[r];
          yp[(ptrdiff_t)rs * ro] = f2bf(yv);
        }
      }
    }
    if (!latent) {
      float* sp = p.out + (size_t)NT * 1024 + sbase + loff;
#pragma unroll
      for (int q = 0; q < 2; ++q)
#pragma unroll
        for (int r = 0; r < 16; ++r) sp[((r & 3) + 8 * (r >> 2)) * 128 + 32 * q] = st[q][r];
    }
    __syncthreads();
  }
}

__device__ __forceinline__ void gate_norm_phase(const Params& p) {
  const int otid = opaque_tid();
  const bf16_t* BIG = (const bf16_t*)(p.ws + OFF_BIG);
  bf16_t* YF = (bf16_t*)(p.ws + OFF_YF);
  const bf16_t* YB = (const bf16_t*)(p.ws + OFF_YB);
  const int lane = otid & 63, w = otid >> 6;
  for (int tok = blockIdx.x * 4 + w; tok < NT; tok += gridDim.x * 4) {
    float v[32];
    float ss = 0.f;
#pragma unroll
    for (int i = 0; i < 4; ++i) {
      const int col = lane * 8 + 512 * i;
      const int head = col >> 6;
      const float dtot = p.ssd_d[head] + p.ssd_d[32 + head];
      uint4 a = *(const uint4*)(YF + tiled(tok, col, 32));
      uint4 b = *(const uint4*)(YB + tiled(tok, col, 32));
      uint4 x = *(const uint4*)(BIG + (size_t)tok * 6144 + 2048 + col);
      uint4 z = *(const uint4*)(BIG + (size_t)tok * 6144 + col);
#pragma unroll
      for (int q = 0; q < 4; ++q) {
        const unsigned aq = u4get(a, q), bq = u4get(b, q), xq = u4get(x, q), zq = u4get(z, q);
        float y0 = lo2f(aq) + lo2f(bq) + dtot * lo2f(xq);
        float y1 = hi2f(aq) + hi2f(bq) + dtot * hi2f(xq);
        y0 *= siluf(lo2f(zq));
        y1 *= siluf(hi2f(zq));
        v[8 * i + 2 * q] = y0; v[8 * i + 2 * q + 1] = y1;
        ss += y0 * y0 + y1 * y1;
      }
      __builtin_amdgcn_sched_barrier(0);
    }
    ss = wave_sum(ss);
    const float sc = rsqrtf(ss * (1.f / 2048.f) + 1e-6f);
#pragma unroll
    for (int i = 0; i < 4; ++i) {
      const int col = lane * 8 + 512 * i;
      float4 g0 = *(const float4*)(p.ssd_norm_g + col), g1 = *(const float4*)(p.ssd_norm_g + col + 4);
      uint4 o;
      o.x = pack2(v[8 * i] * sc * g0.x, v[8 * i + 1] * sc * g0.y);
      o.y = pack2(v[8 * i + 2] * sc * g0.z, v[8 * i + 3] * sc * g0.w);
      o.z = pack2(v[8 * i + 4] * sc * g1.x, v[8 * i + 5] * sc * g1.y);
      o.w = pack2(v[8 * i + 6] * sc * g1.z, v[8 * i + 7] * sc * g1.w);
      *(uint4*)(YF + tiled(tok, col, 32)) = o;
    }
  }
}

__device__ __forceinline__ void final_norm_phase(const Params& p) {
  const int otid = opaque_tid();
  const int lane = otid & 63, w = otid >> 6;
  for (int tok = blockIdx.x * 4 + w; tok < NT; tok += gridDim.x * 4) {
    float* xr = p.out + (size_t)tok * 1024;
    float4 v[4];
    float ss = 0.f;
#pragma unroll
    for (int i = 0; i < 4; ++i) {
      v[i] = *(const float4*)(xr + lane * 4 + 256 * i);
      ss += v[i].x * v[i].x + v[i].y * v[i].y + v[i].z * v[i].z + v[i].w * v[i].w;
    }
    ss = wave_sum(ss);
    const float sc = rsqrtf(ss * (1.f / 1024.f) + 1e-6f);
#pragma unroll
    for (int i = 0; i < 4; ++i) {
      const int col = lane * 4 + 256 * i;
      float4 gg = *(const float4*)(p.norm_f_g + col);
      *(float4*)(xr + col) = make_float4(v[i].x * sc * gg.x, v[i].y * sc * gg.y, v[i].z * sc * gg.z, v[i].w * sc * gg.w);
    }
  }
}


#define XB_TMO      128
#define XB_XCNT(j)  (256  + 64 * (j))
#define XB_XSUB(j)  (1280 + 64 * (j))
#define XB_XGEN(j)  (2304 + 64 * (j))
#define XB_TOP      3328
#define XB_TOPGEN   3392
#define XCD_BAR_WORDS 3456
#define XB_SPIN_CAP (1u << 22)
#define LAS __attribute__((address_space(3)))
__device__ __forceinline__ unsigned xb_ld(unsigned* p) { return __hip_atomic_load(p, __ATOMIC_RELAXED, __HIP_MEMORY_SCOPE_AGENT); }
__device__ __forceinline__ unsigned xb_add(unsigned* p, unsigned v) { return __hip_atomic_fetch_add(p, v, __ATOMIC_RELAXED, __HIP_MEMORY_SCOPE_AGENT); }
__device__ __forceinline__ unsigned xb_xcc_id() { return (unsigned)__builtin_amdgcn_s_getreg((3 << 11) | 20) & 0xFu; }
#define XB_SPIN(cond, bar) do { unsigned _sp = 0; while (cond) { __builtin_amdgcn_s_sleep(1); \
    if ((++_sp & 255u) == 0u) { if (xb_ld(&(bar)[XB_TMO])) break; if (_sp > XB_SPIN_CAP) { atomicAdd(&(bar)[XB_TMO], 1u); break; } } } } while (0)
struct XcdBarrier { unsigned* bar; unsigned x; volatile LAS unsigned* st; };
__device__ __forceinline__ XcdBarrier xcd_barrier_post(unsigned* bar, volatile LAS unsigned* st) {
  XcdBarrier b; b.bar = bar; b.x = xb_xcc_id(); b.st = st;
  if (threadIdx.x == 0) (void)xb_add(&bar[XB_XCNT(b.x)], 1u);
  return b;
}
__device__ __forceinline__ void xcd_barrier_complete(unsigned* bar, unsigned x, unsigned& nloc, unsigned& nx) {
  const unsigned G = gridDim.x * gridDim.y * gridDim.z;
  unsigned sum, cnt, mine, sp = 0u;
  for (;;) {
    sum = 0u; cnt = 0u; mine = 0u;
#pragma unroll
    for (unsigned j = 0; j < 16; ++j) { const unsigned c = xb_ld(&bar[XB_XCNT(j)]); sum += c; cnt += (c > 0u) ? 1u : 0u; mine = (j == x) ? c : mine; }
    if (sum == G) break;
    __builtin_amdgcn_s_sleep(1);
    if ((++sp & 255u) == 0u) { if (xb_ld(&bar[XB_TMO])) break; if (sp > XB_SPIN_CAP) { atomicAdd(&bar[XB_TMO], 1u); break; } }
  }
  nloc = mine > 0u ? mine : 1u; nx = cnt > 0u ? cnt : 1u;
}
__device__ __forceinline__ void xcd_barrier(const XcdBarrier& b) {
  asm volatile("s_waitcnt vmcnt(0)" ::: "memory");
  __syncthreads();
  if (threadIdx.x == 0) {
    unsigned* bar = b.bar;
    __builtin_amdgcn_s_waitcnt(0);
    unsigned nloc = b.st[0], nx = b.st[1];
    if (nloc == 0u) { xcd_barrier_complete(bar, b.x, nloc, nx); b.st[0] = nloc; b.st[1] = nx; }
    const unsigned old = xb_add(&bar[XB_XSUB(b.x)], 1u);
    const unsigned gen = old / nloc;
    if (old + 1u == (gen + 1u) * nloc) {
      __builtin_amdgcn_fence(__ATOMIC_RELEASE, "agent");
      asm volatile("s_waitcnt vmcnt(0)" ::: "memory");
      const unsigned og = xb_add(&bar[XB_TOP], 1u);
      const unsigned tg = og / nx;
      if (og + 1u == (tg + 1u) * nx) xb_add(&bar[XB_TOPGEN], 1u);
      else XB_SPIN(xb_ld(&bar[XB_TOPGEN]) == tg, bar);
      __builtin_amdgcn_fence(__ATOMIC_ACQUIRE, "agent");
      xb_add(&bar[XB_XGEN(b.x)], 1u);
      asm volatile("s_waitcnt vmcnt(0)" ::: "memory");
    } else {
      XB_SPIN(xb_ld(&bar[XB_XGEN(b.x)]) == gen, bar);
      __builtin_amdgcn_fence(__ATOMIC_ACQUIRE, "agent");
      asm volatile("s_waitcnt vmcnt(0)" ::: "memory");
    }
  }
  __syncthreads();
}

#define N_PHASES 19
__global__ void __launch_bounds__(256, 2) mk(Params p, int ph_begin, int ph_end) {
  __shared__ __attribute__((aligned(16))) char smem[SMEM_BYTES];
  __shared__ uint4 xb_words;
  const bool multi = (ph_end - ph_begin) > 1;
  if (threadIdx.x == 0) xb_words = make_uint4(0u, 0u, 0u, 0u);
  __syncthreads();
  XcdBarrier xb;
  xb.bar = (unsigned*)(p.ws + OFF_BAR); xb.x = 0; xb.st = (volatile LAS unsigned*)&xb_words;
  if (multi) xb = xcd_barrier_post((unsigned*)(p.ws + OFF_BAR), (volatile LAS unsigned*)&xb_words);
  if (ph_begin < 0) cg::this_grid().sync();
  bf16_t* WT = (bf16_t*)(p.ws + OFF_WT);
  bf16_t* BIG = (bf16_t*)(p.ws + OFF_BIG);
  bf16_t* Abuf = (bf16_t*)(p.ws + OFF_YF);
  float* MOD = (float*)(p.ws + OFF_MOD);
#define RUN(PH, CALL) if (ph_begin <= PH && PH < ph_end) { CALL; if (PH + 1 < ph_end) xcd_barrier(xb); }
  RUN(0, prep_phase(p, smem))
  RUN(1, norm_mod_phase(p, 0, 0, true))
  RUN(2, gemm_phase(Abuf, WT + WT_SCIN, NT, 3072, 1024, EpiBf16{BIG, 3072}, smem))
  RUN(3, conv_gate_phase(p))
  RUN(4, gemm_phase((const bf16_t*)(p.ws + OFF_BIG + 120 * MIB), WT + WT_SCOUT, NT, 1024, 1024,
                    EpiRes{p.x_prompt, p.x_sample, p.out, MOD + 0 * 5 * 6144 + 2 * 1024}, smem))
  RUN(5, norm_mod_phase(p, 0, 1, false))
  RUN(6, gemm_phase(Abuf, WT + WT_WQ, NT, 2048, 1024, EpiBf16{BIG, 2048}, smem))
  RUN(7, topk_phase(p, 0, smem))
  RUN(8, peer_phase(p, 0, smem))
  RUN(10, gemm_phase(Abuf, WT + WT_SSDIN, NT, 6208, 1024, EpiSsdIn{BIG, (float*)(p.ws + OFF_DT), p.ssd_dt_bias}, smem))
  RUN(11, ssd_conv_phase(p))
  RUN(12, scan_phase(p, smem))
  RUN(13, gate_norm_phase(p))
  RUN(14, gemm_phase(Abuf, WT + WT_SSDOUT, NT, 1024, 2048,
                     EpiRes{p.out, p.out + (size_t)NCTX * 1024, p.out, MOD + 1 * 5 * 6144 + 2 * 1024}, smem))
  RUN(15, norm_mod_phase(p, 1, 1, false))
  RUN(16, gemm_phase(Abuf, WT + WT_WQ + (size_t)2048 * 1024, NT, 2048, 1024, EpiBf16{BIG, 2048}, smem))
  RUN(17, topk_phase(p, 1, smem))
  RUN(18, peer_phase(p, 1, smem))
}

extern "C" void kernel_launch(void* const* d_in, const int* in_sizes, int n_in, void* d_out, int out_size, void* d_ws, size_t ws_size,
                              hipStream_t stream) {
  static int grid_blocks = 0;
  if (!grid_blocks) {
    int dev = 0, cus = 0, per_cu = 0;
    hipGetDevice(&dev);
    hipDeviceGetAttribute(&cus, hipDeviceAttributeMultiprocessorCount, dev);
    hipOccupancyMaxActiveBlocksPerMultiprocessor(&per_cu, mk, 256, 0);
    if (per_cu < 1) per_cu = 1;
    if (per_cu > 2) per_cu = 2;
    grid_blocks = cus * per_cu;
  }
  if (ws_size < WS_NEEDED) { fprintf(stderr, "workspace too small: %zu\n", ws_size); return; }
  Params p{};
  const float** pf = (const float**)&p;
  for (int i = 0; i < 25; ++i) pf[i] = (const float*)d_in[i];
  p.out = (float*)d_out;
  p.ws = (char*)d_ws;
#if COOP
  hipMemsetAsync((char*)d_ws + OFF_BAR, 0, 16384, stream);
  int b = 0, e = N_PHASES;
  void* args[] = {&p, &b, &e};
  hipError_t err = hipLaunchCooperativeKernel((void*)mk, dim3(grid_blocks), dim3(256), args, 0, stream);
  if (err != hipSuccess) fprintf(stderr, "cooperative launch failed: %s (grid %d)\n", hipGetErrorString(err), grid_blocks);
#else
  for (int ph = 0; ph < N_PHASES; ++ph) {
    hipLaunchKernelGGL(mk, dim3(grid_blocks), dim3(256), 0, stream, p, ph, ph + 1);
    if ((DUP_MASK >> ph) & 1) hipLaunchKernelGGL(mk, dim3(grid_blocks), dim3(256), 0, stream, p, ph, ph + 1);
  }
#endif
}
```

```cpp
#include <hip/hip_runtime.h>
#include <hip/hip_cooperative_groups.h>
#include <cstdio>
namespace cg = cooperative_groups;

#ifndef COOP
#define COOP 1
#endif
#ifndef DUP_MASK
#define DUP_MASK 0
#endif

typedef unsigned short bf16_t;
typedef __attribute__((ext_vector_type(8))) short bf16x8;
typedef __attribute__((ext_vector_type(16))) float f32x16;
typedef __attribute__((ext_vector_type(32))) float f32x32;
typedef __attribute__((ext_vector_type(6))) unsigned u32x6;

#define NT 20480
#define NCTX 4096
#define DM 1024
#define MIB ((size_t)1 << 20)
#define OFF_BIG   ((size_t)0)
#define OFF_YF    (240 * MIB)
#define OFF_YB    (320 * MIB)
#define OFF_WT    (400 * MIB)
#define OFF_KEYSB (433 * MIB)
#define OFF_DT    (434 * MIB)
#define OFF_MOD   (439 * MIB)
#define OFF_IDX   (440 * MIB)
#define OFF_GATE  (450 * MIB)
#define OFF_TAB1  (460 * MIB)
#define OFF_SCALE (492 * MIB)
#define OFF_BAR   (493 * MIB)
#define WS_NEEDED (494 * MIB)
#define WT_SCIN   ((size_t)0)
#define WT_SCOUT  (WT_SCIN + (size_t)3072 * 1024)
#define WT_SSDIN  (WT_SCOUT + (size_t)1024 * 1024)
#define WT_SSDOUT (WT_SSDIN + (size_t)6272 * 1024)
#define WT_WQ     (WT_SSDOUT + (size_t)1024 * 2048)

#define SMEM_BYTES 75776

struct Params {
  const float *x_prompt, *x_sample, *state_ssm, *c, *c_ctx, *norm_mix_g, *norm_ffn_g, *norm_f_g, *ada_w, *ada_b;
  const float *sc_w_in, *sc_conv_w, *sc_w_out, *ssd_w_in, *ssd_conv_w, *ssd_conv_b, *ssd_dt_bias, *ssd_a_log, *ssd_d;
  const float *ssd_norm_g, *ssd_w_out, *peer_wq, *peer_keys, *peer_u, *peer_v;
  float* out;
  char* ws;
};

__device__ __forceinline__ float bf2f(bf16_t h) { return __uint_as_float(((unsigned)h) << 16); }
__device__ __forceinline__ bf16_t f2bf(float f) {
  unsigned u = __float_as_uint(f);
  u += 0x7FFFu + ((u >> 16) & 1u);
  return (bf16_t)(u >> 16);
}
__device__ __forceinline__ unsigned pack2(float a, float b) { return (unsigned)f2bf(a) | ((unsigned)f2bf(b) << 16); }
__device__ __forceinline__ float lo2f(unsigned u) { return __uint_as_float(u << 16); }
__device__ __forceinline__ float hi2f(unsigned u) { return __uint_as_float(u & 0xffff0000u); }
__device__ __forceinline__ unsigned u4get(const uint4 v, const int q) { return q == 0 ? v.x : (q == 1 ? v.y : (q == 2 ? v.z : v.w)); }
__device__ __forceinline__ int opaque_tid() { int t = threadIdx.x; asm volatile("" : "+v"(t)); return t; }
__device__ __forceinline__ size_t tiled(int row, int col, int KT) { return ((size_t)(row >> 7) * KT + (col >> 6)) * 8192 + (row & 127) * 64 + (col & 63); }
__device__ __forceinline__ float siluf(float x) { return x / (1.f + __expf(-x)); }
__device__ __forceinline__ int cidx(int tok) { return tok < NCTX ? 0 : 1 + ((tok - NCTX) >> 12); }

template <int CTRL>
__device__ __forceinline__ unsigned dpp_u(unsigned v) {
  return (unsigned)__builtin_amdgcn_update_dpp(0, (int)v, CTRL, 0xF, 0xF, true);
}
template <int CTRL>
__device__ __forceinline__ float dpp_f(float v) {
  return __int_as_float(__builtin_amdgcn_update_dpp(0, __float_as_int(v), CTRL, 0xF, 0xF, true));
}
__device__ __forceinline__ float row16_sum(float v) {
  v += dpp_f<0xB1>(v);
  v += dpp_f<0x4E>(v);
  v += dpp_f<0x141>(v);
  v += dpp_f<0x140>(v);
  return v;
}
__device__ __forceinline__ unsigned umax_(unsigned a, unsigned b) { return a > b ? a : b; }
__device__ __forceinline__ unsigned row_max_u32(unsigned v) {
  v = umax_(v, dpp_u<0xB1>(v));
  v = umax_(v, dpp_u<0x4E>(v));
  v = umax_(v, dpp_u<0x141>(v));
  v = umax_(v, dpp_u<0x140>(v));
  return v;
}
__device__ __forceinline__ unsigned wave_max_u32(unsigned v) {
  v = umax_(v, dpp_u<0xB1>(v));
  v = umax_(v, dpp_u<0x4E>(v));
  v = umax_(v, dpp_u<0x141>(v));
  v = umax_(v, dpp_u<0x140>(v));
  unsigned a = (unsigned)__builtin_amdgcn_readlane((int)v, 0);
  unsigned b = (unsigned)__builtin_amdgcn_readlane((int)v, 16);
  unsigned c = (unsigned)__builtin_amdgcn_readlane((int)v, 32);
  unsigned d = (unsigned)__builtin_amdgcn_readlane((int)v, 48);
  return umax_(umax_(a, b), umax_(c, d));
}
__device__ __forceinline__ float wave_sum(float v) {
  v = row16_sum(v);
  float a, b, c, d;
  a = __int_as_float(__builtin_amdgcn_readlane(__float_as_int(v), 0));
  b = __int_as_float(__builtin_amdgcn_readlane(__float_as_int(v), 16));
  c = __int_as_float(__builtin_amdgcn_readlane(__float_as_int(v), 32));
  d = __int_as_float(__builtin_amdgcn_readlane(__float_as_int(v), 48));
  return (a + b) + (c + d);
}
__device__ __forceinline__ unsigned fkey(float f) {
  unsigned u = __float_as_uint(f);
  return (u & 0x80000000u) ? ~u : (u | 0x80000000u);
}
__device__ __forceinline__ float keyf(unsigned k) {
  unsigned u = (k & 0x80000000u) ? (k & 0x7fffffffu) : ~k;
  return __uint_as_float(u);
}

__device__ __forceinline__ void transpose_tile(const float* __restrict__ src, int K, int N, bf16_t* __restrict__ dst, int tile, float* tb) {
  const int tid = threadIdx.x;
  const int ntn = N >> 6;
  const int kt = tile / ntn, nt = tile % ntn;
  {
    const int n = tid & 63, kb = tid >> 6;
#pragma unroll
    for (int i = 0; i < 16; ++i) {
      int k = kb + 4 * i;
      tb[k * 65 + n] = src[(size_t)(kt * 64 + k) * N + nt * 64 + n];
    }
  }
  __syncthreads();
  {
    const int k8 = (tid & 7) * 8;
#pragma unroll
    for (int pass = 0; pass < 2; ++pass) {
      int n = (tid >> 3) + 32 * pass;
      uint4 o;
      o.x = pack2(tb[(k8 + 0) * 65 + n], tb[(k8 + 1) * 65 + n]);
      o.y = pack2(tb[(k8 + 2) * 65 + n], tb[(k8 + 3) * 65 + n]);
      o.z = pack2(tb[(k8 + 4) * 65 + n], tb[(k8 + 5) * 65 + n]);
      o.w = pack2(tb[(k8 + 6) * 65 + n], tb[(k8 + 7) * 65 + n]);
      *(uint4*)(dst + tiled(nt * 64 + n, kt * 64 + k8, K >> 6)) = o;
    }
  }
  __syncthreads();
}

__device__ __forceinline__ void prep_phase(const Params& p, char* smem) {
  const int otid = opaque_tid();
  const int tid = otid;
  bf16_t* WT = (bf16_t*)(p.ws + OFF_WT);
  float* MOD = (float*)(p.ws + OFF_MOD);
  bf16_t* KEYSB = (bf16_t*)(p.ws + OFF_KEYSB);
  const int U_MOD = 192, U_T0 = 768, U_T1 = 256, U_T2 = 1552, U_T3 = 512, U_T4 = 1024, U_KEYS = 256, U_TAB = 8192;
  const int total = U_MOD + U_T0 + U_T1 + U_T2 + U_T3 + U_T4 + U_KEYS + U_TAB;
  for (int u = blockIdx.x; u < total; u += gridDim.x) {
    int v = u;
    if (v < U_MOD) {
      float* scond = (float*)smem;
      float* red = scond + 5 * 1024;
      for (int i = tid; i < 5 * 1024; i += 256) {
        int r = i >> 10, k = i & 1023;
        float cv = (r == 0) ? p.c_ctx[k] : p.c[(r - 1) * 1024 + k];
        scond[i] = siluf(cv);
      }
      __syncthreads();
      const int l = v / 96, jc = v % 96;
      const int jj = tid & 63, kq = tid >> 6;
      const int j = jc * 64 + jj;
      float acc[5] = {0.f, 0.f, 0.f, 0.f, 0.f};
      const float* wp = p.ada_w + ((size_t)l * 1024 + kq * 256) * 6144 + j;
#pragma unroll 1
      for (int k0 = 0; k0 < 256; k0 += 32) {
        float wv[32];
#pragma unroll
        for (int k = 0; k < 32; ++k) wv[k] = wp[(size_t)(k0 + k) * 6144];
#pragma unroll
        for (int k = 0; k < 32; ++k)
#pragma unroll
          for (int r = 0; r < 5; ++r) acc[r] += scond[r * 1024 + kq * 256 + k0 + k] * wv[k];
      }
#pragma unroll
      for (int r = 0; r < 5; ++r) red[(kq * 5 + r) * 64 + jj] = acc[r];
      __syncthreads();
      for (int i = tid; i < 320; i += 256) {
        int r = i >> 6, j2 = i & 63;
        float s = red[(0 * 5 + r) * 64 + j2] + red[(1 * 5 + r) * 64 + j2] + red[(2 * 5 + r) * 64 + j2] + red[(3 * 5 + r) * 64 + j2];
        MOD[(size_t)(l * 5 + r) * 6144 + jc * 64 + j2] = s + p.ada_b[l * 6144 + jc * 64 + j2];
      }
      __syncthreads();
      continue;
    }
    v -= U_MOD;
    float* tb = (float*)smem;
    if (v < U_T0) { transpose_tile(p.sc_w_in, 1024, 3072, WT + WT_SCIN, v, tb); continue; }
    v -= U_T0;
    if (v < U_T1) { transpose_tile(p.sc_w_out, 1024, 1024, WT + WT_SCOUT, v, tb); continue; }
    v -= U_T1;
    if (v < U_T2) { transpose_tile(p.ssd_w_in, 1024, 6208, WT + WT_SSDIN, v, tb); continue; }
    v -= U_T2;
    if (v < U_T3) { transpose_tile(p.ssd_w_out, 2048, 1024, WT + WT_SSDOUT, v, tb); continue; }
    v -= U_T3;
    if (v < U_T4) {
      int l = v >> 9, t = v & 511;
      transpose_tile(p.peer_wq + (size_t)l * 1024 * 2048, 1024, 2048, WT + WT_WQ + (size_t)l * 2048 * 1024, t, tb);
      continue;
    }
    v -= U_T4;
    if (v < U_KEYS) {
      size_t base = (size_t)v * 2048 + tid * 8;
      float4 a = *(const float4*)(p.peer_keys + base);
      float4 b = *(const float4*)(p.peer_keys + base + 4);
      uint4 o;
      o.x = pack2(a.x, a.y); o.y = pack2(a.z, a.w); o.z = pack2(b.x, b.y); o.w = pack2(b.z, b.w);
      *(uint4*)(KEYSB + base) = o;
      continue;
    }
    v -= U_KEYS;
    {
      const int lane = tid & 63, l31 = lane & 31;
      const int gr = v * 8 + (tid >> 6) * 2 + (lane >> 5);
      const int l = gr >> 15, tab = (gr >> 14) & 1, row = gr & 16383;
      const float* src = (tab ? p.peer_v : p.peer_u) + ((size_t)l * 16384 + row) * 1024 + l31 * 32;
      float4 x[8];
      float am = 0.f;
#pragma unroll
      for (int j = 0; j < 8; ++j) {
        x[j] = *(const float4*)(src + 4 * j);
        am = fmaxf(am, fmaxf(fmaxf(fabsf(x[j].x), fabsf(x[j].y)), fmaxf(fabsf(x[j].z), fabsf(x[j].w))));
      }
      {
        unsigned au = row_max_u32(__float_as_uint(am));
        const unsigned ao = (unsigned)__shfl_xor((int)au, 16);
        am = __uint_as_float(umax_(au, ao));
      }
      const float inv = am > 0.f ? 7.0f / am : 0.f;
      const float scale = am > 0.f ? am / 7.0f : 0.f;
      f32x16 fa, fb;
#pragma unroll
      for (int j = 0; j < 8; ++j) {
        fa[2 * j] = x[j].x * inv; fb[2 * j] = x[j].y * inv; fa[2 * j + 1] = x[j].z * inv; fb[2 * j + 1] = x[j].w * inv;
      }
      const u32x6 pk = __builtin_amdgcn_cvt_scalef32_2xpk16_fp6_f32(fa, fb, 1.0f);
      unsigned char* dst = (unsigned char*)(p.ws + (l ? OFF_TAB1 : OFF_YB)) + ((size_t)tab * 16384 + row) * 768 + l31 * 24;
      *(uint2*)(dst) = make_uint2(pk[0], pk[1]);
      *(uint2*)(dst + 8) = make_uint2(pk[2], pk[3]);
      *(uint2*)(dst + 16) = make_uint2(pk[4], pk[5]);
      if (l31 == 0) ((float*)(p.ws + OFF_SCALE))[gr] = scale;
    }
  }
}

__device__ __forceinline__ void norm_mod_phase(const Params& p, int layer, int which, bool from_input) {
  const int otid = opaque_tid();
  const float* g = (which == 0 ? p.norm_mix_g : p.norm_ffn_g) + layer * 1024;
  const float* MOD = (const float*)(p.ws + OFF_MOD);
  bf16_t* A = (bf16_t*)(p.ws + OFF_YF);
  const int lane = otid & 63, w = otid >> 6;
  for (int tok = blockIdx.x * 4 + w; tok < NT; tok += gridDim.x * 4) {
    const float* xr = from_input ? (tok < NCTX ? p.x_prompt + (size_t)tok * 1024 : p.x_sample + (size_t)(tok - NCTX) * 1024)
                                 : p.out + (size_t)tok * 1024;
    const float* md = MOD + (size_t)(layer * 5 + cidx(tok)) * 6144 + (which ? 3 * 1024 : 0);
    float4 v[4];
    float ss = 0.f;
#pragma unroll
    for (int i = 0; i < 4; ++i) {
      v[i] = *(const float4*)(xr + lane * 4 + 256 * i);
      ss += v[i].x * v[i].x + v[i].y * v[i].y + v[i].z * v[i].z + v[i].w * v[i].w;
    }
    ss = wave_sum(ss);
    const float sc = rsqrtf(ss * (1.f / 1024.f) + 1e-6f);
#pragma unroll
    for (int i = 0; i < 4; ++i) {
      const int col = lane * 4 + 256 * i;
      float4 gg = *(const float4*)(g + col);
      float4 sh = *(const float4*)(md + col);
      float4 sl = *(const float4*)(md + 1024 + col);
      float o0 = v[i].x * sc * gg.x * (1.f + sl.x) + sh.x;
      float o1 = v[i].y * sc * gg.y * (1.f + sl.y) + sh.y;
      float o2 = v[i].z * sc * gg.z * (1.f + sl.z) + sh.z;
      float o3 = v[i].w * sc * gg.w * (1.f + sl.w) + sh.w;
      uint2 o;
      o.x = pack2(o0, o1);
      o.y = pack2(o2, o3);
      *(uint2*)(A + tiled(tok, col, 16)) = o;
    }
  }
}

#define LSTR 72
template <class Epi>
__device__ __forceinline__ void gemm_phase(const bf16_t* __restrict__ A, const bf16_t* __restrict__ Bt, int M, int N, int K, Epi epi, char* smem) {
  const int otid = opaque_tid();
  bf16_t* sA = (bf16_t*)smem;
  bf16_t* sB = sA + 2 * 128 * LSTR;
  float* sC = (float*)smem;
  const int tid = otid, lane = tid & 63, w = tid >> 6;
  const int wm = w >> 1, wn = w & 1;
  const int ntn = (N + 127) >> 7, ntm = M >> 7;
  const int ntiles = ntm * ntn;
  const int KT = K >> 6;
  const int lrow = tid >> 3, lkc = (tid & 7) * 8;
  const bf16_t* apb;
  const bf16_t* bpb;
  uint4 ra0_0, ra0_1, ra0_2, ra0_3, rb0_0, rb0_1, rb0_2, rb0_3, ra1_0, ra1_1, ra1_2, ra1_3, rb1_0, rb1_1, rb1_2, rb1_3;
  const int G_ = gridDim.x;
  const int RN = (ntn % 8 == 0) ? 8 : ((ntn % 7 == 0) ? 7 : ((ntn % 6 == 0) ? 6 : ((ntn % 5 == 0) ? 5 : 4)));
  const int RM = ((G_ >> 3) / RN) > 0 ? ((G_ >> 3) / RN) : 1;
  const int nrn = (ntn + RN - 1) / RN, nrm = (ntm + RM - 1) / RM;
  const int nrects = nrn * nrm;
  const int nslots = ((nrects + 7) >> 3) * G_;
#define G_MAP(T_, VALID_, MT_, NT_) { const int i_ = (T_) / G_, b_ = (T_) - i_ * G_; const int R_ = i_ * 8 + (b_ & 7); const int s_ = b_ >> 3; \
    const int rm_ = R_ / nrn, rn_ = R_ - rm_ * nrn; const int dm_ = s_ / RN, dn_ = s_ - dm_ * RN; MT_ = rm_ * RM + dm_; NT_ = rn_ * RN + dn_; \
    VALID_ = (dm_ < RM) && (R_ < nrects) && (MT_ < ntm) && (NT_ < ntn); }
#define G_NEXT(T_, MT_, NT_) { bool ok_ = false; while ((T_) < nslots) { G_MAP(T_, ok_, MT_, NT_) if (ok_) break; (T_) += G_; } }
#define G_PTRS(MT_, NT_) { apb = A + (size_t)(MT_) * KT * 8192 + lrow * 64 + lkc; bpb = Bt + (size_t)(NT_) * KT * 8192 + lrow * 64 + lkc; }
#define G_LOAD1(S, I, KT_) { ra##S##_##I = *(const uint4*)(apb + (KT_) * 8192 + I * 2048); rb##S##_##I = *(const uint4*)(bpb + (KT_) * 8192 + I * 2048); }
#define G_LOAD(S, KT_) { G_LOAD1(S, 0, KT_) G_LOAD1(S, 1, KT_) G_LOAD1(S, 2, KT_) G_LOAD1(S, 3, KT_) }
#define G_WRITE1(S, I, BUF_) { *(uint4*)(sA + (BUF_) * 128 * LSTR + (lrow + 32 * I) * LSTR + lkc) = ra##S##_##I; *(uint4*)(sB + (BUF_) * 128 * LSTR + (lrow + 32 * I) * LSTR + lkc) = rb##S##_##I; }
#define G_WRITE(S, BUF_) { G_WRITE1(S, 0, BUF_) G_WRITE1(S, 1, BUF_) G_WRITE1(S, 2, BUF_) G_WRITE1(S, 3, BUF_) }
#define G_FRAG(KK, A0, A1, B0, B1) { A0 = *(const bf16x8*)(cA + KK * 16); A1 = *(const bf16x8*)(cA + 32 * LSTR + KK * 16); \
        B0 = *(const bf16x8*)(cB + KK * 16); B1 = *(const bf16x8*)(cB + 32 * LSTR + KK * 16); }
#define G_MMA4(A0, A1, B0, B1) { \
        acc[0][0] = __builtin_amdgcn_mfma_f32_32x32x16_bf16(A0, B0, acc[0][0], 0, 0, 0); \
        acc[0][1] = __builtin_amdgcn_mfma_f32_32x32x16_bf16(A0, B1, acc[0][1], 0, 0, 0); \
        acc[1][0] = __builtin_amdgcn_mfma_f32_32x32x16_bf16(A1, B0, acc[1][0], 0, 0, 0); \
        acc[1][1] = __builtin_amdgcn_mfma_f32_32x32x16_bf16(A1, B1, acc[1][1], 0, 0, 0); }
#define G_COMPUTE(BUF_) { \
      const bf16_t* cA = sA + (BUF_) * 128 * LSTR + (wm * 64 + (lane & 31)) * LSTR + (lane >> 5) * 8; \
      const bf16_t* cB = sB + (BUF_) * 128 * LSTR + (wn * 64 + (lane & 31)) * LSTR + (lane >> 5) * 8; \
      bf16x8 xa0, xa1, xb0, xb1, ya0, ya1, yb0, yb1; \
      G_FRAG(0, xa0, xa1, xb0, xb1) \
      G_FRAG(1, ya0, ya1, yb0, yb1) \
      __builtin_amdgcn_s_setprio(1); \
      G_MMA4(xa0, xa1, xb0, xb1) \
      __builtin_amdgcn_sched_barrier(0); \
      G_FRAG(2, xa0, xa1, xb0, xb1) \
      G_MMA4(ya0, ya1, yb0, yb1) \
      __builtin_amdgcn_sched_barrier(0); \
      G_FRAG(3, ya0, ya1, yb0, yb1) \
      G_MMA4(xa0, xa1, xb0, xb1) \
      __builtin_amdgcn_sched_barrier(0); \
      G_MMA4(ya0, ya1, yb0, yb1) \
      __builtin_amdgcn_s_setprio(0); }
  int tile = blockIdx.x, mt = 0, nt = 0;
  G_NEXT(tile, mt, nt)
  if (tile < nslots) { G_PTRS(mt, nt) G_LOAD(0, 0) G_LOAD(1, 1) }
  while (tile < nslots) {
    const int m0 = mt << 7, n0 = nt << 7;
    f32x16 acc[2][2];
#pragma unroll
    for (int i = 0; i < 2; ++i)
#pragma unroll
      for (int j = 0; j < 2; ++j)
#pragma unroll
        for (int r = 0; r < 16; ++r) acc[i][j][r] = 0.f;
    G_WRITE(0, 0)
    __syncthreads();
    for (int kt = 0; kt < KT; kt += 2) {
      if (kt + 2 < KT) G_LOAD(0, kt + 2)
      G_COMPUTE(0)
      G_WRITE(1, 1)
      __syncthreads();
      if (kt + 3 < KT) G_LOAD(1, kt + 3)
      G_COMPUTE(1)
      if (kt + 2 < KT) G_WRITE(0, 0)
      __syncthreads();
    }
    int next = tile + G_;
    G_NEXT(next, mt, nt)
    if (next < nslots) { G_PTRS(mt, nt) G_LOAD(0, 0) G_LOAD(1, 1) }
#pragma unroll
    for (int mi = 0; mi < 2; ++mi)
#pragma unroll
      for (int ni = 0; ni < 2; ++ni) {
        float* cw = sC + (wm * 64 + mi * 32 + 4 * (lane >> 5)) * 132 + wn * 64 + ni * 32 + (lane & 31);
#pragma unroll
        for (int r = 0; r < 16; ++r) cw[((r & 3) + 8 * (r >> 2)) * 132] = acc[mi][ni][r];
      }
    __syncthreads();
#pragma unroll 4
    for (int i = 0; i < 16; ++i) {
      const int ch = tid + 256 * i;
      const int row = ch >> 5, c4 = (ch & 31) * 4;
      const float4 v = *(const float4*)(sC + row * 132 + c4);
      if (n0 + c4 < N) epi(m0 + row, n0 + c4, v);
    }
    __syncthreads();
    tile = next;
  }
}

struct EpiBf16 {
  bf16_t* C; int ldc;
  __device__ __forceinline__ void operator()(int m, int n, float4 v) const {
    uint2 o; o.x = pack2(v.x, v.y); o.y = pack2(v.z, v.w);
    *(uint2*)(C + (size_t)m * ldc + n) = o;
  }
};
__device__ __forceinline__ float softplusf(float x) { return x > 20.f ? x : log1pf(expf(x)); }
struct EpiSsdIn {
  bf16_t* C; float* DT; const float* dt_bias;
  __device__ __forceinline__ void operator()(int m, int n, float4 v) const {
    if (n < 6144) {
      uint2 o; o.x = pack2(v.x, v.y); o.y = pack2(v.z, v.w);
      *(uint2*)(C + (size_t)m * 6144 + n) = o;
    } else {
      const int c = n - 6144;
      const float4 bb = *(const float4*)(dt_bias + c);
      *(float4*)(DT + (size_t)m * 64 + c) = make_float4(softplusf(v.x + bb.x), softplusf(v.y + bb.y), softplusf(v.z + bb.z), softplusf(v.w + bb.w));
    }
  }
};
struct EpiRes {
  const float* xin_ctx; const float* xin_lat; float* X; const float* gate;
  __device__ __forceinline__ void operator()(int m, int n, float4 v) const {
    const float* xr = m < NCTX ? xin_ctx + (size_t)m * 1024 : xin_lat + (size_t)(m - NCTX) * 1024;
    const float4 xv = *(const float4*)(xr + n);
    const float4 gt = *(const float4*)(gate + (size_t)cidx(m) * 6144 + n);
    *(float4*)(X + (size_t)m * 1024 + n) = make_float4(xv.x + gt.x * v.x, xv.y + gt.y * v.y, xv.z + gt.z * v.z, xv.w + gt.w * v.w);
  }
};

__device__ __forceinline__ void conv_gate_phase(const Params& p) {
  const int otid = opaque_tid();
  const bf16_t* P = (const bf16_t*)(p.ws + OFF_BIG);
  bf16_t* G = (bf16_t*)(p.ws + OFF_BIG + 120 * MIB);
  const float* cw = p.sc_conv_w;
  const int total = NT * 128;
  for (int it = blockIdx.x * 256 + otid; it < total; it += gridDim.x * 256) {
    const int tok = it >> 7, c = (it & 127) * 8;
    const int rowlen = tok < NCTX ? 256 : 64;
    const int pos = tok & (rowlen - 1);
    const bf16_t* pr = P + (size_t)tok * 3072;
    uint4 bg = *(const uint4*)(pr + c);
    uint4 cg = *(const uint4*)(pr + 1024 + c);
    uint4 xv = *(const uint4*)(pr + 2048 + c);
    uint4 cgl = make_uint4(0, 0, 0, 0), xvl = cgl, cgr = cgl, xvr = cgl;
    if (pos > 0) { cgl = *(const uint4*)(pr - 3072 + 1024 + c); xvl = *(const uint4*)(pr - 3072 + 2048 + c); }
    if (pos < rowlen - 1) { cgr = *(const uint4*)(pr + 3072 + 1024 + c); xvr = *(const uint4*)(pr + 3072 + 2048 + c); }
    const unsigned* bgp = (const unsigned*)&bg; const unsigned* cgp = (const unsigned*)&cg; const unsigned* xvp = (const unsigned*)&xv;
    const unsigned* cglp = (const unsigned*)&cgl; const unsigned* xvlp = (const unsigned*)&xvl;
    const unsigned* cgrp = (const unsigned*)&cgr; const unsigned* xvrp = (const unsigned*)&xvr;
    float4 w0a = *(const float4*)(cw + c), w0b = *(const float4*)(cw + c + 4);
    float4 w1a = *(const float4*)(cw + 1024 + c), w1b = *(const float4*)(cw + 1024 + c + 4);
    float4 w2a = *(const float4*)(cw + 2048 + c), w2b = *(const float4*)(cw + 2048 + c + 4);
    const float w0[8] = {w0a.x, w0a.y, w0a.z, w0a.w, w0b.x, w0b.y, w0b.z, w0b.w};
    const float w1[8] = {w1a.x, w1a.y, w1a.z, w1a.w, w1b.x, w1b.y, w1b.z, w1b.w};
    const float w2[8] = {w2a.x, w2a.y, w2a.z, w2a.w, w2b.x, w2b.y, w2b.z, w2b.w};
    unsigned o[4];
#pragma unroll
    for (int q = 0; q < 4; ++q) {
      float r0 = lo2f(bgp[q]) * (w0[2 * q] * lo2f(cglp[q]) * lo2f(xvlp[q]) + w1[2 * q] * lo2f(cgp[q]) * lo2f(xvp[q]) + w2[2 * q] * lo2f(cgrp[q]) * lo2f(xvrp[q]));
      float r1 = hi2f(bgp[q]) * (w0[2 * q + 1] * hi2f(cglp[q]) * hi2f(xvlp[q]) + w1[2 * q + 1] * hi2f(cgp[q]) * hi2f(xvp[q]) + w2[2 * q + 1] * hi2f(cgrp[q]) * hi2f(xvrp[q]));
      o[q] = pack2(r0, r1);
    }
    *(uint4*)(G + tiled(tok, c, 16)) = make_uint4(o[0], o[1], o[2], o[3]);
  }
}

#define SSTR 272
#define CE2_(K, a, b) { unsigned hi_ = umax_(K[a], K[b]); unsigned lo_ = K[a] < K[b] ? K[a] : K[b]; K[a] = hi_; K[b] = lo_; }
#define SORT8_(K) CE2_(K, 0, 1) CE2_(K, 2, 3) CE2_(K, 4, 5) CE2_(K, 6, 7) CE2_(K, 0, 2) CE2_(K, 1, 3) CE2_(K, 4, 6) CE2_(K, 5, 7) \
  CE2_(K, 1, 2) CE2_(K, 5, 6) CE2_(K, 0, 4) CE2_(K, 1, 5) CE2_(K, 2, 6) CE2_(K, 3, 7) CE2_(K, 2, 4) CE2_(K, 3, 5) CE2_(K, 1, 2) CE2_(K, 3, 4) CE2_(K, 5, 6)
__device__ __forceinline__ void top16_rows(const float* Sr0, const float* Sr1, int j, unsigned (&res)[2][2]) {
  unsigned ka[8], kb[8], kc[8], kd[8];
#pragma unroll
  for (int m = 0; m < 8; ++m) {
    const unsigned tag = (unsigned)(127 - (j + 16 * m));
    ka[m] = (fkey(Sr0[j + 16 * m]) & ~0x7Fu) | tag;
    kb[m] = (fkey(Sr0[128 + j + 16 * m]) & ~0x7Fu) | tag;
    kc[m] = (fkey(Sr1[j + 16 * m]) & ~0x7Fu) | tag;
    kd[m] = (fkey(Sr1[128 + j + 16 * m]) & ~0x7Fu) | tag;
  }
  SORT8_(ka)
  SORT8_(kb)
  SORT8_(kc)
  SORT8_(kd)
  unsigned r0 = 0, r1 = 0, r2 = 0, r3 = 0;
#pragma unroll 2
  for (int it = 0; it < 16; ++it) {
    const unsigned wa = row_max_u32(ka[0]);
    const unsigned wb = row_max_u32(kb[0]);
    const unsigned wc = row_max_u32(kc[0]);
    const unsigned wd = row_max_u32(kd[0]);
    const bool wina = ka[0] == wa, winb = kb[0] == wb, winc = kc[0] == wc, wind = kd[0] == wd;
#pragma unroll
    for (int m = 0; m < 7; ++m) {
      ka[m] = wina ? ka[m + 1] : ka[m]; kb[m] = winb ? kb[m + 1] : kb[m];
      kc[m] = winc ? kc[m + 1] : kc[m]; kd[m] = wind ? kd[m + 1] : kd[m];
    }
    ka[7] = wina ? 0u : ka[7]; kb[7] = winb ? 0u : kb[7]; kc[7] = winc ? 0u : kc[7]; kd[7] = wind ? 0u : kd[7];
    r0 = (j == it) ? wa : r0; r1 = (j == it) ? wb : r1; r2 = (j == it) ? wc : r2; r3 = (j == it) ? wd : r3;
  }
  res[0][0] = r0; res[0][1] = r1; res[1][0] = r2; res[1][1] = r3;
}

__device__ __forceinline__ void topk_phase(const Params& p, int layer, char* smem) {
  const int otid = opaque_tid();
  float* S = (float*)smem;
  const bf16_t* Q = (const bf16_t*)(p.ws + OFF_BIG);
  const bf16_t* KB = (const bf16_t*)(p.ws + OFF_KEYSB) + (size_t)layer * (8 * 2 * 128 * 128);
  int* IDX = (int*)(p.ws + OFF_IDX);
  float* GATE = (float*)(p.ws + OFF_GATE);
  const int tid = otid, lane = tid & 63;
  const int w = __builtin_amdgcn_readfirstlane(tid >> 6);
  const int G = gridDim.x;
  const int per = (5120 + G - 1) / G;
  const int start = blockIdx.x * per;
  const int end = (start + per < 5120) ? start + per : 5120;
  const int pp = w >> 1, nt0 = (w & 1) * 2;
  const int j = lane & 15, rowbase = lane & 48;
  int ca[4], cb[4];
  bool cvalid3;
  ca[0] = 0; cb[0] = j;
  if (j < 8) { ca[1] = 1; cb[1] = j; } else { ca[1] = j; cb[1] = 0; }
  if (j < 5) { ca[2] = 2; cb[2] = j; } else if (j < 9) { ca[2] = 3; cb[2] = j - 5; } else if (j < 12) { ca[2] = 4; cb[2] = j - 9; }
  else if (j < 14) { ca[2] = 5; cb[2] = j - 12; } else { ca[2] = 6; cb[2] = j - 14; }
  ca[3] = 7; cb[3] = j & 1; cvalid3 = j < 2;
  int curh = -1;
  bf16x8 kf[2][8];
  bf16x8 qa[8];
  for (int pr = start; pr < end; ++pr) {
    const int h = pr / 640, tile = pr % 640;
    const int t0 = tile * 32;
    if (h != curh) {
#pragma unroll
      for (int jj = 0; jj < 2; ++jj)
#pragma unroll
        for (int kk = 0; kk < 8; ++kk)
          kf[jj][kk] = *(const bf16x8*)(KB + ((size_t)((h * 2 + pp) * 128 + (nt0 + jj) * 32 + (lane & 31))) * 128 + kk * 16 + (lane >> 5) * 8);
      curh = h;
    }
    f32x16 acc[2];
#pragma unroll
    for (int jj = 0; jj < 2; ++jj)
#pragma unroll
      for (int r = 0; r < 16; ++r) acc[jj][r] = 0.f;
    if (pr == start) {
      const bf16_t* qp = Q + (size_t)(t0 + (lane & 31)) * 2048 + h * 256 + pp * 128 + (lane >> 5) * 8;
#pragma unroll
      for (int kk = 0; kk < 8; ++kk) qa[kk] = *(const bf16x8*)(qp + kk * 16);
    }
#pragma unroll
    for (int kk = 0; kk < 8; ++kk) {
      acc[0] = __builtin_amdgcn_mfma_f32_32x32x16_bf16(qa[kk], kf[0][kk], acc[0], 0, 0, 0);
      acc[1] = __builtin_amdgcn_mfma_f32_32x32x16_bf16(qa[kk], kf[1][kk], acc[1], 0, 0, 0);
    }
    if (pr + 1 < end) {
      const int hn = (pr + 1) / 640, tn = ((pr + 1) % 640) * 32;
      const bf16_t* qn = Q + (size_t)(tn + (lane & 31)) * 2048 + hn * 256 + pp * 128 + (lane >> 5) * 8;
#pragma unroll
      for (int kk = 0; kk < 8; ++kk) qa[kk] = *(const bf16x8*)(qn + kk * 16);
    }
#pragma unroll
    for (int jj = 0; jj < 2; ++jj)
#pragma unroll
      for (int r = 0; r < 16; ++r) {
        const int tl = (r & 3) + 8 * (r >> 2) + 4 * (lane >> 5);
        S[tl * SSTR + pp * 128 + (nt0 + jj) * 32 + (lane & 31)] = acc[jj][r];
      }
    __syncthreads();
    {
      const int tl0 = w * 8 + (lane >> 4), tl1 = tl0 + 4;
      unsigned res[2][2];
      top16_rows(S + tl0 * SSTR, S + tl1 * SSTR, j, res);
      unsigned ck[2][4];
#pragma unroll
      for (int u = 0; u < 2; ++u) {
#pragma unroll
        for (int sl = 0; sl < 4; ++sl) {
          const float v1 = keyf((unsigned)__shfl((int)res[u][0], rowbase + ca[sl]) & ~0x7Fu);
          const float v2 = keyf((unsigned)__shfl((int)res[u][1], rowbase + cb[sl]) & ~0x7Fu);
          ck[u][sl] = (fkey(v1 + v2) & ~0xFFu) | (unsigned)(255 - (ca[sl] * 16 + cb[sl]));
        }
        ck[u][3] = cvalid3 ? ck[u][3] : 0u;
      }
      unsigned resc0 = 0, resc1 = 0;
#pragma unroll 2
      for (int it = 0; it < 16; ++it) {
        const unsigned wm0 = row_max_u32(umax_(umax_(ck[0][0], ck[0][1]), umax_(ck[0][2], ck[0][3])));
        const unsigned wm1 = row_max_u32(umax_(umax_(ck[1][0], ck[1][1]), umax_(ck[1][2], ck[1][3])));
#pragma unroll
        for (int sl = 0; sl < 4; ++sl) { ck[0][sl] = (ck[0][sl] == wm0) ? 0u : ck[0][sl]; ck[1][sl] = (ck[1][sl] == wm1) ? 0u : ck[1][sl]; }
        resc0 = (j == it) ? wm0 : resc0;
        resc1 = (j == it) ? wm1 : resc1;
      }
#pragma unroll
      for (int u = 0; u < 2; ++u) {
        const unsigned resc = u ? resc1 : resc0;
        const int tl = u ? tl1 : tl0;
        const int code = 255 - (int)(resc & 0xFFu);
        const int wa = code >> 4, wb = code & 15;
        const float val = keyf(resc & ~0xFFu);
        const unsigned r1 = (unsigned)__shfl((int)res[u][0], rowbase + wa);
        const unsigned r2 = (unsigned)__shfl((int)res[u][1], rowbase + wb);
        const int i1 = 127 - (int)(r1 & 0x7Fu), i2 = 127 - (int)(r2 & 0x7Fu);
        const float vmax = __shfl(val, rowbase);
        const float e = __expf(val - vmax);
        const float ssum = row16_sum(e);
        const size_t ob = ((size_t)(t0 + tl) * 8 + h) * 16 + j;
        IDX[ob] = i1 * 128 + i2;
        GATE[ob] = e / ssum;
      }
    }
    __syncthreads();
  }
}

typedef __attribute__((ext_vector_type(2))) float f32x2;
__device__ __forceinline__ void peer_phase(const Params& p, int layer, char* smem) {
  const int otid = opaque_tid();
  float* coefs = (float*)smem;
  int* idxs = (int*)(smem + 2048);
  float* sus = (float*)(smem + 4096);
  float* gsv = (float*)(smem + 6144);
  const unsigned char* U6 = (const unsigned char*)(p.ws + (layer ? OFF_TAB1 : OFF_YB));
  const unsigned char* V6 = U6 + (size_t)16384 * 768;
  const float* SCU = (const float*)(p.ws + OFF_SCALE) + (size_t)layer * 32768;
  const float* SCV = SCU + 16384;
  const bf16_t* A = (const bf16_t*)(p.ws + OFF_YF);
  const int* IDX = (const int*)(p.ws + OFF_IDX);
  const float* GATE = (const float*)(p.ws + OFF_GATE);
  const float* MOD = (const float*)(p.ws + OFF_MOD);
  float* X = p.out;
  const int lane = otid & 63;
  const int w = __builtin_amdgcn_readfirstlane(otid >> 6);
  const int sub = lane & 15, rg = lane >> 4;
  const int half = lane >> 5, l31 = lane & 31;
  int pe0 = 0, pe1 = 0; float pg0 = 0.f, pg1 = 0.f;
  {
    const int tok0_ = blockIdx.x * 4 + w;
    if (tok0_ < NT) { pe0 = IDX[(size_t)tok0_ * 128 + lane]; pe1 = IDX[(size_t)tok0_ * 128 + 64 + lane]; pg0 = GATE[(size_t)tok0_ * 128 + lane]; pg1 = GATE[(size_t)tok0_ * 128 + 64 + lane]; }
  }
  for (int tok = blockIdx.x * 4 + w; tok < NT; tok += gridDim.x * 4) {
#pragma unroll
    for (int hh = 0; hh < 2; ++hh) {
      const int kk = lane + 64 * hh;
      const int e = hh ? pe1 : pe0;
      const float gk = hh ? pg1 : pg0;
      idxs[w * 128 + kk] = e;
      sus[w * 128 + kk] = SCU[e];
      gsv[w * 128 + kk] = gk * SCV[e];
    }
    float t[64];
    {
      const uint4* ap = (const uint4*)(A + tiled(tok, 64 * sub, 16));
#pragma unroll
      for (int i = 0; i < 8; ++i) {
        const uint4 r0 = ap[i];
#pragma unroll
        for (int q = 0; q < 4; ++q) { t[8 * i + 2 * q] = lo2f(u4get(r0, q)); t[8 * i + 2 * q + 1] = hi2f(u4get(r0, q)); }
      }
    }
    float chain = 0.f;
#pragma unroll 4
    for (int it = 0; it < 32; ++it) {
      const int k = it * 4 + rg;
      const int e = idxs[w * 128 + k];
      const uint4* row = (const uint4*)(U6 + (size_t)e * 768 + sub * 48);
      const uint4 r0 = row[0], r1 = row[1], r2 = row[2];
      u32x6 g0, g1;
      g0[0] = r0.x; g0[1] = r0.y; g0[2] = r0.z; g0[3] = r0.w; g0[4] = r1.x; g0[5] = r1.y;
      g1[0] = r1.z; g1[1] = r1.w; g1[2] = r2.x; g1[3] = r2.y; g1[4] = r2.z; g1[5] = r2.w;
      float acc0 = 0.f, acc1 = 0.f;
      asm volatile("" : "+v"(g0), "+v"(chain));
      {
        const f32x32 d0 = __builtin_amdgcn_cvt_scalef32_pk32_f32_fp6(g0, 1.0f);
#pragma unroll
        for (int j = 0; j < 32; j += 2) { acc0 += d0[j] * t[j]; acc1 += d0[j + 1] * t[j + 1]; }
      }
      asm volatile("" : "+v"(g1), "+v"(acc0), "+v"(acc1));
      {
        const f32x32 d1 = __builtin_amdgcn_cvt_scalef32_pk32_f32_fp6(g1, 1.0f);
#pragma unroll
        for (int j = 0; j < 32; j += 2) { acc0 += d1[j] * t[32 + j]; acc1 += d1[j + 1] * t[32 + j + 1]; }
      }
      chain = acc0 + acc1;
      float acc = row16_sum(chain) * sus[w * 128 + k];
      const float co = 0.5f * acc * (1.f + erff(acc * 0.70710678118654752f)) * gsv[w * 128 + k];
      if (sub == 0) coefs[w * 128 + k] = co;
    }
    {
      const int tokn = tok + gridDim.x * 4;
      if (tokn < NT) { pe0 = IDX[(size_t)tokn * 128 + lane]; pe1 = IDX[(size_t)tokn * 128 + 64 + lane]; pg0 = GATE[(size_t)tokn * 128 + lane]; pg1 = GATE[(size_t)tokn * 128 + 64 + lane]; }
    }
    f32x32 ov;
#pragma unroll
    for (int i = 0; i < 32; ++i) ov[i] = 0.f;
#pragma unroll 1
    for (int k = 0; k < 128; k += 16) {
      uint2 ra[8], rb[8], rc[8]; float c[8];
#pragma unroll
      for (int j = 0; j < 8; ++j) {
        const int kk = k + 2 * j + half;
        const int e = idxs[w * 128 + kk];
        c[j] = coefs[w * 128 + kk];
        const uint2* rp = (const uint2*)(V6 + (size_t)e * 768 + l31 * 24);
        ra[j] = rp[0]; rb[j] = rp[1]; rc[j] = rp[2];
      }
#pragma unroll
      for (int j = 0; j < 8; ++j) {
        u32x6 g;
        g[0] = ra[j].x; g[1] = ra[j].y; g[2] = rb[j].x; g[3] = rb[j].y; g[4] = rc[j].x; g[5] = rc[j].y;
        asm volatile("" : "+v"(g), "+v"(ov));
        const f32x32 d = __builtin_amdgcn_cvt_scalef32_pk32_f32_fp6(g, 1.0f);
        ov += d * c[j];
      }
    }
    float o[16];
#pragma unroll
    for (int i = 0; i < 16; ++i) {
      const float lo = ov[i] + __shfl_xor(ov[i], 32);
      const float hi = ov[16 + i] + __shfl_xor(ov[16 + i], 32);
      o[i] = half ? hi : lo;
    }
    const int col0 = 32 * l31 + 16 * half;
    const float* gate = MOD + (size_t)(layer * 5 + cidx(tok)) * 6144 + 5 * 1024;
    float xr[16];
    float ss = 0.f;
#pragma unroll
    for (int i = 0; i < 4; ++i) {
      const int col = col0 + 4 * i;
      const float4 xv = *(const float4*)(X + (size_t)tok * 1024 + col);
      const float4 gt = *(const float4*)(gate + col);
      xr[4 * i] = xv.x + gt.x * o[4 * i]; xr[4 * i + 1] = xv.y + gt.y * o[4 * i + 1];
      xr[4 * i + 2] = xv.z + gt.z * o[4 * i + 2]; xr[4 * i + 3] = xv.w + gt.w * o[4 * i + 3];
      ss += xr[4 * i] * xr[4 * i] + xr[4 * i + 1] * xr[4 * i + 1] + xr[4 * i + 2] * xr[4 * i + 2] + xr[4 * i + 3] * xr[4 * i + 3];
    }
    ss = wave_sum(ss);
    const float sc = rsqrtf(ss * (1.f / 1024.f) + 1e-6f);
    if (layer == 0) {
      const float* g1 = p.norm_mix_g + 1024;
      const float* md = MOD + (size_t)(5 + cidx(tok)) * 6144;
      unsigned pk[8];
#pragma unroll
      for (int i = 0; i < 4; ++i) {
        const int col = col0 + 4 * i;
        *(float4*)(X + (size_t)tok * 1024 + col) = make_float4(xr[4 * i], xr[4 * i + 1], xr[4 * i + 2], xr[4 * i + 3]);
        const float4 gg = *(const float4*)(g1 + col);
        const float4 sh = *(const float4*)(md + col);
        const float4 sl = *(const float4*)(md + 1024 + col);
        pk[2 * i] = pack2(xr[4 * i] * sc * gg.x * (1.f + sl.x) + sh.x, xr[4 * i + 1] * sc * gg.y * (1.f + sl.y) + sh.y);
        pk[2 * i + 1] = pack2(xr[4 * i + 2] * sc * gg.z * (1.f + sl.z) + sh.z, xr[4 * i + 3] * sc * gg.w * (1.f + sl.w) + sh.w);
      }
      bf16_t* An = (bf16_t*)(p.ws + OFF_YF) + tiled(tok, col0, 16);
      *(uint4*)(An) = make_uint4(pk[0], pk[1], pk[2], pk[3]);
      *(uint4*)(An + 8) = make_uint4(pk[4], pk[5], pk[6], pk[7]);
    } else {
#pragma unroll
      for (int i = 0; i < 4; ++i) {
        const int col = col0 + 4 * i;
        const float4 gg = *(const float4*)(p.norm_f_g + col);
        *(float4*)(X + (size_t)tok * 1024 + col) = make_float4(xr[4 * i] * sc * gg.x, xr[4 * i + 1] * sc * gg.y, xr[4 * i + 2] * sc * gg.z, xr[4 * i + 3] * sc * gg.w);
      }
    }
  }
}

__device__ __forceinline__ void ssd_conv_phase(const Params& p) {
  const int otid = opaque_tid();
  bf16_t* BIG = (bf16_t*)(p.ws + OFF_BIG);
  const float* cw = p.ssd_conv_w;
  const float* cb = p.ssd_conv_b;
  const int total = 272 * 512;
  for (int it = blockIdx.x * 256 + otid; it < total; it += gridDim.x * 256) {
    const int c8 = it & 511, r = it >> 9;
    const int c = c8 * 8;
    int tok0, len;
    if (r < 16) { tok0 = r * 256; len = 256; } else { tok0 = NCTX + (r - 16) * 64; len = 64; }
    float w0[8], w1[8], w2[8], bb[8];
#pragma unroll
    for (int j = 0; j < 8; ++j) { w0[j] = cw[c + j]; w1[j] = cw[4096 + c + j]; w2[j] = cw[8192 + c + j]; bb[j] = cb[c + j]; }
    bf16_t* base = BIG + (size_t)tok0 * 6144 + 2048 + c;
    uint4 buf[8], nxt[8];
#pragma unroll
    for (int j = 0; j < 8; ++j) buf[j] = *(const uint4*)(base + (size_t)j * 6144);
    uint4 prev = make_uint4(0, 0, 0, 0);
    for (int t0 = 0; t0 < len; t0 += 8) {
      const bool more = (t0 + 8) < len;
#pragma unroll
      for (int j = 0; j < 8; ++j) nxt[j] = more ? *(const uint4*)(base + (size_t)(t0 + 8 + j) * 6144) : make_uint4(0, 0, 0, 0);
#pragma unroll
      for (int j = 0; j < 8; ++j) {
        const uint4 cur = buf[j];
        const uint4 nx = (j < 7) ? buf[j + 1] : nxt[0];
        const unsigned* pp = (const unsigned*)&prev; const unsigned* cp = (const unsigned*)&cur; const unsigned* np = (const unsigned*)&nx;
        unsigned o[4];
#pragma unroll
        for (int q = 0; q < 4; ++q) {
          float a0 = w0[2 * q] * lo2f(pp[q]) + w1[2 * q] * lo2f(cp[q]) + w2[2 * q] * lo2f(np[q]) + bb[2 * q];
          float a1 = w0[2 * q + 1] * hi2f(pp[q]) + w1[2 * q + 1] * hi2f(cp[q]) + w2[2 * q + 1] * hi2f(np[q]) + bb[2 * q + 1];
          o[q] = pack2(siluf(a0), siluf(a1));
        }
        *(uint4*)(base + (size_t)(t0 + j) * 6144) = make_uint4(o[0], o[1], o[2], o[3]);
        prev = cur;
      }
#pragma unroll
      for (int j = 0; j < 8; ++j) buf[j] = nxt[j];
    }
  }
}

#define XT_STR 72
#define HB_STR 136
#define SCAN_LOAD_FRAGS(CC) { \
      { const int t_ = (CC) * 64 + 32 * it + l31; const int tok_ = tok0 + (dir ? L - 1 - t_ : t_); \
        const bf16_t* cp_ = BIG + (size_t)tok_ * 6144 + 5120 + g * 128 + 8 * h5; \
        _Pragma("unroll") for (int kk = 0; kk < 8; ++kk) cfr[kk] = *(const bf16x8*)(cp_ + 16 * kk); } \
      if (jt <= it) { const int t_ = (CC) * 64 + 32 * jt + l31; const int tok_ = tok0 + (dir ? L - 1 - t_ : t_); \
        const bf16_t* bp_ = BIG + (size_t)tok_ * 6144 + 4096 + g * 128 + 8 * h5; \
        _Pragma("unroll") for (int kk = 0; kk < 8; ++kk) bfr[kk] = *(const bf16x8*)(bp_ + 16 * kk); } }
#define SCAN_LOAD_STAGE(CC) { \
      const int t_ = (CC) * 64 + lane; const int tok_ = tok0 + (dir ? L - 1 - t_ : t_); \
      const bf16_t* rowp_ = BIG + (size_t)tok_ * 6144; \
      _Pragma("unroll") for (int r = 0; r < 2; ++r) sx[r] = *(const uint4*)(rowp_ + 2048 + head * 64 + (w + 4 * r) * 8); \
      _Pragma("unroll") for (int r = 0; r < 4; ++r) sb[r] = *(const uint4*)(rowp_ + 4096 + g * 128 + (w + 4 * r) * 8); \
      sdt = DT[(size_t)tok_ * 64 + dir * 32 + head]; }
__device__ __forceinline__ void scan_phase(const Params& p, char* smem) {
  const int otid = opaque_tid();
  bf16_t* XTd = (bf16_t*)smem;
  bf16_t* BTs = XTd + 64 * XT_STR;
  bf16_t* Ms = BTs + 128 * XT_STR;
  bf16_t* Hb = Ms + 64 * XT_STR;
  float* cumS = (float*)(Hb + 2 * 64 * HB_STR);
  const bf16_t* BIG = (const bf16_t*)(p.ws + OFF_BIG);
  const float* DT = (const float*)(p.ws + OFF_DT);
  const int tid = otid, lane = tid & 63;
  const int w = __builtin_amdgcn_readfirstlane(tid >> 6);
  const int h5 = lane >> 5, l31 = lane & 31;
  const int it = w >> 1, jt = w & 1, pt = w & 1, nt0 = (w >> 1) * 2;
  int item0, istride;
  if (gridDim.x >= 512) { if (blockIdx.x < 256) { item0 = blockIdx.x; istride = 1 << 28; } else { item0 = blockIdx.x; istride = gridDim.x - 256; } }
  else { item0 = blockIdx.x; istride = gridDim.x; }
  for (int item = item0; item < 1280; item += istride) {
    int b, head, dir, L, tok0;
    const bool latent = item < 256;
    if (latent) { b = item >> 6; head = (item >> 1) & 31; dir = item & 1; L = 4096; tok0 = NCTX + b * 4096; }
    else { int jj = item - 256; b = jj >> 6; head = (jj >> 1) & 31; dir = jj & 1; L = 256; tok0 = b * 256; }
    const int g = head >> 2;
    const float a = -expf(p.ssd_a_log[dir * 32 + head]);
    bf16_t* Y = (bf16_t*)(p.ws + (dir ? OFF_YB : OFF_YF));
    f32x16 st[2];
    const size_t sbase = ((size_t)((b * 2 + dir) * 32 + head)) * 8192;
    const int loff = (32 * pt + l31) * 128 + 32 * nt0 + 4 * h5;
    if (latent) {
      const float* sp = p.state_ssm + sbase + loff;
#pragma unroll
      for (int q = 0; q < 2; ++q)
#pragma unroll
        for (int qq = 0; qq < 4; ++qq) {
          const float4 v = *(const float4*)(sp + 32 * q + 8 * qq);
          st[q][4 * qq] = v.x; st[q][4 * qq + 1] = v.y; st[q][4 * qq + 2] = v.z; st[q][4 * qq + 3] = v.w;
        }
    } else {
#pragma unroll
      for (int q = 0; q < 2; ++q)
#pragma unroll
        for (int r = 0; r < 16; ++r) st[q][r] = 0.f;
    }
    {
      bf16_t* hb0 = Hb + (32 * pt + l31) * HB_STR + 32 * nt0 + 4 * h5;
#pragma unroll
      for (int q = 0; q < 2; ++q)
#pragma unroll
        for (int qq = 0; qq < 4; ++qq) {
          uint2 o; o.x = pack2(st[q][4 * qq], st[q][4 * qq + 1]); o.y = pack2(st[q][4 * qq + 2], st[q][4 * qq + 3]);
          *(uint2*)(hb0 + 32 * q + 8 * qq) = o;
        }
    }
    __syncthreads();
    const int nchunks = L >> 6;
    uint4 sx[2], sb[4];
    float sdt;
    SCAN_LOAD_STAGE(0)
    bf16x8 cfr[8], bfr[8];
    SCAN_LOAD_FRAGS(0)
#pragma nounroll
    for (int c = 0; c < nchunks; ++c) {
      const int cur = c & 1;
      __builtin_amdgcn_sched_barrier(0);
      float cum = sdt * a;
#pragma unroll
      for (int off = 1; off < 64; off <<= 1) {
        const float tv = __shfl_up(cum, off);
        cum += (lane >= off) ? tv : 0.f;
      }
      const float cum_last = __shfl(cum, 63);
      const float wj = __expf(cum_last - cum);
      if (w == 0) cumS[cur * 64 + lane] = cum;
#pragma unroll
      for (int r = 0; r < 2; ++r) {
        const int p8 = (w + 4 * r) * 8;
#pragma unroll
        for (int q = 0; q < 4; ++q) {
          const unsigned u = u4get(sx[r], q);
          XTd[(p8 + 2 * q) * XT_STR + lane] = f2bf(sdt * lo2f(u));
          XTd[(p8 + 2 * q + 1) * XT_STR + lane] = f2bf(sdt * hi2f(u));
        }
      }
#pragma unroll
      for (int r = 0; r < 4; ++r) {
        const int n8 = (w + 4 * r) * 8;
#pragma unroll
        for (int q = 0; q < 4; ++q) {
          const unsigned u = u4get(sb[r], q);
          BTs[(n8 + 2 * q) * XT_STR + lane] = f2bf(wj * lo2f(u));
          BTs[(n8 + 2 * q + 1) * XT_STR + lane] = f2bf(wj * hi2f(u));
        }
      }
      if (c + 1 < nchunks) SCAN_LOAD_STAGE(c + 1)
      __builtin_amdgcn_sched_barrier(0);
      f32x16 cb;
#pragma unroll
      for (int r = 0; r < 16; ++r) cb[r] = 0.f;
      if (jt <= it) {
#pragma unroll
        for (int kk = 0; kk < 8; ++kk) cb = __builtin_amdgcn_mfma_f32_32x32x16_bf16(bfr[kk], cfr[kk], cb, 0, 0, 0);
      }
      __builtin_amdgcn_sched_barrier(0);
      f32x16 yo;
#pragma unroll
      for (int r = 0; r < 16; ++r) yo[r] = 0.f;
      {
        const bf16_t* hp = Hb + cur * 64 * HB_STR + (32 * pt + l31) * HB_STR + 8 * h5;
#pragma unroll
        for (int kk = 0; kk < 8; ++kk) {
          const bf16x8 hf = *(const bf16x8*)(hp + 16 * kk);
          yo = __builtin_amdgcn_mfma_f32_32x32x16_bf16(hf, cfr[kk], yo, 0, 0, 0);
        }
      }
      __builtin_amdgcn_sched_barrier(0);
      if (c + 1 < nchunks) SCAN_LOAD_FRAGS(c + 1)
      __syncthreads();
      __builtin_amdgcn_sched_barrier(0);
      const float dec = __expf(cum_last);
      bf16x8 xf[4];
#pragma unroll
      for (int kk = 0; kk < 4; ++kk) xf[kk] = *(const bf16x8*)(XTd + (32 * pt + l31) * XT_STR + 16 * kk + 8 * h5);
#pragma unroll
      for (int q = 0; q < 2; ++q) {
#pragma unroll
        for (int r = 0; r < 16; ++r) st[q][r] *= dec;
#pragma unroll
        for (int kk = 0; kk < 4; ++kk) {
          const bf16x8 bt = *(const bf16x8*)(BTs + (32 * (nt0 + q) + l31) * XT_STR + 16 * kk + 8 * h5);
          st[q] = __builtin_amdgcn_mfma_f32_32x32x16_bf16(bt, xf[kk], st[q], 0, 0, 0);
        }
        {
          bf16_t* hbw = Hb + (cur ^ 1) * 64 * HB_STR + (32 * pt + l31) * HB_STR + 32 * (nt0 + q) + 4 * h5;
#pragma unroll
          for (int qq = 0; qq < 4; ++qq) {
            uint2 o; o.x = pack2(st[q][4 * qq], st[q][4 * qq + 1]); o.y = pack2(st[q][4 * qq + 2], st[q][4 * qq + 3]);
            *(uint2*)(hbw + 8 * qq) = o;
          }
        }
      }
      __builtin_amdgcn_sched_barrier(0);
      if (jt <= it) {
        const int ii = 32 * it + l31;
        const float ci = cumS[cur * 64 + ii];
        const int jb = 32 * jt + 4 * h5;
        const float* cs = cumS + cur * 64 + jb;
        bf16_t* mw = Ms + ii * XT_STR + jb;
#pragma unroll
        for (int qq = 0; qq < 4; ++qq) {
          const float4 cj = *(const float4*)(cs + 8 * qq);
          const int j0 = jb + 8 * qq;
          const float m0 = (j0 <= ii) ? cb[4 * qq] * __expf(ci - cj.x) : 0.f;
          const float m1 = (j0 + 1 <= ii) ? cb[4 * qq + 1] * __expf(ci - cj.y) : 0.f;
          const float m2 = (j0 + 2 <= ii) ? cb[4 * qq + 2] * __expf(ci - cj.z) : 0.f;
          const float m3 = (j0 + 3 <= ii) ? cb[4 * qq + 3] * __expf(ci - cj.w) : 0.f;
          uint2 o; o.x = pack2(m0, m1); o.y = pack2(m2, m3);
          *(uint2*)(mw + 8 * qq) = o;
        }
      }
      __syncthreads();
      __builtin_amdgcn_sched_barrier(0);
      f32x16 yd;
#pragma unroll
      for (int r = 0; r < 16; ++r) yd[r] = 0.f;
#pragma unroll
      for (int kk = 0; kk < 4; ++kk) {
        if (kk < 2 * (it + 1)) {
          const bf16x8 mf = *(const bf16x8*)(Ms + (32 * it + l31) * XT_STR + 16 * kk + 8 * h5);
          yd = __builtin_amdgcn_mfma_f32_32x32x16_bf16(xf[kk], mf, yd, 0, 0, 0);
        }
      }
      {
        const int ti = c * 64 + 32 * it + l31;
        const int tok = tok0 + (dir ? L - 1 - ti : ti);
        const float ei = __expf(cumS[cur * 64 + 32 * it + l31]);
        bf16_t* yp = Y + ((size_t)(tok >> 7) * 32 + head) * 8192 + (tok & 127) * 64 + 32 * pt + 4 * h5;
#pragma unroll
        for (int qq = 0; qq < 4; ++qq) {
          uint2 o;
          o.x = pack2(yd[4 * qq] + ei * yo[4 * qq], yd[4 * qq + 1] + ei * yo[4 * qq + 1]);
          o.y = pack2(yd[4 * qq + 2] + ei * yo[4 * qq + 2], yd[4 * qq + 3] + ei * yo[4 * qq + 3]);
          *(uint2*)(yp + 8 * qq) = o;
        }
      }
    }
    if (!latent) {
      float* sp = p.out + (size_t)NT * 1024 + sbase + loff;
#pragma unroll
      for (int q = 0; q < 2; ++q)
#pragma unroll
        for (int qq = 0; qq < 4; ++qq)
          *(float4*)(sp + 32 * q + 8 * qq) = make_float4(st[q][4 * qq], st[q][4 * qq + 1], st[q][4 * qq + 2], st[q][4 * qq + 3]);
    }
    __syncthreads();
  }
}

__device__ __forceinline__ void gate_norm_phase(const Params& p) {
  const int otid = opaque_tid();
  const bf16_t* BIG = (const bf16_t*)(p.ws + OFF_BIG);
  bf16_t* YF = (bf16_t*)(p.ws + OFF_YF);
  const bf16_t* YB = (const bf16_t*)(p.ws + OFF_YB);
  const int lane = otid & 63, w = otid >> 6;
  for (int tok = blockIdx.x * 4 + w; tok < NT; tok += gridDim.x * 4) {
    float v[32];
    float ss = 0.f;
#pragma unroll
    for (int i = 0; i < 4; ++i) {
      const int col = lane * 8 + 512 * i;
      const int head = col >> 6;
      const float dtot = p.ssd_d[head] + p.ssd_d[32 + head];
      uint4 a = *(const uint4*)(YF + tiled(tok, col, 32));
      uint4 b = *(const uint4*)(YB + tiled(tok, col, 32));
      uint4 x = *(const uint4*)(BIG + (size_t)tok * 6144 + 2048 + col);
      uint4 z = *(const uint4*)(BIG + (size_t)tok * 6144 + col);
#pragma unroll
      for (int q = 0; q < 4; ++q) {
        const unsigned aq = u4get(a, q), bq = u4get(b, q), xq = u4get(x, q), zq = u4get(z, q);
        float y0 = lo2f(aq) + lo2f(bq) + dtot * lo2f(xq);
        float y1 = hi2f(aq) + hi2f(bq) + dtot * hi2f(xq);
        y0 *= siluf(lo2f(zq));
        y1 *= siluf(hi2f(zq));
        v[8 * i + 2 * q] = y0; v[8 * i + 2 * q + 1] = y1;
        ss += y0 * y0 + y1 * y1;
      }
      __builtin_amdgcn_sched_barrier(0);
    }
    ss = wave_sum(ss);
    const float sc = rsqrtf(ss * (1.f / 2048.f) + 1e-6f);
#pragma unroll
    for (int i = 0; i < 4; ++i) {
      const int col = lane * 8 + 512 * i;
      float4 g0 = *(const float4*)(p.ssd_norm_g + col), g1 = *(const float4*)(p.ssd_norm_g + col + 4);
      uint4 o;
      o.x = pack2(v[8 * i] * sc * g0.x, v[8 * i + 1] * sc * g0.y);
      o.y = pack2(v[8 * i + 2] * sc * g0.z, v[8 * i + 3] * sc * g0.w);
      o.z = pack2(v[8 * i + 4] * sc * g1.x, v[8 * i + 5] * sc * g1.y);
      o.w = pack2(v[8 * i + 6] * sc * g1.z, v[8 * i + 7] * sc * g1.w);
      *(uint4*)(YF + tiled(tok, col, 32)) = o;
    }
  }
}

__device__ __forceinline__ void final_norm_phase(const Params& p) {
  const int otid = opaque_tid();
  const int lane = otid & 63, w = otid >> 6;
  for (int tok = blockIdx.x * 4 + w; tok < NT; tok += gridDim.x * 4) {
    float* xr = p.out + (size_t)tok * 1024;
    float4 v[4];
    float ss = 0.f;
#pragma unroll
    for (int i = 0; i < 4; ++i) {
      v[i] = *(const float4*)(xr + lane * 4 + 256 * i);
      ss += v[i].x * v[i].x + v[i].y * v[i].y + v[i].z * v[i].z + v[i].w * v[i].w;
    }
    ss = wave_sum(ss);
    const float sc = rsqrtf(ss * (1.f / 1024.f) + 1e-6f);
#pragma unroll
    for (int i = 0; i < 4; ++i) {
      const int col = lane * 4 + 256 * i;
      float4 gg = *(const float4*)(p.norm_f_g + col);
      *(float4*)(xr + col) = make_float4(v[i].x * sc * gg.x, v[i].y * sc * gg.y, v[i].z * sc * gg.z, v[i].w * sc * gg.w);
    }
  }
}


#define XB_TMO      128
#define XB_XCNT(j)  (256  + 64 * (j))
#define XB_XSUB(j)  (1280 + 64 * (j))
#define XB_XGEN(j)  (2304 + 64 * (j))
#define XB_TOP      3328
#define XB_TOPGEN   3392
#define XCD_BAR_WORDS 3456
#define XB_SPIN_CAP (1u << 22)
#define LAS __attribute__((address_space(3)))
__device__ __forceinline__ unsigned xb_ld(unsigned* p) { return __hip_atomic_load(p, __ATOMIC_RELAXED, __HIP_MEMORY_SCOPE_AGENT); }
__device__ __forceinline__ unsigned xb_add(unsigned* p, unsigned v) { return __hip_atomic_fetch_add(p, v, __ATOMIC_RELAXED, __HIP_MEMORY_SCOPE_AGENT); }
__device__ __forceinline__ unsigned xb_xcc_id() { return (unsigned)__builtin_amdgcn_s_getreg((3 << 11) | 20) & 0xFu; }
#define XB_SPIN(cond, bar) do { unsigned _sp = 0; while (cond) { __builtin_amdgcn_s_sleep(1); \
    if ((++_sp & 255u) == 0u) { if (xb_ld(&(bar)[XB_TMO])) break; if (_sp > XB_SPIN_CAP) { atomicAdd(&(bar)[XB_TMO], 1u); break; } } } } while (0)
struct XcdBarrier { unsigned* bar; unsigned x; volatile LAS unsigned* st; };
__device__ __forceinline__ XcdBarrier xcd_barrier_post(unsigned* bar, volatile LAS unsigned* st) {
  XcdBarrier b; b.bar = bar; b.x = xb_xcc_id(); b.st = st;
  if (threadIdx.x == 0) (void)xb_add(&bar[XB_XCNT(b.x)], 1u);
  return b;
}
__device__ __forceinline__ void xcd_barrier_complete(unsigned* bar, unsigned x, unsigned& nloc, unsigned& nx) {
  const unsigned G = gridDim.x * gridDim.y * gridDim.z;
  unsigned sum, cnt, mine, sp = 0u;
  for (;;) {
    sum = 0u; cnt = 0u; mine = 0u;
#pragma unroll
    for (unsigned j = 0; j < 16; ++j) { const unsigned c = xb_ld(&bar[XB_XCNT(j)]); sum += c; cnt += (c > 0u) ? 1u : 0u; mine = (j == x) ? c : mine; }
    if (sum == G) break;
    __builtin_amdgcn_s_sleep(1);
    if ((++sp & 255u) == 0u) { if (xb_ld(&bar[XB_TMO])) break; if (sp > XB_SPIN_CAP) { atomicAdd(&bar[XB_TMO], 1u); break; } }
  }
  nloc = mine > 0u ? mine : 1u; nx = cnt > 0u ? cnt : 1u;
}
__device__ __forceinline__ void xcd_barrier(const XcdBarrier& b) {
  asm volatile("s_waitcnt vmcnt(0)" ::: "memory");
  __syncthreads();
  if (threadIdx.x == 0) {
    unsigned* bar = b.bar;
    __builtin_amdgcn_s_waitcnt(0);
    unsigned nloc = b.st[0], nx = b.st[1];
    if (nloc == 0u) { xcd_barrier_complete(bar, b.x, nloc, nx); b.st[0] = nloc; b.st[1] = nx; }
    const unsigned old = xb_add(&bar[XB_XSUB(b.x)], 1u);
    const unsigned gen = old / nloc;
    if (old + 1u == (gen + 1u) * nloc) {
      __builtin_amdgcn_fence(__ATOMIC_RELEASE, "agent");
      asm volatile("s_waitcnt vmcnt(0)" ::: "memory");
      const unsigned og = xb_add(&bar[XB_TOP], 1u);
      const unsigned tg = og / nx;
      if (og + 1u == (tg + 1u) * nx) xb_add(&bar[XB_TOPGEN], 1u);
      else XB_SPIN(xb_ld(&bar[XB_TOPGEN]) == tg, bar);
      __builtin_amdgcn_fence(__ATOMIC_ACQUIRE, "agent");
      xb_add(&bar[XB_XGEN(b.x)], 1u);
      asm volatile("s_waitcnt vmcnt(0)" ::: "memory");
    } else {
      XB_SPIN(xb_ld(&bar[XB_XGEN(b.x)]) == gen, bar);
      __builtin_amdgcn_fence(__ATOMIC_ACQUIRE, "agent");
      asm volatile("s_waitcnt vmcnt(0)" ::: "memory");
    }
  }
  __syncthreads();
}

#define N_PHASES 19
__global__ void __launch_bounds__(256, 2) mk(Params p, int ph_begin, int ph_end) {
  __shared__ __attribute__((aligned(16))) char smem[SMEM_BYTES];
  __shared__ uint4 xb_words;
  const bool multi = (ph_end - ph_begin) > 1;
  if (threadIdx.x == 0) xb_words = make_uint4(0u, 0u, 0u, 0u);
  __syncthreads();
  XcdBarrier xb;
  xb.bar = (unsigned*)(p.ws + OFF_BAR); xb.x = 0; xb.st = (volatile LAS unsigned*)&xb_words;
  if (multi) xb = xcd_barrier_post((unsigned*)(p.ws + OFF_BAR), (volatile LAS unsigned*)&xb_words);
  if (ph_begin < 0) cg::this_grid().sync();
  bf16_t* WT = (bf16_t*)(p.ws + OFF_WT);
  bf16_t* BIG = (bf16_t*)(p.ws + OFF_BIG);
  bf16_t* Abuf = (bf16_t*)(p.ws + OFF_YF);
  float* MOD = (float*)(p.ws + OFF_MOD);
#define RUN(PH, CALL) if (ph_begin <= PH && PH < ph_end) { CALL; if (PH + 1 < ph_end) xcd_barrier(xb); }
  RUN(0, prep_phase(p, smem))
  RUN(1, norm_mod_phase(p, 0, 0, true))
  RUN(2, gemm_phase(Abuf, WT + WT_SCIN, NT, 3072, 1024, EpiBf16{BIG, 3072}, smem))
  RUN(3, conv_gate_phase(p))
  RUN(4, gemm_phase((const bf16_t*)(p.ws + OFF_BIG + 120 * MIB), WT + WT_SCOUT, NT, 1024, 1024,
                    EpiRes{p.x_prompt, p.x_sample, p.out, MOD + 0 * 5 * 6144 + 2 * 1024}, smem))
  RUN(5, norm_mod_phase(p, 0, 1, false))
  RUN(6, gemm_phase(Abuf, WT + WT_WQ, NT, 2048, 1024, EpiBf16{BIG, 2048}, smem))
  RUN(7, topk_phase(p, 0, smem))
  RUN(8, peer_phase(p, 0, smem))
  RUN(10, gemm_phase(Abuf, WT + WT_SSDIN, NT, 6208, 1024, EpiSsdIn{BIG, (float*)(p.ws + OFF_DT), p.ssd_dt_bias}, smem))
  RUN(11, ssd_conv_phase(p))
  RUN(12, scan_phase(p, smem))
  RUN(13, gate_norm_phase(p))
  RUN(14, gemm_phase(Abuf, WT + WT_SSDOUT, NT, 1024, 2048,
                     EpiRes{p.out, p.out + (size_t)NCTX * 1024, p.out, MOD + 1 * 5 * 6144 + 2 * 1024}, smem))
  RUN(15, norm_mod_phase(p, 1, 1, false))
  RUN(16, gemm_phase(Abuf, WT + WT_WQ + (size_t)2048 * 1024, NT, 2048, 1024, EpiBf16{BIG, 2048}, smem))
  RUN(17, topk_phase(p, 1, smem))
  RUN(18, peer_phase(p, 1, smem))
}

extern "C" void kernel_launch(void* const* d_in, const int* in_sizes, int n_in, void* d_out, int out_size, void* d_ws, size_t ws_size,
                              hipStream_t stream) {
  static int grid_blocks = 0;
  if (!grid_blocks) {
    int dev = 0, cus = 0, per_cu = 0;
    hipGetDevice(&dev);
    hipDeviceGetAttribute(&cus, hipDeviceAttributeMultiprocessorCount, dev);
    hipOccupancyMaxActiveBlocksPerMultiprocessor(&per_cu, mk, 256, 0);
    if (per_cu < 1) per_cu = 1;
    if (per_cu > 2) per_cu = 2;
    grid_blocks = cus * per_cu;
  }
  if (ws_size < WS_NEEDED) { fprintf(stderr, "workspace too small: %zu\n", ws_size); return; }
  Params p{};
  const float** pf = (const float**)&p;
  for (int i = 0; i < 25; ++i) pf[i] = (const float*)d_in[i];
  p.out = (float*)d_out;
  p.ws = (char*)d_ws;
#if COOP
  hipMemsetAsync((char*)d_ws + OFF_BAR, 0, 16384, stream);
  int b = 0, e = N_PHASES;
  void* args[] = {&p, &b, &e};
  hipError_t err = hipLaunchCooperativeKernel((void*)mk, dim3(grid_blocks), dim3(256), args, 0, stream);
  if (err != hipSuccess) fprintf(stderr, "cooperative launch failed: %s (grid %d)\n", hipGetErrorString(err), grid_blocks);
#else
  for (int ph = 0; ph < N_PHASES; ++ph) {
    hipLaunchKernelGGL(mk, dim3(grid_blocks), dim3(256), 0, stream, p, ph, ph + 1);
    if ((DUP_MASK >> ph) & 1) hipLaunchKernelGGL(mk, dim3(grid_blocks), dim3(256), 0, stream, p, ph, ph + 1);
  }
#endif
}
```

```cpp
#include <hip/hip_runtime.h>
#include <hip/hip_cooperative_groups.h>
#include <cstdio>
namespace cg = cooperative_groups;

#ifndef COOP
#define COOP 1
#endif
#ifndef DUP_MASK
#define DUP_MASK 0
#endif

typedef unsigned short bf16_t;
typedef __attribute__((ext_vector_type(8))) short bf16x8;
typedef __attribute__((ext_vector_type(16))) float f32x16;
typedef __attribute__((ext_vector_type(32))) float f32x32;
typedef __attribute__((ext_vector_type(6))) unsigned u32x6;

#define NT 20480
#define NCTX 4096
#define DM 1024
#define MIB ((size_t)1 << 20)
#define OFF_BIG   ((size_t)0)
#define OFF_YF    (240 * MIB)
#define OFF_YB    (320 * MIB)
#define OFF_WT    (400 * MIB)
#define OFF_KEYSB (433 * MIB)
#define OFF_DT    (434 * MIB)
#define OFF_MOD   (439 * MIB)
#define OFF_IDX   (440 * MIB)
#define OFF_GATE  (450 * MIB)
#define OFF_TAB1  (460 * MIB)
#define OFF_SCALE (492 * MIB)
#define OFF_BAR   (493 * MIB)
#define WS_NEEDED (494 * MIB)
#define WT_SCIN   ((size_t)0)
#define WT_SCOUT  (WT_SCIN + (size_t)3072 * 1024)
#define WT_SSDIN  (WT_SCOUT + (size_t)1024 * 1024)
#define WT_SSDOUT (WT_SSDIN + (size_t)6272 * 1024)
#define WT_WQ     (WT_SSDOUT + (size_t)1024 * 2048)

#define SMEM_BYTES 75776

struct Params {
  const float *x_prompt, *x_sample, *state_ssm, *c, *c_ctx, *norm_mix_g, *norm_ffn_g, *norm_f_g, *ada_w, *ada_b;
  const float *sc_w_in, *sc_conv_w, *sc_w_out, *ssd_w_in, *ssd_conv_w, *ssd_conv_b, *ssd_dt_bias, *ssd_a_log, *ssd_d;
  const float *ssd_norm_g, *ssd_w_out, *peer_wq, *peer_keys, *peer_u, *peer_v;
  float* out;
  char* ws;
};

__device__ __forceinline__ float bf2f(bf16_t h) { return __uint_as_float(((unsigned)h) << 16); }
__device__ __forceinline__ bf16_t f2bf(float f) {
  unsigned u = __float_as_uint(f);
  u += 0x7FFFu + ((u >> 16) & 1u);
  return (bf16_t)(u >> 16);
}
__device__ __forceinline__ unsigned pack2(float a, float b) { return (unsigned)f2bf(a) | ((unsigned)f2bf(b) << 16); }
__device__ __forceinline__ float lo2f(unsigned u) { return __uint_as_float(u << 16); }
__device__ __forceinline__ float hi2f(unsigned u) { return __uint_as_float(u & 0xffff0000u); }
__device__ __forceinline__ unsigned u4get(const uint4 v, const int q) { return q == 0 ? v.x : (q == 1 ? v.y : (q == 2 ? v.z : v.w)); }
__device__ __forceinline__ int opaque_tid() { int t = threadIdx.x; asm volatile("" : "+v"(t)); return t; }
__device__ __forceinline__ size_t tiled(int row, int col, int KT) { return ((size_t)(row >> 7) * KT + (col >> 6)) * 8192 + (row & 127) * 64 + (col & 63); }
__device__ __forceinline__ float siluf(float x) { return x / (1.f + __expf(-x)); }
__device__ __forceinline__ int cidx(int tok) { return tok < NCTX ? 0 : 1 + ((tok - NCTX) >> 12); }

template <int CTRL>
__device__ __forceinline__ unsigned dpp_u(unsigned v) {
  return (unsigned)__builtin_amdgcn_update_dpp(0, (int)v, CTRL, 0xF, 0xF, true);
}
template <int CTRL>
__device__ __forceinline__ float dpp_f(float v) {
  return __int_as_float(__builtin_amdgcn_update_dpp(0, __float_as_int(v), CTRL, 0xF, 0xF, true));
}
__device__ __forceinline__ float row16_sum(float v) {
  v += dpp_f<0xB1>(v);
  v += dpp_f<0x4E>(v);
  v += dpp_f<0x141>(v);
  v += dpp_f<0x140>(v);
  return v;
}
__device__ __forceinline__ unsigned umax_(unsigned a, unsigned b) { return a > b ? a : b; }
__device__ __forceinline__ unsigned row_max_u32(unsigned v) {
  v = umax_(v, dpp_u<0xB1>(v));
  v = umax_(v, dpp_u<0x4E>(v));
  v = umax_(v, dpp_u<0x141>(v));
  v = umax_(v, dpp_u<0x140>(v));
  return v;
}
__device__ __forceinline__ unsigned wave_max_u32(unsigned v) {
  v = umax_(v, dpp_u<0xB1>(v));
  v = umax_(v, dpp_u<0x4E>(v));
  v = umax_(v, dpp_u<0x141>(v));
  v = umax_(v, dpp_u<0x140>(v));
  unsigned a = (unsigned)__builtin_amdgcn_readlane((int)v, 0);
  unsigned b = (unsigned)__builtin_amdgcn_readlane((int)v, 16);
  unsigned c = (unsigned)__builtin_amdgcn_readlane((int)v, 32);
  unsigned d = (unsigned)__builtin_amdgcn_readlane((int)v, 48);
  return umax_(umax_(a, b), umax_(c, d));
}
__device__ __forceinline__ float wave_sum(float v) {
  v = row16_sum(v);
  float a, b, c, d;
  a = __int_as_float(__builtin_amdgcn_readlane(__float_as_int(v), 0));
  b = __int_as_float(__builtin_amdgcn_readlane(__float_as_int(v), 16));
  c = __int_as_float(__builtin_amdgcn_readlane(__float_as_int(v), 32));
  d = __int_as_float(__builtin_amdgcn_readlane(__float_as_int(v), 48));
  return (a + b) + (c + d);
}
__device__ __forceinline__ unsigned fkey(float f) {
  unsigned u = __float_as_uint(f);
  return (u & 0x80000000u) ? ~u : (u | 0x80000000u);
}
__device__ __forceinline__ float keyf(unsigned k) {
  unsigned u = (k & 0x80000000u) ? (k & 0x7fffffffu) : ~k;
  return __uint_as_float(u);
}

__device__ __forceinline__ void transpose_tile(const float* __restrict__ src, int K, int N, bf16_t* __restrict__ dst, int tile, float* tb) {
  const int tid = threadIdx.x;
  const int ntn = N >> 6;
  const int kt = tile / ntn, nt = tile % ntn;
  {
    const int n = tid & 63, kb = tid >> 6;
#pragma unroll
    for (int i = 0; i < 16; ++i) {
      int k = kb + 4 * i;
      tb[k * 65 + n] = src[(size_t)(kt * 64 + k) * N + nt * 64 + n];
    }
  }
  __syncthreads();
  {
    const int k8 = (tid & 7) * 8;
#pragma unroll
    for (int pass = 0; pass < 2; ++pass) {
      int n = (tid >> 3) + 32 * pass;
      uint4 o;
      o.x = pack2(tb[(k8 + 0) * 65 + n], tb[(k8 + 1) * 65 + n]);
      o.y = pack2(tb[(k8 + 2) * 65 + n], tb[(k8 + 3) * 65 + n]);
      o.z = pack2(tb[(k8 + 4) * 65 + n], tb[(k8 + 5) * 65 + n]);
      o.w = pack2(tb[(k8 + 6) * 65 + n], tb[(k8 + 7) * 65 + n]);
      *(uint4*)(dst + tiled(nt * 64 + n, kt * 64 + k8, K >> 6)) = o;
    }
  }
  __syncthreads();
}

__device__ __forceinline__ void prep_phase(const Params& p, char* smem) {
  const int otid = opaque_tid();
  const int tid = otid;
  bf16_t* WT = (bf16_t*)(p.ws + OFF_WT);
  float* MOD = (float*)(p.ws + OFF_MOD);
  bf16_t* KEYSB = (bf16_t*)(p.ws + OFF_KEYSB);
  const int U_MOD = 192, U_T0 = 768, U_T1 = 256, U_T2 = 1552, U_T3 = 512, U_T4 = 1024, U_KEYS = 256, U_TAB = 8192;
  const int total = U_MOD + U_T0 + U_T1 + U_T2 + U_T3 + U_T4 + U_KEYS + U_TAB;
  for (int u = blockIdx.x; u < total; u += gridDim.x) {
    int v = u;
    if (v < U_MOD) {
      float* scond = (float*)smem;
      float* red = scond + 5 * 1024;
      for (int i = tid; i < 5 * 1024; i += 256) {
        int r = i >> 10, k = i & 1023;
        float cv = (r == 0) ? p.c_ctx[k] : p.c[(r - 1) * 1024 + k];
        scond[i] = siluf(cv);
      }
      __syncthreads();
      const int l = v / 96, jc = v % 96;
      const int jj = tid & 63, kq = tid >> 6;
      const int j = jc * 64 + jj;
      float acc[5] = {0.f, 0.f, 0.f, 0.f, 0.f};
      const float* wp = p.ada_w + ((size_t)l * 1024 + kq * 256) * 6144 + j;
#pragma unroll 1
      for (int k0 = 0; k0 < 256; k0 += 32) {
        float wv[32];
#pragma unroll
        for (int k = 0; k < 32; ++k) wv[k] = wp[(size_t)(k0 + k) * 6144];
#pragma unroll
        for (int k = 0; k < 32; ++k)
#pragma unroll
          for (int r = 0; r < 5; ++r) acc[r] += scond[r * 1024 + kq * 256 + k0 + k] * wv[k];
      }
#pragma unroll
      for (int r = 0; r < 5; ++r) red[(kq * 5 + r) * 64 + jj] = acc[r];
      __syncthreads();
      for (int i = tid; i < 320; i += 256) {
        int r = i >> 6, j2 = i & 63;
        float s = red[(0 * 5 + r) * 64 + j2] + red[(1 * 5 + r) * 64 + j2] + red[(2 * 5 + r) * 64 + j2] + red[(3 * 5 + r) * 64 + j2];
        MOD[(size_t)(l * 5 + r) * 6144 + jc * 64 + j2] = s + p.ada_b[l * 6144 + jc * 64 + j2];
      }
      __syncthreads();
      continue;
    }
    v -= U_MOD;
    float* tb = (float*)smem;
    if (v < U_T0) { transpose_tile(p.sc_w_in, 1024, 3072, WT + WT_SCIN, v, tb); continue; }
    v -= U_T0;
    if (v < U_T1) { transpose_tile(p.sc_w_out, 1024, 1024, WT + WT_SCOUT, v, tb); continue; }
    v -= U_T1;
    if (v < U_T2) { transpose_tile(p.ssd_w_in, 1024, 6208, WT + WT_SSDIN, v, tb); continue; }
    v -= U_T2;
    if (v < U_T3) { transpose_tile(p.ssd_w_out, 2048, 1024, WT + WT_SSDOUT, v, tb); continue; }
    v -= U_T3;
    if (v < U_T4) {
      int l = v >> 9, t = v & 511;
      transpose_tile(p.peer_wq + (size_t)l * 1024 * 2048, 1024, 2048, WT + WT_WQ + (size_t)l * 2048 * 1024, t, tb);
      continue;
    }
    v -= U_T4;
    if (v < U_KEYS) {
      size_t base = (size_t)v * 2048 + tid * 8;
      float4 a = *(const float4*)(p.peer_keys + base);
      float4 b = *(const float4*)(p.peer_keys + base + 4);
      uint4 o;
      o.x = pack2(a.x, a.y); o.y = pack2(a.z, a.w); o.z = pack2(b.x, b.y); o.w = pack2(b.z, b.w);
      *(uint4*)(KEYSB + base) = o;
      continue;
    }
    v -= U_KEYS;
    {
      const int lane = tid & 63, l31 = lane & 31;
      const int gr = v * 8 + (tid >> 6) * 2 + (lane >> 5);
      const int l = gr >> 15, tab = (gr >> 14) & 1, row = gr & 16383;
      const float* src = (tab ? p.peer_v : p.peer_u) + ((size_t)l * 16384 + row) * 1024 + l31 * 32;
      float4 x[8];
      float am = 0.f;
#pragma unroll
      for (int j = 0; j < 8; ++j) {
        x[j] = *(const float4*)(src + 4 * j);
        am = fmaxf(am, fmaxf(fmaxf(fabsf(x[j].x), fabsf(x[j].y)), fmaxf(fabsf(x[j].z), fabsf(x[j].w))));
      }
      {
        unsigned au = row_max_u32(__float_as_uint(am));
        const unsigned ao = (unsigned)__shfl_xor((int)au, 16);
        am = __uint_as_float(umax_(au, ao));
      }
      const float inv = am > 0.f ? 7.0f / am : 0.f;
      const float scale = am > 0.f ? am / 7.0f : 0.f;
      f32x16 fa, fb;
#pragma unroll
      for (int j = 0; j < 8; ++j) {
        fa[2 * j] = x[j].x * inv; fb[2 * j] = x[j].y * inv; fa[2 * j + 1] = x[j].z * inv; fb[2 * j + 1] = x[j].w * inv;
      }
      const u32x6 pk = __builtin_amdgcn_cvt_scalef32_2xpk16_fp6_f32(fa, fb, 1.0f);
      unsigned char* dst = (unsigned char*)(p.ws + (l ? OFF_TAB1 : OFF_YB)) + ((size_t)tab * 16384 + row) * 768 + l31 * 24;
      *(uint2*)(dst) = make_uint2(pk[0], pk[1]);
      *(uint2*)(dst + 8) = make_uint2(pk[2], pk[3]);
      *(uint2*)(dst + 16) = make_uint2(pk[4], pk[5]);
      if (l31 == 0) ((float*)(p.ws + OFF_SCALE))[gr] = scale;
    }
  }
}

__device__ __forceinline__ void norm_mod_phase(const Params& p, int layer, int which, bool from_input) {
  const int otid = opaque_tid();
  const float* g = (which == 0 ? p.norm_mix_g : p.norm_ffn_g) + layer * 1024;
  const float* MOD = (const float*)(p.ws + OFF_MOD);
  bf16_t* A = (bf16_t*)(p.ws + OFF_YF);
  const int lane = otid & 63, w = otid >> 6;
  for (int tok = blockIdx.x * 4 + w; tok < NT; tok += gridDim.x * 4) {
    const float* xr = from_input ? (tok < NCTX ? p.x_prompt + (size_t)tok * 1024 : p.x_sample + (size_t)(tok - NCTX) * 1024)
                                 : p.out + (size_t)tok * 1024;
    const float* md = MOD + (size_t)(layer * 5 + cidx(tok)) * 6144 + (which ? 3 * 1024 : 0);
    float4 v[4];
    float ss = 0.f;
#pragma unroll
    for (int i = 0; i < 4; ++i) {
      v[i] = *(const float4*)(xr + lane * 4 + 256 * i);
      ss += v[i].x * v[i].x + v[i].y * v[i].y + v[i].z * v[i].z + v[i].w * v[i].w;
    }
    ss = wave_sum(ss);
    const float sc = rsqrtf(ss * (1.f / 1024.f) + 1e-6f);
#pragma unroll
    for (int i = 0; i < 4; ++i) {
      const int col = lane * 4 + 256 * i;
      float4 gg = *(const float4*)(g + col);
      float4 sh = *(const float4*)(md + col);
      float4 sl = *(const float4*)(md + 1024 + col);
      float o0 = v[i].x * sc * gg.x * (1.f + sl.x) + sh.x;
      float o1 = v[i].y * sc * gg.y * (1.f + sl.y) + sh.y;
      float o2 = v[i].z * sc * gg.z * (1.f + sl.z) + sh.z;
      float o3 = v[i].w * sc * gg.w * (1.f + sl.w) + sh.w;
      uint2 o;
      o.x = pack2(o0, o1);
      o.y = pack2(o2, o3);
      *(uint2*)(A + tiled(tok, col, 16)) = o;
    }
  }
}

#define LSTR 72
template <class Epi>
__device__ __forceinline__ void gemm_phase(const bf16_t* __restrict__ A, const bf16_t* __restrict__ Bt, int M, int N, int K, Epi epi, char* smem) {
  const int otid = opaque_tid();
  bf16_t* sA = (bf16_t*)smem;
  bf16_t* sB = sA + 2 * 128 * LSTR;
  float* sC = (float*)smem;
  const int tid = otid, lane = tid & 63, w = tid >> 6;
  const int wm = w >> 1, wn = w & 1;
  const int ntn = (N + 127) >> 7, ntm = M >> 7;
  const int ntiles = ntm * ntn;
  const int KT = K >> 6;
  const int lrow = tid >> 3, lkc = (tid & 7) * 8;
  const bf16_t* apb;
  const bf16_t* bpb;
  uint4 ra0_0, ra0_1, ra0_2, ra0_3, rb0_0, rb0_1, rb0_2, rb0_3, ra1_0, ra1_1, ra1_2, ra1_3, rb1_0, rb1_1, rb1_2, rb1_3;
  const int G_ = gridDim.x;
  const int RN = (ntn % 8 == 0) ? 8 : ((ntn % 7 == 0) ? 7 : ((ntn % 6 == 0) ? 6 : ((ntn % 5 == 0) ? 5 : 4)));
  const int RM = ((G_ >> 3) / RN) > 0 ? ((G_ >> 3) / RN) : 1;
  const int nrn = (ntn + RN - 1) / RN, nrm = (ntm + RM - 1) / RM;
  const int nrects = nrn * nrm;
  const int nslots = ((nrects + 7) >> 3) * G_;
#define G_MAP(T_, VALID_, MT_, NT_) { const int i_ = (T_) / G_, b_ = (T_) - i_ * G_; const int R_ = i_ * 8 + (b_ & 7); const int s_ = b_ >> 3; \
    const int rm_ = R_ / nrn, rn_ = R_ - rm_ * nrn; const int dm_ = s_ / RN, dn_ = s_ - dm_ * RN; MT_ = rm_ * RM + dm_; NT_ = rn_ * RN + dn_; \
    VALID_ = (dm_ < RM) && (R_ < nrects) && (MT_ < ntm) && (NT_ < ntn); }
#define G_NEXT(T_, MT_, NT_) { bool ok_ = false; while ((T_) < nslots) { G_MAP(T_, ok_, MT_, NT_) if (ok_) break; (T_) += G_; } }
#define G_PTRS(MT_, NT_) { apb = A + (size_t)(MT_) * KT * 8192 + lrow * 64 + lkc; bpb = Bt + (size_t)(NT_) * KT * 8192 + lrow * 64 + lkc; }
#define G_LOAD1(S, I, KT_) { ra##S##_##I = *(const uint4*)(apb + (KT_) * 8192 + I * 2048); rb##S##_##I = *(const uint4*)(bpb + (KT_) * 8192 + I * 2048); }
#define G_LOAD(S, KT_) { G_LOAD1(S, 0, KT_) G_LOAD1(S, 1, KT_) G_LOAD1(S, 2, KT_) G_LOAD1(S, 3, KT_) }
#define G_WRITE1(S, I, BUF_) { *(uint4*)(sA + (BUF_) * 128 * LSTR + (lrow + 32 * I) * LSTR + lkc) = ra##S##_##I; *(uint4*)(sB + (BUF_) * 128 * LSTR + (lrow + 32 * I) * LSTR + lkc) = rb##S##_##I; }
#define G_WRITE(S, BUF_) { G_WRITE1(S, 0, BUF_) G_WRITE1(S, 1, BUF_) G_WRITE1(S, 2, BUF_) G_WRITE1(S, 3, BUF_) }
#define G_FRAG(KK, A0, A1, B0, B1) { A0 = *(const bf16x8*)(cA + KK * 16); A1 = *(const bf16x8*)(cA + 32 * LSTR + KK * 16); \
        B0 = *(const bf16x8*)(cB + KK * 16); B1 = *(const bf16x8*)(cB + 32 * LSTR + KK * 16); }
#define G_MMA4(A0, A1, B0, B1) { \
        acc[0][0] = __builtin_amdgcn_mfma_f32_32x32x16_bf16(A0, B0, acc[0][0], 0, 0, 0); \
        acc[0][1] = __builtin_amdgcn_mfma_f32_32x32x16_bf16(A0, B1, acc[0][1], 0, 0, 0); \
        acc[1][0] = __builtin_amdgcn_mfma_f32_32x32x16_bf16(A1, B0, acc[1][0], 0, 0, 0); \
        acc[1][1] = __builtin_amdgcn_mfma_f32_32x32x16_bf16(A1, B1, acc[1][1], 0, 0, 0); }
#define G_COMPUTE(BUF_, PART) { \
      const bf16_t* cA = sA + (BUF_) * 128 * LSTR + (wm * 64 + (lane & 31)) * LSTR + (lane >> 5) * 8; \
      const bf16_t* cB = sB + (BUF_) * 128 * LSTR + (wn * 64 + (lane & 31)) * LSTR + (lane >> 5) * 8; \
      bf16x8 xa0, xa1, xb0, xb1, ya0, ya1, yb0, yb1; \
      G_FRAG(0, xa0, xa1, xb0, xb1) \
      G_FRAG(1, ya0, ya1, yb0, yb1) \
      G_MMA4(xa0, xa1, xb0, xb1) \
      PART(0) \
      __builtin_amdgcn_sched_barrier(0); \
      G_FRAG(2, xa0, xa1, xb0, xb1) \
      G_MMA4(ya0, ya1, yb0, yb1) \
      PART(1) \
      __builtin_amdgcn_sched_barrier(0); \
      G_FRAG(3, ya0, ya1, yb0, yb1) \
      G_MMA4(xa0, xa1, xb0, xb1) \
      PART(2) \
      __builtin_amdgcn_sched_barrier(0); \
      G_MMA4(ya0, ya1, yb0, yb1) \
      PART(3) \
      }
#define G_PA(I) { if (kt == 0) G_WRITE1(1, I, 1) else G_WRITE1(0, I, 1) if (kt + 2 < KT) G_LOAD1(0, I, kt + 2) }
#define G_PB(I) { if (kt + 2 < KT) G_WRITE1(0, I, 0) if (kt + 3 < KT) G_LOAD1(0, I, kt + 3) }
  int tile = blockIdx.x, mt = 0, nt = 0;
  G_NEXT(tile, mt, nt)
  if (tile < nslots) { G_PTRS(mt, nt) G_LOAD(0, 0) G_LOAD(1, 1) }
  while (tile < nslots) {
    const int m0 = mt << 7, n0 = nt << 7;
    f32x16 acc[2][2];
#pragma unroll
    for (int i = 0; i < 2; ++i)
#pragma unroll
      for (int j = 0; j < 2; ++j)
#pragma unroll
        for (int r = 0; r < 16; ++r) acc[i][j][r] = 0.f;
    G_WRITE(0, 0)
    __syncthreads();
    for (int kt = 0; kt < KT; kt += 2) {
      G_COMPUTE(0, G_PA)
      __syncthreads();
      G_COMPUTE(1, G_PB)
      __syncthreads();
    }
    int next = tile + G_;
    G_NEXT(next, mt, nt)
    if (next < nslots) { G_PTRS(mt, nt) G_LOAD(0, 0) G_LOAD(1, 1) }
#pragma unroll
    for (int mi = 0; mi < 2; ++mi)
#pragma unroll
      for (int ni = 0; ni < 2; ++ni) {
        float* cw = sC + (wm * 64 + mi * 32 + 4 * (lane >> 5)) * 132 + wn * 64 + ni * 32 + (lane & 31);
#pragma unroll
        for (int r = 0; r < 16; ++r) cw[((r & 3) + 8 * (r >> 2)) * 132] = acc[mi][ni][r];
      }
    __syncthreads();
#pragma unroll 4
    for (int i = 0; i < 16; ++i) {
      const int ch = tid + 256 * i;
      const int row = ch >> 5, c4 = (ch & 31) * 4;
      const float4 v = *(const float4*)(sC + row * 132 + c4);
      if (n0 + c4 < N) epi(m0 + row, n0 + c4, v);
    }
    __syncthreads();
    tile = next;
  }
}

struct EpiBf16 {
  bf16_t* C; int ldc;
  __device__ __forceinline__ void operator()(int m, int n, float4 v) const {
    uint2 o; o.x = pack2(v.x, v.y); o.y = pack2(v.z, v.w);
    *(uint2*)(C + (size_t)m * ldc + n) = o;
  }
};
__device__ __forceinline__ float softplusf(float x) { return x > 20.f ? x : log1pf(expf(x)); }
struct EpiSsdIn {
  bf16_t* C; float* DT; const float* dt_bias;
  __device__ __forceinline__ void operator()(int m, int n, float4 v) const {
    if (n < 6144) {
      uint2 o; o.x = pack2(v.x, v.y); o.y = pack2(v.z, v.w);
      *(uint2*)(C + (size_t)m * 6144 + n) = o;
    } else {
      const int c = n - 6144;
      const float4 bb = *(const float4*)(dt_bias + c);
      *(float4*)(DT + (size_t)m * 64 + c) = make_float4(softplusf(v.x + bb.x), softplusf(v.y + bb.y), softplusf(v.z + bb.z), softplusf(v.w + bb.w));
    }
  }
};
struct EpiRes {
  const float* xin_ctx; const float* xin_lat; float* X; const float* gate;
  __device__ __forceinline__ void operator()(int m, int n, float4 v) const {
    const float* xr = m < NCTX ? xin_ctx + (size_t)m * 1024 : xin_lat + (size_t)(m - NCTX) * 1024;
    const float4 xv = *(const float4*)(xr + n);
    const float4 gt = *(const float4*)(gate + (size_t)cidx(m) * 6144 + n);
    *(float4*)(X + (size_t)m * 1024 + n) = make_float4(xv.x + gt.x * v.x, xv.y + gt.y * v.y, xv.z + gt.z * v.z, xv.w + gt.w * v.w);
  }
};

__device__ __forceinline__ void conv_gate_phase(const Params& p) {
  const int otid = opaque_tid();
  const bf16_t* P = (const bf16_t*)(p.ws + OFF_BIG);
  bf16_t* G = (bf16_t*)(p.ws + OFF_BIG + 120 * MIB);
  const float* cw = p.sc_conv_w;
  const int total = NT * 128;
  for (int it = blockIdx.x * 256 + otid; it < total; it += gridDim.x * 256) {
    const int tok = it >> 7, c = (it & 127) * 8;
    const int rowlen = tok < NCTX ? 256 : 64;
    const int pos = tok & (rowlen - 1);
    const bf16_t* pr = P + (size_t)tok * 3072;
    uint4 bg = *(const uint4*)(pr + c);
    uint4 cg = *(const uint4*)(pr + 1024 + c);
    uint4 xv = *(const uint4*)(pr + 2048 + c);
    uint4 cgl = make_uint4(0, 0, 0, 0), xvl = cgl, cgr = cgl, xvr = cgl;
    if (pos > 0) { cgl = *(const uint4*)(pr - 3072 + 1024 + c); xvl = *(const uint4*)(pr - 3072 + 2048 + c); }
    if (pos < rowlen - 1) { cgr = *(const uint4*)(pr + 3072 + 1024 + c); xvr = *(const uint4*)(pr + 3072 + 2048 + c); }
    const unsigned* bgp = (const unsigned*)&bg; const unsigned* cgp = (const unsigned*)&cg; const unsigned* xvp = (const unsigned*)&xv;
    const unsigned* cglp = (const unsigned*)&cgl; const unsigned* xvlp = (const unsigned*)&xvl;
    const unsigned* cgrp = (const unsigned*)&cgr; const unsigned* xvrp = (const unsigned*)&xvr;
    float4 w0a = *(const float4*)(cw + c), w0b = *(const float4*)(cw + c + 4);
    float4 w1a = *(const float4*)(cw + 1024 + c), w1b = *(const float4*)(cw + 1024 + c + 4);
    float4 w2a = *(const float4*)(cw + 2048 + c), w2b = *(const float4*)(cw + 2048 + c + 4);
    const float w0[8] = {w0a.x, w0a.y, w0a.z, w0a.w, w0b.x, w0b.y, w0b.z, w0b.w};
    const float w1[8] = {w1a.x, w1a.y, w1a.z, w1a.w, w1b.x, w1b.y, w1b.z, w1b.w};
    const float w2[8] = {w2a.x, w2a.y, w2a.z, w2a.w, w2b.x, w2b.y, w2b.z, w2b.w};
    unsigned o[4];
#pragma unroll
    for (int q = 0; q < 4; ++q) {
      float r0 = lo2f(bgp[q]) * (w0[2 * q] * lo2f(cglp[q]) * lo2f(xvlp[q]) + w1[2 * q] * lo2f(cgp[q]) * lo2f(xvp[q]) + w2[2 * q] * lo2f(cgrp[q]) * lo2f(xvrp[q]));
      float r1 = hi2f(bgp[q]) * (w0[2 * q + 1] * hi2f(cglp[q]) * hi2f(xvlp[q]) + w1[2 * q + 1] * hi2f(cgp[q]) * hi2f(xvp[q]) + w2[2 * q + 1] * hi2f(cgrp[q]) * hi2f(xvrp[q]));
      o[q] = pack2(r0, r1);
    }
    *(uint4*)(G + tiled(tok, c, 16)) = make_uint4(o[0], o[1], o[2], o[3]);
  }
}

#define SSTR 272
#define CE2_(K, a, b) { unsigned hi_ = umax_(K[a], K[b]); unsigned lo_ = K[a] < K[b] ? K[a] : K[b]; K[a] = hi_; K[b] = lo_; }
#define SORT8_(K) CE2_(K, 0, 1) CE2_(K, 2, 3) CE2_(K, 4, 5) CE2_(K, 6, 7) CE2_(K, 0, 2) CE2_(K, 1, 3) CE2_(K, 4, 6) CE2_(K, 5, 7) \
  CE2_(K, 1, 2) CE2_(K, 5, 6) CE2_(K, 0, 4) CE2_(K, 1, 5) CE2_(K, 2, 6) CE2_(K, 3, 7) CE2_(K, 2, 4) CE2_(K, 3, 5) CE2_(K, 1, 2) CE2_(K, 3, 4) CE2_(K, 5, 6)
__device__ __forceinline__ void top16_rows(const float* Sr0, const float* Sr1, int j, unsigned (&res)[2][2]) {
  unsigned ka[8], kb[8], kc[8], kd[8];
#pragma unroll
  for (int m = 0; m < 8; ++m) {
    const unsigned tag = (unsigned)(127 - (j + 16 * m));
    ka[m] = (fkey(Sr0[j + 16 * m]) & ~0x7Fu) | tag;
    kb[m] = (fkey(Sr0[128 + j + 16 * m]) & ~0x7Fu) | tag;
    kc[m] = (fkey(Sr1[j + 16 * m]) & ~0x7Fu) | tag;
    kd[m] = (fkey(Sr1[128 + j + 16 * m]) & ~0x7Fu) | tag;
  }
  SORT8_(ka)
  SORT8_(kb)
  SORT8_(kc)
  SORT8_(kd)
  unsigned r0 = 0, r1 = 0, r2 = 0, r3 = 0;
#pragma unroll 2
  for (int it = 0; it < 16; ++it) {
    const unsigned wa = row_max_u32(ka[0]);
    const unsigned wb = row_max_u32(kb[0]);
    const unsigned wc = row_max_u32(kc[0]);
    const unsigned wd = row_max_u32(kd[0]);
    const bool wina = ka[0] == wa, winb = kb[0] == wb, winc = kc[0] == wc, wind = kd[0] == wd;
#pragma unroll
    for (int m = 0; m < 7; ++m) {
      ka[m] = wina ? ka[m + 1] : ka[m]; kb[m] = winb ? kb[m + 1] : kb[m];
      kc[m] = winc ? kc[m + 1] : kc[m]; kd[m] = wind ? kd[m + 1] : kd[m];
    }
    ka[7] = wina ? 0u : ka[7]; kb[7] = winb ? 0u : kb[7]; kc[7] = winc ? 0u : kc[7]; kd[7] = wind ? 0u : kd[7];
    r0 = (j == it) ? wa : r0; r1 = (j == it) ? wb : r1; r2 = (j == it) ? wc : r2; r3 = (j == it) ? wd : r3;
  }
  res[0][0] = r0; res[0][1] = r1; res[1][0] = r2; res[1][1] = r3;
}

__device__ __forceinline__ void topk_phase(const Params& p, int layer, char* smem) {
  const int otid = opaque_tid();
  float* S0 = (float*)smem;
  const bf16_t* Q = (const bf16_t*)(p.ws + OFF_BIG);
  const bf16_t* KB = (const bf16_t*)(p.ws + OFF_KEYSB) + (size_t)layer * (8 * 2 * 128 * 128);
  int* IDX = (int*)(p.ws + OFF_IDX);
  float* GATE = (float*)(p.ws + OFF_GATE);
  const int tid = otid, lane = tid & 63;
  const int w = __builtin_amdgcn_readfirstlane(tid >> 6);
  const int G = gridDim.x;
  const int per = (5120 + G - 1) / G;
  const int start = blockIdx.x * per;
  const int end = (start + per < 5120) ? start + per : 5120;
  const int pp = w >> 1, nt0 = (w & 1) * 2;
  const int j = lane & 15, rowbase = lane & 48;
  int ca[4], cb[4];
  bool cvalid3;
  ca[0] = 0; cb[0] = j;
  if (j < 8) { ca[1] = 1; cb[1] = j; } else { ca[1] = j; cb[1] = 0; }
  if (j < 5) { ca[2] = 2; cb[2] = j; } else if (j < 9) { ca[2] = 3; cb[2] = j - 5; } else if (j < 12) { ca[2] = 4; cb[2] = j - 9; }
  else if (j < 14) { ca[2] = 5; cb[2] = j - 12; } else { ca[2] = 6; cb[2] = j - 14; }
  ca[3] = 7; cb[3] = j & 1; cvalid3 = j < 2;
  int curh = -1;
  bf16x8 kf[2][8];
  bf16x8 qa[8];
  for (int pr = start; pr < end; ++pr) {
    const int h = pr / 640, tile = pr % 640;
    const int t0 = tile * 32;
    float* S = S0 + ((pr - start) & 1) * (32 * SSTR);
    if (h != curh) {
#pragma unroll
      for (int jj = 0; jj < 2; ++jj)
#pragma unroll
        for (int kk = 0; kk < 8; ++kk)
          kf[jj][kk] = *(const bf16x8*)(KB + ((size_t)((h * 2 + pp) * 128 + (nt0 + jj) * 32 + (lane & 31))) * 128 + kk * 16 + (lane >> 5) * 8);
      curh = h;
    }
    f32x16 acc[2];
#pragma unroll
    for (int jj = 0; jj < 2; ++jj)
#pragma unroll
      for (int r = 0; r < 16; ++r) acc[jj][r] = 0.f;
    if (pr == start) {
      const bf16_t* qp = Q + (size_t)(t0 + (lane & 31)) * 2048 + h * 256 + pp * 128 + (lane >> 5) * 8;
#pragma unroll
      for (int kk = 0; kk < 8; ++kk) qa[kk] = *(const bf16x8*)(qp + kk * 16);
    }
#pragma unroll
    for (int kk = 0; kk < 8; ++kk) {
      acc[0] = __builtin_amdgcn_mfma_f32_32x32x16_bf16(qa[kk], kf[0][kk], acc[0], 0, 0, 0);
      acc[1] = __builtin_amdgcn_mfma_f32_32x32x16_bf16(qa[kk], kf[1][kk], acc[1], 0, 0, 0);
    }
    if (pr + 1 < end) {
      const int hn = (pr + 1) / 640, tn = ((pr + 1) % 640) * 32;
      const bf16_t* qn = Q + (size_t)(tn + (lane & 31)) * 2048 + hn * 256 + pp * 128 + (lane >> 5) * 8;
#pragma unroll
      for (int kk = 0; kk < 8; ++kk) qa[kk] = *(const bf16x8*)(qn + kk * 16);
    }
#pragma unroll
    for (int jj = 0; jj < 2; ++jj)
#pragma unroll
      for (int r = 0; r < 16; ++r) {
        const int tl = (r & 3) + 8 * (r >> 2) + 4 * (lane >> 5);
        S[tl * SSTR + pp * 128 + (nt0 + jj) * 32 + (lane & 31)] = acc[jj][r];
      }
    __syncthreads();
    {
      const int tl0 = w * 8 + (lane >> 4), tl1 = tl0 + 4;
      unsigned res[2][2];
      top16_rows(S + tl0 * SSTR, S + tl1 * SSTR, j, res);
      unsigned ck[2][4];
#pragma unroll
      for (int u = 0; u < 2; ++u) {
#pragma unroll
        for (int sl = 0; sl < 4; ++sl) {
          const float v1 = keyf((unsigned)__shfl((int)res[u][0], rowbase + ca[sl]) & ~0x7Fu);
          const float v2 = keyf((unsigned)__shfl((int)res[u][1], rowbase + cb[sl]) & ~0x7Fu);
          ck[u][sl] = (fkey(v1 + v2) & ~0xFFu) | (unsigned)(255 - (ca[sl] * 16 + cb[sl]));
        }
        ck[u][3] = cvalid3 ? ck[u][3] : 0u;
      }
      unsigned resc0 = 0, resc1 = 0;
#pragma unroll 2
      for (int it = 0; it < 16; ++it) {
        const unsigned wm0 = row_max_u32(umax_(umax_(ck[0][0], ck[0][1]), umax_(ck[0][2], ck[0][3])));
        const unsigned wm1 = row_max_u32(umax_(umax_(ck[1][0], ck[1][1]), umax_(ck[1][2], ck[1][3])));
#pragma unroll
        for (int sl = 0; sl < 4; ++sl) { ck[0][sl] = (ck[0][sl] == wm0) ? 0u : ck[0][sl]; ck[1][sl] = (ck[1][sl] == wm1) ? 0u : ck[1][sl]; }
        resc0 = (j == it) ? wm0 : resc0;
        resc1 = (j == it) ? wm1 : resc1;
      }
#pragma unroll
      for (int u = 0; u < 2; ++u) {
        const unsigned resc = u ? resc1 : resc0;
        const int tl = u ? tl1 : tl0;
        const int code = 255 - (int)(resc & 0xFFu);
        const int wa = code >> 4, wb = code & 15;
        const float val = keyf(resc & ~0xFFu);
        const unsigned r1 = (unsigned)__shfl((int)res[u][0], rowbase + wa);
        const unsigned r2 = (unsigned)__shfl((int)res[u][1], rowbase + wb);
        const int i1 = 127 - (int)(r1 & 0x7Fu), i2 = 127 - (int)(r2 & 0x7Fu);
        const float vmax = __shfl(val, rowbase);
        const float e = __expf(val - vmax);
        const float ssum = row16_sum(e);
        const size_t ob = ((size_t)(t0 + tl) * 8 + h) * 16 + j;
        IDX[ob] = i1 * 128 + i2;
        GATE[ob] = e / ssum;
      }
    }
  }
}

typedef __attribute__((ext_vector_type(2))) float f32x2;
__device__ __forceinline__ void peer_phase(const Params& p, int layer, char* smem) {
  const int otid = opaque_tid();
  float* coefs = (float*)smem;
  int* idxs = (int*)(smem + 2048);
  float* sus = (float*)(smem + 4096);
  float* gsv = (float*)(smem + 6144);
  const unsigned char* U6 = (const unsigned char*)(p.ws + (layer ? OFF_TAB1 : OFF_YB));
  const unsigned char* V6 = U6 + (size_t)16384 * 768;
  const float* SCU = (const float*)(p.ws + OFF_SCALE) + (size_t)layer * 32768;
  const float* SCV = SCU + 16384;
  const bf16_t* A = (const bf16_t*)(p.ws + OFF_YF);
  const int* IDX = (const int*)(p.ws + OFF_IDX);
  const float* GATE = (const float*)(p.ws + OFF_GATE);
  const float* MOD = (const float*)(p.ws + OFF_MOD);
  float* X = p.out;
  const int lane = otid & 63;
  const int w = __builtin_amdgcn_readfirstlane(otid >> 6);
  const int sub = lane & 15, rg = lane >> 4;
  const int half = lane >> 5, l31 = lane & 31;
  int pe0 = 0, pe1 = 0; float pg0 = 0.f, pg1 = 0.f;
  {
    const int tok0_ = blockIdx.x * 4 + w;
    if (tok0_ < NT) { pe0 = IDX[(size_t)tok0_ * 128 + lane]; pe1 = IDX[(size_t)tok0_ * 128 + 64 + lane]; pg0 = GATE[(size_t)tok0_ * 128 + lane]; pg1 = GATE[(size_t)tok0_ * 128 + 64 + lane]; }
  }
  for (int tok = blockIdx.x * 4 + w; tok < NT; tok += gridDim.x * 4) {
#pragma unroll
    for (int hh = 0; hh < 2; ++hh) {
      const int kk = lane + 64 * hh;
      const int e = hh ? pe1 : pe0;
      const float gk = hh ? pg1 : pg0;
      idxs[w * 128 + kk] = e;
      sus[w * 128 + kk] = SCU[e];
      gsv[w * 128 + kk] = gk * SCV[e];
    }
    float t[64];
    {
      const uint4* ap = (const uint4*)(A + tiled(tok, 64 * sub, 16));
#pragma unroll
      for (int i = 0; i < 8; ++i) {
        const uint4 r0 = ap[i];
#pragma unroll
        for (int q = 0; q < 4; ++q) { t[8 * i + 2 * q] = lo2f(u4get(r0, q)); t[8 * i + 2 * q + 1] = hi2f(u4get(r0, q)); }
      }
    }
    float chain = 0.f;
#pragma unroll 4
    for (int it = 0; it < 32; ++it) {
      const int k = it * 4 + rg;
      const int e = idxs[w * 128 + k];
      const uint4* row = (const uint4*)(U6 + (size_t)e * 768 + sub * 48);
      const uint4 r0 = row[0], r1 = row[1], r2 = row[2];
      u32x6 g0, g1;
      g0[0] = r0.x; g0[1] = r0.y; g0[2] = r0.z; g0[3] = r0.w; g0[4] = r1.x; g0[5] = r1.y;
      g1[0] = r1.z; g1[1] = r1.w; g1[2] = r2.x; g1[3] = r2.y; g1[4] = r2.z; g1[5] = r2.w;
      float acc0 = 0.f, acc1 = 0.f;
      asm volatile("" : "+v"(g0), "+v"(chain));
      {
        const f32x32 d0 = __builtin_amdgcn_cvt_scalef32_pk32_f32_fp6(g0, 1.0f);
#pragma unroll
        for (int j = 0; j < 32; j += 2) { acc0 += d0[j] * t[j]; acc1 += d0[j + 1] * t[j + 1]; }
      }
      asm volatile("" : "+v"(g1), "+v"(acc0), "+v"(acc1));
      {
        const f32x32 d1 = __builtin_amdgcn_cvt_scalef32_pk32_f32_fp6(g1, 1.0f);
#pragma unroll
        for (int j = 0; j < 32; j += 2) { acc0 += d1[j] * t[32 + j]; acc1 += d1[j + 1] * t[32 + j + 1]; }
      }
      chain = acc0 + acc1;
      float acc = row16_sum(chain) * sus[w * 128 + k];
      const float co = 0.5f * acc * (1.f + erff(acc * 0.70710678118654752f)) * gsv[w * 128 + k];
      if (sub == 0) coefs[w * 128 + k] = co;
    }
    {
      const int tokn = tok + gridDim.x * 4;
      if (tokn < NT) { pe0 = IDX[(size_t)tokn * 128 + lane]; pe1 = IDX[(size_t)tokn * 128 + 64 + lane]; pg0 = GATE[(size_t)tokn * 128 + lane]; pg1 = GATE[(size_t)tokn * 128 + 64 + lane]; }
    }
    f32x32 ov;
#pragma unroll
    for (int i = 0; i < 32; ++i) ov[i] = 0.f;
#pragma unroll 1
    for (int k = 0; k < 128; k += 16) {
      uint2 ra[8], rb[8], rc[8]; float c[8];
#pragma unroll
      for (int j = 0; j < 8; ++j) {
        const int kk = k + 2 * j + half;
        const int e = idxs[w * 128 + kk];
        c[j] = coefs[w * 128 + kk];
        const uint2* rp = (const uint2*)(V6 + (size_t)e * 768 + l31 * 24);
        ra[j] = rp[0]; rb[j] = rp[1]; rc[j] = rp[2];
      }
#pragma unroll
      for (int j = 0; j < 8; ++j) {
        u32x6 g;
        g[0] = ra[j].x; g[1] = ra[j].y; g[2] = rb[j].x; g[3] = rb[j].y; g[4] = rc[j].x; g[5] = rc[j].y;
        asm volatile("" : "+v"(g), "+v"(ov));
        const f32x32 d = __builtin_amdgcn_cvt_scalef32_pk32_f32_fp6(g, 1.0f);
        ov += d * c[j];
      }
    }
    float o[16];
#pragma unroll
    for (int i = 0; i < 16; ++i) {
      const float lo = ov[i] + __shfl_xor(ov[i], 32);
      const float hi = ov[16 + i] + __shfl_xor(ov[16 + i], 32);
      o[i] = half ? hi : lo;
    }
    const int col0 = 32 * l31 + 16 * half;
    const float* gate = MOD + (size_t)(layer * 5 + cidx(tok)) * 6144 + 5 * 1024;
    float xr[16];
    float ss = 0.f;
#pragma unroll
    for (int i = 0; i < 4; ++i) {
      const int col = col0 + 4 * i;
      const float4 xv = *(const float4*)(X + (size_t)tok * 1024 + col);
      const float4 gt = *(const float4*)(gate + col);
      xr[4 * i] = xv.x + gt.x * o[4 * i]; xr[4 * i + 1] = xv.y + gt.y * o[4 * i + 1];
      xr[4 * i + 2] = xv.z + gt.z * o[4 * i + 2]; xr[4 * i + 3] = xv.w + gt.w * o[4 * i + 3];
      ss += xr[4 * i] * xr[4 * i] + xr[4 * i + 1] * xr[4 * i + 1] + xr[4 * i + 2] * xr[4 * i + 2] + xr[4 * i + 3] * xr[4 * i + 3];
    }
    ss = wave_sum(ss);
    const float sc = rsqrtf(ss * (1.f / 1024.f) + 1e-6f);
    if (layer == 0) {
      const float* g1 = p.norm_mix_g + 1024;
      const float* md = MOD + (size_t)(5 + cidx(tok)) * 6144;
      unsigned pk[8];
#pragma unroll
      for (int i = 0; i < 4; ++i) {
        const int col = col0 + 4 * i;
        *(float4*)(X + (size_t)tok * 1024 + col) = make_float4(xr[4 * i], xr[4 * i + 1], xr[4 * i + 2], xr[4 * i + 3]);
        const float4 gg = *(const float4*)(g1 + col);
        const float4 sh = *(const float4*)(md + col);
        const float4 sl = *(const float4*)(md + 1024 + col);
        pk[2 * i] = pack2(xr[4 * i] * sc * gg.x * (1.f + sl.x) + sh.x, xr[4 * i + 1] * sc * gg.y * (1.f + sl.y) + sh.y);
        pk[2 * i + 1] = pack2(xr[4 * i + 2] * sc * gg.z * (1.f + sl.z) + sh.z, xr[4 * i + 3] * sc * gg.w * (1.f + sl.w) + sh.w);
      }
      bf16_t* An = (bf16_t*)(p.ws + OFF_YF) + tiled(tok, col0, 16);
      *(uint4*)(An) = make_uint4(pk[0], pk[1], pk[2], pk[3]);
      *(uint4*)(An + 8) = make_uint4(pk[4], pk[5], pk[6], pk[7]);
    } else {
#pragma unroll
      for (int i = 0; i < 4; ++i) {
        const int col = col0 + 4 * i;
        const float4 gg = *(const float4*)(p.norm_f_g + col);
        *(float4*)(X + (size_t)tok * 1024 + col) = make_float4(xr[4 * i] * sc * gg.x, xr[4 * i + 1] * sc * gg.y, xr[4 * i + 2] * sc * gg.z, xr[4 * i + 3] * sc * gg.w);
      }
    }
  }
}

__device__ __forceinline__ void ssd_conv_phase(const Params& p) {
  const int otid = opaque_tid();
  bf16_t* BIG = (bf16_t*)(p.ws + OFF_BIG);
  const float* cw = p.ssd_conv_w;
  const float* cb = p.ssd_conv_b;
  const int total = 272 * 512;
  for (int it = blockIdx.x * 256 + otid; it < total; it += gridDim.x * 256) {
    const int c8 = it & 511, r = it >> 9;
    const int c = c8 * 8;
    int tok0, len;
    if (r < 16) { tok0 = r * 256; len = 256; } else { tok0 = NCTX + (r - 16) * 64; len = 64; }
    float w0[8], w1[8], w2[8], bb[8];
#pragma unroll
    for (int j = 0; j < 8; ++j) { w0[j] = cw[c + j]; w1[j] = cw[4096 + c + j]; w2[j] = cw[8192 + c + j]; bb[j] = cb[c + j]; }
    bf16_t* base = BIG + (size_t)tok0 * 6144 + 2048 + c;
    uint4 buf[8], nxt[8];
#pragma unroll
    for (int j = 0; j < 8; ++j) buf[j] = *(const uint4*)(base + (size_t)j * 6144);
    uint4 prev = make_uint4(0, 0, 0, 0);
    for (int t0 = 0; t0 < len; t0 += 8) {
      const bool more = (t0 + 8) < len;
#pragma unroll
      for (int j = 0; j < 8; ++j) nxt[j] = more ? *(const uint4*)(base + (size_t)(t0 + 8 + j) * 6144) : make_uint4(0, 0, 0, 0);
#pragma unroll
      for (int j = 0; j < 8; ++j) {
        const uint4 cur = buf[j];
        const uint4 nx = (j < 7) ? buf[j + 1] : nxt[0];
        const unsigned* pp = (const unsigned*)&prev; const unsigned* cp = (const unsigned*)&cur; const unsigned* np = (const unsigned*)&nx;
        unsigned o[4];
#pragma unroll
        for (int q = 0; q < 4; ++q) {
          float a0 = w0[2 * q] * lo2f(pp[q]) + w1[2 * q] * lo2f(cp[q]) + w2[2 * q] * lo2f(np[q]) + bb[2 * q];
          float a1 = w0[2 * q + 1] * hi2f(pp[q]) + w1[2 * q + 1] * hi2f(cp[q]) + w2[2 * q + 1] * hi2f(np[q]) + bb[2 * q + 1];
          o[q] = pack2(siluf(a0), siluf(a1));
        }
        *(uint4*)(base + (size_t)(t0 + j) * 6144) = make_uint4(o[0], o[1], o[2], o[3]);
        prev = cur;
      }
#pragma unroll
      for (int j = 0; j < 8; ++j) buf[j] = nxt[j];
    }
  }
}

#define XT_STR 72
#define HB_STR 136
#define SCAN_LOAD_FRAGS(CC) { \
      { const int t_ = (CC) * 64 + 32 * it + l31; const int tok_ = tok0 + (dir ? L - 1 - t_ : t_); \
        const bf16_t* cp_ = BIG + (size_t)tok_ * 6144 + 5120 + g * 128 + 8 * h5; \
        _Pragma("unroll") for (int kk = 0; kk < 8; ++kk) cfr[kk] = *(const bf16x8*)(cp_ + 16 * kk); } \
      if (jt <= it) { const int t_ = (CC) * 64 + 32 * jt + l31; const int tok_ = tok0 + (dir ? L - 1 - t_ : t_); \
        const bf16_t* bp_ = BIG + (size_t)tok_ * 6144 + 4096 + g * 128 + 8 * h5; \
        _Pragma("unroll") for (int kk = 0; kk < 8; ++kk) bfr[kk] = *(const bf16x8*)(bp_ + 16 * kk); } }
#define SCAN_LOAD_STAGE(CC) { \
      const int t_ = (CC) * 64 + lane; const int tok_ = tok0 + (dir ? L - 1 - t_ : t_); \
      const bf16_t* rowp_ = BIG + (size_t)tok_ * 6144; \
      _Pragma("unroll") for (int r = 0; r < 2; ++r) sx[r] = *(const uint4*)(rowp_ + 2048 + head * 64 + (w + 4 * r) * 8); \
      _Pragma("unroll") for (int r = 0; r < 4; ++r) sb[r] = *(const uint4*)(rowp_ + 4096 + g * 128 + (w + 4 * r) * 8); \
      sdt = DT[(size_t)tok_ * 64 + dir * 32 + head]; }
__device__ __forceinline__ void scan_phase(const Params& p, char* smem) {
  const int otid = opaque_tid();
  bf16_t* XTd = (bf16_t*)smem;
  bf16_t* BTs = XTd + 64 * XT_STR;
  bf16_t* Ms = BTs + 128 * XT_STR;
  bf16_t* Hb = Ms + 64 * XT_STR;
  float* cumS = (float*)(Hb + 2 * 64 * HB_STR);
  const bf16_t* BIG = (const bf16_t*)(p.ws + OFF_BIG);
  const float* DT = (const float*)(p.ws + OFF_DT);
  const int tid = otid, lane = tid & 63;
  const int w = __builtin_amdgcn_readfirstlane(tid >> 6);
  const int h5 = lane >> 5, l31 = lane & 31;
  const int it = w >> 1, jt = w & 1, pt = w & 1, nt0 = (w >> 1) * 2;
  int item0, istride;
  if (gridDim.x >= 512) { if (blockIdx.x < 256) { item0 = blockIdx.x; istride = 1 << 28; } else { item0 = blockIdx.x; istride = gridDim.x - 256; } }
  else { item0 = blockIdx.x; istride = gridDim.x; }
  for (int item = item0; item < 1280; item += istride) {
    int b, head, dir, L, tok0;
    const bool latent = item < 256;
    if (latent) { b = item >> 6; head = (item >> 1) & 31; dir = item & 1; L = 4096; tok0 = NCTX + b * 4096; }
    else { int jj = item - 256; b = jj >> 6; head = (jj >> 1) & 31; dir = jj & 1; L = 256; tok0 = b * 256; }
    const int g = head >> 2;
    const float a = -expf(p.ssd_a_log[dir * 32 + head]);
    bf16_t* Y = (bf16_t*)(p.ws + (dir ? OFF_YB : OFF_YF));
    f32x16 st[2];
    const size_t sbase = ((size_t)((b * 2 + dir) * 32 + head)) * 8192;
    const int loff = (32 * pt + l31) * 128 + 32 * nt0 + 4 * h5;
    if (latent) {
      const float* sp = p.state_ssm + sbase + loff;
#pragma unroll
      for (int q = 0; q < 2; ++q)
#pragma unroll
        for (int qq = 0; qq < 4; ++qq) {
          const float4 v = *(const float4*)(sp + 32 * q + 8 * qq);
          st[q][4 * qq] = v.x; st[q][4 * qq + 1] = v.y; st[q][4 * qq + 2] = v.z; st[q][4 * qq + 3] = v.w;
        }
    } else {
#pragma unroll
      for (int q = 0; q < 2; ++q)
#pragma unroll
        for (int r = 0; r < 16; ++r) st[q][r] = 0.f;
    }
    {
      bf16_t* hb0 = Hb + (32 * pt + l31) * HB_STR + 32 * nt0 + 4 * h5;
#pragma unroll
      for (int q = 0; q < 2; ++q)
#pragma unroll
        for (int qq = 0; qq < 4; ++qq) {
          uint2 o; o.x = pack2(st[q][4 * qq], st[q][4 * qq + 1]); o.y = pack2(st[q][4 * qq + 2], st[q][4 * qq + 3]);
          *(uint2*)(hb0 + 32 * q + 8 * qq) = o;
        }
    }
    __syncthreads();
    const int nchunks = L >> 6;
    uint4 sx[2], sb[4];
    float sdt;
    SCAN_LOAD_STAGE(0)
    bf16x8 cfr[8], bfr[8];
    SCAN_LOAD_FRAGS(0)
#pragma nounroll
    for (int c = 0; c < nchunks; ++c) {
      const int cur = c & 1;
      __builtin_amdgcn_sched_barrier(0);
      float cum = sdt * a;
      cum += dpp_f<0x111>(cum);
      cum += dpp_f<0x112>(cum);
      cum += dpp_f<0x114>(cum);
      cum += dpp_f<0x118>(cum);
      {
        const float r0 = __int_as_float(__builtin_amdgcn_readlane(__float_as_int(cum), 15));
        const float r1 = __int_as_float(__builtin_amdgcn_readlane(__float_as_int(cum), 31));
        const float r2 = __int_as_float(__builtin_amdgcn_readlane(__float_as_int(cum), 47));
        const int rw = lane >> 4;
        cum += (rw == 0) ? 0.f : ((rw == 1) ? r0 : ((rw == 2) ? r0 + r1 : r0 + r1 + r2));
      }
      const float cum_last = __int_as_float(__builtin_amdgcn_readlane(__float_as_int(cum), 63));
      const float wj = __expf(cum_last - cum);
      if (w == 0) cumS[cur * 64 + lane] = cum;
#pragma unroll
      for (int r = 0; r < 2; ++r) {
        const int p8 = (w + 4 * r) * 8;
#pragma unroll
        for (int q = 0; q < 4; ++q) {
          const unsigned u = u4get(sx[r], q);
          XTd[(p8 + 2 * q) * XT_STR + lane] = f2bf(sdt * lo2f(u));
          XTd[(p8 + 2 * q + 1) * XT_STR + lane] = f2bf(sdt * hi2f(u));
        }
      }
#pragma unroll
      for (int r = 0; r < 4; ++r) {
        const int n8 = (w + 4 * r) * 8;
#pragma unroll
        for (int q = 0; q < 4; ++q) {
          const unsigned u = u4get(sb[r], q);
          BTs[(n8 + 2 * q) * XT_STR + lane] = f2bf(wj * lo2f(u));
          BTs[(n8 + 2 * q + 1) * XT_STR + lane] = f2bf(wj * hi2f(u));
        }
      }
      if (c + 1 < nchunks) SCAN_LOAD_STAGE(c + 1)
      __builtin_amdgcn_sched_barrier(0);
      f32x16 cb;
#pragma unroll
      for (int r = 0; r < 16; ++r) cb[r] = 0.f;
      if (jt <= it) {
#pragma unroll
        for (int kk = 0; kk < 8; ++kk) cb = __builtin_amdgcn_mfma_f32_32x32x16_bf16(bfr[kk], cfr[kk], cb, 0, 0, 0);
      }
      __builtin_amdgcn_sched_barrier(0);
      f32x16 yo;
#pragma unroll
      for (int r = 0; r < 16; ++r) yo[r] = 0.f;
      {
        const bf16_t* hp = Hb + cur * 64 * HB_STR + (32 * pt + l31) * HB_STR + 8 * h5;
#pragma unroll
        for (int kk = 0; kk < 8; ++kk) {
          const bf16x8 hf = *(const bf16x8*)(hp + 16 * kk);
          yo = __builtin_amdgcn_mfma_f32_32x32x16_bf16(hf, cfr[kk], yo, 0, 0, 0);
        }
      }
      __builtin_amdgcn_sched_barrier(0);
      if (c + 1 < nchunks) SCAN_LOAD_FRAGS(c + 1)
      __syncthreads();
      __builtin_amdgcn_sched_barrier(0);
      const float dec = __expf(cum_last);
      bf16x8 xf[4];
#pragma unroll
      for (int kk = 0; kk < 4; ++kk) xf[kk] = *(const bf16x8*)(XTd + (32 * pt + l31) * XT_STR + 16 * kk + 8 * h5);
#pragma unroll
      for (int q = 0; q < 2; ++q) {
#pragma unroll
        for (int r = 0; r < 16; ++r) st[q][r] *= dec;
#pragma unroll
        for (int kk = 0; kk < 4; ++kk) {
          const bf16x8 bt = *(const bf16x8*)(BTs + (32 * (nt0 + q) + l31) * XT_STR + 16 * kk + 8 * h5);
          st[q] = __builtin_amdgcn_mfma_f32_32x32x16_bf16(bt, xf[kk], st[q], 0, 0, 0);
        }
        {
          bf16_t* hbw = Hb + (cur ^ 1) * 64 * HB_STR + (32 * pt + l31) * HB_STR + 32 * (nt0 + q) + 4 * h5;
#pragma unroll
          for (int qq = 0; qq < 4; ++qq) {
            uint2 o; o.x = pack2(st[q][4 * qq], st[q][4 * qq + 1]); o.y = pack2(st[q][4 * qq + 2], st[q][4 * qq + 3]);
            *(uint2*)(hbw + 8 * qq) = o;
          }
        }
      }
      __builtin_amdgcn_sched_barrier(0);
      if (jt <= it) {
        const int ii = 32 * it + l31;
        const float ci = cumS[cur * 64 + ii];
        const int jb = 32 * jt + 4 * h5;
        const float* cs = cumS + cur * 64 + jb;
        bf16_t* mw = Ms + ii * XT_STR + jb;
#pragma unroll
        for (int qq = 0; qq < 4; ++qq) {
          const float4 cj = *(const float4*)(cs + 8 * qq);
          const int j0 = jb + 8 * qq;
          const float m0 = (j0 <= ii) ? cb[4 * qq] * __expf(ci - cj.x) : 0.f;
          const float m1 = (j0 + 1 <= ii) ? cb[4 * qq + 1] * __expf(ci - cj.y) : 0.f;
          const float m2 = (j0 + 2 <= ii) ? cb[4 * qq + 2] * __expf(ci - cj.z) : 0.f;
          const float m3 = (j0 + 3 <= ii) ? cb[4 * qq + 3] * __expf(ci - cj.w) : 0.f;
          uint2 o; o.x = pack2(m0, m1); o.y = pack2(m2, m3);
          *(uint2*)(mw + 8 * qq) = o;
        }
      }
      __syncthreads();
      __builtin_amdgcn_sched_barrier(0);
      f32x16 yd;
#pragma unroll
      for (int r = 0; r < 16; ++r) yd[r] = 0.f;
#pragma unroll
      for (int kk = 0; kk < 4; ++kk) {
        if (kk < 2 * (it + 1)) {
          const bf16x8 mf = *(const bf16x8*)(Ms + (32 * it + l31) * XT_STR + 16 * kk + 8 * h5);
          yd = __builtin_amdgcn_mfma_f32_32x32x16_bf16(xf[kk], mf, yd, 0, 0, 0);
        }
      }
      {
        const int ti = c * 64 + 32 * it + l31;
        const int tok = tok0 + (dir ? L - 1 - ti : ti);
        const float ei = __expf(cumS[cur * 64 + 32 * it + l31]);
        bf16_t* yp = Y + ((size_t)(tok >> 7) * 32 + head) * 8192 + (tok & 127) * 64 + 32 * pt + 4 * h5;
#pragma unroll
        for (int qq = 0; qq < 4; ++qq) {
          uint2 o;
          o.x = pack2(yd[4 * qq] + ei * yo[4 * qq], yd[4 * qq + 1] + ei * yo[4 * qq + 1]);
          o.y = pack2(yd[4 * qq + 2] + ei * yo[4 * qq + 2], yd[4 * qq + 3] + ei * yo[4 * qq + 3]);
          *(uint2*)(yp + 8 * qq) = o;
        }
      }
    }
    if (!latent) {
      float* sp = p.out + (size_t)NT * 1024 + sbase + loff;
#pragma unroll
      for (int q = 0; q < 2; ++q)
#pragma unroll
        for (int qq = 0; qq < 4; ++qq)
          *(float4*)(sp + 32 * q + 8 * qq) = make_float4(st[q][4 * qq], st[q][4 * qq + 1], st[q][4 * qq + 2], st[q][4 * qq + 3]);
    }
    __syncthreads();
  }
}

__device__ __forceinline__ void gate_norm_phase(const Params& p) {
  const int otid = opaque_tid();
  const bf16_t* BIG = (const bf16_t*)(p.ws + OFF_BIG);
  bf16_t* YF = (bf16_t*)(p.ws + OFF_YF);
  const bf16_t* YB = (const bf16_t*)(p.ws + OFF_YB);
  const int lane = otid & 63, w = otid >> 6;
  for (int tok = blockIdx.x * 4 + w; tok < NT; tok += gridDim.x * 4) {
    float v[32];
    float ss = 0.f;
#pragma unroll
    for (int i = 0; i < 4; ++i) {
      const int col = lane * 8 + 512 * i;
      const int head = col >> 6;
      const float dtot = p.ssd_d[head] + p.ssd_d[32 + head];
      uint4 a = *(const uint4*)(YF + tiled(tok, col, 32));
      uint4 b = *(const uint4*)(YB + tiled(tok, col, 32));
      uint4 x = *(const uint4*)(BIG + (size_t)tok * 6144 + 2048 + col);
      uint4 z = *(const uint4*)(BIG + (size_t)tok * 6144 + col);
#pragma unroll
      for (int q = 0; q < 4; ++q) {
        const unsigned aq = u4get(a, q), bq = u4get(b, q), xq = u4get(x, q), zq = u4get(z, q);
        float y0 = lo2f(aq) + lo2f(bq) + dtot * lo2f(xq);
        float y1 = hi2f(aq) + hi2f(bq) + dtot * hi2f(xq);
        y0 *= siluf(lo2f(zq));
        y1 *= siluf(hi2f(zq));
        v[8 * i + 2 * q] = y0; v[8 * i + 2 * q + 1] = y1;
        ss += y0 * y0 + y1 * y1;
      }
      __builtin_amdgcn_sched_barrier(0);
    }
    ss = wave_sum(ss);
    const float sc = rsqrtf(ss * (1.f / 2048.f) + 1e-6f);
#pragma unroll
    for (int i = 0; i < 4; ++i) {
      const int col = lane * 8 + 512 * i;
      float4 g0 = *(const float4*)(p.ssd_norm_g + col), g1 = *(const float4*)(p.ssd_norm_g + col + 4);
      uint4 o;
      o.x = pack2(v[8 * i] * sc * g0.x, v[8 * i + 1] * sc * g0.y);
      o.y = pack2(v[8 * i + 2] * sc * g0.z, v[8 * i + 3] * sc * g0.w);
      o.z = pack2(v[8 * i + 4] * sc * g1.x, v[8 * i + 5] * sc * g1.y);
      o.w = pack2(v[8 * i + 6] * sc * g1.z, v[8 * i + 7] * sc * g1.w);
      *(uint4*)(YF + tiled(tok, col, 32)) = o;
    }
  }
}

__device__ __forceinline__ void final_norm_phase(const Params& p) {
  const int otid = opaque_tid();
  const int lane = otid & 63, w = otid >> 6;
  for (int tok = blockIdx.x * 4 + w; tok < NT; tok += gridDim.x * 4) {
    float* xr = p.out + (size_t)tok * 1024;
    float4 v[4];
    float ss = 0.f;
#pragma unroll
    for (int i = 0; i < 4; ++i) {
      v[i] = *(const float4*)(xr + lane * 4 + 256 * i);
      ss += v[i].x * v[i].x + v[i].y * v[i].y + v[i].z * v[i].z + v[i].w * v[i].w;
    }
    ss = wave_sum(ss);
    const float sc = rsqrtf(ss * (1.f / 1024.f) + 1e-6f);
#pragma unroll
    for (int i = 0; i < 4; ++i) {
      const int col = lane * 4 + 256 * i;
      float4 gg = *(const float4*)(p.norm_f_g + col);
      *(float4*)(xr + col) = make_float4(v[i].x * sc * gg.x, v[i].y * sc * gg.y, v[i].z * sc * gg.z, v[i].w * sc * gg.w);
    }
  }
}


#define XB_TMO      128
#define XB_XCNT(j)  (256  + 64 * (j))
#define XB_XSUB(j)  (1280 + 64 * (j))
#define XB_XGEN(j)  (2304 + 64 * (j))
#define XB_TOP      3328
#define XB_TOPGEN   3392
#define XCD_BAR_WORDS 3456
#define XB_SPIN_CAP (1u << 22)
#define LAS __attribute__((address_space(3)))
__device__ __forceinline__ unsigned xb_ld(unsigned* p) { return __hip_atomic_load(p, __ATOMIC_RELAXED, __HIP_MEMORY_SCOPE_AGENT); }
__device__ __forceinline__ unsigned xb_add(unsigned* p, unsigned v) { return __hip_atomic_fetch_add(p, v, __ATOMIC_RELAXED, __HIP_MEMORY_SCOPE_AGENT); }
__device__ __forceinline__ unsigned xb_xcc_id() { return (unsigned)__builtin_amdgcn_s_getreg((3 << 11) | 20) & 0xFu; }
#define XB_SPIN(cond, bar) do { unsigned _sp = 0; while (cond) { __builtin_amdgcn_s_sleep(1); \
    if ((++_sp & 255u) == 0u) { if (xb_ld(&(bar)[XB_TMO])) break; if (_sp > XB_SPIN_CAP) { atomicAdd(&(bar)[XB_TMO], 1u); break; } } } } while (0)
struct XcdBarrier { unsigned* bar; unsigned x; volatile LAS unsigned* st; };
__device__ __forceinline__ XcdBarrier xcd_barrier_post(unsigned* bar, volatile LAS unsigned* st) {
  XcdBarrier b; b.bar = bar; b.x = xb_xcc_id(); b.st = st;
  if (threadIdx.x == 0) (void)xb_add(&bar[XB_XCNT(b.x)], 1u);
  return b;
}
__device__ __forceinline__ void xcd_barrier_complete(unsigned* bar, unsigned x, unsigned& nloc, unsigned& nx) {
  const unsigned G = gridDim.x * gridDim.y * gridDim.z;
  unsigned sum, cnt, mine, sp = 0u;
  for (;;) {
    sum = 0u; cnt = 0u; mine = 0u;
#pragma unroll
    for (unsigned j = 0; j < 16; ++j) { const unsigned c = xb_ld(&bar[XB_XCNT(j)]); sum += c; cnt += (c > 0u) ? 1u : 0u; mine = (j == x) ? c : mine; }
    if (sum == G) break;
    __builtin_amdgcn_s_sleep(1);
    if ((++sp & 255u) == 0u) { if (xb_ld(&bar[XB_TMO])) break; if (sp > XB_SPIN_CAP) { atomicAdd(&bar[XB_TMO], 1u); break; } }
  }
  nloc = mine > 0u ? mine : 1u; nx = cnt > 0u ? cnt : 1u;
}
__device__ __forceinline__ void xcd_barrier(const XcdBarrier& b) {
  asm volatile("s_waitcnt vmcnt(0)" ::: "memory");
  __syncthreads();
  if (threadIdx.x == 0) {
    unsigned* bar = b.bar;
    __builtin_amdgcn_s_waitcnt(0);
    unsigned nloc = b.st[0], nx = b.st[1];
    if (nloc == 0u) { xcd_barrier_complete(bar, b.x, nloc, nx); b.st[0] = nloc; b.st[1] = nx; }
    const unsigned old = xb_add(&bar[XB_XSUB(b.x)], 1u);
    const unsigned gen = old / nloc;
    if (old + 1u == (gen + 1u) * nloc) {
      __builtin_amdgcn_fence(__ATOMIC_RELEASE, "agent");
      asm volatile("s_waitcnt vmcnt(0)" ::: "memory");
      const unsigned og = xb_add(&bar[XB_TOP], 1u);
      const unsigned tg = og / nx;
      if (og + 1u == (tg + 1u) * nx) xb_add(&bar[XB_TOPGEN], 1u);
      else XB_SPIN(xb_ld(&bar[XB_TOPGEN]) == tg, bar);
      __builtin_amdgcn_fence(__ATOMIC_ACQUIRE, "agent");
      xb_add(&bar[XB_XGEN(b.x)], 1u);
      asm volatile("s_waitcnt vmcnt(0)" ::: "memory");
    } else {
      XB_SPIN(xb_ld(&bar[XB_XGEN(b.x)]) == gen, bar);
      __builtin_amdgcn_fence(__ATOMIC_ACQUIRE, "agent");
      asm volatile("s_waitcnt vmcnt(0)" ::: "memory");
    }
  }
  __syncthreads();
}

#define N_PHASES 19
__global__ void __launch_bounds__(256, 2) mk(Params p, int ph_begin, int ph_end) {
  __shared__ __attribute__((aligned(16))) char smem[SMEM_BYTES];
  __shared__ uint4 xb_words;
  const bool multi = (ph_end - ph_begin) > 1;
  if (threadIdx.x == 0) xb_words = make_uint4(0u, 0u, 0u, 0u);
  __syncthreads();
  XcdBarrier xb;
  xb.bar = (unsigned*)(p.ws + OFF_BAR); xb.x = 0; xb.st = (volatile LAS unsigned*)&xb_words;
  if (multi) xb = xcd_barrier_post((unsigned*)(p.ws + OFF_BAR), (volatile LAS unsigned*)&xb_words);
  if (ph_begin < 0) cg::this_grid().sync();
  bf16_t* WT = (bf16_t*)(p.ws + OFF_WT);
  bf16_t* BIG = (bf16_t*)(p.ws + OFF_BIG);
  bf16_t* Abuf = (bf16_t*)(p.ws + OFF_YF);
  float* MOD = (float*)(p.ws + OFF_MOD);
#define RUN(PH, CALL) if (ph_begin <= PH && PH < ph_end) { CALL; if (PH + 1 < ph_end) xcd_barrier(xb); }
  RUN(0, prep_phase(p, smem))
  RUN(1, norm_mod_phase(p, 0, 0, true))
  RUN(2, gemm_phase(Abuf, WT + WT_SCIN, NT, 3072, 1024, EpiBf16{BIG, 3072}, smem))
  RUN(3, conv_gate_phase(p))
  RUN(4, gemm_phase((const bf16_t*)(p.ws + OFF_BIG + 120 * MIB), WT + WT_SCOUT, NT, 1024, 1024,
                    EpiRes{p.x_prompt, p.x_sample, p.out, MOD + 0 * 5 * 6144 + 2 * 1024}, smem))
  RUN(5, norm_mod_phase(p, 0, 1, false))
  RUN(6, gemm_phase(Abuf, WT + WT_WQ, NT, 2048, 1024, EpiBf16{BIG, 2048}, smem))
  RUN(7, topk_phase(p, 0, smem))
  RUN(8, peer_phase(p, 0, smem))
  RUN(10, gemm_phase(Abuf, WT + WT_SSDIN, NT, 6208, 1024, EpiSsdIn{BIG, (float*)(p.ws + OFF_DT), p.ssd_dt_bias}, smem))
  RUN(11, ssd_conv_phase(p))
  RUN(12, scan_phase(p, smem))
  RUN(13, gate_norm_phase(p))
  RUN(14, gemm_phase(Abuf, WT + WT_SSDOUT, NT, 1024, 2048,
                     EpiRes{p.out, p.out + (size_t)NCTX * 1024, p.out, MOD + 1 * 5 * 6144 + 2 * 1024}, smem))
  RUN(15, norm_mod_phase(p, 1, 1, false))
  RUN(16, gemm_phase(Abuf, WT + WT_WQ + (size_t)2048 * 1024, NT, 2048, 1024, EpiBf16{BIG, 2048}, smem))
  RUN(17, topk_phase(p, 1, smem))
  RUN(18, peer_phase(p, 1, smem))
}

extern "C" void kernel_launch(void* const* d_in, const int* in_sizes, int n_in, void* d_out, int out_size, void* d_ws, size_t ws_size,
                              hipStream_t stream) {
  static int grid_blocks = 0;
  if (!grid_blocks) {
    int dev = 0, cus = 0, per_cu = 0;
    hipGetDevice(&dev);
    hipDeviceGetAttribute(&cus, hipDeviceAttributeMultiprocessorCount, dev);
    hipOccupancyMaxActiveBlocksPerMultiprocessor(&per_cu, mk, 256, 0);
    if (per_cu < 1) per_cu = 1;
    if (per_cu > 2) per_cu = 2;
    grid_blocks = cus * per_cu;
  }
  if (ws_size < WS_NEEDED) { fprintf(stderr, "workspace too small: %zu\n", ws_size); return; }
  Params p{};
  const float** pf = (const float**)&p;
  for (int i = 0; i < 25; ++i) pf[i] = (const float*)d_in[i];
  p.out = (float*)d_out;
  p.ws = (char*)d_ws;
#if COOP
  hipMemsetAsync((char*)d_ws + OFF_BAR, 0, 16384, stream);
  int b = 0, e = N_PHASES;
  void* args[] = {&p, &b, &e};
  hipError_t err = hipLaunchCooperativeKernel((void*)mk, dim3(grid_blocks), dim3(256), args, 0, stream);
  if (err != hipSuccess) fprintf(stderr, "cooperative launch failed: %s (grid %d)\n", hipGetErrorString(err), grid_blocks);
#else
  for (int ph = 0; ph < N_PHASES; ++ph) {
    hipLaunchKernelGGL(mk, dim3(grid_blocks), dim3(256), 0, stream, p, ph, ph + 1);
    if ((DUP_MASK >> ph) & 1) hipLaunchKernelGGL(mk, dim3(grid_blocks), dim3(256), 0, stream, p, ph, ph + 1);
  }
#endif
}
```

```cpp
#include <hip/hip_runtime.h>
#include <hip/hip_cooperative_groups.h>
#include <cstdio>
namespace cg = cooperative_groups;

#ifndef COOP
#define COOP 1
#endif
#ifndef DUP_MASK
#define DUP_MASK 0
#endif

typedef unsigned short bf16_t;
typedef __attribute__((ext_vector_type(8))) short bf16x8;
typedef __attribute__((ext_vector_type(16))) float f32x16;
typedef __attribute__((ext_vector_type(32))) float f32x32;
typedef __attribute__((ext_vector_type(6))) unsigned u32x6;

#define NT 20480
#define NCTX 4096
#define DM 1024
#define MIB ((size_t)1 << 20)
#define OFF_BIG   ((size_t)0)
#define OFF_YF    (240 * MIB)
#define OFF_YB    (320 * MIB)
#define OFF_WT    (400 * MIB)
#define OFF_KEYSB (433 * MIB)
#define OFF_DT    (434 * MIB)
#define OFF_MOD   (439 * MIB)
#define OFF_IDX   (440 * MIB)
#define OFF_GATE  (450 * MIB)
#define OFF_TAB1  (460 * MIB)
#define OFF_SCALE (492 * MIB)
#define OFF_BAR   (493 * MIB)
#define WS_NEEDED (494 * MIB)
#define WT_SCIN   ((size_t)0)
#define WT_SCOUT  (WT_SCIN + (size_t)3072 * 1024)
#define WT_SSDIN  (WT_SCOUT + (size_t)1024 * 1024)
#define WT_SSDOUT (WT_SSDIN + (size_t)6272 * 1024)
#define WT_WQ     (WT_SSDOUT + (size_t)1024 * 2048)

#define SMEM_BYTES 75776

struct Params {
  const float *x_prompt, *x_sample, *state_ssm, *c, *c_ctx, *norm_mix_g, *norm_ffn_g, *norm_f_g, *ada_w, *ada_b;
  const float *sc_w_in, *sc_conv_w, *sc_w_out, *ssd_w_in, *ssd_conv_w, *ssd_conv_b, *ssd_dt_bias, *ssd_a_log, *ssd_d;
  const float *ssd_norm_g, *ssd_w_out, *peer_wq, *peer_keys, *peer_u, *peer_v;
  float* out;
  char* ws;
};

__device__ __forceinline__ float bf2f(bf16_t h) { return __uint_as_float(((unsigned)h) << 16); }
__device__ __forceinline__ bf16_t f2bf(float f) {
  unsigned u = __float_as_uint(f);
  u += 0x7FFFu + ((u >> 16) & 1u);
  return (bf16_t)(u >> 16);
}
__device__ __forceinline__ unsigned pack2(float a, float b) { return (unsigned)f2bf(a) | ((unsigned)f2bf(b) << 16); }
__device__ __forceinline__ float lo2f(unsigned u) { return __uint_as_float(u << 16); }
__device__ __forceinline__ float hi2f(unsigned u) { return __uint_as_float(u & 0xffff0000u); }
__device__ __forceinline__ unsigned u4get(const uint4 v, const int q) { return q == 0 ? v.x : (q == 1 ? v.y : (q == 2 ? v.z : v.w)); }
__device__ __forceinline__ int opaque_tid() { int t = threadIdx.x; asm volatile("" : "+v"(t)); return t; }
__device__ __forceinline__ size_t tiled(int row, int col, int KT) { return ((size_t)(row >> 7) * KT + (col >> 6)) * 8192 + (row & 127) * 64 + (col & 63); }
__device__ __forceinline__ float siluf(float x) { return x / (1.f + __expf(-x)); }
__device__ __forceinline__ int cidx(int tok) { return tok < NCTX ? 0 : 1 + ((tok - NCTX) >> 12); }

template <int CTRL>
__device__ __forceinline__ unsigned dpp_u(unsigned v) {
  return (unsigned)__builtin_amdgcn_update_dpp(0, (int)v, CTRL, 0xF, 0xF, true);
}
template <int CTRL>
__device__ __forceinline__ float dpp_f(float v) {
  return __int_as_float(__builtin_amdgcn_update_dpp(0, __float_as_int(v), CTRL, 0xF, 0xF, true));
}
__device__ __forceinline__ float row16_sum(float v) {
  v += dpp_f<0xB1>(v);
  v += dpp_f<0x4E>(v);
  v += dpp_f<0x141>(v);
  v += dpp_f<0x140>(v);
  return v;
}
__device__ __forceinline__ unsigned umax_(unsigned a, unsigned b) { return a > b ? a : b; }
__device__ __forceinline__ unsigned row_max_u32(unsigned v) {
  v = umax_(v, dpp_u<0xB1>(v));
  v = umax_(v, dpp_u<0x4E>(v));
  v = umax_(v, dpp_u<0x141>(v));
  v = umax_(v, dpp_u<0x140>(v));
  return v;
}
__device__ __forceinline__ unsigned wave_max_u32(unsigned v) {
  v = umax_(v, dpp_u<0xB1>(v));
  v = umax_(v, dpp_u<0x4E>(v));
  v = umax_(v, dpp_u<0x141>(v));
  v = umax_(v, dpp_u<0x140>(v));
  unsigned a = (unsigned)__builtin_amdgcn_readlane((int)v, 0);
  unsigned b = (unsigned)__builtin_amdgcn_readlane((int)v, 16);
  unsigned c = (unsigned)__builtin_amdgcn_readlane((int)v, 32);
  unsigned d = (unsigned)__builtin_amdgcn_readlane((int)v, 48);
  return umax_(umax_(a, b), umax_(c, d));
}
__device__ __forceinline__ float wave_sum(float v) {
  v = row16_sum(v);
  float a, b, c, d;
  a = __int_as_float(__builtin_amdgcn_readlane(__float_as_int(v), 0));
  b = __int_as_float(__builtin_amdgcn_readlane(__float_as_int(v), 16));
  c = __int_as_float(__builtin_amdgcn_readlane(__float_as_int(v), 32));
  d = __int_as_float(__builtin_amdgcn_readlane(__float_as_int(v), 48));
  return (a + b) + (c + d);
}
__device__ __forceinline__ unsigned fkey(float f) {
  unsigned u = __float_as_uint(f);
  return (u & 0x80000000u) ? ~u : (u | 0x80000000u);
}
__device__ __forceinline__ float keyf(unsigned k) {
  unsigned u = (k & 0x80000000u) ? (k & 0x7fffffffu) : ~k;
  return __uint_as_float(u);
}

__device__ __forceinline__ void transpose_tile(const float* __restrict__ src, int K, int N, bf16_t* __restrict__ dst, int tile, float* tb) {
  const int tid = threadIdx.x;
  const int ntn = N >> 6;
  const int kt = tile / ntn, nt = tile % ntn;
  {
    const int n = tid & 63, kb = tid >> 6;
#pragma unroll
    for (int i = 0; i < 16; ++i) {
      int k = kb + 4 * i;
      tb[k * 65 + n] = src[(size_t)(kt * 64 + k) * N + nt * 64 + n];
    }
  }
  __syncthreads();
  {
    const int k8 = (tid & 7) * 8;
#pragma unroll
    for (int pass = 0; pass < 2; ++pass) {
      int n = (tid >> 3) + 32 * pass;
      uint4 o;
      o.x = pack2(tb[(k8 + 0) * 65 + n], tb[(k8 + 1) * 65 + n]);
      o.y = pack2(tb[(k8 + 2) * 65 + n], tb[(k8 + 3) * 65 + n]);
      o.z = pack2(tb[(k8 + 4) * 65 + n], tb[(k8 + 5) * 65 + n]);
      o.w = pack2(tb[(k8 + 6) * 65 + n], tb[(k8 + 7) * 65 + n]);
      *(uint4*)(dst + tiled(nt * 64 + n, kt * 64 + k8, K >> 6)) = o;
    }
  }
  __syncthreads();
}

__device__ __forceinline__ void prep_phase(const Params& p, char* smem) {
  const int otid = opaque_tid();
  const int tid = otid;
  bf16_t* WT = (bf16_t*)(p.ws + OFF_WT);
  float* MOD = (float*)(p.ws + OFF_MOD);
  bf16_t* KEYSB = (bf16_t*)(p.ws + OFF_KEYSB);
  const int U_MOD = 192, U_T0 = 768, U_T1 = 256, U_T2 = 1552, U_T3 = 512, U_T4 = 1024, U_KEYS = 256, U_TAB = 8192;
  const int total = U_MOD + U_T0 + U_T1 + U_T2 + U_T3 + U_T4 + U_KEYS + U_TAB;
  for (int u = blockIdx.x; u < total; u += gridDim.x) {
    int v = u;
    if (v < U_MOD) {
      float* scond = (float*)smem;
      float* red = scond + 5 * 1024;
      for (int i = tid; i < 5 * 1024; i += 256) {
        int r = i >> 10, k = i & 1023;
        float cv = (r == 0) ? p.c_ctx[k] : p.c[(r - 1) * 1024 + k];
        scond[i] = siluf(cv);
      }
      __syncthreads();
      const int l = v / 96, jc = v % 96;
      const int jj = tid & 63, kq = tid >> 6;
      const int j = jc * 64 + jj;
      float acc[5] = {0.f, 0.f, 0.f, 0.f, 0.f};
      const float* wp = p.ada_w + ((size_t)l * 1024 + kq * 256) * 6144 + j;
#pragma unroll 1
      for (int k0 = 0; k0 < 256; k0 += 32) {
        float wv[32];
#pragma unroll
        for (int k = 0; k < 32; ++k) wv[k] = wp[(size_t)(k0 + k) * 6144];
#pragma unroll
        for (int k = 0; k < 32; ++k)
#pragma unroll
          for (int r = 0; r < 5; ++r) acc[r] += scond[r * 1024 + kq * 256 + k0 + k] * wv[k];
      }
#pragma unroll
      for (int r = 0; r < 5; ++r) red[(kq * 5 + r) * 64 + jj] = acc[r];
      __syncthreads();
      for (int i = tid; i < 320; i += 256) {
        int r = i >> 6, j2 = i & 63;
        float s = red[(0 * 5 + r) * 64 + j2] + red[(1 * 5 + r) * 64 + j2] + red[(2 * 5 + r) * 64 + j2] + red[(3 * 5 + r) * 64 + j2];
        MOD[(size_t)(l * 5 + r) * 6144 + jc * 64 + j2] = s + p.ada_b[l * 6144 + jc * 64 + j2];
      }
      __syncthreads();
      continue;
    }
    v -= U_MOD;
    float* tb = (float*)smem;
    if (v < U_T0) { transpose_tile(p.sc_w_in, 1024, 3072, WT + WT_SCIN, v, tb); continue; }
    v -= U_T0;
    if (v < U_T1) { transpose_tile(p.sc_w_out, 1024, 1024, WT + WT_SCOUT, v, tb); continue; }
    v -= U_T1;
    if (v < U_T2) { transpose_tile(p.ssd_w_in, 1024, 6208, WT + WT_SSDIN, v, tb); continue; }
    v -= U_T2;
    if (v < U_T3) { transpose_tile(p.ssd_w_out, 2048, 1024, WT + WT_SSDOUT, v, tb); continue; }
    v -= U_T3;
    if (v < U_T4) {
      int l = v >> 9, t = v & 511;
      transpose_tile(p.peer_wq + (size_t)l * 1024 * 2048, 1024, 2048, WT + WT_WQ + (size_t)l * 2048 * 1024, t, tb);
      continue;
    }
    v -= U_T4;
    if (v < U_KEYS) {
      size_t base = (size_t)v * 2048 + tid * 8;
      float4 a = *(const float4*)(p.peer_keys + base);
      float4 b = *(const float4*)(p.peer_keys + base + 4);
      uint4 o;
      o.x = pack2(a.x, a.y); o.y = pack2(a.z, a.w); o.z = pack2(b.x, b.y); o.w = pack2(b.z, b.w);
      *(uint4*)(KEYSB + base) = o;
      continue;
    }
    v -= U_KEYS;
    {
      const int lane = tid & 63, l31 = lane & 31;
      const int gr = v * 8 + (tid >> 6) * 2 + (lane >> 5);
      const int l = gr >> 15, tab = (gr >> 14) & 1, row = gr & 16383;
      const float* src = (tab ? p.peer_v : p.peer_u) + ((size_t)l * 16384 + row) * 1024 + l31 * 32;
      float4 x[8];
      float am = 0.f;
#pragma unroll
      for (int j = 0; j < 8; ++j) {
        x[j] = *(const float4*)(src + 4 * j);
        am = fmaxf(am, fmaxf(fmaxf(fabsf(x[j].x), fabsf(x[j].y)), fmaxf(fabsf(x[j].z), fabsf(x[j].w))));
      }
      {
        unsigned au = row_max_u32(__float_as_uint(am));
        const unsigned ao = (unsigned)__shfl_xor((int)au, 16);
        am = __uint_as_float(umax_(au, ao));
      }
      const float inv = am > 0.f ? 7.0f / am : 0.f;
      const float scale = am > 0.f ? am / 7.0f : 0.f;
      f32x16 fa, fb;
#pragma unroll
      for (int j = 0; j < 8; ++j) {
        fa[2 * j] = x[j].x * inv; fb[2 * j] = x[j].y * inv; fa[2 * j + 1] = x[j].z * inv; fb[2 * j + 1] = x[j].w * inv;
      }
      const u32x6 pk = __builtin_amdgcn_cvt_scalef32_2xpk16_fp6_f32(fa, fb, 1.0f);
      unsigned char* dst = (unsigned char*)(p.ws + (l ? OFF_TAB1 : OFF_YB)) + ((size_t)tab * 16384 + row) * 768 + l31 * 24;
      *(uint2*)(dst) = make_uint2(pk[0], pk[1]);
      *(uint2*)(dst + 8) = make_uint2(pk[2], pk[3]);
      *(uint2*)(dst + 16) = make_uint2(pk[4], pk[5]);
      if (l31 == 0) ((float*)(p.ws + OFF_SCALE))[gr] = scale;
    }
  }
}

__device__ __forceinline__ void norm_mod_phase(const Params& p, int layer, int which, bool from_input) {
  const int otid = opaque_tid();
  const float* g = (which == 0 ? p.norm_mix_g : p.norm_ffn_g) + layer * 1024;
  const float* MOD = (const float*)(p.ws + OFF_MOD);
  bf16_t* A = (bf16_t*)(p.ws + OFF_YF);
  const int lane = otid & 63, w = otid >> 6;
  for (int tok = blockIdx.x * 4 + w; tok < NT; tok += gridDim.x * 4) {
    const float* xr = from_input ? (tok < NCTX ? p.x_prompt + (size_t)tok * 1024 : p.x_sample + (size_t)(tok - NCTX) * 1024)
                                 : p.out + (size_t)tok * 1024;
    const float* md = MOD + (size_t)(layer * 5 + cidx(tok)) * 6144 + (which ? 3 * 1024 : 0);
    float4 v[4];
    float ss = 0.f;
#pragma unroll
    for (int i = 0; i < 4; ++i) {
      v[i] = *(const float4*)(xr + lane * 4 + 256 * i);
      ss += v[i].x * v[i].x + v[i].y * v[i].y + v[i].z * v[i].z + v[i].w * v[i].w;
    }
    ss = wave_sum(ss);
    const float sc = rsqrtf(ss * (1.f / 1024.f) + 1e-6f);
#pragma unroll
    for (int i = 0; i < 4; ++i) {
      const int col = lane * 4 + 256 * i;
      float4 gg = *(const float4*)(g + col);
      float4 sh = *(const float4*)(md + col);
      float4 sl = *(const float4*)(md + 1024 + col);
      float o0 = v[i].x * sc * gg.x * (1.f + sl.x) + sh.x;
      float o1 = v[i].y * sc * gg.y * (1.f + sl.y) + sh.y;
      float o2 = v[i].z * sc * gg.z * (1.f + sl.z) + sh.z;
      float o3 = v[i].w * sc * gg.w * (1.f + sl.w) + sh.w;
      uint2 o;
      o.x = pack2(o0, o1);
      o.y = pack2(o2, o3);
      *(uint2*)(A + tiled(tok, col, 16)) = o;
    }
  }
}

#define LSTR 72
template <class Epi>
__device__ __forceinline__ void gemm_phase(const bf16_t* __restrict__ A, const bf16_t* __restrict__ Bt, int M, int N, int K, Epi epi, char* smem) {
  const int otid = opaque_tid();
  bf16_t* sA = (bf16_t*)smem;
  bf16_t* sB = sA + 2 * 128 * LSTR;
  float* sC = (float*)smem;
  const int tid = otid, lane = tid & 63, w = tid >> 6;
  const int wm = w >> 1, wn = w & 1;
  const int ntn = (N + 127) >> 7, ntm = M >> 7;
  const int ntiles = ntm * ntn;
  const int KT = K >> 6;
  const int lrow = tid >> 3, lkc = (tid & 7) * 8;
  const bf16_t* apb;
  const bf16_t* bpb;
  uint4 ra0_0, ra0_1, ra0_2, ra0_3, rb0_0, rb0_1, rb0_2, rb0_3, ra1_0, ra1_1, ra1_2, ra1_3, rb1_0, rb1_1, rb1_2, rb1_3;
  const int G_ = gridDim.x;
  const int RN = (ntn % 8 == 0) ? 8 : ((ntn % 7 == 0) ? 7 : ((ntn % 6 == 0) ? 6 : ((ntn % 5 == 0) ? 5 : 4)));
  const int RM = ((G_ >> 3) / RN) > 0 ? ((G_ >> 3) / RN) : 1;
  const int nrn = (ntn + RN - 1) / RN, nrm = (ntm + RM - 1) / RM;
  const int nrects = nrn * nrm;
  const int nslots = ((nrects + 7) >> 3) * G_;
#define G_MAP(T_, VALID_, MT_, NT_) { const int i_ = (T_) / G_, b_ = (T_) - i_ * G_; const int R_ = i_ * 8 + (b_ & 7); const int s_ = b_ >> 3; \
    const int rm_ = R_ / nrn, rn_ = R_ - rm_ * nrn; const int dm_ = s_ / RN, dn_ = s_ - dm_ * RN; MT_ = rm_ * RM + dm_; NT_ = rn_ * RN + dn_; \
    VALID_ = (dm_ < RM) && (R_ < nrects) && (MT_ < ntm) && (NT_ < ntn); }
#define G_NEXT(T_, MT_, NT_) { bool ok_ = false; while ((T_) < nslots) { G_MAP(T_, ok_, MT_, NT_) if (ok_) break; (T_) += G_; } }
#define G_PTRS(MT_, NT_) { apb = A + (size_t)(MT_) * KT * 8192 + lrow * 64 + lkc; bpb = Bt + (size_t)(NT_) * KT * 8192 + lrow * 64 + lkc; }
#define G_LOAD1(S, I, KT_) { ra##S##_##I = *(const uint4*)(apb + (KT_) * 8192 + I * 2048); rb##S##_##I = *(const uint4*)(bpb + (KT_) * 8192 + I * 2048); }
#define G_LOAD(S, KT_) { G_LOAD1(S, 0, KT_) G_LOAD1(S, 1, KT_) G_LOAD1(S, 2, KT_) G_LOAD1(S, 3, KT_) }
#define G_WRITE1(S, I, BUF_) { *(uint4*)(sA + (BUF_) * 128 * LSTR + (lrow + 32 * I) * LSTR + lkc) = ra##S##_##I; *(uint4*)(sB + (BUF_) * 128 * LSTR + (lrow + 32 * I) * LSTR + lkc) = rb##S##_##I; }
#define G_WRITE(S, BUF_) { G_WRITE1(S, 0, BUF_) G_WRITE1(S, 1, BUF_) G_WRITE1(S, 2, BUF_) G_WRITE1(S, 3, BUF_) }
#define G_FRAG(KK, A0, A1, B0, B1) { A0 = *(const bf16x8*)(cA + KK * 16); A1 = *(const bf16x8*)(cA + 32 * LSTR + KK * 16); \
        B0 = *(const bf16x8*)(cB + KK * 16); B1 = *(const bf16x8*)(cB + 32 * LSTR + KK * 16); }
#define G_MMA4(A0, A1, B0, B1) { \
        acc[0][0] = __builtin_amdgcn_mfma_f32_32x32x16_bf16(A0, B0, acc[0][0], 0, 0, 0); \
        acc[0][1] = __builtin_amdgcn_mfma_f32_32x32x16_bf16(A0, B1, acc[0][1], 0, 0, 0); \
        acc[1][0] = __builtin_amdgcn_mfma_f32_32x32x16_bf16(A1, B0, acc[1][0], 0, 0, 0); \
        acc[1][1] = __builtin_amdgcn_mfma_f32_32x32x16_bf16(A1, B1, acc[1][1], 0, 0, 0); }
#define G_COMPUTE(BUF_, PART) { \
      const bf16_t* cA = sA + (BUF_) * 128 * LSTR + (wm * 64 + (lane & 31)) * LSTR + (lane >> 5) * 8; \
      const bf16_t* cB = sB + (BUF_) * 128 * LSTR + (wn * 64 + (lane & 31)) * LSTR + (lane >> 5) * 8; \
      bf16x8 xa0, xa1, xb0, xb1, ya0, ya1, yb0, yb1; \
      G_FRAG(0, xa0, xa1, xb0, xb1) \
      G_FRAG(1, ya0, ya1, yb0, yb1) \
      __builtin_amdgcn_s_setprio(1); \
      G_MMA4(xa0, xa1, xb0, xb1) \
      PART(0) \
      __builtin_amdgcn_sched_barrier(0); \
      G_FRAG(2, xa0, xa1, xb0, xb1) \
      G_MMA4(ya0, ya1, yb0, yb1) \
      PART(1) \
      __builtin_amdgcn_sched_barrier(0); \
      G_FRAG(3, ya0, ya1, yb0, yb1) \
      G_MMA4(xa0, xa1, xb0, xb1) \
      PART(2) \
      __builtin_amdgcn_sched_barrier(0); \
      G_MMA4(ya0, ya1, yb0, yb1) \
      PART(3) \
      __builtin_amdgcn_s_setprio(0); }
#define G_PA(I) { G_WRITE1(1, I, 1) if (kt + 3 < KT) G_LOAD1(1, I, kt + 3) }
#define G_PB(I) { if (kt + 2 < KT) G_WRITE1(0, I, 0) if (kt + 4 < KT) G_LOAD1(0, I, kt + 4) }
  int tile = blockIdx.x, mt = 0, nt = 0;
  G_NEXT(tile, mt, nt)
  if (tile < nslots) { G_PTRS(mt, nt) G_LOAD(0, 0) G_LOAD(1, 1) }
  while (tile < nslots) {
    const int m0 = mt << 7, n0 = nt << 7;
    f32x16 acc[2][2];
#pragma unroll
    for (int i = 0; i < 2; ++i)
#pragma unroll
      for (int j = 0; j < 2; ++j)
#pragma unroll
        for (int r = 0; r < 16; ++r) acc[i][j][r] = 0.f;
    G_WRITE(0, 0)
    G_LOAD(0, 2)
    __syncthreads();
    for (int kt = 0; kt < KT; kt += 2) {
      G_COMPUTE(0, G_PA)
      __syncthreads();
      G_COMPUTE(1, G_PB)
      __syncthreads();
    }
    int next = tile + G_;
    G_NEXT(next, mt, nt)
    if (next < nslots) { G_PTRS(mt, nt) G_LOAD(0, 0) G_LOAD(1, 1) }
#pragma unroll
    for (int mi = 0; mi < 2; ++mi)
#pragma unroll
      for (int ni = 0; ni < 2; ++ni) {
        float* cw = sC + (wm * 64 + mi * 32 + 4 * (lane >> 5)) * 132 + wn * 64 + ni * 32 + (lane & 31);
#pragma unroll
        for (int r = 0; r < 16; ++r) cw[((r & 3) + 8 * (r >> 2)) * 132] = acc[mi][ni][r];
      }
    __syncthreads();
#pragma unroll 4
    for (int i = 0; i < 16; ++i) {
      const int ch = tid + 256 * i;
      const int row = ch >> 5, c4 = (ch & 31) * 4;
      const float4 v = *(const float4*)(sC + row * 132 + c4);
      if (n0 + c4 < N) epi(m0 + row, n0 + c4, v);
    }
    __syncthreads();
    tile = next;
  }
}

struct EpiBf16 {
  bf16_t* C; int ldc;
  __device__ __forceinline__ void operator()(int m, int n, float4 v) const {
    uint2 o; o.x = pack2(v.x, v.y); o.y = pack2(v.z, v.w);
    *(uint2*)(C + (size_t)m * ldc + n) = o;
  }
};
__device__ __forceinline__ float softplusf(float x) { return x > 20.f ? x : log1pf(expf(x)); }
struct EpiSsdIn {
  bf16_t* C; float* DT; const float* dt_bias;
  __device__ __forceinline__ void operator()(int m, int n, float4 v) const {
    if (n < 6144) {
      uint2 o; o.x = pack2(v.x, v.y); o.y = pack2(v.z, v.w);
      *(uint2*)(C + (size_t)m * 6144 + n) = o;
    } else {
      const int c = n - 6144;
      const float4 bb = *(const float4*)(dt_bias + c);
      *(float4*)(DT + (size_t)m * 64 + c) = make_float4(softplusf(v.x + bb.x), softplusf(v.y + bb.y), softplusf(v.z + bb.z), softplusf(v.w + bb.w));
    }
  }
};
struct EpiRes {
  const float* xin_ctx; const float* xin_lat; float* X; const float* gate;
  __device__ __forceinline__ void operator()(int m, int n, float4 v) const {
    const float* xr = m < NCTX ? xin_ctx + (size_t)m * 1024 : xin_lat + (size_t)(m - NCTX) * 1024;
    const float4 xv = *(const float4*)(xr + n);
    const float4 gt = *(const float4*)(gate + (size_t)cidx(m) * 6144 + n);
    *(float4*)(X + (size_t)m * 1024 + n) = make_float4(xv.x + gt.x * v.x, xv.y + gt.y * v.y, xv.z + gt.z * v.z, xv.w + gt.w * v.w);
  }
};

__device__ __forceinline__ void conv_gate_phase(const Params& p) {
  const int otid = opaque_tid();
  const bf16_t* P = (const bf16_t*)(p.ws + OFF_BIG);
  bf16_t* G = (bf16_t*)(p.ws + OFF_BIG + 120 * MIB);
  const float* cw = p.sc_conv_w;
  const int total = NT * 128;
  for (int it = blockIdx.x * 256 + otid; it < total; it += gridDim.x * 256) {
    const int tok = it >> 7, c = (it & 127) * 8;
    const int rowlen = tok < NCTX ? 256 : 64;
    const int pos = tok & (rowlen - 1);
    const bf16_t* pr = P + (size_t)tok * 3072;
    uint4 bg = *(const uint4*)(pr + c);
    uint4 cg = *(const uint4*)(pr + 1024 + c);
    uint4 xv = *(const uint4*)(pr + 2048 + c);
    uint4 cgl = make_uint4(0, 0, 0, 0), xvl = cgl, cgr = cgl, xvr = cgl;
    if (pos > 0) { cgl = *(const uint4*)(pr - 3072 + 1024 + c); xvl = *(const uint4*)(pr - 3072 + 2048 + c); }
    if (pos < rowlen - 1) { cgr = *(const uint4*)(pr + 3072 + 1024 + c); xvr = *(const uint4*)(pr + 3072 + 2048 + c); }
    const unsigned* bgp = (const unsigned*)&bg; const unsigned* cgp = (const unsigned*)&cg; const unsigned* xvp = (const unsigned*)&xv;
    const unsigned* cglp = (const unsigned*)&cgl; const unsigned* xvlp = (const unsigned*)&xvl;
    const unsigned* cgrp = (const unsigned*)&cgr; const unsigned* xvrp = (const unsigned*)&xvr;
    float4 w0a = *(const float4*)(cw + c), w0b = *(const float4*)(cw + c + 4);
    float4 w1a = *(const float4*)(cw + 1024 + c), w1b = *(const float4*)(cw + 1024 + c + 4);
    float4 w2a = *(const float4*)(cw + 2048 + c), w2b = *(const float4*)(cw + 2048 + c + 4);
    const float w0[8] = {w0a.x, w0a.y, w0a.z, w0a.w, w0b.x, w0b.y, w0b.z, w0b.w};
    const float w1[8] = {w1a.x, w1a.y, w1a.z, w1a.w, w1b.x, w1b.y, w1b.z, w1b.w};
    const float w2[8] = {w2a.x, w2a.y, w2a.z, w2a.w, w2b.x, w2b.y, w2b.z, w2b.w};
    unsigned o[4];
#pragma unroll
    for (int q = 0; q < 4; ++q) {
      float r0 = lo2f(bgp[q]) * (w0[2 * q] * lo2f(cglp[q]) * lo2f(xvlp[q]) + w1[2 * q] * lo2f(cgp[q]) * lo2f(xvp[q]) + w2[2 * q] * lo2f(cgrp[q]) * lo2f(xvrp[q]));
      float r1 = hi2f(bgp[q]) * (w0[2 * q + 1] * hi2f(cglp[q]) * hi2f(xvlp[q]) + w1[2 * q + 1] * hi2f(cgp[q]) * hi2f(xvp[q]) + w2[2 * q + 1] * hi2f(cgrp[q]) * hi2f(xvrp[q]));
      o[q] = pack2(r0, r1);
    }
    *(uint4*)(G + tiled(tok, c, 16)) = make_uint4(o[0], o[1], o[2], o[3]);
  }
}

#define SSTR 272
#define CE2_(K, a, b) { unsigned hi_ = umax_(K[a], K[b]); unsigned lo_ = K[a] < K[b] ? K[a] : K[b]; K[a] = hi_; K[b] = lo_; }
#define SORT8_(K) CE2_(K, 0, 1) CE2_(K, 2, 3) CE2_(K, 4, 5) CE2_(K, 6, 7) CE2_(K, 0, 2) CE2_(K, 1, 3) CE2_(K, 4, 6) CE2_(K, 5, 7) \
  CE2_(K, 1, 2) CE2_(K, 5, 6) CE2_(K, 0, 4) CE2_(K, 1, 5) CE2_(K, 2, 6) CE2_(K, 3, 7) CE2_(K, 2, 4) CE2_(K, 3, 5) CE2_(K, 1, 2) CE2_(K, 3, 4) CE2_(K, 5, 6)
__device__ __forceinline__ void top16_rows(const float* Sr0, const float* Sr1, int j, unsigned (&res)[2][2]) {
  unsigned ka[8], kb[8], kc[8], kd[8];
#pragma unroll
  for (int m = 0; m < 8; ++m) {
    const unsigned tag = (unsigned)(127 - (j + 16 * m));
    ka[m] = (fkey(Sr0[j + 16 * m]) & ~0x7Fu) | tag;
    kb[m] = (fkey(Sr0[128 + j + 16 * m]) & ~0x7Fu) | tag;
    kc[m] = (fkey(Sr1[j + 16 * m]) & ~0x7Fu) | tag;
    kd[m] = (fkey(Sr1[128 + j + 16 * m]) & ~0x7Fu) | tag;
  }
  SORT8_(ka)
  SORT8_(kb)
  SORT8_(kc)
  SORT8_(kd)
  unsigned r0 = 0, r1 = 0, r2 = 0, r3 = 0;
#pragma unroll 2
  for (int it = 0; it < 16; ++it) {
    const unsigned wa = row_max_u32(ka[0]);
    const unsigned wb = row_max_u32(kb[0]);
    const unsigned wc = row_max_u32(kc[0]);
    const unsigned wd = row_max_u32(kd[0]);
    const bool wina = ka[0] == wa, winb = kb[0] == wb, winc = kc[0] == wc, wind = kd[0] == wd;
#pragma unroll
    for (int m = 0; m < 7; ++m) {
      ka[m] = wina ? ka[m + 1] : ka[m]; kb[m] = winb ? kb[m + 1] : kb[m];
      kc[m] = winc ? kc[m + 1] : kc[m]; kd[m] = wind ? kd[m + 1] : kd[m];
    }
    ka[7] = wina ? 0u : ka[7]; kb[7] = winb ? 0u : kb[7]; kc[7] = winc ? 0u : kc[7]; kd[7] = wind ? 0u : kd[7];
    r0 = (j == it) ? wa : r0; r1 = (j == it) ? wb : r1; r2 = (j == it) ? wc : r2; r3 = (j == it) ? wd : r3;
  }
  res[0][0] = r0; res[0][1] = r1; res[1][0] = r2; res[1][1] = r3;
}

__device__ __forceinline__ void topk_phase(const Params& p, int layer, char* smem) {
  const int otid = opaque_tid();
  float* S0 = (float*)smem;
  const bf16_t* Q = (const bf16_t*)(p.ws + OFF_BIG);
  const bf16_t* KB = (const bf16_t*)(p.ws + OFF_KEYSB) + (size_t)layer * (8 * 2 * 128 * 128);
  int* IDX = (int*)(p.ws + OFF_IDX);
  float* GATE = (float*)(p.ws + OFF_GATE);
  const int tid = otid, lane = tid & 63;
  const int w = __builtin_amdgcn_readfirstlane(tid >> 6);
  const int G = gridDim.x;
  const int per = (5120 + G - 1) / G;
  const int start = blockIdx.x * per;
  const int end = (start + per < 5120) ? start + per : 5120;
  const int pp = w >> 1, nt0 = (w & 1) * 2;
  const int j = lane & 15, rowbase = lane & 48;
  int ca[4], cb[4];
  bool cvalid3;
  ca[0] = 0; cb[0] = j;
  if (j < 8) { ca[1] = 1; cb[1] = j; } else { ca[1] = j; cb[1] = 0; }
  if (j < 5) { ca[2] = 2; cb[2] = j; } else if (j < 9) { ca[2] = 3; cb[2] = j - 5; } else if (j < 12) { ca[2] = 4; cb[2] = j - 9; }
  else if (j < 14) { ca[2] = 5; cb[2] = j - 12; } else { ca[2] = 6; cb[2] = j - 14; }
  ca[3] = 7; cb[3] = j & 1; cvalid3 = j < 2;
  int curh = -1;
  bf16x8 kf[2][8];
  bf16x8 qa[8];
  for (int pr = start; pr < end; ++pr) {
    const int h = pr / 640, tile = pr % 640;
    const int t0 = tile * 32;
    float* S = S0 + ((pr - start) & 1) * (32 * SSTR);
    if (h != curh) {
#pragma unroll
      for (int jj = 0; jj < 2; ++jj)
#pragma unroll
        for (int kk = 0; kk < 8; ++kk)
          kf[jj][kk] = *(const bf16x8*)(KB + ((size_t)((h * 2 + pp) * 128 + (nt0 + jj) * 32 + (lane & 31))) * 128 + kk * 16 + (lane >> 5) * 8);
      curh = h;
    }
    f32x16 acc[2];
#pragma unroll
    for (int jj = 0; jj < 2; ++jj)
#pragma unroll
      for (int r = 0; r < 16; ++r) acc[jj][r] = 0.f;
    if (pr == start) {
      const bf16_t* qp = Q + (size_t)(t0 + (lane & 31)) * 2048 + h * 256 + pp * 128 + (lane >> 5) * 8;
#pragma unroll
      for (int kk = 0; kk < 8; ++kk) qa[kk] = *(const bf16x8*)(qp + kk * 16);
    }
#pragma unroll
    for (int kk = 0; kk < 8; ++kk) {
      acc[0] = __builtin_amdgcn_mfma_f32_32x32x16_bf16(qa[kk], kf[0][kk], acc[0], 0, 0, 0);
      acc[1] = __builtin_amdgcn_mfma_f32_32x32x16_bf16(qa[kk], kf[1][kk], acc[1], 0, 0, 0);
    }
    if (pr + 1 < end) {
      const int hn = (pr + 1) / 640, tn = ((pr + 1) % 640) * 32;
      const bf16_t* qn = Q + (size_t)(tn + (lane & 31)) * 2048 + hn * 256 + pp * 128 + (lane >> 5) * 8;
#pragma unroll
      for (int kk = 0; kk < 8; ++kk) qa[kk] = *(const bf16x8*)(qn + kk * 16);
    }
#pragma unroll
    for (int jj = 0; jj < 2; ++jj)
#pragma unroll
      for (int r = 0; r < 16; ++r) {
        const int tl = (r & 3) + 8 * (r >> 2) + 4 * (lane >> 5);
        S[tl * SSTR + pp * 128 + (nt0 + jj) * 32 + (lane & 31)] = acc[jj][r];
      }
    __syncthreads();
    {
      const int tl0 = w * 8 + (lane >> 4), tl1 = tl0 + 4;
      unsigned res[2][2];
      top16_rows(S + tl0 * SSTR, S + tl1 * SSTR, j, res);
      unsigned ck[2][4];
#pragma unroll
      for (int u = 0; u < 2; ++u) {
#pragma unroll
        for (int sl = 0; sl < 4; ++sl) {
          const float v1 = keyf((unsigned)__shfl((int)res[u][0], rowbase + ca[sl]) & ~0x7Fu);
          const float v2 = keyf((unsigned)__shfl((int)res[u][1], rowbase + cb[sl]) & ~0x7Fu);
          ck[u][sl] = (fkey(v1 + v2) & ~0xFFu) | (unsigned)(255 - (ca[sl] * 16 + cb[sl]));
        }
        ck[u][3] = cvalid3 ? ck[u][3] : 0u;
      }
      unsigned resc0 = 0, resc1 = 0;
#pragma unroll 2
      for (int it = 0; it < 16; ++it) {
        const unsigned wm0 = row_max_u32(umax_(umax_(ck[0][0], ck[0][1]), umax_(ck[0][2], ck[0][3])));
        const unsigned wm1 = row_max_u32(umax_(umax_(ck[1][0], ck[1][1]), umax_(ck[1][2], ck[1][3])));
#pragma unroll
        for (int sl = 0; sl < 4; ++sl) { ck[0][sl] = (ck[0][sl] == wm0) ? 0u : ck[0][sl]; ck[1][sl] = (ck[1][sl] == wm1) ? 0u : ck[1][sl]; }
        resc0 = (j == it) ? wm0 : resc0;
        resc1 = (j == it) ? wm1 : resc1;
      }
#pragma unroll
      for (int u = 0; u < 2; ++u) {
        const unsigned resc = u ? resc1 : resc0;
        const int tl = u ? tl1 : tl0;
        const int code = 255 - (int)(resc & 0xFFu);
        const int wa = code >> 4, wb = code & 15;
        const float val = keyf(resc & ~0xFFu);
        const unsigned r1 = (unsigned)__shfl((int)res[u][0], rowbase + wa);
        const unsigned r2 = (unsigned)__shfl((int)res[u][1], rowbase + wb);
        const int i1 = 127 - (int)(r1 & 0x7Fu), i2 = 127 - (int)(r2 & 0x7Fu);
        const float vmax = __shfl(val, rowbase);
        const float e = __expf(val - vmax);
        const float ssum = row16_sum(e);
        const size_t ob = ((size_t)(t0 + tl) * 8 + h) * 16 + j;
        IDX[ob] = i1 * 128 + i2;
        GATE[ob] = e / ssum;
      }
    }
  }
}

typedef __attribute__((ext_vector_type(2))) float f32x2;
__device__ __forceinline__ void peer_phase(const Params& p, int layer, char* smem) {
  const int otid = opaque_tid();
  float* coefs = (float*)smem;
  int* idxs = (int*)(smem + 2048);
  float* sus = (float*)(smem + 4096);
  float* gsv = (float*)(smem + 6144);
  const unsigned char* U6 = (const unsigned char*)(p.ws + (layer ? OFF_TAB1 : OFF_YB));
  const unsigned char* V6 = U6 + (size_t)16384 * 768;
  const float* SCU = (const float*)(p.ws + OFF_SCALE) + (size_t)layer * 32768;
  const float* SCV = SCU + 16384;
  const bf16_t* A = (const bf16_t*)(p.ws + OFF_YF);
  const int* IDX = (const int*)(p.ws + OFF_IDX);
  const float* GATE = (const float*)(p.ws + OFF_GATE);
  const float* MOD = (const float*)(p.ws + OFF_MOD);
  float* X = p.out;
  const int lane = otid & 63;
  const int w = __builtin_amdgcn_readfirstlane(otid >> 6);
  const int sub = lane & 15, rg = lane >> 4;
  const int half = lane >> 5, l31 = lane & 31;
  int pe0 = 0, pe1 = 0; float pg0 = 0.f, pg1 = 0.f;
  {
    const int tok0_ = blockIdx.x * 4 + w;
    if (tok0_ < NT) { pe0 = IDX[(size_t)tok0_ * 128 + lane]; pe1 = IDX[(size_t)tok0_ * 128 + 64 + lane]; pg0 = GATE[(size_t)tok0_ * 128 + lane]; pg1 = GATE[(size_t)tok0_ * 128 + 64 + lane]; }
  }
  for (int tok = blockIdx.x * 4 + w; tok < NT; tok += gridDim.x * 4) {
#pragma unroll
    for (int hh = 0; hh < 2; ++hh) {
      const int kk = lane + 64 * hh;
      const int e = hh ? pe1 : pe0;
      const float gk = hh ? pg1 : pg0;
      idxs[w * 128 + kk] = e;
      sus[w * 128 + kk] = SCU[e];
      gsv[w * 128 + kk] = gk * SCV[e];
    }
    float t[64];
    {
      const uint4* ap = (const uint4*)(A + tiled(tok, 64 * sub, 16));
#pragma unroll
      for (int i = 0; i < 8; ++i) {
        const uint4 r0 = ap[i];
#pragma unroll
        for (int q = 0; q < 4; ++q) { t[8 * i + 2 * q] = lo2f(u4get(r0, q)); t[8 * i + 2 * q + 1] = hi2f(u4get(r0, q)); }
      }
    }
    float chain = 0.f;
#pragma unroll 4
    for (int it = 0; it < 32; ++it) {
      const int k = it * 4 + rg;
      const int e = idxs[w * 128 + k];
      const uint4* row = (const uint4*)(U6 + (size_t)e * 768 + sub * 48);
      const uint4 r0 = row[0], r1 = row[1], r2 = row[2];
      u32x6 g0, g1;
      g0[0] = r0.x; g0[1] = r0.y; g0[2] = r0.z; g0[3] = r0.w; g0[4] = r1.x; g0[5] = r1.y;
      g1[0] = r1.z; g1[1] = r1.w; g1[2] = r2.x; g1[3] = r2.y; g1[4] = r2.z; g1[5] = r2.w;
      float acc0 = 0.f, acc1 = 0.f;
      asm volatile("" : "+v"(g0), "+v"(chain));
      {
        const f32x32 d0 = __builtin_amdgcn_cvt_scalef32_pk32_f32_fp6(g0, 1.0f);
#pragma unroll
        for (int j = 0; j < 32; j += 2) { acc0 += d0[j] * t[j]; acc1 += d0[j + 1] * t[j + 1]; }
      }
      asm volatile("" : "+v"(g1), "+v"(acc0), "+v"(acc1));
      {
        const f32x32 d1 = __builtin_amdgcn_cvt_scalef32_pk32_f32_fp6(g1, 1.0f);
#pragma unroll
        for (int j = 0; j < 32; j += 2) { acc0 += d1[j] * t[32 + j]; acc1 += d1[j + 1] * t[32 + j + 1]; }
      }
      chain = acc0 + acc1;
      float acc = row16_sum(chain) * sus[w * 128 + k];
      const float co = 0.5f * acc * (1.f + erff(acc * 0.70710678118654752f)) * gsv[w * 128 + k];
      if (sub == 0) coefs[w * 128 + k] = co;
    }
    {
      const int tokn = tok + gridDim.x * 4;
      if (tokn < NT) { pe0 = IDX[(size_t)tokn * 128 + lane]; pe1 = IDX[(size_t)tokn * 128 + 64 + lane]; pg0 = GATE[(size_t)tokn * 128 + lane]; pg1 = GATE[(size_t)tokn * 128 + 64 + lane]; }
    }
    f32x32 ov;
#pragma unroll
    for (int i = 0; i < 32; ++i) ov[i] = 0.f;
#pragma unroll 1
    for (int k = 0; k < 128; k += 16) {
      uint2 ra[8], rb[8], rc[8]; float c[8];
#pragma unroll
      for (int j = 0; j < 8; ++j) {
        const int kk = k + 2 * j + half;
        const int e = idxs[w * 128 + kk];
        c[j] = coefs[w * 128 + kk];
        const uint2* rp = (const uint2*)(V6 + (size_t)e * 768 + l31 * 24);
        ra[j] = rp[0]; rb[j] = rp[1]; rc[j] = rp[2];
      }
#pragma unroll
      for (int j = 0; j < 8; ++j) {
        u32x6 g;
        g[0] = ra[j].x; g[1] = ra[j].y; g[2] = rb[j].x; g[3] = rb[j].y; g[4] = rc[j].x; g[5] = rc[j].y;
        asm volatile("" : "+v"(g), "+v"(ov));
        const f32x32 d = __builtin_amdgcn_cvt_scalef32_pk32_f32_fp6(g, 1.0f);
        ov += d * c[j];
      }
    }
    float o[16];
#pragma unroll
    for (int i = 0; i < 16; ++i) {
      const float lo = ov[i] + __shfl_xor(ov[i], 32);
      const float hi = ov[16 + i] + __shfl_xor(ov[16 + i], 32);
      o[i] = half ? hi : lo;
    }
    const int col0 = 32 * l31 + 16 * half;
    const float* gate = MOD + (size_t)(layer * 5 + cidx(tok)) * 6144 + 5 * 1024;
    float xr[16];
    float ss = 0.f;
#pragma unroll
    for (int i = 0; i < 4; ++i) {
      const int col = col0 + 4 * i;
      const float4 xv = *(const float4*)(X + (size_t)tok * 1024 + col);
      const float4 gt = *(const float4*)(gate + col);
      xr[4 * i] = xv.x + gt.x * o[4 * i]; xr[4 * i + 1] = xv.y + gt.y * o[4 * i + 1];
      xr[4 * i + 2] = xv.z + gt.z * o[4 * i + 2]; xr[4 * i + 3] = xv.w + gt.w * o[4 * i + 3];
      ss += xr[4 * i] * xr[4 * i] + xr[4 * i + 1] * xr[4 * i + 1] + xr[4 * i + 2] * xr[4 * i + 2] + xr[4 * i + 3] * xr[4 * i + 3];
    }
    ss = wave_sum(ss);
    const float sc = rsqrtf(ss * (1.f / 1024.f) + 1e-6f);
    if (layer == 0) {
      const float* g1 = p.norm_mix_g + 1024;
      const float* md = MOD + (size_t)(5 + cidx(tok)) * 6144;
      unsigned pk[8];
#pragma unroll
      for (int i = 0; i < 4; ++i) {
        const int col = col0 + 4 * i;
        *(float4*)(X + (size_t)tok * 1024 + col) = make_float4(xr[4 * i], xr[4 * i + 1], xr[4 * i + 2], xr[4 * i + 3]);
        const float4 gg = *(const float4*)(g1 + col);
        const float4 sh = *(const float4*)(md + col);
        const float4 sl = *(const float4*)(md + 1024 + col);
        pk[2 * i] = pack2(xr[4 * i] * sc * gg.x * (1.f + sl.x) + sh.x, xr[4 * i + 1] * sc * gg.y * (1.f + sl.y) + sh.y);
        pk[2 * i + 1] = pack2(xr[4 * i + 2] * sc * gg.z * (1.f + sl.z) + sh.z, xr[4 * i + 3] * sc * gg.w * (1.f + sl.w) + sh.w);
      }
      bf16_t* An = (bf16_t*)(p.ws + OFF_YF) + tiled(tok, col0, 16);
      *(uint4*)(An) = make_uint4(pk[0], pk[1], pk[2], pk[3]);
      *(uint4*)(An + 8) = make_uint4(pk[4], pk[5], pk[6], pk[7]);
    } else {
#pragma unroll
      for (int i = 0; i < 4; ++i) {
        const int col = col0 + 4 * i;
        const float4 gg = *(const float4*)(p.norm_f_g + col);
        *(float4*)(X + (size_t)tok * 1024 + col) = make_float4(xr[4 * i] * sc * gg.x, xr[4 * i + 1] * sc * gg.y, xr[4 * i + 2] * sc * gg.z, xr[4 * i + 3] * sc * gg.w);
      }
    }
  }
}

__device__ __forceinline__ void ssd_conv_phase(const Params& p) {
  const int otid = opaque_tid();
  bf16_t* BIG = (bf16_t*)(p.ws + OFF_BIG);
  const float* cw = p.ssd_conv_w;
  const float* cb = p.ssd_conv_b;
  const int total = 272 * 512;
  for (int it = blockIdx.x * 256 + otid; it < total; it += gridDim.x * 256) {
    const int c8 = it & 511, r = it >> 9;
    const int c = c8 * 8;
    int tok0, len;
    if (r < 16) { tok0 = r * 256; len = 256; } else { tok0 = NCTX + (r - 16) * 64; len = 64; }
    float w0[8], w1[8], w2[8], bb[8];
#pragma unroll
    for (int j = 0; j < 8; ++j) { w0[j] = cw[c + j]; w1[j] = cw[4096 + c + j]; w2[j] = cw[8192 + c + j]; bb[j] = cb[c + j]; }
    bf16_t* base = BIG + (size_t)tok0 * 6144 + 2048 + c;
    uint4 buf[8], nxt[8];
#pragma unroll
    for (int j = 0; j < 8; ++j) buf[j] = *(const uint4*)(base + (size_t)j * 6144);
    uint4 prev = make_uint4(0, 0, 0, 0);
    for (int t0 = 0; t0 < len; t0 += 8) {
      const bool more = (t0 + 8) < len;
#pragma unroll
      for (int j = 0; j < 8; ++j) nxt[j] = more ? *(const uint4*)(base + (size_t)(t0 + 8 + j) * 6144) : make_uint4(0, 0, 0, 0);
#pragma unroll
      for (int j = 0; j < 8; ++j) {
        const uint4 cur = buf[j];
        const uint4 nx = (j < 7) ? buf[j + 1] : nxt[0];
        const unsigned* pp = (const unsigned*)&prev; const unsigned* cp = (const unsigned*)&cur; const unsigned* np = (const unsigned*)&nx;
        unsigned o[4];
#pragma unroll
        for (int q = 0; q < 4; ++q) {
          float a0 = w0[2 * q] * lo2f(pp[q]) + w1[2 * q] * lo2f(cp[q]) + w2[2 * q] * lo2f(np[q]) + bb[2 * q];
          float a1 = w0[2 * q + 1] * hi2f(pp[q]) + w1[2 * q + 1] * hi2f(cp[q]) + w2[2 * q + 1] * hi2f(np[q]) + bb[2 * q + 1];
          o[q] = pack2(siluf(a0), siluf(a1));
        }
        *(uint4*)(base + (size_t)(t0 + j) * 6144) = make_uint4(o[0], o[1], o[2], o[3]);
        prev = cur;
      }
#pragma unroll
      for (int j = 0; j < 8; ++j) buf[j] = nxt[j];
    }
  }
}

#define XT_STR 72
#define HB_STR 136
#define SCAN_LOAD_FRAGS(CC) { \
      { const int t_ = (CC) * 64 + 32 * it + l31; const int tok_ = tok0 + (dir ? L - 1 - t_ : t_); \
        const bf16_t* cp_ = BIG + (size_t)tok_ * 6144 + 5120 + g * 128 + 8 * h5; \
        _Pragma("unroll") for (int kk = 0; kk < 8; ++kk) cfr[kk] = *(const bf16x8*)(cp_ + 16 * kk); } \
      if (jt <= it) { const int t_ = (CC) * 64 + 32 * jt + l31; const int tok_ = tok0 + (dir ? L - 1 - t_ : t_); \
        const bf16_t* bp_ = BIG + (size_t)tok_ * 6144 + 4096 + g * 128 + 8 * h5; \
        _Pragma("unroll") for (int kk = 0; kk < 8; ++kk) bfr[kk] = *(const bf16x8*)(bp_ + 16 * kk); } }
#define SCAN_LOAD_STAGE(CC) { \
      const int t_ = (CC) * 64 + lane; const int tok_ = tok0 + (dir ? L - 1 - t_ : t_); \
      const bf16_t* rowp_ = BIG + (size_t)tok_ * 6144; \
      _Pragma("unroll") for (int r = 0; r < 2; ++r) sx[r] = *(const uint4*)(rowp_ + 2048 + head * 64 + (w + 4 * r) * 8); \
      _Pragma("unroll") for (int r = 0; r < 4; ++r) sb[r] = *(const uint4*)(rowp_ + 4096 + g * 128 + (w + 4 * r) * 8); \
      sdt = DT[(size_t)tok_ * 64 + dir * 32 + head]; }
__device__ __forceinline__ void scan_phase(const Params& p, char* smem) {
  const int otid = opaque_tid();
  bf16_t* XTd = (bf16_t*)smem;
  bf16_t* BTs = XTd + 64 * XT_STR;
  bf16_t* Ms = BTs + 128 * XT_STR;
  bf16_t* Hb = Ms + 64 * XT_STR;
  float* cumS = (float*)(Hb + 2 * 64 * HB_STR);
  const bf16_t* BIG = (const bf16_t*)(p.ws + OFF_BIG);
  const float* DT = (const float*)(p.ws + OFF_DT);
  const int tid = otid, lane = tid & 63;
  const int w = __builtin_amdgcn_readfirstlane(tid >> 6);
  const int h5 = lane >> 5, l31 = lane & 31;
  const int it = w >> 1, jt = w & 1, pt = w & 1, nt0 = (w >> 1) * 2;
  int item0, istride;
  if (gridDim.x >= 512) { if (blockIdx.x < 256) { item0 = blockIdx.x; istride = 1 << 28; } else { item0 = blockIdx.x; istride = gridDim.x - 256; } }
  else { item0 = blockIdx.x; istride = gridDim.x; }
  for (int item = item0; item < 1280; item += istride) {
    int b, head, dir, L, tok0;
    const bool latent = item < 256;
    if (latent) { b = item >> 6; head = (item >> 1) & 31; dir = item & 1; L = 4096; tok0 = NCTX + b * 4096; }
    else { int jj = item - 256; b = jj >> 6; head = (jj >> 1) & 31; dir = jj & 1; L = 256; tok0 = b * 256; }
    const int g = head >> 2;
    const float a = -expf(p.ssd_a_log[dir * 32 + head]);
    bf16_t* Y = (bf16_t*)(p.ws + (dir ? OFF_YB : OFF_YF));
    f32x16 st[2];
    const size_t sbase = ((size_t)((b * 2 + dir) * 32 + head)) * 8192;
    const int loff = (32 * pt + l31) * 128 + 32 * nt0 + 4 * h5;
    if (latent) {
      const float* sp = p.state_ssm + sbase + loff;
#pragma unroll
      for (int q = 0; q < 2; ++q)
#pragma unroll
        for (int qq = 0; qq < 4; ++qq) {
          const float4 v = *(const float4*)(sp + 32 * q + 8 * qq);
          st[q][4 * qq] = v.x; st[q][4 * qq + 1] = v.y; st[q][4 * qq + 2] = v.z; st[q][4 * qq + 3] = v.w;
        }
    } else {
#pragma unroll
      for (int q = 0; q < 2; ++q)
#pragma unroll
        for (int r = 0; r < 16; ++r) st[q][r] = 0.f;
    }
    {
      bf16_t* hb0 = Hb + (32 * pt + l31) * HB_STR + 32 * nt0 + 4 * h5;
#pragma unroll
      for (int q = 0; q < 2; ++q)
#pragma unroll
        for (int qq = 0; qq < 4; ++qq) {
          uint2 o; o.x = pack2(st[q][4 * qq], st[q][4 * qq + 1]); o.y = pack2(st[q][4 * qq + 2], st[q][4 * qq + 3]);
          *(uint2*)(hb0 + 32 * q + 8 * qq) = o;
        }
    }
    __syncthreads();
    const int nchunks = L >> 6;
    uint4 sx[2], sb[4];
    float sdt;
    SCAN_LOAD_STAGE(0)
    bf16x8 cfr[8], bfr[8];
    SCAN_LOAD_FRAGS(0)
#pragma nounroll
    for (int c = 0; c < nchunks; ++c) {
      const int cur = c & 1;
      __builtin_amdgcn_sched_barrier(0);
      float cum = sdt * a;
      cum += dpp_f<0x111>(cum);
      cum += dpp_f<0x112>(cum);
      cum += dpp_f<0x114>(cum);
      cum += dpp_f<0x118>(cum);
      {
        const float r0 = __int_as_float(__builtin_amdgcn_readlane(__float_as_int(cum), 15));
        const float r1 = __int_as_float(__builtin_amdgcn_readlane(__float_as_int(cum), 31));
        const float r2 = __int_as_float(__builtin_amdgcn_readlane(__float_as_int(cum), 47));
        const int rw = lane >> 4;
        cum += (rw == 0) ? 0.f : ((rw == 1) ? r0 : ((rw == 2) ? r0 + r1 : r0 + r1 + r2));
      }
      const float cum_last = __int_as_float(__builtin_amdgcn_readlane(__float_as_int(cum), 63));
      const float wj = __expf(cum_last - cum);
      if (w == 0) cumS[cur * 64 + lane] = cum;
#pragma unroll
      for (int r = 0; r < 2; ++r) {
        const int p8 = (w + 4 * r) * 8;
#pragma unroll
        for (int q = 0; q < 4; ++q) {
          const unsigned u = u4get(sx[r], q);
          XTd[(p8 + 2 * q) * XT_STR + lane] = f2bf(sdt * lo2f(u));
          XTd[(p8 + 2 * q + 1) * XT_STR + lane] = f2bf(sdt * hi2f(u));
        }
      }
#pragma unroll
      for (int r = 0; r < 4; ++r) {
        const int n8 = (w + 4 * r) * 8;
#pragma unroll
        for (int q = 0; q < 4; ++q) {
          const unsigned u = u4get(sb[r], q);
          BTs[(n8 + 2 * q) * XT_STR + lane] = f2bf(wj * lo2f(u));
          BTs[(n8 + 2 * q + 1) * XT_STR + lane] = f2bf(wj * hi2f(u));
        }
      }
      if (c + 1 < nchunks) SCAN_LOAD_STAGE(c + 1)
      __builtin_amdgcn_sched_barrier(0);
      f32x16 cb;
#pragma unroll
      for (int r = 0; r < 16; ++r) cb[r] = 0.f;
      if (jt <= it) {
#pragma unroll
        for (int kk = 0; kk < 8; ++kk) cb = __builtin_amdgcn_mfma_f32_32x32x16_bf16(bfr[kk], cfr[kk], cb, 0, 0, 0);
      }
      __builtin_amdgcn_sched_barrier(0);
      f32x16 yo;
#pragma unroll
      for (int r = 0; r < 16; ++r) yo[r] = 0.f;
      {
        const bf16_t* hp = Hb + cur * 64 * HB_STR + (32 * pt + l31) * HB_STR + 8 * h5;
#pragma unroll
        for (int kk = 0; kk < 8; ++kk) {
          const bf16x8 hf = *(const bf16x8*)(hp + 16 * kk);
          yo = __builtin_amdgcn_mfma_f32_32x32x16_bf16(hf, cfr[kk], yo, 0, 0, 0);
        }
      }
      __builtin_amdgcn_sched_barrier(0);
      if (c + 1 < nchunks) SCAN_LOAD_FRAGS(c + 1)
      __syncthreads();
      __builtin_amdgcn_sched_barrier(0);
      const float dec = __expf(cum_last);
      bf16x8 xf[4];
#pragma unroll
      for (int kk = 0; kk < 4; ++kk) xf[kk] = *(const bf16x8*)(XTd + (32 * pt + l31) * XT_STR + 16 * kk + 8 * h5);
#pragma unroll
      for (int q = 0; q < 2; ++q) {
#pragma unroll
        for (int r = 0; r < 16; ++r) st[q][r] *= dec;
#pragma unroll
        for (int kk = 0; kk < 4; ++kk) {
          const bf16x8 bt = *(const bf16x8*)(BTs + (32 * (nt0 + q) + l31) * XT_STR + 16 * kk + 8 * h5);
          st[q] = __builtin_amdgcn_mfma_f32_32x32x16_bf16(bt, xf[kk], st[q], 0, 0, 0);
        }
        {
          bf16_t* hbw = Hb + (cur ^ 1) * 64 * HB_STR + (32 * pt + l31) * HB_STR + 32 * (nt0 + q) + 4 * h5;
#pragma unroll
          for (int qq = 0; qq < 4; ++qq) {
            uint2 o; o.x = pack2(st[q][4 * qq], st[q][4 * qq + 1]); o.y = pack2(st[q][4 * qq + 2], st[q][4 * qq + 3]);
            *(uint2*)(hbw + 8 * qq) = o;
          }
        }
      }
      __builtin_amdgcn_sched_barrier(0);
      if (jt <= it) {
        const int ii = 32 * it + l31;
        const float ci = cumS[cur * 64 + ii];
        const int jb = 32 * jt + 4 * h5;
        const float* cs = cumS + cur * 64 + jb;
        bf16_t* mw = Ms + ii * XT_STR + jb;
#pragma unroll
        for (int qq = 0; qq < 4; ++qq) {
          const float4 cj = *(const float4*)(cs + 8 * qq);
          const int j0 = jb + 8 * qq;
          const float m0 = (j0 <= ii) ? cb[4 * qq] * __expf(ci - cj.x) : 0.f;
          const float m1 = (j0 + 1 <= ii) ? cb[4 * qq + 1] * __expf(ci - cj.y) : 0.f;
          const float m2 = (j0 + 2 <= ii) ? cb[4 * qq + 2] * __expf(ci - cj.z) : 0.f;
          const float m3 = (j0 + 3 <= ii) ? cb[4 * qq + 3] * __expf(ci - cj.w) : 0.f;
          uint2 o; o.x = pack2(m0, m1); o.y = pack2(m2, m3);
          *(uint2*)(mw + 8 * qq) = o;
        }
      }
      __syncthreads();
      __builtin_amdgcn_sched_barrier(0);
      f32x16 yd;
#pragma unroll
      for (int r = 0; r < 16; ++r) yd[r] = 0.f;
#pragma unroll
      for (int kk = 0; kk < 4; ++kk) {
        if (kk < 2 * (it + 1)) {
          const bf16x8 mf = *(const bf16x8*)(Ms + (32 * it + l31) * XT_STR + 16 * kk + 8 * h5);
          yd = __builtin_amdgcn_mfma_f32_32x32x16_bf16(xf[kk], mf, yd, 0, 0, 0);
        }
      }
      {
        const int ti = c * 64 + 32 * it + l31;
        const int tok = tok0 + (dir ? L - 1 - ti : ti);
        const float ei = __expf(cumS[cur * 64 + 32 * it + l31]);
        bf16_t* yp = Y + ((size_t)(tok >> 7) * 32 + head) * 8192 + (tok & 127) * 64 + 32 * pt + 4 * h5;
#pragma unroll
        for (int qq = 0; qq < 4; ++qq) {
          uint2 o;
          o.x = pack2(yd[4 * qq] + ei * yo[4 * qq], yd[4 * qq + 1] + ei * yo[4 * qq + 1]);
          o.y = pack2(yd[4 * qq + 2] + ei * yo[4 * qq + 2], yd[4 * qq + 3] + ei * yo[4 * qq + 3]);
          *(uint2*)(yp + 8 * qq) = o;
        }
      }
    }
    if (!latent) {
      float* sp = p.out + (size_t)NT * 1024 + sbase + loff;
#pragma unroll
      for (int q = 0; q < 2; ++q)
#pragma unroll
        for (int qq = 0; qq < 4; ++qq)
          *(float4*)(sp + 32 * q + 8 * qq) = make_float4(st[q][4 * qq], st[q][4 * qq + 1], st[q][4 * qq + 2], st[q][4 * qq + 3]);
    }
    __syncthreads();
  }
}

__device__ __forceinline__ void gate_norm_phase(const Params& p) {
  const int otid = opaque_tid();
  const bf16_t* BIG = (const bf16_t*)(p.ws + OFF_BIG);
  bf16_t* YF = (bf16_t*)(p.ws + OFF_YF);
  const bf16_t* YB = (const bf16_t*)(p.ws + OFF_YB);
  const int lane = otid & 63, w = otid >> 6;
  for (int tok = blockIdx.x * 4 + w; tok < NT; tok += gridDim.x * 4) {
    float v[32];
    float ss = 0.f;
#pragma unroll
    for (int i = 0; i < 4; ++i) {
      const int col = lane * 8 + 512 * i;
      const int head = col >> 6;
      const float dtot = p.ssd_d[head] + p.ssd_d[32 + head];
      uint4 a = *(const uint4*)(YF + tiled(tok, col, 32));
      uint4 b = *(const uint4*)(YB + tiled(tok, col, 32));
      uint4 x = *(const uint4*)(BIG + (size_t)tok * 6144 + 2048 + col);
      uint4 z = *(const uint4*)(BIG + (size_t)tok * 6144 + col);
#pragma unroll
      for (int q = 0; q < 4; ++q) {
        const unsigned aq = u4get(a, q), bq = u4get(b, q), xq = u4get(x, q), zq = u4get(z, q);
        float y0 = lo2f(aq) + lo2f(bq) + dtot * lo2f(xq);
        float y1 = hi2f(aq) + hi2f(bq) + dtot * hi2f(xq);
        y0 *= siluf(lo2f(zq));
        y1 *= siluf(hi2f(zq));
        v[8 * i + 2 * q] = y0; v[8 * i + 2 * q + 1] = y1;
        ss += y0 * y0 + y1 * y1;
      }
      __builtin_amdgcn_sched_barrier(0);
    }
    ss = wave_sum(ss);
    const float sc = rsqrtf(ss * (1.f / 2048.f) + 1e-6f);
#pragma unroll
    for (int i = 0; i < 4; ++i) {
      const int col = lane * 8 + 512 * i;
      float4 g0 = *(const float4*)(p.ssd_norm_g + col), g1 = *(const float4*)(p.ssd_norm_g + col + 4);
      uint4 o;
      o.x = pack2(v[8 * i] * sc * g0.x, v[8 * i + 1] * sc * g0.y);
      o.y = pack2(v[8 * i + 2] * sc * g0.z, v[8 * i + 3] * sc * g0.w);
      o.z = pack2(v[8 * i + 4] * sc * g1.x, v[8 * i + 5] * sc * g1.y);
      o.w = pack2(v[8 * i + 6] * sc * g1.z, v[8 * i + 7] * sc * g1.w);
      *(uint4*)(YF + tiled(tok, col, 32)) = o;
    }
  }
}

__device__ __forceinline__ void final_norm_phase(const Params& p) {
  const int otid = opaque_tid();
  const int lane = otid & 63, w = otid >> 6;
  for (int tok = blockIdx.x * 4 + w; tok < NT; tok += gridDim.x * 4) {
    float* xr = p.out + (size_t)tok * 1024;
    float4 v[4];
    float ss = 0.f;
#pragma unroll
    for (int i = 0; i < 4; ++i) {
      v[i] = *(const float4*)(xr + lane * 4 + 256 * i);
      ss += v[i].x * v[i].x + v[i].y * v[i].y + v[i].z * v[i].z + v[i].w * v[i].w;
    }
    ss = wave_sum(ss);
    const float sc = rsqrtf(ss * (1.f / 1024.f) + 1e-6f);
#pragma unroll
    for (int i = 0; i < 4; ++i) {
      const int col = lane * 4 + 256 * i;
      float4 gg = *(const float4*)(p.norm_f_g + col);
      *(float4*)(xr + col) = make_float4(v[i].x * sc * gg.x, v[i].y * sc * gg.y, v[i].z * sc * gg.z, v[i].w * sc * gg.w);
    }
  }
}


#define XB_TMO      128
#define XB_XCNT(j)  (256  + 64 * (j))
#define XB_XSUB(j)  (1280 + 64 * (j))
#define XB_XGEN(j)  (2304 + 64 * (j))
#define XB_TOP      3328
#define XB_TOPGEN   3392
#define XCD_BAR_WORDS 3456
#define XB_SPIN_CAP (1u << 22)
#define LAS __attribute__((address_space(3)))
__device__ __forceinline__ unsigned xb_ld(unsigned* p) { return __hip_atomic_load(p, __ATOMIC_RELAXED, __HIP_MEMORY_SCOPE_AGENT); }
__device__ __forceinline__ unsigned xb_add(unsigned* p, unsigned v) { return __hip_atomic_fetch_add(p, v, __ATOMIC_RELAXED, __HIP_MEMORY_SCOPE_AGENT); }
__device__ __forceinline__ unsigned xb_xcc_id() { return (unsigned)__builtin_amdgcn_s_getreg((3 << 11) | 20) & 0xFu; }
#define XB_SPIN(cond, bar) do { unsigned _sp = 0; while (cond) { __builtin_amdgcn_s_sleep(1); \
    if ((++_sp & 255u) == 0u) { if (xb_ld(&(bar)[XB_TMO])) break; if (_sp > XB_SPIN_CAP) { atomicAdd(&(bar)[XB_TMO], 1u); break; } } } } while (0)
struct XcdBarrier { unsigned* bar; unsigned x; volatile LAS unsigned* st; };
__device__ __forceinline__ XcdBarrier xcd_barrier_post(unsigned* bar, volatile LAS unsigned* st) {
  XcdBarrier b; b.bar = bar; b.x = xb_xcc_id(); b.st = st;
  if (threadIdx.x == 0) (void)xb_add(&bar[XB_XCNT(b.x)], 1u);
  return b;
}
__device__ __forceinline__ void xcd_barrier_complete(unsigned* bar, unsigned x, unsigned& nloc, unsigned& nx) {
  const unsigned G = gridDim.x * gridDim.y * gridDim.z;
  unsigned sum, cnt, mine, sp = 0u;
  for (;;) {
    sum = 0u; cnt = 0u; mine = 0u;
#pragma unroll
    for (unsigned j = 0; j < 16; ++j) { const unsigned c = xb_ld(&bar[XB_XCNT(j)]); sum += c; cnt += (c > 0u) ? 1u : 0u; mine = (j == x) ? c : mine; }
    if (sum == G) break;
    __builtin_amdgcn_s_sleep(1);
    if ((++sp & 255u) == 0u) { if (xb_ld(&bar[XB_TMO])) break; if (sp > XB_SPIN_CAP) { atomicAdd(&bar[XB_TMO], 1u); break; } }
  }
  nloc = mine > 0u ? mine : 1u; nx = cnt > 0u ? cnt : 1u;
}
__device__ __forceinline__ void xcd_barrier(const XcdBarrier& b) {
  asm volatile("s_waitcnt vmcnt(0)" ::: "memory");
  __syncthreads();
  if (threadIdx.x == 0) {
    unsigned* bar = b.bar;
    __builtin_amdgcn_s_waitcnt(0);
    unsigned nloc = b.st[0], nx = b.st[1];
    if (nloc == 0u) { xcd_barrier_complete(bar, b.x, nloc, nx); b.st[0] = nloc; b.st[1] = nx; }
    const unsigned old = xb_add(&bar[XB_XSUB(b.x)], 1u);
    const unsigned gen = old / nloc;
    if (old + 1u == (gen + 1u) * nloc) {
      __builtin_amdgcn_fence(__ATOMIC_RELEASE, "agent");
      asm volatile("s_waitcnt vmcnt(0)" ::: "memory");
      const unsigned og = xb_add(&bar[XB_TOP], 1u);
      const unsigned tg = og / nx;
      if (og + 1u == (tg + 1u) * nx) xb_add(&bar[XB_TOPGEN], 1u);
      else XB_SPIN(xb_ld(&bar[XB_TOPGEN]) == tg, bar);
      __builtin_amdgcn_fence(__ATOMIC_ACQUIRE, "agent");
      xb_add(&bar[XB_XGEN(b.x)], 1u);
      asm volatile("s_waitcnt vmcnt(0)" ::: "memory");
    } else {
      XB_SPIN(xb_ld(&bar[XB_XGEN(b.x)]) == gen, bar);
      __builtin_amdgcn_fence(__ATOMIC_ACQUIRE, "agent");
      asm volatile("s_waitcnt vmcnt(0)" ::: "memory");
    }
  }
  __syncthreads();
}

#define N_PHASES 19
__global__ void __launch_bounds__(256, 2) mk(Params p, int ph_begin, int ph_end) {
  __shared__ __attribute__((aligned(16))) char smem[SMEM_BYTES];
  __shared__ uint4 xb_words;
  const bool multi = (ph_end - ph_begin) > 1;
  if (threadIdx.x == 0) xb_words = make_uint4(0u, 0u, 0u, 0u);
  __syncthreads();
  XcdBarrier xb;
  xb.bar = (unsigned*)(p.ws + OFF_BAR); xb.x = 0; xb.st = (volatile LAS unsigned*)&xb_words;
  if (multi) xb = xcd_barrier_post((unsigned*)(p.ws + OFF_BAR), (volatile LAS unsigned*)&xb_words);
  if (ph_begin < 0) cg::this_grid().sync();
  bf16_t* WT = (bf16_t*)(p.ws + OFF_WT);
  bf16_t* BIG = (bf16_t*)(p.ws + OFF_BIG);
  bf16_t* Abuf = (bf16_t*)(p.ws + OFF_YF);
  float* MOD = (float*)(p.ws + OFF_MOD);
#define RUN(PH, CALL) if (ph_begin <= PH && PH < ph_end) { CALL; if (PH + 1 < ph_end) xcd_barrier(xb); }
  RUN(0, prep_phase(p, smem))
  RUN(1, norm_mod_phase(p, 0, 0, true))
  RUN(2, gemm_phase(Abuf, WT + WT_SCIN, NT, 3072, 1024, EpiBf16{BIG, 3072}, smem))
  RUN(3, conv_gate_phase(p))
  RUN(4, gemm_phase((const bf16_t*)(p.ws + OFF_BIG + 120 * MIB), WT + WT_SCOUT, NT, 1024, 1024,
                    EpiRes{p.x_prompt, p.x_sample, p.out, MOD + 0 * 5 * 6144 + 2 * 1024}, smem))
  RUN(5, norm_mod_phase(p, 0, 1, false))
  RUN(6, gemm_phase(Abuf, WT + WT_WQ, NT, 2048, 1024, EpiBf16{BIG, 2048}, smem))
  RUN(7, topk_phase(p, 0, smem))
  RUN(8, peer_phase(p, 0, smem))
  RUN(10, gemm_phase(Abuf, WT + WT_SSDIN, NT, 6208, 1024, EpiSsdIn{BIG, (float*)(p.ws + OFF_DT), p.ssd_dt_bias}, smem))
  RUN(11, ssd_conv_phase(p))
  RUN(12, scan_phase(p, smem))
  RUN(13, gate_norm_phase(p))
  RUN(14, gemm_phase(Abuf, WT + WT_SSDOUT, NT, 1024, 2048,
                     EpiRes{p.out, p.out + (size_t)NCTX * 1024, p.out, MOD + 1 * 5 * 6144 + 2 * 1024}, smem))
  RUN(15, norm_mod_phase(p, 1, 1, false))
  RUN(16, gemm_phase(Abuf, WT + WT_WQ + (size_t)2048 * 1024, NT, 2048, 1024, EpiBf16{BIG, 2048}, smem))
  RUN(17, topk_phase(p, 1, smem))
  RUN(18, peer_phase(p, 1, smem))
}

extern "C" void kernel_launch(void* const* d_in, const int* in_sizes, int n_in, void* d_out, int out_size, void* d_ws, size_t ws_size,
                              hipStream_t stream) {
  static int grid_blocks = 0;
  if (!grid_blocks) {
    int dev = 0, cus = 0, per_cu = 0;
    hipGetDevice(&dev);
    hipDeviceGetAttribute(&cus, hipDeviceAttributeMultiprocessorCount, dev);
    hipOccupancyMaxActiveBlocksPerMultiprocessor(&per_cu, mk, 256, 0);
    if (per_cu < 1) per_cu = 1;
    if (per_cu > 2) per_cu = 2;
    grid_blocks = cus * per_cu;
  }
  if (ws_size < WS_NEEDED) { fprintf(stderr, "workspace too small: %zu\n", ws_size); return; }
  Params p{};
  const float** pf = (const float**)&p;
  for (int i = 0; i < 25; ++i) pf[i] = (const float*)d_in[i];
  p.out = (float*)d_out;
  p.ws = (char*)d_ws;
#if COOP
  hipMemsetAsync((char*)d_ws + OFF_BAR, 0, 16384, stream);
  int b = 0, e = N_PHASES;
  void* args[] = {&p, &b, &e};
  hipError_t err = hipLaunchCooperativeKernel((void*)mk, dim3(grid_blocks), dim3(256), args, 0, stream);
  if (err != hipSuccess) fprintf(stderr, "cooperative launch failed: %s (grid %d)\n", hipGetErrorString(err), grid_blocks);
#else
  for (int ph = 0; ph < N_PHASES; ++ph) {
    hipLaunchKernelGGL(mk, dim3(grid_blocks), dim3(256), 0, stream, p, ph, ph + 1);
    if ((DUP_MASK >> ph) & 1) hipLaunchKernelGGL(mk, dim3(grid_blocks), dim3(256), 0, stream, p, ph, ph + 1);
  }
#endif
}
```
